# Optimizing an MI355X kernel written in HIP

```python
import math
import jax, jax.numpy as jnp
from jax import lax
import numpy as np

D_MODEL = 1024
BATCH = 8
SEQ = 4096
DEPTH = 2

N_MEM = 256
MEM_HEADS = 4
MEM_WIDTH = D_MODEL // 4
MEM_HEAD_DIM = MEM_WIDTH // MEM_HEADS
MIX_WIDTH = D_MODEL - MEM_WIDTH
BRANCH_WIDTH = D_MODEL
EPS = 1e-6

QK_NOPE_DIM = 128
QK_ROPE_DIM = 64
V_HEAD_DIM = 128
MLA_HEADS = MIX_WIDTH // V_HEAD_DIM
Q_LORA_RANK = 384
KV_LORA_RANK = 256
ROPE_THETA = 10000.0
Q_BLOCK = 128

MLSTM_HEADS = 4
MLSTM_V_DIM = MIX_WIDTH // MLSTM_HEADS
MLSTM_QK_DIM = MLSTM_V_DIM // 2
CONV_WIDTH = 4
CHUNK = 64

N_LAYERS_A = (DEPTH + 1) // 2
N_LAYERS_B = DEPTH // 2
A_IN_SIZES = [Q_LORA_RANK, KV_LORA_RANK, QK_ROPE_DIM, MEM_WIDTH, BRANCH_WIDTH]
B_IN_SIZES = [MIX_WIDTH, 2 * MLSTM_HEADS, MIX_WIDTH, MEM_WIDTH, BRANCH_WIDTH]
A_IN_COLS = sum(A_IN_SIZES)
B_IN_COLS = sum(B_IN_SIZES)

kernel_name = 'hybrid_mla_mlstm_memory_trunk'


def rms_norm(x, g):
    xf = x.astype(jnp.float32)
    y = xf * lax.rsqrt(jnp.mean(xf * xf, axis=-1, keepdims=True) + EPS)
    return (y * g.astype(jnp.float32)).astype(x.dtype)


def split_cols(t, sizes):
    offs = np.cumsum(sizes)[:-1].tolist()
    return jnp.split(t, offs, axis=-1)


def rope_tables(positions):
    inv_freq = ROPE_THETA ** (-jnp.arange(0, QK_ROPE_DIM, 2, dtype=jnp.float32) / QK_ROPE_DIM)
    ang = positions.astype(jnp.float32)[..., None] * inv_freq
    return jnp.cos(ang), jnp.sin(ang)


def apply_rope(x, cos, sin):
    x1, x2 = jnp.split(x, 2, axis=-1)
    c = cos.astype(x.dtype)
    s = sin.astype(x.dtype)
    return jnp.concatenate([x1 * c - x2 * s, x1 * s + x2 * c], axis=-1)


def causal_block_attention(q, k, v, scale):
    B, S, H, Dqk = q.shape
    nb = S // Q_BLOCK
    qb = jnp.moveaxis(q.reshape(B, nb, Q_BLOCK, H, Dqk), 1, 0)
    kpos = jnp.arange(S)

    def one_block(args):
        qi, blk = args
        s = jnp.einsum('bqhd,bkhd->bhqk', qi, k).astype(jnp.float32) * scale
        qpos = blk * Q_BLOCK + jnp.arange(Q_BLOCK)
        s = jnp.where(kpos[None, :] <= qpos[:, None], s, -jnp.inf)
        p = jax.nn.softmax(s, axis=-1).astype(v.dtype)
        return jnp.einsum('bhqk,bkhd->bqhd', p, v)

    out = lax.map(one_block, (qb, jnp.arange(nb)))
    return jnp.moveaxis(out, 0, 1).reshape(B, S, H, v.shape[-1])


def memory_attention(q_mem, mem, mem_g, w_mem_kv):
    B, S, _ = q_mem.shape
    kv = rms_norm(mem, mem_g) @ w_mem_kv
    k, v = jnp.split(kv, 2, axis=-1)
    q = q_mem.reshape(B, S, MEM_HEADS, MEM_HEAD_DIM)
    k = k.reshape(B, N_MEM, MEM_HEADS, MEM_HEAD_DIM)
    v = v.reshape(B, N_MEM, MEM_HEADS, MEM_HEAD_DIM)
    s = jnp.einsum('bshd,bmhd->bhsm', q, k).astype(jnp.float32) * (MEM_HEAD_DIM ** -0.5)
    p = jax.nn.softmax(s, axis=-1).astype(v.dtype)
    o = jnp.einsum('bhsm,bmhd->bshd', p, v)
    return o.reshape(B, S, MEM_WIDTH)


def mla_mixer(c_q, c_kv, k_rope, cos, sin, q_a_g, w_uq, kv_a_g, w_ukv):
    B, S, _ = c_q.shape
    q = (rms_norm(c_q, q_a_g) @ w_uq).reshape(B, S, MLA_HEADS, QK_NOPE_DIM + QK_ROPE_DIM)
    q_nope, q_rope = split_cols(q, [QK_NOPE_DIM, QK_ROPE_DIM])
    q_rope = apply_rope(q_rope, cos[:, :, None, :], sin[:, :, None, :])
    kv = (rms_norm(c_kv, kv_a_g) @ w_ukv).reshape(B, S, MLA_HEADS, QK_NOPE_DIM + V_HEAD_DIM)
    k_nope, v = split_cols(kv, [QK_NOPE_DIM, V_HEAD_DIM])
    k_rope = apply_rope(k_rope, cos, sin)
    k = jnp.concatenate(
        [k_nope, jnp.broadcast_to(k_rope[:, :, None, :], (B, S, MLA_HEADS, QK_ROPE_DIM))], axis=-1)
    q = jnp.concatenate([q_nope, q_rope], axis=-1)
    o = causal_block_attention(q, k, v, (QK_NOPE_DIM + QK_ROPE_DIM) ** -0.5)
    return o.reshape(B, S, MIX_WIDTH)


def mlstm_chunkwise(q, k, v, i_pre, f_pre):
    B, S, H, Dk = q.shape
    Dv = v.shape[-1]
    nc = S // CHUNK

    def to_chunks(t):
        t = t.astype(jnp.float32).reshape((B, nc, CHUNK, H) + t.shape[3:])
        return jnp.moveaxis(t, (1, 3), (0, 2))

    log_i = i_pre.astype(jnp.float32)
    log_f = jax.nn.log_sigmoid(f_pre.astype(jnp.float32))
    xs = (to_chunks(q), to_chunks(k), to_chunks(v), to_chunks(log_i), to_chunks(log_f))
    causal = jnp.tril(jnp.ones((CHUNK, CHUNK), dtype=bool))

    def step(carry, xs_c):
        C, n, m = carry
        qc, kc, vc, li, lf = xs_c
        b = jnp.cumsum(lf, axis=-1)
        d = jnp.where(causal, b[..., :, None] - b[..., None, :] + li[..., None, :], -jnp.inf)
        inter = b + m[..., None]
        m_t = jnp.maximum(inter, jnp.max(d, axis=-1))
        w_intra = jnp.exp(d - m_t[..., None])
        w_inter = jnp.exp(inter - m_t)
        sqk = jnp.einsum('bhtd,bhsd->bhts', qc, kc) * w_intra
        num = (w_inter[..., None] * jnp.einsum('bhtd,bhde->bhte', qc, C)
               + jnp.einsum('bhts,bhse->bhte', sqk, vc))
        den = w_inter * jnp.einsum('bhtd,bhd->bht', qc, n) + jnp.sum(sqk, axis=-1)
        den = jnp.maximum(jnp.abs(den), jnp.exp(-m_t))
        h = num / den[..., None]
        bL = b[..., -1]
        dec = bL[..., None] - b + li
        m_new = jnp.maximum(bL + m, jnp.max(dec, axis=-1))
        a = jnp.exp(bL + m - m_new)
        ws = jnp.exp(dec - m_new[..., None])
        C_new = a[..., None, None] * C + jnp.einsum('bhs,bhsd,bhse->bhde', ws, kc, vc)
        n_new = a[..., None] * n + jnp.einsum('bhs,bhsd->bhd', ws, kc)
        return (C_new, n_new, m_new), h

    init = (jnp.zeros((B, H, Dk, Dv), jnp.float32), jnp.zeros((B, H, Dk), jnp.float32),
            jnp.zeros((B, H), jnp.float32))
    _, h = lax.scan(step, init, xs)
    return jnp.moveaxis(h, (0, 2), (1, 3)).reshape(B, S, H, Dv).astype(v.dtype)


def mlstm_mixer(u, if_pre, o_pre, gate_bias, conv_w, conv_b, w_q, w_k, w_v, head_g, skip):
    B, S, _ = u.shape
    u_pad = jnp.pad(u, ((0, 0), (CONV_WIDTH - 1, 0), (0, 0)))
    conv = conv_b + sum(u_pad[:, t:t + S, :] * conv_w[t] for t in range(CONV_WIDTH))
    uc = jax.nn.silu(conv)
    uch = uc.reshape(B, S, MLSTM_HEADS, MLSTM_V_DIM)
    uh = u.reshape(B, S, MLSTM_HEADS, MLSTM_V_DIM)
    q = jnp.einsum('bshd,hde->bshe', uch, w_q)
    k = jnp.einsum('bshd,hde->bshe', uch, w_k) * (MLSTM_QK_DIM ** -0.5)
    v = jnp.einsum('bshd,hde->bshe', uh, w_v)
    gates = if_pre + gate_bias
    i_pre, f_pre = jnp.split(gates, 2, axis=-1)
    h = mlstm_chunkwise(q, k, v, i_pre, f_pre)
    h = rms_norm(h, head_g).reshape(B, S, MIX_WIDTH)
    return jax.nn.sigmoid(o_pre) * h + skip * uc


def mla_layer(x, mem, cos, sin, pre_g, w_in, q_a_g, w_uq, kv_a_g, w_ukv, mem_g, w_mem_kv, w_out, post_g):
    h = rms_norm(x, pre_g)
    c_q, c_kv, k_rope, q_mem, gate = split_cols(h @ w_in, A_IN_SIZES)
    mix = mla_mixer(c_q, c_kv, k_rope, cos, sin, q_a_g, w_uq, kv_a_g, w_ukv)
    mo = memory_attention(q_mem, mem, mem_g, w_mem_kv)
    y = (jnp.concatenate([mix, mo], axis=-1) * jax.nn.silu(gate)) @ w_out
    return x + rms_norm(y, post_g)


def mlstm_layer(x, mem, pre_g, w_in, gate_bias, conv_w, conv_b, w_q, w_k, w_v, head_g, skip,
                mem_g, w_mem_kv, w_out, post_g):
    h = rms_norm(x, pre_g)
    u, if_pre, o_pre, q_mem, gate = split_cols(h @ w_in, B_IN_SIZES)
    mix = mlstm_mixer(u, if_pre, o_pre, gate_bias, conv_w, conv_b, w_q, w_k, w_v, head_g, skip)
    mo = memory_attention(q_mem, mem, mem_g, w_mem_kv)
    y = (jnp.concatenate([mix, mo], axis=-1) * jax.nn.silu(gate)) @ w_out
    return x + rms_norm(y, post_g)


def setup_inputs(seed: int = 0) -> dict:
    key = jax.random.key(seed)
    ks = jax.random.split(key, 32)
    f32 = jnp.float32
    NA, NB, H = N_LAYERS_A, N_LAYERS_B, MLSTM_HEADS

    def nrm(k, shape, fan_in):
        return jax.random.normal(k, shape, f32) * (fan_in ** -0.5)

    def gain(k, shape):
        return 1.0 + 0.02 * jax.random.normal(k, shape, f32)

    x = jax.random.normal(ks[0], (BATCH, SEQ, D_MODEL), f32)
    mem = jax.random.normal(ks[1], (BATCH, N_MEM, D_MODEL), f32)
    offs = jax.random.randint(ks[2], (BATCH, 1), 0, 1024, dtype=jnp.int32)
    positions = (jnp.arange(SEQ, dtype=jnp.int32)[None, :] + offs).astype(jnp.int32)
    gb_i = 0.1 * jax.random.normal(ks[23], (NB, H), f32)
    gb_f = 3.0 + 0.1 * jax.random.normal(ks[24], (NB, H), f32)
    return {
        'x': x, 'mem': mem, 'positions': positions,
        'a_pre_g': gain(ks[3], (NA, D_MODEL)),
        'a_w_in': nrm(ks[4], (NA, D_MODEL, A_IN_COLS), D_MODEL),
        'a_q_a_g': gain(ks[5], (NA, Q_LORA_RANK)),
        'a_w_uq': nrm(ks[6], (NA, Q_LORA_RANK, MLA_HEADS * (QK_NOPE_DIM + QK_ROPE_DIM)), Q_LORA_RANK),
        'a_kv_a_g': gain(ks[7], (NA, KV_LORA_RANK)),
        'a_w_ukv': nrm(ks[8], (NA, KV_LORA_RANK, MLA_HEADS * (QK_NOPE_DIM + V_HEAD_DIM)), KV_LORA_RANK),
        'a_mem_g': gain(ks[9], (NA, D_MODEL)),
        'a_w_mem_kv': nrm(ks[10], (NA, D_MODEL, 2 * MEM_WIDTH), D_MODEL),
        'a_w_out': nrm(ks[11], (NA, BRANCH_WIDTH, D_MODEL), BRANCH_WIDTH),
        'a_post_g': gain(ks[12], (NA, D_MODEL)),
        'b_pre_g': gain(ks[13], (NB, D_MODEL)),
        'b_w_in': nrm(ks[14], (NB, D_MODEL, B_IN_COLS), D_MODEL),
        'b_gate_bias': jnp.concatenate([gb_i, gb_f], axis=-1),
        'b_conv_w': nrm(ks[15], (NB, CONV_WIDTH, MIX_WIDTH), CONV_WIDTH),
        'b_conv_b': 0.01 * jax.random.normal(ks[16], (NB, MIX_WIDTH), f32),
        'b_w_q': nrm(ks[17], (NB, H, MLSTM_V_DIM, MLSTM_QK_DIM), MLSTM_V_DIM),
        'b_w_k': nrm(ks[18], (NB, H, MLSTM_V_DIM, MLSTM_QK_DIM), MLSTM_V_DIM),
        'b_w_v': nrm(ks[19], (NB, H, MLSTM_V_DIM, MLSTM_V_DIM), MLSTM_V_DIM),
        'b_head_g': gain(ks[20], (NB, H, MLSTM_V_DIM)),
        'b_skip': gain(ks[21], (NB, MIX_WIDTH)),
        'b_mem_g': gain(ks[22], (NB, D_MODEL)),
        'b_w_mem_kv': nrm(ks[25], (NB, D_MODEL, 2 * MEM_WIDTH), D_MODEL),
        'b_w_out': nrm(ks[26], (NB, BRANCH_WIDTH, D_MODEL), BRANCH_WIDTH),
        'b_post_g': gain(ks[27], (NB, D_MODEL)),
    }


def reference(x, mem, positions, a_pre_g, a_w_in, a_q_a_g, a_w_uq, a_kv_a_g, a_w_ukv, a_mem_g,
              a_w_mem_kv, a_w_out, a_post_g, b_pre_g, b_w_in, b_gate_bias, b_conv_w, b_conv_b,
              b_w_q, b_w_k, b_w_v, b_head_g, b_skip, b_mem_g, b_w_mem_kv, b_w_out, b_post_g):
    cos, sin = rope_tables(positions)
    for i in range(DEPTH):
        j = i // 2
        if i % 2 == 0:
            x = mla_layer(x, mem, cos, sin, a_pre_g[j], a_w_in[j], a_q_a_g[j], a_w_uq[j],
                          a_kv_a_g[j], a_w_ukv[j], a_mem_g[j], a_w_mem_kv[j], a_w_out[j], a_post_g[j])
        else:
            x = mlstm_layer(x, mem, b_pre_g[j], b_w_in[j], b_gate_bias[j], b_conv_w[j], b_conv_b[j],
                            b_w_q[j], b_w_k[j], b_w_v[j], b_head_g[j], b_skip[j], b_mem_g[j],
                            b_w_mem_kv[j], b_w_out[j], b_post_g[j])
    return x
```

```cpp
#define N_LAUNCH_SPLIT 0
#include <hip/hip_runtime.h>
#include <cstdio>
#include <cstdint>

#define LAS __attribute__((address_space(3)))
#define GAS __attribute__((address_space(1)))
typedef unsigned short bf16_t;
typedef short bf16x8 __attribute__((ext_vector_type(8)));
typedef short s16x4 __attribute__((ext_vector_type(4)));
typedef float f32x4 __attribute__((ext_vector_type(4)));
typedef float f32x16 __attribute__((ext_vector_type(16)));
typedef unsigned u32x4 __attribute__((ext_vector_type(4)));
typedef unsigned u32x2 __attribute__((ext_vector_type(2)));

constexpr int NB = 8, SEQ = 4096, DM = 1024, T = NB * SEQ;
constexpr int NMEM = 256;
constexpr float EPS = 1e-6f;
constexpr int A_IN = 1984, B_IN = 2824;
constexpr int G1W = 2048;
constexpr int G1_CKV = 0, G1_CQ = 256, G1_KR = 640, G1_QM = 768, G1_GATE = 1024;
constexpr int G2W = 2816;
constexpr int G2_U = 0, G2_O = 768, G2_QM = 1536, G2_GATE = 1792;
constexpr int QW = 1152;
constexpr float LOG2E = 1.4426950408889634f;
constexpr float QSCALE = 0.07216878364870323f * LOG2E;
constexpr float MSCALE = 0.125f * LOG2E;
constexpr float KSCALE_B = 0.10206207261596577f;

constexpr size_t MiB = 1u << 20;
constexpr size_t WS_CTL = 0, CTL_ZERO_BYTES = 64 * 1024;
constexpr size_t WS_WINA = 2 * MiB;
constexpr size_t WS_WUQ = 6 * MiB;
constexpr size_t WS_WUKV = 7 * MiB;
constexpr size_t WS_WMKV = 8 * MiB;
constexpr size_t WS_WOA = 10 * MiB;
constexpr size_t WS_WINB = 12 * MiB;
constexpr size_t WS_WQK = 18 * MiB;
constexpr size_t WS_WV = 19 * MiB;
constexpr size_t WS_WOB = 20 * MiB;
constexpr size_t WS_WG = 22 * MiB;
constexpr size_t WS_RSTD = 23 * MiB;
constexpr size_t WS_SSQA = WS_RSTD + 128 * 1024;
constexpr size_t WS_SSQB = WS_SSQA + 128 * 1024;
constexpr size_t WS_ROPE = 24 * MiB;
constexpr size_t WS_MEMN = 32 * MiB;
constexpr size_t WS_KVM = 36 * MiB;
constexpr size_t WS_IFP = 40 * MiB;
constexpr size_t WS_BL = 41 * MiB;
constexpr size_t WS_MLOC = WS_BL + 8192;
constexpr size_t WS_MST = WS_MLOC + 8192;
constexpr size_t WS_C0 = WS_MST + 8192;
constexpr size_t WS_U0 = WS_C0 + 1024;
constexpr size_t WS_DN = 42 * MiB;
constexpr size_t WS_DC = 56 * MiB;
constexpr size_t WS_XB = 64 * MiB;
constexpr size_t WS_Y = 64 * MiB;
constexpr size_t WS_G = 128 * MiB;
constexpr size_t WS_Q = 304 * MiB;
constexpr size_t WS_KN = 376 * MiB;
constexpr size_t WS_V = 424 * MiB;
constexpr size_t WS_Z = 304 * MiB;
constexpr size_t WS_UC = 304 * MiB;
constexpr size_t WS_QK = 352 * MiB;
constexpr size_t WS_VV = 400 * MiB;
constexpr size_t WS_Y2 = 448 * MiB;
constexpr size_t WS_END = 512 * MiB;

typedef float f32x2_t __attribute__((ext_vector_type(2))); typedef __bf16 bf16x2_t __attribute__((ext_vector_type(2)));
__device__ __forceinline__ unsigned cvt_pk_bf16(float lo, float hi) { f32x2_t v = {lo, hi}; bf16x2_t b = __builtin_convertvector(v, bf16x2_t); return __builtin_bit_cast(unsigned, b); }
__device__ __forceinline__ float bf2f(unsigned short b) { return __uint_as_float((unsigned)b << 16); }
__device__ __forceinline__ float bflo(unsigned w) { return __uint_as_float(w << 16); }
__device__ __forceinline__ float bfhi(unsigned w) { return __uint_as_float(w & 0xffff0000u); }
__device__ __forceinline__ unsigned short f2bf(float f) { return (unsigned short)(cvt_pk_bf16(f, f) & 0xffffu); }
__device__ __forceinline__ float wave_sum(float v) {
#pragma unroll
    for (int o = 1; o < 64; o <<= 1) v += __shfl_xor(v, o);
    return v;
}
__device__ __forceinline__ float wave_max(float v) {
#pragma unroll
    for (int o = 1; o < 64; o <<= 1) v = fmaxf(v, __shfl_xor(v, o));
    return v;
}
__device__ __forceinline__ float silu_f(float g) { return g / (1.f + __expf(-g)); }
__device__ __forceinline__ float sigmoid_f(float g) { return 1.f / (1.f + __expf(-g)); }
namespace pg8 {
constexpr int BM = 256, BK = 64, HALF = 128, HTB = HALF * BK * 2  , STAGE_BYTES = 8 * HTB, NXCD = 8, WGM = 8;
__host__ __device__ __forceinline__ int lds_byte(int r, int c) { const int st = (r >> 4) * 2 + (c >> 5), rr = r & 15, cc = c & 31, ob = rr * 64 + cc * 2; return st * 1024 + (ob ^ (((ob >> 9) & 1) << 5)); }
__host__ __device__ __forceinline__ void stage_rc(int b, int& R, int& C) { const int st = b / 1024, sb = b % 1024, swz = sb ^ (((sb >> 9) & 1) << 5); R = (st >> 1) * 16 + swz / 64; C = (st & 1) * 32 + (swz % 64) / 2; }
__host__ __device__ __forceinline__ int perm32(int rho) { const int n = rho >> 4, i = rho & 15; return 8 * (i >> 2) + 4 * n + (i & 3); }

struct Unit { int pm, pn; };
struct Gemm { const bf16_t* A; const bf16_t* Bt; int M, N, K, lda, apn; };

struct StaticOrder {
    int nM, nN, nwg, G, c;
    __host__ __device__ void init(int M, int N, int G_, int c_) { nM = M / BM; nN = N / BM; nwg = nM * nN; G = G_; c = c_; }
    __host__ __device__ bool next(int i, Unit& u) const {
        const long L = (long)i * G + c; if (L >= nwg) return false;
        int wgid = (int)L; { const int q = nwg / NXCD, r = nwg % NXCD, xcd = wgid % NXCD, off = wgid / NXCD; wgid = (xcd < r ? xcd * (q + 1) : r * (q + 1) + (xcd - r) * q) + off; }
        const int nig = WGM * nN, gid = wgid / nig, fm = gid * WGM, gsz = (nM - fm) < WGM ? (nM - fm) : WGM;
        u.pm = fm + ((wgid % nig) % gsz); u.pn = (wgid % nig) / gsz; return true;
    }
};

__device__ __forceinline__ void rope8(float (&v)[8], const float2* rp) {
#pragma unroll
    for (int j = 0; j < 4; ++j) { const float2 cs = rp[j]; const float x1 = v[2 * j], x2 = v[2 * j + 1]; v[2 * j] = x1 * cs.x - x2 * cs.y; v[2 * j + 1] = x1 * cs.y + x2 * cs.x; }
}
struct Epi {
    bf16_t* out; int ldc; int ncols;
    bf16_t* out2; int ldc2; int split;
    const float* rs; int rs_mode; float rs_invdim;
    float* ssqA; float* ssqB; int ssq_mode;
    const float2* rope; int rope_mode;
    __device__ __forceinline__ void operator()(const f32x4 (&acc)[2][2][4][2], const Unit& u, int wr, int wc, int fr, int fq) const {
#pragma unroll
        for (int ai = 0; ai < 2; ++ai)
#pragma unroll
            for (int m = 0; m < 4; ++m) {
                const int row = u.pm * BM + ai * HALF + wr * 64 + m * 16 + fr;
                float sc = 1.f;
                if (rs_mode == 1) sc = rs[row]; else if (rs_mode == 2) sc = rsqrtf(rs[row] * rs_invdim + EPS);
                float ss = 0.f;
#pragma unroll
                for (int bj = 0; bj < 2; ++bj) {
                    const int col0 = u.pn * BM + bj * HALF + wc * 32 + 8 * fq;
                    float v[8];
#pragma unroll
                    for (int j = 0; j < 4; ++j) { v[j] = acc[ai][bj][m][0][j] * sc; v[4 + j] = acc[ai][bj][m][1][j] * sc; }
                    if (ssq_mode == 1 && (u.pn < 2 || (u.pn == 2 && bj == 0))) {
#pragma unroll
                        for (int j = 0; j < 8; ++j) ss += v[j] * v[j];
                    }
                    if (rope_mode == 1) { if (col0 >= 640 && col0 < 704) rope8(v, rope + (size_t)row * 32 + ((col0 - 640) >> 1)); }
                    else if (rope_mode == 2) { const int d = col0 % 192; if (d >= 128) rope8(v, rope + (size_t)row * 32 + ((d - 128) >> 1)); }
                    if (col0 < ncols) {
                        u32x4 w; w.x = cvt_pk_bf16(v[0], v[1]); w.y = cvt_pk_bf16(v[2], v[3]); w.z = cvt_pk_bf16(v[4], v[5]); w.w = cvt_pk_bf16(v[6], v[7]);
                        if (col0 < split) *(u32x4*)(out + (size_t)row * ldc + col0) = w;
                        else *(u32x4*)(out2 + (size_t)row * ldc2 + (col0 - split)) = w;
                    }
                }
                if (ssq_mode == 1 && u.pn <= 2) {
                    ss += __shfl_xor(ss, 16); ss += __shfl_xor(ss, 32);
                    if (fq == 0) atomicAdd((u.pn == 0 ? ssqB : ssqA) + row, ss);
                }
            }
    }
};

template <bool ALIGN_EPI>
__device__ __forceinline__ void gemm_phase(LAS unsigned char* lds, const Gemm g, const StaticOrder& S, const Epi& E, const int tid) {
    const int wid = __builtin_amdgcn_readfirstlane(tid >> 6), lane = tid & 63, wr = wid >> 2, wc = wid & 3, fr = lane & 15, fq = lane >> 4;
    const int K = g.K, nt = K / BK, lda = g.lda;
    unsigned voffA[2], voffB[2];
#pragma unroll
    for (int i = 0; i < 2; ++i) { int R, C; stage_rc(tid * 16 + i * 8192, R, C); const int Rb = (R & ~31) + perm32(R & 31);
        voffA[i] = (unsigned)(R * lda + C) * 2u; voffB[i] = (unsigned)(Rb * K + C) * 2u; }
    const size_t kstep = (size_t)(BK * 2);
    const size_t hstepA = (size_t)HALF * lda * 2, hstepB = (size_t)HALF * K * 2;
    const size_t tstepA = 2 * hstepA, tstepB = 2 * hstepB;
    const unsigned ldsw = (unsigned)wid * 1024u;
    const int aoff = lds_byte(wr * 64 + fr, fq * 8), boff = lds_byte(wc * 32 + fr, fq * 8);
#define PG8_SA(b, h) (((b) * 2 + (h)) * HTB)
#define PG8_SB(b, h) ((4 + (b) * 2 + (h)) * HTB)
#define PG8_STAGE(bufoff, gbase, voff) do { _Pragma("unroll") for (int _i = 0; _i < 2; ++_i) \
        __builtin_amdgcn_global_load_lds((const unsigned*)((const char*)(gbase) + (voff)[_i]), (LAS unsigned*)(lds + (bufoff) + ldsw + _i * 8192), 16, 0, 0); } while (0)
#define PG8_LDA(dst, b, h) do { _Pragma("unroll") for (int m = 0; m < 4; ++m) _Pragma("unroll") for (int k = 0; k < 2; ++k) dst[m][k] = *(const LAS bf16x8*)(lds + PG8_SA(b, h) + aoff + m * 2048 + k * 1024); } while (0)
#define PG8_LDB(dst, b, h) do { _Pragma("unroll") for (int n = 0; n < 2; ++n) _Pragma("unroll") for (int k = 0; k < 2; ++k) dst[n][k] = *(const LAS bf16x8*)(lds + PG8_SB(b, h) + boff + n * 2048 + k * 1024); } while (0)
#define PG8_MMA(ai, bj, At, Bt) do { __builtin_amdgcn_s_setprio(1); _Pragma("unroll") for (int m = 0; m < 4; ++m) _Pragma("unroll") for (int n = 0; n < 2; ++n) _Pragma("unroll") for (int k = 0; k < 2; ++k) \
        acc[ai][bj][m][n] = __builtin_amdgcn_mfma_f32_16x16x32_bf16(Bt[n][k], At[m][k], acc[ai][bj][m][n], 0, 0, 0); __builtin_amdgcn_s_setprio(0); } while (0)
#define PG8_WAIT_V(n) asm volatile("s_waitcnt vmcnt(" #n ")" ::: "memory")
#define PG8_WAIT_L(n) asm volatile("s_waitcnt lgkmcnt(" #n ")" ::: "memory")
#define PG8_BAR __builtin_amdgcn_s_barrier()
#define PG8_SCHED __builtin_amdgcn_sched_barrier(0)
    Unit cur, nxt; int ui = 0;
    if (!S.next(0, cur)) return;
    f32x4 acc[2][2][4][2];
#pragma unroll
    for (int a = 0; a < 2; ++a)
#pragma unroll
        for (int b = 0; b < 2; ++b)
#pragma unroll
            for (int m = 0; m < 4; ++m)
#pragma unroll
                for (int n = 0; n < 2; ++n) acc[a][b][m][n] = (f32x4){0.f, 0.f, 0.f, 0.f};
    bf16x8 At[4][2], B0[2][2], B1[2][2];
    const char* cA = (const char*)g.A + (size_t)cur.pm * tstepA + (size_t)cur.pn * g.apn * 2; const char* cB = (const char*)g.Bt + (size_t)cur.pn * tstepB;
    PG8_STAGE(PG8_SB(0, 0), cB, voffB); PG8_STAGE(PG8_SB(0, 1), cB + hstepB, voffB); PG8_STAGE(PG8_SA(0, 0), cA, voffA); PG8_STAGE(PG8_SA(0, 1), cA + hstepA, voffA);
    if (wr == 1) PG8_BAR;
    PG8_WAIT_V(2); PG8_BAR;
    PG8_STAGE(PG8_SB(1, 0), cB + kstep, voffB); PG8_STAGE(PG8_SA(1, 0), cA + kstep, voffA); PG8_STAGE(PG8_SB(1, 1), cB + hstepB + kstep, voffB);
    PG8_WAIT_V(6); PG8_BAR;
    for (;;) {
        const bool has_next = S.next(ui + 1, nxt);
        const char* nA = has_next ? (const char*)g.A + (size_t)nxt.pm * tstepA + (size_t)nxt.pn * g.apn * 2 : cA; const char* nB = has_next ? (const char*)g.Bt + (size_t)nxt.pn * tstepB : cB;
        for (int t = 0; t < nt; t += 2) {
            const bool last = (t == nt - 2);
            const char* a1 = cA + (size_t)(t + 1) * kstep;
            const char* a2 = last ? nA : cA + (size_t)(t + 2) * kstep; const char* b2 = last ? nB : cB + (size_t)(t + 2) * kstep;
            const char* a3 = a2 + kstep; const char* b3 = b2 + kstep;
            PG8_LDB(B0, 0, 0); PG8_LDB(B1, 0, 1); PG8_SCHED; PG8_LDA(At, 0, 0); PG8_STAGE(PG8_SA(1, 1), a1 + hstepA, voffA);
            PG8_WAIT_V(8); PG8_WAIT_L(0); PG8_BAR; PG8_MMA(0, 0, At, B0); PG8_MMA(0, 1, At, B1); PG8_BAR; PG8_SCHED;
            PG8_LDA(At, 0, 1); PG8_STAGE(PG8_SB(0, 0), b2, voffB); PG8_STAGE(PG8_SB(0, 1), b2 + hstepB, voffB); PG8_STAGE(PG8_SA(0, 0), a2, voffA);
            PG8_WAIT_V(8); PG8_WAIT_L(0); PG8_BAR; PG8_MMA(1, 0, At, B0); PG8_MMA(1, 1, At, B1); PG8_BAR; PG8_SCHED;
            PG8_LDB(B0, 1, 0); PG8_LDB(B1, 1, 1); PG8_SCHED; PG8_LDA(At, 1, 0); PG8_STAGE(PG8_SA(0, 1), a2 + hstepA, voffA);
            PG8_WAIT_V(8); PG8_WAIT_L(0); PG8_BAR; PG8_MMA(0, 0, At, B0); PG8_MMA(0, 1, At, B1); PG8_BAR; PG8_SCHED;
            PG8_LDA(At, 1, 1); PG8_STAGE(PG8_SB(1, 0), b3, voffB); PG8_STAGE(PG8_SB(1, 1), b3 + hstepB, voffB); PG8_STAGE(PG8_SA(1, 0), a3, voffA);
            PG8_WAIT_V(8); PG8_WAIT_L(0); PG8_BAR; PG8_MMA(1, 0, At, B0); PG8_MMA(1, 1, At, B1); PG8_BAR; PG8_SCHED;
        }
        if constexpr (ALIGN_EPI) { if (wr == 0) PG8_BAR; }
        E(acc, cur, wr, wc, fr, fq);
        if (!has_next) break;
#pragma unroll
        for (int a = 0; a < 2; ++a)
#pragma unroll
            for (int b = 0; b < 2; ++b)
#pragma unroll
                for (int m = 0; m < 4; ++m)
#pragma unroll
                    for (int n = 0; n < 2; ++n) acc[a][b][m][n] = (f32x4){0.f, 0.f, 0.f, 0.f};
        cur = nxt; cA = nA; cB = nB; ++ui;
        if constexpr (ALIGN_EPI) { if (wr == 1) PG8_BAR; }
    }
    PG8_WAIT_V(0);
    if constexpr (!ALIGN_EPI) { if (wr == 0) PG8_BAR; }
    PG8_BAR;
#undef PG8_SA
#undef PG8_SB
#undef PG8_STAGE
#undef PG8_LDA
#undef PG8_LDB
#undef PG8_MMA
#undef PG8_WAIT_V
#undef PG8_WAIT_L
#undef PG8_BAR
#undef PG8_SCHED
}
}
namespace att {
#define SBAR() __builtin_amdgcn_sched_barrier(0)
__device__ __forceinline__ int crow(int r, int hi) { return (r & 3) + 8 * (r >> 2) + 4 * hi; }
template <int DQK> __device__ __forceinline__ int kaddr(int row, int c) { return row * (DQK * 2) + ((c ^ ((row >> 1) & 7)) << 4); }
template <int NCB> __device__ __forceinline__ int v_st(int k, int c) { const int kk = (k & ~0xC) | ((k & 4) << 1) | ((k & 8) >> 1); return ((kk >> 3) * NCB + (c >> 5)) * 512 + ((kk & 7) * 32 + (c & 31)) * 2; }
__device__ __forceinline__ int v_rd_base(int lane) { return ((lane & 3) << 3) | (((lane >> 2) & 3) << 6) | (((lane >> 4) & 1) << 5) | (((lane >> 5) & 1) << 8); }

__device__ __forceinline__ void mask_tile(f32x16& p0, f32x16& p1, int dq) {
    const float NEG = -__builtin_inff();
#pragma unroll
    for (int r = 0; r < 16; ++r) {
        const int c = (r & 3) + 8 * (r >> 2);
        if (dq - c < 0) p0[r] = NEG;
        if (dq - c - 32 < 0) p1[r] = NEG;
    }
}
__device__ __forceinline__ void partialSM(f32x16& p0, f32x16& p1, float& m_reg, float& alpha) {
    float pmax = p0[0];
#pragma unroll
    for (int r = 1; r < 16; ++r) pmax = fmaxf(pmax, p0[r]);
#pragma unroll
    for (int r = 0; r < 16; ++r) pmax = fmaxf(pmax, p1[r]);
    { auto rr = __builtin_amdgcn_permlane32_swap(__float_as_uint(pmax), __float_as_uint(pmax), false, false);
      pmax = fmaxf(__uint_as_float(rr[0]), __uint_as_float(rr[1])); }
    const float mn = fmaxf(m_reg, pmax);
    alpha = __builtin_amdgcn_exp2f(m_reg - mn); m_reg = mn;
#pragma unroll
    for (int r = 0; r < 16; ++r) p0[r] = __builtin_amdgcn_exp2f(p0[r] - mn);
#pragma unroll
    for (int r = 0; r < 16; ++r) p1[r] = p1[r] - mn;
}
__device__ __forceinline__ void finishSM(f32x16& p0, f32x16& p1, float alpha, float& l_reg, bf16x8& pa0, bf16x8& pa1, bf16x8& pa2, bf16x8& pa3) {
#pragma unroll
    for (int r = 0; r < 16; ++r) p1[r] = __builtin_amdgcn_exp2f(p1[r]);
    float ps = 0.f;
#pragma unroll
    for (int r = 0; r < 16; ++r) ps += p0[r];
#pragma unroll
    for (int r = 0; r < 16; ++r) ps += p1[r];
    { auto rr = __builtin_amdgcn_permlane32_swap(__float_as_uint(ps), __float_as_uint(ps), false, false);
      ps = __uint_as_float(rr[0]) + __uint_as_float(rr[1]); }
    l_reg = l_reg * alpha + ps;
#define PK4(P, B_, OUT) do { unsigned a0 = cvt_pk_bf16(P[B_+0], P[B_+1]), a1 = cvt_pk_bf16(P[B_+2], P[B_+3]);                          \
        unsigned b0 = cvt_pk_bf16(P[B_+4], P[B_+5]), b1 = cvt_pk_bf16(P[B_+6], P[B_+7]);                                             \
        auto r0 = __builtin_amdgcn_permlane32_swap(a0, b0, false, false); auto r1 = __builtin_amdgcn_permlane32_swap(a1, b1, false, false); \
        u32x4 w = {r0[0], r1[0], r0[1], r1[1]}; OUT = *reinterpret_cast<bf16x8*>(&w); } while (0)
    PK4(p0, 0, pa0); PK4(p0, 8, pa1); PK4(p1, 0, pa2); PK4(p1, 8, pa3);
#undef PK4
}
template <int DQK>
__device__ __forceinline__ void qkt(f32x16& p0, f32x16& p1, const LAS unsigned char* Kb, int r32, int hi, const bf16x8* qr) {
    constexpr int NKS = DQK / 16, ROWB = DQK * 2;
    p0 = f32x16{}; p1 = f32x16{};
    const int f = (r32 >> 1) & 7;
    const LAS unsigned char* kb[4];
#pragma unroll
    for (int dd = 0; dd < 4; ++dd) kb[dd] = Kb + r32 * ROWB + ((((2 * dd + hi) ^ f)) << 4);
#pragma unroll
    for (int d0 = 0; d0 < NKS; ++d0) { const LAS unsigned char* a = kb[d0 & 3] + (d0 >> 2) * 128;
        bf16x8 b0 = *reinterpret_cast<const LAS bf16x8*>(a);
        bf16x8 b1 = *reinterpret_cast<const LAS bf16x8*>(a + 32 * ROWB);
        p0 = __builtin_amdgcn_mfma_f32_32x32x16_bf16(b0, qr[d0], p0, 0, 0, 0);
        p1 = __builtin_amdgcn_mfma_f32_32x32x16_bf16(b1, qr[d0], p1, 0, 0, 0);
    }
}
template <int DV>
__device__ __forceinline__ void pv_tile(f32x16* o, int vb0, bf16x8 pa0, bf16x8 pa1, bf16x8 pa2, bf16x8 pa3) {
    constexpr int NCB = DV / 32, KS = 2 * NCB * 512, HF = NCB * 512;
#define TRRD(dst, off) asm volatile("ds_read_b64_tr_b16 %0, %1 offset:%2" : "=&v"(dst) : "v"(vb0), "i"(off) : "memory")
#pragma unroll
    for (int d0 = 0; d0 < NCB; ++d0) {
        s16x4 l0, l1, l2, l3, h0, h1, h2, h3;
        if (d0 == 0) { TRRD(l0, 0 * 512); TRRD(h0, 0 * 512 + HF); TRRD(l1, 0 * 512 + KS); TRRD(h1, 0 * 512 + KS + HF); TRRD(l2, 0 * 512 + 2 * KS); TRRD(h2, 0 * 512 + 2 * KS + HF); TRRD(l3, 0 * 512 + 3 * KS); TRRD(h3, 0 * 512 + 3 * KS + HF); }
        else if (d0 == 1) { TRRD(l0, 1 * 512); TRRD(h0, 1 * 512 + HF); TRRD(l1, 1 * 512 + KS); TRRD(h1, 1 * 512 + KS + HF); TRRD(l2, 1 * 512 + 2 * KS); TRRD(h2, 1 * 512 + 2 * KS + HF); TRRD(l3, 1 * 512 + 3 * KS); TRRD(h3, 1 * 512 + 3 * KS + HF); }
        else if (d0 == 2) { TRRD(l0, 2 * 512); TRRD(h0, 2 * 512 + HF); TRRD(l1, 2 * 512 + KS); TRRD(h1, 2 * 512 + KS + HF); TRRD(l2, 2 * 512 + 2 * KS); TRRD(h2, 2 * 512 + 2 * KS + HF); TRRD(l3, 2 * 512 + 3 * KS); TRRD(h3, 2 * 512 + 3 * KS + HF); }
        else { TRRD(l0, 3 * 512); TRRD(h0, 3 * 512 + HF); TRRD(l1, 3 * 512 + KS); TRRD(h1, 3 * 512 + KS + HF); TRRD(l2, 3 * 512 + 2 * KS); TRRD(h2, 3 * 512 + 2 * KS + HF); TRRD(l3, 3 * 512 + 3 * KS); TRRD(h3, 3 * 512 + 3 * KS + HF); }
        asm volatile("s_waitcnt lgkmcnt(0)" ::: "memory"); SBAR();
        o[d0] = __builtin_amdgcn_mfma_f32_32x32x16_bf16(pa0, (bf16x8){l0[0], l0[1], l0[2], l0[3], h0[0], h0[1], h0[2], h0[3]}, o[d0], 0, 0, 0);
        o[d0] = __builtin_amdgcn_mfma_f32_32x32x16_bf16(pa1, (bf16x8){l1[0], l1[1], l1[2], l1[3], h1[0], h1[1], h1[2], h1[3]}, o[d0], 0, 0, 0);
        o[d0] = __builtin_amdgcn_mfma_f32_32x32x16_bf16(pa2, (bf16x8){l2[0], l2[1], l2[2], l2[3], h2[0], h2[1], h2[2], h2[3]}, o[d0], 0, 0, 0);
        o[d0] = __builtin_amdgcn_mfma_f32_32x32x16_bf16(pa3, (bf16x8){l3[0], l3[1], l3[2], l3[3], h3[0], h3[1], h3[2], h3[3]}, o[d0], 0, 0, 0);
    }
#undef TRRD
}

template <int DQK, int DV, bool CAUSAL, int ABL = 0>
__device__ __forceinline__ void attn_unit(const bf16_t* Qb, int qp, const bf16_t* Km, int kp, int c1, const bf16_t* Ke, int kep, const bf16_t* Vb, int vp,
                                          int NT, int q0, const bf16_t* gate, int gp, bf16_t* Y, int yp, LAS unsigned char* lds, const int tid) {
    constexpr int SHM_V = 64 * DV * 2, SHM_K = 64 * DQK * 2, NCK = DQK / 8, NKS = DQK / 16, NCB = DV / 32;
    constexpr int KPT = SHM_K / 8192, VPT = SHM_V / 8192;
    const int wid = __builtin_amdgcn_readfirstlane(tid >> 6), lane = tid & 63, r32 = lane & 31, hi = lane >> 5;
    LAS unsigned char* V_lds = lds; LAS unsigned char* K_lds = lds + 3 * SHM_V; LAS float* ws = (LAS float*)(lds + 3 * SHM_V + 3 * SHM_K) + wid * 64;
    bf16x8 qr[NKS];
#pragma unroll
    for (int d0 = 0; d0 < NKS; ++d0) qr[d0] = *reinterpret_cast<const bf16x8*>(Qb + (size_t)(wid * 32 + r32) * qp + d0 * 16 + hi * 8);
    const char* kbase = (const char*)(Km < Ke ? Km : Ke);
    unsigned koff[KPT]; unsigned kstr[KPT];
#pragma unroll
    for (int i = 0; i < KPT; ++i) { const int p = (wid + 8 * i) * 64 + lane, row = p / NCK, cpos = p % NCK, c = cpos ^ ((row >> 1) & 7);
        if (c < c1) { koff[i] = (unsigned)((const char*)(Km + (size_t)row * kp + c * 8) - kbase); kstr[i] = (unsigned)kp * 128u; }
        else { koff[i] = (unsigned)((const char*)(Ke + (size_t)row * kep + (c - c1) * 8) - kbase); kstr[i] = (unsigned)kep * 128u; } }
    unsigned voff[VPT];
#pragma unroll
    for (int i = 0; i < VPT; ++i) { const int st = 2 * (wid + 8 * i) + (lane >> 5), kk = (st / NCB) * 8 + ((lane & 31) >> 2), k = (kk & ~0xC) | ((kk & 4) << 1) | ((kk & 8) >> 1), col = (st % NCB) * 32 + (lane & 3) * 8;
        voff[i] = (unsigned)(k * vp + col) * 2u; }
    const char* vbase = (const char*)Vb;
    float m_reg = -1e30f, l_reg = 0.f; f32x16 o[NCB];
#pragma unroll
    for (int d = 0; d < NCB; ++d) o[d] = f32x16{};
    const int vb0 = (int)(size_t)V_lds + v_rd_base(lane);
    const int qlo = q0 + wid * 32;
#define DMA_K(sl) do { _Pragma("unroll") for (int i = 0; i < KPT; ++i) { __builtin_amdgcn_global_load_lds((const unsigned*)(kbase + koff[i]), (LAS unsigned*)(K_lds + (sl) * SHM_K + (wid + 8 * i) * 1024), 16, 0, 0); koff[i] += kstr[i]; } } while (0)
#define DMA_V(sl) do { _Pragma("unroll") for (int i = 0; i < VPT; ++i) { __builtin_amdgcn_global_load_lds((const unsigned*)(vbase + voff[i]), (LAS unsigned*)(V_lds + (sl) * SHM_V + (wid + 8 * i) * 1024), 16, 0, 0); } vbase += (size_t)vp * 128; } while (0)
#define WAIT_BAR(N) do { asm volatile("s_waitcnt vmcnt(%0) lgkmcnt(0)\n\ts_barrier" :: "i"(N) : "memory"); } while (0)
#define MASKT(P0_, P1_, t) do { if (CAUSAL) { const int kb_ = (t) * 64; if (kb_ + 63 > qlo) mask_tile(P0_, P1_, qlo + r32 - 4 * hi - kb_); } } while (0)
#define RESC(a) do { if (__any((a) < 1.f)) { if (hi == 0) ws[r32] = (a); asm volatile("s_waitcnt lgkmcnt(0)" ::: "memory"); \
        _Pragma("unroll") for (int d_ = 0; d_ < NCB; ++d_) _Pragma("unroll") for (int r = 0; r < 16; ++r) o[d_][r] *= ws[crow(r, hi)]; } } while (0)
    f32x16 pA0, pA1, pB0, pB1; float alA = 1.f, alB = 1.f; bf16x8 pa0, pa1, pa2, pa3;
    DMA_K(0); DMA_K(1); DMA_V(0);
    WAIT_BAR(KPT + VPT);
    DMA_K(2); DMA_V(1);
    qkt<DQK>(pA0, pA1, K_lds, r32, hi, qr);
    MASKT(pA0, pA1, 0); partialSM(pA0, pA1, m_reg, alA);
    WAIT_BAR(KPT + VPT);
    int ks = 1, vs = 0, ns = 2;
#define ROT() do { vs = ks; ks = ns; ns = (ns == 2) ? 0 : ns + 1; } while (0)
#define STEP(PX0, PX1, alX, PY0, PY1, alY, t, NW) do { \
        if (!(ABL & 1)) { if ((t) + 2 < NT) DMA_K(vs); if ((t) + 1 < NT) DMA_V(ns); } \
        SBAR(); if (!(ABL & 8)) qkt<DQK>(PX0, PX1, K_lds + ks * SHM_K, r32, hi, qr); else { asm volatile("" : "+v"(PX0), "+v"(PX1)); } \
        if (!(ABL & 2)) finishSM(PY0, PY1, alY, l_reg, pa0, pa1, pa2, pa3); else { asm volatile("" : "+v"(PY0), "+v"(PY1), "+v"(pa0), "+v"(pa1), "+v"(pa2), "+v"(pa3)); } SBAR(); \
        if (!(ABL & 4)) pv_tile<DV>(o, vb0 + vs * SHM_V, pa0, pa1, pa2, pa3); \
        if (!(ABL & 2)) { MASKT(PX0, PX1, t); partialSM(PX0, PX1, m_reg, alX); } \
        if (ABL & 1) WAIT_BAR(0); else WAIT_BAR(NW); \
        RESC(alX); ROT(); } while (0)
    int t = 1;
    for (; t + 3 < NT; t += 2) {
        STEP(pB0, pB1, alB, pA0, pA1, alA, t, KPT + VPT);
        STEP(pA0, pA1, alA, pB0, pB1, alB, t + 1, KPT + VPT);
    }
    STEP(pB0, pB1, alB, pA0, pA1, alA, t, KPT + VPT);
    STEP(pA0, pA1, alA, pB0, pB1, alB, t + 1, VPT);
    STEP(pB0, pB1, alB, pA0, pA1, alA, t + 2, 0);
    finishSM(pB0, pB1, alB, l_reg, pa0, pa1, pa2, pa3); SBAR(); pv_tile<DV>(o, vb0 + vs * SHM_V, pa0, pa1, pa2, pa3);
#undef STEP
#undef ROT
#undef RESC
#undef MASKT
#undef WAIT_BAR
#undef DMA_K
#undef DMA_V
    if (hi == 0) ws[32 + r32] = l_reg;
    asm volatile("s_waitcnt lgkmcnt(0)" ::: "memory");
#pragma unroll
    for (int r = 0; r < 16; ++r) {
        const int orow = wid * 32 + crow(r, hi);
        const float rl = __builtin_amdgcn_rcpf(ws[32 + crow(r, hi)]);
#pragma unroll
        for (int d0 = 0; d0 < NCB; ++d0) {
            const int col = d0 * 32 + r32;
            const float g = bf2f(gate[(size_t)orow * gp + col]);
            const float v = o[d0][r] * rl * silu_f(g);
            const float vn = __shfl_xor(v, 1);
            if ((r32 & 1) == 0) *reinterpret_cast<unsigned*>(Y + (size_t)orow * yp + col) = cvt_pk_bf16(v, vn);
        }
    }
    __syncthreads();
}
#undef SBAR
}
struct Params {
    const float* x; const float* mem; const int* pos;
    const float *a_pre_g, *a_w_in, *a_q_a_g, *a_w_uq, *a_kv_a_g, *a_w_ukv, *a_mem_g, *a_w_mem_kv, *a_w_out, *a_post_g;
    const float *b_pre_g, *b_w_in, *b_gate_bias, *b_conv_w, *b_conv_b, *b_w_q, *b_w_k, *b_w_v, *b_head_g, *b_skip, *b_mem_g, *b_w_mem_kv, *b_w_out, *b_post_g;
    float* out; unsigned char* ws; int ph_lo, ph_hi;
};
struct Wk { int tid, lane, wave, vcu, G; };
#define LDS_WAIT() asm volatile("s_waitcnt lgkmcnt(0)" ::: "memory")

__device__ __forceinline__ float wsrc(const Params& P, int mat, int k, int n) {
    switch (mat) {
    case 0: { int col; float s = 1.f;
        if (n < 256) col = 384 + n; else if (n < 512) col = n - 256; else if (n < 640) col = 256 + (n - 512);
        else if (n < 704) { const int p_ = n - 640, i = p_ >> 1; col = 640 + ((p_ & 1) ? 32 + i : i); }
        else if (n < 768) return 0.f; else if (n < 1024) { col = 704 + (n - 768); s = MSCALE; } else col = 960 + (n - 1024);
        return P.a_w_in[(size_t)k * A_IN + col] * P.a_pre_g[k] * s; }
    case 1: { if (n >= 1152) return 0.f; const int h = n / 192, d = n % 192; int col;
        if (d < 128) col = h * 192 + d; else { const int p_ = d - 128, i = p_ >> 1; col = h * 192 + 128 + ((p_ & 1) ? 32 + i : i); }
        return P.a_w_uq[(size_t)k * 1152 + col] * P.a_q_a_g[k] * QSCALE; }
    case 2: { int col; if (n < 768) col = (n / 128) * 256 + (n % 128); else { const int n2 = n - 768; col = (n2 / 128) * 256 + 128 + (n2 % 128); }
        return P.a_w_ukv[(size_t)k * 1536 + col] * P.a_kv_a_g[k]; }
    case 3: { if (n < 512) return P.a_w_mem_kv[(size_t)k * 512 + n] * P.a_mem_g[k]; return P.b_w_mem_kv[(size_t)k * 512 + (n - 512)] * P.b_mem_g[k]; }
    case 4: return P.a_w_out[(size_t)k * 1024 + n];
    case 5: { int col; float s = 1.f; if (n < 768) col = n; else if (n < 1536) col = 776 + (n - 768); else if (n < 1792) { col = 1544 + (n - 1536); s = MSCALE; } else col = 1800 + (n - 1792);
        return P.b_w_in[(size_t)k * B_IN + col] * P.b_pre_g[k] * s; }
    case 6: { const int h = n / 192, j = n % 192, pn = n / 256, kabs = k + 192 * pn - 192 * h; if (kabs < 0 || kabs >= 192) return 0.f;
        if (j < 96) return P.b_w_q[((size_t)h * 192 + kabs) * 96 + j]; return P.b_w_k[((size_t)h * 192 + kabs) * 96 + (j - 96)] * KSCALE_B; }
    case 7: { const int h = n / 192, j = n % 192, pn = n / 256, kabs = k + 192 * pn - 192 * h; if (kabs < 0 || kabs >= 192) return 0.f;
        return P.b_w_v[((size_t)h * 192 + kabs) * 192 + j]; }
    default: return P.b_w_out[(size_t)k * 1024 + n];
    }
}
__device__ __forceinline__ void tr_item(const Params& P, int mat, int K, int nblk, bf16_t* WT, LAS float* scr, int item, int lane) {
    const int kb = item / nblk, nb = item % nblk, k0 = 64 * kb, n0 = 32 * nb;
#pragma unroll 4
    for (int i = 0; i < 32; ++i) { const int kk = 2 * i + (lane >> 5); scr[kk * 33 + (lane & 31)] = wsrc(P, mat, k0 + kk, n0 + (lane & 31)); }
    LDS_WAIT(); asm volatile("" ::: "memory");
    const int c = lane & 7;
#pragma unroll
    for (int j = 0; j < 4; ++j) { const int n = (lane >> 3) + 8 * j; const LAS float* s = scr + (8 * c) * 33 + n;
        u32x4 o; o.x = cvt_pk_bf16(s[0 * 33], s[1 * 33]); o.y = cvt_pk_bf16(s[2 * 33], s[3 * 33]); o.z = cvt_pk_bf16(s[4 * 33], s[5 * 33]); o.w = cvt_pk_bf16(s[6 * 33], s[7 * 33]);
        *(u32x4*)(WT + (size_t)(n0 + n) * K + k0 + 8 * c) = o; }
    LDS_WAIT(); asm volatile("" ::: "memory");
}
__device__ __forceinline__ void row_to_bf16(const float* xrow, bf16_t* orow, float* rstd_out, bool normalise, int lane) {
    const f32x4* xr = (const f32x4*)xrow + lane;
    f32x4 v[4]; float s = 0.f;
#pragma unroll
    for (int j = 0; j < 4; ++j) { v[j] = xr[64 * j]; s += (v[j].x * v[j].x + v[j].y * v[j].y) + (v[j].z * v[j].z + v[j].w * v[j].w); }
    const float rstd = rsqrtf(wave_sum(s) * (1.f / DM) + EPS);
    if (rstd_out && lane == 0) *rstd_out = rstd;
    const float sc = normalise ? rstd : 1.f;
    u32x2* o8 = (u32x2*)orow + lane;
#pragma unroll
    for (int j = 0; j < 4; ++j) { u32x2 w; w.x = cvt_pk_bf16(v[j].x * sc, v[j].y * sc); w.y = cvt_pk_bf16(v[j].z * sc, v[j].w * sc); o8[64 * j] = w; }
}
__device__ __forceinline__ void phase_prologue(const Params& P, const Wk& W, LAS unsigned char* lds) {
    unsigned char* ws = P.ws;
    LAS float* scr = (LAS float*)(lds + W.wave * 8704);
    const int gw = W.vcu * 8 + W.wave, NGW = W.G * 8;
    int base = 0;
#define DO_MAT(mt, K_, N_, OFF_) do { const int nblk = (N_) / 32, nit = ((K_) / 64) * nblk; \
        int first = gw - (base % NGW); if (first < 0) first += NGW; \
        for (int r = first; r < nit; r += NGW) tr_item(P, mt, K_, nblk, (bf16_t*)(ws + (OFF_)), scr, r, W.lane); \
        base += nit; } while (0)
    DO_MAT(0, 1024, 2048, WS_WINA); DO_MAT(1, 384, 1280, WS_WUQ); DO_MAT(2, 256, 1536, WS_WUKV); DO_MAT(3, 1024, 1024, WS_WMKV); DO_MAT(4, 1024, 1024, WS_WOA);
    DO_MAT(5, 1024, 2816, WS_WINB); DO_MAT(6, 384, 768, WS_WQK); DO_MAT(7, 384, 768, WS_WV); DO_MAT(8, 1024, 1024, WS_WOB);
#undef DO_MAT
    const int gt = (W.vcu * 512 + W.tid), NGT = W.G * 512;
    for (int idx = gt; idx < 8 * 1024; idx += NGT) { const int g = idx >> 10, k = idx & 1023; ((float*)(ws + WS_WG))[idx] = P.b_w_in[(size_t)k * B_IN + 768 + g] * P.b_pre_g[k]; }
    for (int idx = gt; idx < 2 * T; idx += NGT) ((float*)(ws + WS_SSQA))[idx] = 0.f;
    for (int idx = gt; idx < T * 32; idx += NGT) { const int row = idx >> 5, i = idx & 31;
        const float inv = exp2f(-(float)i * (13.287712379549449f / 32.f));
        const float ang = (float)P.pos[row] * inv;
        double tr = (double)ang * 0.15915494309189535; tr -= floor(tr); const float tf = (float)tr;
        ((float2*)(ws + WS_ROPE))[idx] = make_float2(__builtin_amdgcn_cosf(tf), __builtin_amdgcn_sinf(tf)); }
    for (int m = gw; m < T; m += NGW) row_to_bf16(P.x + (size_t)m * DM, (bf16_t*)(ws + WS_XB) + (size_t)m * DM, (float*)(ws + WS_RSTD) + m, false, W.lane);
    for (int m = gw; m < NB * NMEM; m += NGW) row_to_bf16(P.mem + (size_t)m * DM, (bf16_t*)(ws + WS_MEMN) + (size_t)m * DM, nullptr, true, W.lane);
}

__device__ __forceinline__ void phase_rowmid(const Params& P, const Wk& W, LAS unsigned char* lds) {
    unsigned char* ws = P.ws;
    const int gw = W.vcu * 8 + W.wave, NGW = W.G * 8, lane = W.lane;
    const bf16_t* Z = (const bf16_t*)(ws + WS_Z);
    { const int gt_ = W.vcu * 512 + W.tid; if (gt_ < 32 * 192) ((float*)(ws + WS_U0))[gt_] = 0.f; }
    LAS float* Wg = (LAS float*)lds;
    for (int i = W.tid; i < 2048; i += 512) ((LAS f32x4*)Wg)[i] = ((const f32x4*)(ws + WS_WG))[i];
    __syncthreads();
    for (int m = gw; m < T; m += NGW) {
        const f32x4* xr = (const f32x4*)(P.x + (size_t)m * DM) + lane; const u32x2* zr = (const u32x2*)(Z + (size_t)m * DM) + lane;
        f32x4 v[4], z[4]; float s = 0.f;
#pragma unroll
        for (int j = 0; j < 4; ++j) { v[j] = xr[64 * j]; const u32x2 w = zr[64 * j]; z[j] = (f32x4){bflo(w.x), bfhi(w.x), bflo(w.y), bfhi(w.y)};
            s += (z[j].x * z[j].x + z[j].y * z[j].y) + (z[j].z * z[j].z + z[j].w * z[j].w); }
        const float rz = rsqrtf(wave_sum(s) * (1.f / DM) + EPS);
        float s1 = 0.f;
#pragma unroll
        for (int j = 0; j < 4; ++j) { const f32x4 g = ((const f32x4*)P.a_post_g)[lane + 64 * j]; v[j] = v[j] + z[j] * rz * g;
            s1 += (v[j].x * v[j].x + v[j].y * v[j].y) + (v[j].z * v[j].z + v[j].w * v[j].w); }
        const float r1 = rsqrtf(wave_sum(s1) * (1.f / DM) + EPS);
        f32x4* orow = (f32x4*)(P.out + (size_t)m * DM) + lane; u32x2* o8 = (u32x2*)((bf16_t*)(ws + WS_XB) + (size_t)m * DM) + lane;
#pragma unroll
        for (int j = 0; j < 4; ++j) { orow[64 * j] = v[j]; u32x2 w; w.x = cvt_pk_bf16(v[j].x, v[j].y); w.y = cvt_pk_bf16(v[j].z, v[j].w); o8[64 * j] = w; }
        if (lane == 0) ((float*)(ws + WS_RSTD))[m] = r1;
        float gacc[8];
#pragma unroll
        for (int g = 0; g < 8; ++g) { float a = 0.f;
#pragma unroll
            for (int j = 0; j < 4; ++j) { const f32x4 w4 = ((const LAS f32x4*)(Wg + g * 1024))[lane + 64 * j]; a += (v[j].x * w4.x + v[j].y * w4.y) + (v[j].z * w4.z + v[j].w * w4.w); }
            gacc[g] = wave_sum(a); }
        if (lane < 8) { float r = gacc[0];
#pragma unroll
            for (int g = 1; g < 8; ++g) r = (lane == g) ? gacc[g] : r;
            ((float*)(ws + WS_IFP))[(size_t)m * 8 + lane] = r * r1 + P.b_gate_bias[lane]; }
    }
}
__device__ __forceinline__ void phase_rowfinal(const Params& P, const Wk& W) {
    unsigned char* ws = P.ws;
    const int gw = W.vcu * 8 + W.wave, NGW = W.G * 8, lane = W.lane;
    const bf16_t* Z = (const bf16_t*)(ws + WS_Z);
    for (int m = gw; m < T; m += NGW) {
        f32x4* xr = (f32x4*)(P.out + (size_t)m * DM) + lane; const u32x2* zr = (const u32x2*)(Z + (size_t)m * DM) + lane;
        f32x4 v[4], z[4]; float s = 0.f;
#pragma unroll
        for (int j = 0; j < 4; ++j) { v[j] = xr[64 * j]; const u32x2 w = zr[64 * j]; z[j] = (f32x4){bflo(w.x), bfhi(w.x), bflo(w.y), bfhi(w.y)};
            s += (z[j].x * z[j].x + z[j].y * z[j].y) + (z[j].z * z[j].z + z[j].w * z[j].w); }
        const float rz = rsqrtf(wave_sum(s) * (1.f / DM) + EPS);
#pragma unroll
        for (int j = 0; j < 4; ++j) { const f32x4 g = ((const f32x4*)P.b_post_g)[lane + 64 * j]; xr[64 * j] = v[j] + z[j] * rz * g; }
    }
}
__device__ __forceinline__ void first_token_u0(const Params& P, const Wk& W, LAS unsigned char* lds) {
    unsigned char* ws = P.ws;
    if (W.vcu >= 256) return;
    const int bh = W.vcu >> 3, sl = W.vcu & 7, b = bh >> 2, h = bh & 3, j = W.tid % 192, sub = W.tid / 192; const size_t row = (size_t)b * SEQ;
    LAS float* hs = (LAS float*)lds;
    if (W.tid < 128) hs[W.tid] = P.out[row * DM + sl * 128 + W.tid] * P.b_pre_g[sl * 128 + W.tid] * ((const float*)(ws + WS_RSTD))[row];
    __syncthreads();
    if (W.tid < 384) {
        const float* wp = P.b_w_in + (size_t)(sl * 128 + sub * 64) * B_IN + h * 192 + j; float a = 0.f;
#pragma unroll
        for (int k = 0; k < 64; ++k) a += hs[sub * 64 + k] * wp[(size_t)k * B_IN];
        atomicAdd((float*)(ws + WS_U0) + bh * 192 + j, a); }
    __syncthreads();
}
__device__ __forceinline__ void first_token_qk(const Params& P, const Wk& W, LAS unsigned char* lds) {
    if (W.vcu < 224 || W.vcu >= 256) return;
    unsigned char* ws = P.ws;
    const int bh = W.vcu - 224, h = bh & 3, tid = W.tid;
    LAS float* uc0 = (LAS float*)lds; LAS float* qk0 = uc0 + 192;
    if (tid < 192) { const int col = h * 192 + tid; uc0[tid] = silu_f(P.b_conv_b[col] + P.b_conv_w[3 * 768 + col] * ((const float*)(ws + WS_U0))[bh * 192 + tid]); }
    __syncthreads();
    if (tid < 384) { const int o = tid % 192, part = tid / 192, j = o % 96; const float* Wm = (o < 96 ? P.b_w_q : P.b_w_k) + (size_t)h * 192 * 96 + (size_t)(part * 96) * 96 + j; float a = 0.f;
#pragma unroll 48
        for (int i = 0; i < 96; ++i) a += uc0[part * 96 + i] * Wm[i * 96];
        qk0[part * 192 + o] = a; }
    __syncthreads();
    if (tid < 64) { float a = (qk0[tid] + qk0[192 + tid]) * (qk0[96 + tid] + qk0[288 + tid]); if (tid < 32) a += (qk0[64 + tid] + qk0[256 + tid]) * (qk0[160 + tid] + qk0[352 + tid]);
        a = wave_sum(a); if (tid == 0) ((float*)(ws + WS_C0))[bh] = a * KSCALE_B; }
    __syncthreads();
}
__device__ __forceinline__ void phase_conv(const Params& P, const Wk& W) {
    unsigned char* ws = P.ws;
    const bf16_t* G2 = (const bf16_t*)(ws + WS_G); bf16_t* UC = (bf16_t*)(ws + WS_UC);
    const int gt = W.vcu * 512 + W.tid, NGT = W.G * 512;
    for (int it = gt; it < (T / 8) * 96; it += NGT) {
        const int rg = it / 96, cc = it % 96, row0 = rg * 8, c0 = cc * 8, s0 = row0 & (SEQ - 1);
        float w[4][8], bsv[8];
#pragma unroll
        for (int j = 0; j < 4; ++j) { const f32x4 a = *(const f32x4*)(P.b_conv_w + j * 768 + c0), b = *(const f32x4*)(P.b_conv_w + j * 768 + c0 + 4);
            w[j][0] = a.x; w[j][1] = a.y; w[j][2] = a.z; w[j][3] = a.w; w[j][4] = b.x; w[j][5] = b.y; w[j][6] = b.z; w[j][7] = b.w; }
        { const f32x4 a = *(const f32x4*)(P.b_conv_b + c0), b = *(const f32x4*)(P.b_conv_b + c0 + 4); bsv[0] = a.x; bsv[1] = a.y; bsv[2] = a.z; bsv[3] = a.w; bsv[4] = b.x; bsv[5] = b.y; bsv[6] = b.z; bsv[7] = b.w; }
        float h[3][8];
#pragma unroll
        for (int j = 0; j < 3; ++j) {
            if (s0 - 3 + j >= 0) { const u32x4 q = *(const u32x4*)(G2 + (size_t)(row0 - 3 + j) * G2W + G2_U + c0);
                h[j][0] = bflo(q.x); h[j][1] = bfhi(q.x); h[j][2] = bflo(q.y); h[j][3] = bfhi(q.y); h[j][4] = bflo(q.z); h[j][5] = bfhi(q.z); h[j][6] = bflo(q.w); h[j][7] = bfhi(q.w); }
            else {
#pragma unroll
                for (int e = 0; e < 8; ++e) h[j][e] = 0.f; }
        }
#pragma unroll
        for (int r = 0; r < 8; ++r) {
            const u32x4 q = *(const u32x4*)(G2 + (size_t)(row0 + r) * G2W + G2_U + c0);
            float u[8] = {bflo(q.x), bfhi(q.x), bflo(q.y), bfhi(q.y), bflo(q.z), bfhi(q.z), bflo(q.w), bfhi(q.w)};
            float o[8];
#pragma unroll
            for (int e = 0; e < 8; ++e) { const float cv = bsv[e] + h[0][e] * w[0][e] + h[1][e] * w[1][e] + h[2][e] * w[2][e] + u[e] * w[3][e]; o[e] = silu_f(cv);
                h[0][e] = h[1][e]; h[1][e] = h[2][e]; h[2][e] = u[e]; }
            u32x4 ov; ov.x = cvt_pk_bf16(o[0], o[1]); ov.y = cvt_pk_bf16(o[2], o[3]); ov.z = cvt_pk_bf16(o[4], o[5]); ov.w = cvt_pk_bf16(o[6], o[7]);
            *(u32x4*)(UC + (size_t)(row0 + r) * 768 + c0) = ov;
        }
    }
}
namespace ml {
__device__ __forceinline__ int crow(int r, int hi) { return (r & 3) + 8 * (r >> 2) + 4 * hi; }
template <int NKS>
__device__ __forceinline__ f32x16 tile32(const LAS bf16_t* A, int lda, const LAS bf16_t* B, int ldb, int r32, int hi, f32x16 acc) {
    const LAS bf16_t* ap = A + r32 * lda + hi * 8; const LAS bf16_t* bp = B + r32 * ldb + hi * 8;
#pragma unroll
    for (int ks = 0; ks < NKS; ++ks) { const bf16x8 a = *(const LAS bf16x8*)(ap + ks * 16); const bf16x8 b = *(const LAS bf16x8*)(bp + ks * 16);
        acc = __builtin_amdgcn_mfma_f32_32x32x16_bf16(a, b, acc, 0, 0, 0); }
    return acc;
}
__device__ __forceinline__ float logsigmoid_f(float f) { return fminf(f, 0.f) - log1pf(__expf(-fabsf(f))); }
__device__ __forceinline__ float scan_add(float v, int lane) {
#pragma unroll
    for (int o = 1; o < 64; o <<= 1) { const float t = __shfl_up(v, o); if (lane >= o) v += t; }
    return v;
}
__device__ __forceinline__ float scan_max(float v, int lane) {
#pragma unroll
    for (int o = 1; o < 64; o <<= 1) { const float t = __shfl_up(v, o); if (lane >= o) v = fmaxf(v, t); }
    return v;
}
constexpr int P72 = 72, P104 = 104;
__device__ __forceinline__ float sum8(const u32x4 q) { return ((bflo(q.x) + bfhi(q.x)) + (bflo(q.y) + bfhi(q.y))) + ((bflo(q.z) + bfhi(q.z)) + (bflo(q.w) + bfhi(q.w))); }

__device__ __forceinline__ void pass1_unit(const Params& P, const Wk& W, LAS unsigned char* lds, int u) {
    unsigned char* ws = P.ws;
    const int bh = u >> 6, c = u & 63, b = bh >> 2, h = bh & 3, row0 = b * SEQ + c * 64;
    LAS bf16_t* vT = (LAS bf16_t*)lds;
    LAS bf16_t* kwT = (LAS bf16_t*)(lds + 27648);
    LAS float* wsl = (LAS float*)(lds + 41472);
    const float* ifp = (const float*)(ws + WS_IFP);
    const int tid = W.tid, lane = W.lane, wid = W.wave, r32 = lane & 31, hi = lane >> 5;
    if (wid == 0) {
        const float li = ifp[(size_t)(row0 + lane) * 8 + h], f = ifp[(size_t)(row0 + lane) * 8 + 4 + h];
        const float bcs = scan_add(logsigmoid_f(f), lane);
        const float bL = __shfl(bcs, 63);
        const float dec = bL - bcs + li;
        const float mloc = wave_max(dec);
        wsl[lane] = __expf(dec - mloc);
        if (lane == 0) { ((float*)(ws + WS_BL))[u] = bL; ((float*)(ws + WS_MLOC))[u] = mloc; }
    }
    __syncthreads();
    const bf16_t* QK = (const bf16_t*)(ws + WS_QK); const bf16_t* VV = (const bf16_t*)(ws + WS_VV);
    {
        u32x4 q[5];
#pragma unroll
        for (int i = 0; i < 5; ++i) { const int id = tid + 512 * i;
            if (id < 768) q[i] = *(const u32x4*)(QK + (size_t)(row0 + (id & 63)) * 768 + h * 192 + 96 + (id >> 6) * 8);
            else if (id < 2304) q[i] = *(const u32x4*)(VV + (size_t)(row0 + (id & 63)) * 768 + h * 192 + ((id - 768) >> 6) * 8); }
#pragma unroll
        for (int i = 0; i < 5; ++i) { const int id = tid + 512 * i, row = id & 63;
            if (id < 768) { const int cc = id >> 6; const float wv = wsl[row];
                const float e[8] = {bflo(q[i].x), bfhi(q[i].x), bflo(q[i].y), bfhi(q[i].y), bflo(q[i].z), bfhi(q[i].z), bflo(q[i].w), bfhi(q[i].w)};
#pragma unroll
                for (int j = 0; j < 8; ++j) kwT[(cc * 8 + j) * P72 + row] = f2bf(e[j] * wv);
            } else if (id < 2304) { const int cc = (id - 768) >> 6;
                const unsigned short e[8] = {(unsigned short)(q[i].x & 0xffff), (unsigned short)(q[i].x >> 16), (unsigned short)(q[i].y & 0xffff), (unsigned short)(q[i].y >> 16), (unsigned short)(q[i].z & 0xffff), (unsigned short)(q[i].z >> 16), (unsigned short)(q[i].w & 0xffff), (unsigned short)(q[i].w >> 16)};
#pragma unroll
                for (int j = 0; j < 8; ++j) vT[(cc * 8 + j) * P72 + row] = e[j]; }
        }
    }
    __syncthreads();
    bf16_t* DC = (bf16_t*)(ws + WS_DC) + (size_t)u * (192 * 96);
    for (int tt = wid; tt < 18; tt += 8) {
        const int mt = tt / 3, nt = tt % 3;
        f32x16 acc = f32x16{};
        acc = tile32<4>(vT + mt * 32 * P72, P72, kwT + nt * 32 * P72, P72, r32, hi, acc);
#pragma unroll
        for (int r = 0; r < 16; ++r) DC[(mt * 32 + crow(r, hi)) * 96 + nt * 32 + r32] = f2bf(acc[r]);
    }
    if (tid < 384) { const int dk = tid >> 2, sub = tid & 3;
        float s = sum8(*(const LAS u32x4*)(kwT + dk * P72 + sub * 8)) + sum8(*(const LAS u32x4*)(kwT + dk * P72 + (sub + 4) * 8));
        s += __shfl_xor(s, 1); s += __shfl_xor(s, 2);
        if (sub == 0) ((float*)(ws + WS_DN))[(size_t)u * 96 + dk] = s; }
    __syncthreads();
}

__device__ __forceinline__ void pass2(const Params& P, const Wk& W) {
    unsigned char* ws = P.ws;
    const float* BL = (const float*)(ws + WS_BL); const float* ML = (const float*)(ws + WS_MLOC); float* MST = (float*)(ws + WS_MST);
    const int gt = W.vcu * 512 + W.tid, NGT = W.G * 512;
    constexpr int NCE = 32 * 2304, NNE = 32 * 96;
    for (int g = gt; g < NCE + NNE; g += NGT) {
        if (g < NCE) {
            const int bh = g / 2304, e = g % 2304;
            float C[8]; float m = 0.f;
#pragma unroll
            for (int j = 0; j < 8; ++j) C[j] = 0.f;
            u32x4* base = (u32x4*)((bf16_t*)(ws + WS_DC) + (size_t)bh * 64 * 18432 + e * 8);
            for (int c0 = 0; c0 < 64; c0 += 8) {
                u32x4 d[8]; float bL[8], ml[8];
#pragma unroll
                for (int j = 0; j < 8; ++j) { d[j] = base[(size_t)(c0 + j) * (18432 / 8)]; bL[j] = BL[bh * 64 + c0 + j]; ml[j] = ML[bh * 64 + c0 + j]; }
#pragma unroll
                for (int j = 0; j < 8; ++j) {
                    u32x4 o; o.x = cvt_pk_bf16(C[0], C[1]); o.y = cvt_pk_bf16(C[2], C[3]); o.z = cvt_pk_bf16(C[4], C[5]); o.w = cvt_pk_bf16(C[6], C[7]);
                    base[(size_t)(c0 + j) * (18432 / 8)] = o;
                    if (e == 0) MST[bh * 64 + c0 + j] = m;
                    const float mn = fmaxf(bL[j] + m, ml[j]), a = __expf(bL[j] + m - mn), w = __expf(ml[j] - mn);
                    C[0] = a * C[0] + w * bflo(d[j].x); C[1] = a * C[1] + w * bfhi(d[j].x); C[2] = a * C[2] + w * bflo(d[j].y); C[3] = a * C[3] + w * bfhi(d[j].y);
                    C[4] = a * C[4] + w * bflo(d[j].z); C[5] = a * C[5] + w * bfhi(d[j].z); C[6] = a * C[6] + w * bflo(d[j].w); C[7] = a * C[7] + w * bfhi(d[j].w);
                    m = mn;
                }
            }
        } else {
            const int g2 = g - NCE, bh = g2 / 96, e = g2 % 96;
            float n = 0.f, m = 0.f; float* base = (float*)(ws + WS_DN) + (size_t)bh * 64 * 96 + e;
            for (int c0 = 0; c0 < 64; c0 += 8) { float d[8], bL[8], ml[8];
#pragma unroll
                for (int j = 0; j < 8; ++j) { d[j] = base[(c0 + j) * 96]; bL[j] = BL[bh * 64 + c0 + j]; ml[j] = ML[bh * 64 + c0 + j]; }
#pragma unroll
                for (int j = 0; j < 8; ++j) { base[(c0 + j) * 96] = n; const float mn = fmaxf(bL[j] + m, ml[j]), a = __expf(bL[j] + m - mn), w = __expf(ml[j] - mn); n = a * n + w * d[j]; m = mn; } }
        }
    }
}

__device__ __forceinline__ void pass3_phase(const Params& P, const Wk& W, LAS unsigned char* lds) {
    unsigned char* ws = P.ws;
    LAS bf16_t* Qs = (LAS bf16_t*)lds;
    LAS bf16_t* Ks = (LAS bf16_t*)(lds + 13312);
    LAS bf16_t* vT = (LAS bf16_t*)(lds + 26624);
    LAS bf16_t* CT = (LAS bf16_t*)(lds + 54272);
    LAS bf16_t* Ps = (LAS bf16_t*)(lds + 94208);
    LAS float* Hs = (LAS float*)lds;
    LAS float* sm = (LAS float*)(lds + 103424);
    LAS float* g_s = sm, *Mt = sm + 64, *wint = sm + 128, *eneg = sm + 192, *qn = sm + 256, *rden = sm + 320, *nvec = sm + 384;
    const float* ifp = (const float*)(ws + WS_IFP);
    const bf16_t* QK = (const bf16_t*)(ws + WS_QK); const bf16_t* VV = (const bf16_t*)(ws + WS_VV);
    const int tid = W.tid, lane = W.lane, wid = W.wave, r32 = lane & 31, hi = lane >> 5;
    int u = W.vcu; if (u >= 2048) return;
    u32x4 qa[3], qb[3], qc[5]; float pli = 0.f, pf = 0.f, pm = 0.f, pn = 0.f;
#define P3_LOAD(uu) do { const int bh_ = (uu) >> 6, c_ = (uu) & 63, b_ = bh_ >> 2, h_ = bh_ & 3, row0_ = b_ * SEQ + c_ * 64; \
        const char* CS_ = (const char*)(ws + WS_DC) + (size_t)(uu) * (192 * 96 * 2); \
        _Pragma("unroll") for (int i = 0; i < 3; ++i) { const int id = tid + 512 * i; \
            { const int which = id / 768, i2 = id % 768, row = i2 / 12, cc = i2 % 12; qa[i] = *(const u32x4*)((const char*)QK + (unsigned)(((row0_ + row) * 768 + h_ * 192 + which * 96 + cc * 8) * 2)); } \
            { const int cc = id >> 6, row = id & 63; qb[i] = *(const u32x4*)((const char*)VV + (unsigned)(((row0_ + row) * 768 + h_ * 192 + cc * 8) * 2)); } } \
        _Pragma("unroll") for (int i = 0; i < 5; ++i) { const int id = tid + 512 * i; if (id < 2304) qc[i] = *(const u32x4*)(CS_ + (unsigned)(id * 16)); } \
        if (wid == 0) { pm = ((const float*)(ws + WS_MST))[uu]; pli = *(const float*)((const char*)ifp + (unsigned)(((row0_ + lane) * 8 + h_) * 4)); pf = *(const float*)((const char*)ifp + (unsigned)(((row0_ + lane) * 8 + 4 + h_) * 4)); } \
        if (tid < 96) pn = *(const float*)((const char*)(ws + WS_DN) + (unsigned)(((uu) * 96 + tid) * 4)); } while (0)
    P3_LOAD(u);
    for (;;) {
        const int bh = u >> 6, c = u & 63, b = bh >> 2, h = bh & 3, row0 = b * SEQ + c * 64;
        const int un = u + W.G;
        if (wid == 0) {
            const float bcs = scan_add(logsigmoid_f(pf), lane);
            const float g = pli - bcs;
            const float pmx = scan_max(g, lane);
            const float M = fmaxf(pm, pmx);
            g_s[lane] = g; Mt[lane] = M; wint[lane] = __expf(pm - M); eneg[lane] = __expf(-bcs - M);
        }
#pragma unroll
        for (int i = 0; i < 3; ++i) { const int id = tid + 512 * i;
            { const int which = id / 768, i2 = id % 768, row = i2 / 12, cc = i2 % 12; *(LAS u32x4*)((which ? Ks : Qs) + row * P104 + cc * 8) = qa[i]; }
            { const int cc = id >> 6, row = id & 63;
              const unsigned short e[8] = {(unsigned short)(qb[i].x & 0xffff), (unsigned short)(qb[i].x >> 16), (unsigned short)(qb[i].y & 0xffff), (unsigned short)(qb[i].y >> 16), (unsigned short)(qb[i].z & 0xffff), (unsigned short)(qb[i].z >> 16), (unsigned short)(qb[i].w & 0xffff), (unsigned short)(qb[i].w >> 16)};
#pragma unroll
              for (int j = 0; j < 8; ++j) vT[(cc * 8 + j) * P72 + row] = e[j]; } }
#pragma unroll
        for (int i = 0; i < 5; ++i) { const int id = tid + 512 * i; if (id < 2304) { const int dv = id / 12, cc = id % 12; *(LAS u32x4*)(CT + dv * P104 + cc * 8) = qc[i]; } }
        if (tid < 96) nvec[tid] = pn;
        __syncthreads();
        if (un < 2048) P3_LOAD(un);
        __builtin_amdgcn_sched_barrier(0);
        if (wid < 4) {
            const int mt = wid >> 1, nt = wid & 1;
            f32x16 acc = f32x16{};
            acc = tile32<6>(Qs + mt * 32 * P104, P104, Ks + nt * 32 * P104, P104, r32, hi, acc);
            if (c == 0 && wid == 0 && lane == 0) acc[0] = ((const float*)(ws + WS_C0))[bh];
            const int s = nt * 32 + r32; const float gs = g_s[s];
#pragma unroll
            for (int r = 0; r < 16; ++r) { const int t = mt * 32 + crow(r, hi);
                const float w = (s <= t) ? __expf(gs - Mt[t]) : 0.f;
                Ps[t * P72 + s] = f2bf(acc[r] * w); }
        } else {
            const int t = (tid - 256) >> 2, sub = tid & 3; float a = 0.f;
#pragma unroll
            for (int j = 0; j < 3; ++j) { const int cc = sub + 4 * j; const u32x4 q = *(const LAS u32x4*)(Qs + t * P104 + cc * 8); const LAS float* nv = nvec + cc * 8;
                a += (bflo(q.x) * nv[0] + bfhi(q.x) * nv[1]) + (bflo(q.y) * nv[2] + bfhi(q.y) * nv[3]) + (bflo(q.z) * nv[4] + bfhi(q.z) * nv[5]) + (bflo(q.w) * nv[6] + bfhi(q.w) * nv[7]); }
            a += __shfl_xor(a, 1); a += __shfl_xor(a, 2);
            if (sub == 0) qn[t] = a;
        }
        __syncthreads();
        { const int t = tid >> 3, sub = tid & 7;
          float rs = sum8(*(const LAS u32x4*)(Ps + t * P72 + sub * 8));
          rs += __shfl_xor(rs, 1); rs += __shfl_xor(rs, 2); rs += __shfl_xor(rs, 4);
          if (sub == 0) { float den = wint[t] * qn[t] + rs; den = fmaxf(fabsf(den), eneg[t]); rden[t] = 1.f / den; } }
        const int te = tid >> 3, sube = tid & 7;
        const bf16_t* G2 = (const bf16_t*)(ws + WS_G) + (size_t)(row0 + te) * G2W; const bf16_t* UC = (const bf16_t*)(ws + WS_UC) + (size_t)(row0 + te) * 768;
        u32x4 eop[3], egq[3], euq[3];
#pragma unroll
        for (int j = 0; j < 3; ++j) { const int col = h * 192 + (sube + 8 * j) * 8; eop[j] = *(const u32x4*)(G2 + G2_O + col); egq[j] = *(const u32x4*)(G2 + G2_GATE + col); euq[j] = *(const u32x4*)(UC + col); }
        f32x16 accA = f32x16{}, accB = f32x16{};
        {
            const int tt = wid, mt = tt / 6, nt = tt % 6;
            accA = tile32<6>(Qs + mt * 32 * P104, P104, CT + nt * 32 * P104, P104, r32, hi, accA);
#pragma unroll
            for (int r = 0; r < 16; ++r) accA[r] *= wint[mt * 32 + crow(r, hi)];
            accA = tile32<4>(Ps + mt * 32 * P72, P72, vT + nt * 32 * P72, P72, r32, hi, accA);
        }
        if (wid < 4) {
            const int tt = wid + 8, mt = tt / 6, nt = tt % 6;
            accB = tile32<6>(Qs + mt * 32 * P104, P104, CT + nt * 32 * P104, P104, r32, hi, accB);
#pragma unroll
            for (int r = 0; r < 16; ++r) accB[r] *= wint[mt * 32 + crow(r, hi)];
            accB = tile32<4>(Ps + mt * 32 * P72, P72, vT + nt * 32 * P72, P72, r32, hi, accB);
        }
        __syncthreads();
        {
            const int tt = wid, mt = tt / 6, nt = tt % 6;
#pragma unroll
            for (int r = 0; r < 16; ++r) { const int t = mt * 32 + crow(r, hi); Hs[t * 196 + nt * 32 + r32] = accA[r] * rden[t]; }
        }
        if (wid < 4) {
            const int tt = wid + 8, mt = tt / 6, nt = tt % 6;
#pragma unroll
            for (int r = 0; r < 16; ++r) { const int t = mt * 32 + crow(r, hi); Hs[t * 196 + nt * 32 + r32] = accB[r] * rden[t]; }
        }
        __syncthreads();
        __builtin_amdgcn_sched_barrier(0);
        {
            float hv[3][8]; float ss = 0.f;
#pragma unroll
            for (int j = 0; j < 3; ++j) { const int col = (sube + 8 * j) * 8;
                const f32x4 a = *(const LAS f32x4*)(Hs + te * 196 + col), bq = *(const LAS f32x4*)(Hs + te * 196 + col + 4);
                hv[j][0] = a.x; hv[j][1] = a.y; hv[j][2] = a.z; hv[j][3] = a.w; hv[j][4] = bq.x; hv[j][5] = bq.y; hv[j][6] = bq.z; hv[j][7] = bq.w;
#pragma unroll
                for (int e = 0; e < 8; ++e) ss += hv[j][e] * hv[j][e]; }
            ss += __shfl_xor(ss, 1); ss += __shfl_xor(ss, 2); ss += __shfl_xor(ss, 4);
            const float rstd = rsqrtf(ss * (1.f / 192.f) + EPS);
            bf16_t* Y = (bf16_t*)(ws + WS_Y2) + (size_t)(row0 + te) * DM;
#pragma unroll
            for (int j = 0; j < 3; ++j) { const int col = h * 192 + (sube + 8 * j) * 8;
                const u32x4 op = eop[j], gq = egq[j], uq = euq[j];
                const float ov[8] = {bflo(op.x), bfhi(op.x), bflo(op.y), bfhi(op.y), bflo(op.z), bfhi(op.z), bflo(op.w), bfhi(op.w)};
                const float gv[8] = {bflo(gq.x), bfhi(gq.x), bflo(gq.y), bfhi(gq.y), bflo(gq.z), bfhi(gq.z), bflo(gq.w), bfhi(gq.w)};
                const float uv[8] = {bflo(uq.x), bfhi(uq.x), bflo(uq.y), bfhi(uq.y), bflo(uq.z), bfhi(uq.z), bflo(uq.w), bfhi(uq.w)};
                float o[8];
#pragma unroll
                for (int e = 0; e < 8; ++e) { const float hn = hv[j][e] * rstd * P.b_head_g[col + e]; const float mix = sigmoid_f(ov[e]) * hn + P.b_skip[col + e] * uv[e]; o[e] = mix * silu_f(gv[e]); }
                u32x4 w; w.x = cvt_pk_bf16(o[0], o[1]); w.y = cvt_pk_bf16(o[2], o[3]); w.z = cvt_pk_bf16(o[4], o[5]); w.w = cvt_pk_bf16(o[6], o[7]);
                *(u32x4*)(Y + col) = w; }
        }
        __syncthreads();
        if (un >= 2048) break;
        u = un;
    }
#undef P3_LOAD
}
}
typedef GAS unsigned gu32;
#define XB_TMO      128
#define XB_XCNT(j)  (256  + 64 * (j))
#define XB_XSUB(j)  (1280 + 64 * (j))
#define XB_XGEN(j)  (2304 + 64 * (j))
#define XB_TOP      3328
#define XB_TOPGEN   3392
#define XCD_BAR_WORDS 3456
#define XB_SPIN_CAP (1u << 18)
__device__ __forceinline__ unsigned xb_ld(unsigned* p)              { return __hip_atomic_load(p, __ATOMIC_RELAXED, __HIP_MEMORY_SCOPE_AGENT); }
__device__ __forceinline__ unsigned xb_add(unsigned* p, unsigned v) { return __hip_atomic_fetch_add(p, v, __ATOMIC_RELAXED, __HIP_MEMORY_SCOPE_AGENT); }
__device__ __forceinline__ unsigned xb_xcc_id() { return (unsigned)__builtin_amdgcn_s_getreg((3 << 11) | 20) & 0xFu; }
#define XB_SPIN(cond, bar) do { unsigned _sp = 0; while (cond) { __builtin_amdgcn_s_sleep(1); \
    if ((++_sp & 255u) == 0u) { if (xb_ld(&(bar)[XB_TMO])) break; if (_sp > XB_SPIN_CAP) { atomicAdd(&(bar)[XB_TMO], 1u); break; } } } } while (0)
struct XcdBarrier { unsigned* bar; unsigned x; volatile LAS unsigned* st; };
__device__ __forceinline__ XcdBarrier xcd_barrier_post(unsigned* bar, volatile LAS unsigned* st) {
    XcdBarrier b; b.bar = bar; b.x = xb_xcc_id(); b.st = st;
    if (threadIdx.x == 0) (void)xb_add(&bar[XB_XCNT(b.x)], 1u);
    return b;
}
__device__ __forceinline__ void xcd_barrier_complete(unsigned* bar, unsigned x, unsigned& nloc, unsigned& nx) {
    const unsigned G = gridDim.x * gridDim.y * gridDim.z;
    unsigned sum, cnt, mine, sp = 0u;
    for (;;) {
        sum = 0u; cnt = 0u; mine = 0u;
#pragma unroll
        for (unsigned j = 0; j < 16; ++j) { const unsigned c = xb_ld(&bar[XB_XCNT(j)]); sum += c; cnt += (c > 0u) ? 1u : 0u; mine = (j == x) ? c : mine; }
        if (sum == G) break;
        __builtin_amdgcn_s_sleep(1);
        if ((++sp & 255u) == 0u) { if (xb_ld(&bar[XB_TMO])) break; if (sp > XB_SPIN_CAP) { atomicAdd(&bar[XB_TMO], 1u); break; } }
    }
    nloc = mine > 0u ? mine : 1u; nx = cnt > 0u ? cnt : 1u;
}
__device__ __forceinline__ void xcd_barrier(const XcdBarrier& b) {
    asm volatile("s_waitcnt vmcnt(0)" ::: "memory");
    __syncthreads();
    if (threadIdx.x == 0) {
        unsigned* bar = b.bar;
        __builtin_amdgcn_s_waitcnt(0);
        unsigned nloc = b.st[0], nx = b.st[1];
        if (nloc == 0u) { xcd_barrier_complete(bar, b.x, nloc, nx); b.st[0] = nloc; b.st[1] = nx; }
        const unsigned old = xb_add(&bar[XB_XSUB(b.x)], 1u);
        const unsigned gen = old / nloc;
        if (old + 1u == (gen + 1u) * nloc) {
            __builtin_amdgcn_fence(__ATOMIC_RELEASE, "agent");
            asm volatile("s_waitcnt vmcnt(0)" ::: "memory");
            const unsigned og = xb_add(&bar[XB_TOP], 1u);
            const unsigned tg = og / nx;
            if (og + 1u == (tg + 1u) * nx) xb_add(&bar[XB_TOPGEN], 1u);
            else XB_SPIN(xb_ld(&bar[XB_TOPGEN]) == tg, bar);
            __builtin_amdgcn_fence(__ATOMIC_ACQUIRE, "agent");
            xb_add(&bar[XB_XGEN(b.x)], 1u);
            asm volatile("s_waitcnt vmcnt(0)" ::: "memory");
        } else {
            XB_SPIN(xb_ld(&bar[XB_XGEN(b.x)]) == gen, bar);
            __builtin_amdgcn_fence(__ATOMIC_ACQUIRE, "agent");
            asm volatile("s_waitcnt vmcnt(0)" ::: "memory");
        }
    }
    __syncthreads();
}

constexpr int RING_BYTES = 131072, LDSCTL_OFF = RING_BYTES, LDS_BYTES = 147456;
constexpr int CW_BAR = 4096;
constexpr int N_PHASES = 14;

__device__ __forceinline__ void setup_job(const Params& P, int j, pg8::Gemm& g, pg8::Epi& E) {
    unsigned char* ws = P.ws;
    E.out = nullptr; E.ldc = 0; E.ncols = 1 << 30; E.out2 = nullptr; E.ldc2 = 0; E.split = 1 << 30; E.rs = nullptr; E.rs_mode = 0; E.rs_invdim = 0.f;
    E.ssqA = nullptr; E.ssqB = nullptr; E.ssq_mode = 0; E.rope = (const float2*)(ws + WS_ROPE); E.rope_mode = 0;
    g.M = T; g.lda = 1024; g.apn = 0;
    switch (j) {
    case 0: g.A = (const bf16_t*)(ws + WS_XB); g.Bt = (const bf16_t*)(ws + WS_WINA); g.N = 2048; g.K = 1024;
        E.out = (bf16_t*)(ws + WS_G); E.ldc = G1W; E.rs = (const float*)(ws + WS_RSTD); E.rs_mode = 1; E.ssqA = (float*)(ws + WS_SSQA); E.ssqB = (float*)(ws + WS_SSQB); E.ssq_mode = 1; E.rope_mode = 1; break;
    case 1: g.A = (const bf16_t*)(ws + WS_MEMN); g.Bt = (const bf16_t*)(ws + WS_WMKV); g.M = NB * NMEM; g.N = 1024; g.K = 1024;
        E.out = (bf16_t*)(ws + WS_KVM); E.ldc = 1024; break;
    case 2: g.A = (const bf16_t*)(ws + WS_G) + G1_CQ; g.lda = G1W; g.Bt = (const bf16_t*)(ws + WS_WUQ); g.N = 1280; g.K = 384;
        E.out = (bf16_t*)(ws + WS_Q); E.ldc = QW; E.ncols = QW; E.rs = (const float*)(ws + WS_SSQA); E.rs_mode = 2; E.rs_invdim = 1.f / 384.f; E.rope_mode = 2; break;
    case 3: g.A = (const bf16_t*)(ws + WS_G) + G1_CKV; g.lda = G1W; g.Bt = (const bf16_t*)(ws + WS_WUKV); g.N = 1536; g.K = 256;
        E.out = (bf16_t*)(ws + WS_KN); E.ldc = 768; E.out2 = (bf16_t*)(ws + WS_V); E.ldc2 = 768; E.split = 768; E.rs = (const float*)(ws + WS_SSQB); E.rs_mode = 2; E.rs_invdim = 1.f / 256.f; break;
    case 4: g.A = (const bf16_t*)(ws + WS_Y); g.Bt = (const bf16_t*)(ws + WS_WOA); g.N = 1024; g.K = 1024; E.out = (bf16_t*)(ws + WS_Z); E.ldc = 1024; break;
    case 5: g.A = (const bf16_t*)(ws + WS_XB); g.Bt = (const bf16_t*)(ws + WS_WINB); g.N = G2W; g.K = 1024;
        E.out = (bf16_t*)(ws + WS_G); E.ldc = G2W; E.rs = (const float*)(ws + WS_RSTD); E.rs_mode = 1; break;
    case 6: g.A = (const bf16_t*)(ws + WS_UC); g.lda = 768; g.apn = 192; g.Bt = (const bf16_t*)(ws + WS_WQK); g.N = 768; g.K = 384; E.out = (bf16_t*)(ws + WS_QK); E.ldc = 768; break;
    case 7: g.A = (const bf16_t*)(ws + WS_G) + G2_U; g.lda = G2W; g.apn = 192; g.Bt = (const bf16_t*)(ws + WS_WV); g.N = 768; g.K = 384; E.out = (bf16_t*)(ws + WS_VV); E.ldc = 768; break;
    default: g.A = (const bf16_t*)(ws + WS_Y2); g.Bt = (const bf16_t*)(ws + WS_WOB); g.N = 1024; g.K = 1024; E.out = (bf16_t*)(ws + WS_Z); E.ldc = 1024; break;
    }
}

__device__ __forceinline__ void phase_memattn(const Params& P, const Wk& W, LAS unsigned char* lds, int L) {
    unsigned char* ws = P.ws;
    const bf16_t* G = (const bf16_t*)(ws + WS_G); const bf16_t* KVM = (const bf16_t*)(ws + WS_KVM);
    const int gpitch = L ? G2W : G1W, qm_off = L ? G2_QM : G1_QM, gate_off = L ? G2_GATE : G1_GATE;
    bf16_t* Yb = (bf16_t*)(ws + (L ? WS_Y2 : WS_Y));
    for (int u = W.vcu; u < 512; u += W.G) {
        const int rb = u >> 2, hm = u & 3, row0 = rb * 256, b = row0 / SEQ;
        const bf16_t* Km = KVM + (size_t)(b * NMEM) * 1024 + L * 512 + hm * 64;
        att::attn_unit<64, 64, false>(G + (size_t)row0 * gpitch + qm_off + hm * 64, gpitch, Km, 1024, 8, Km, 1024, Km + 256, 1024, 4, 0,
                                      G + (size_t)row0 * gpitch + gate_off + 768 + hm * 64, gpitch, Yb + (size_t)row0 * DM + 768 + hm * 64, DM, lds, W.tid);
    }
}
template <int ABL>
__device__ __forceinline__ void phase_attn(const Params& P, const Wk& W, LAS unsigned char* lds) {
    unsigned char* ws = P.ws;
    const bf16_t* G = (const bf16_t*)(ws + WS_G); const bf16_t* Qp = (const bf16_t*)(ws + WS_Q); const bf16_t* KN = (const bf16_t*)(ws + WS_KN); const bf16_t* Vp = (const bf16_t*)(ws + WS_V);
    bf16_t* Yb = (bf16_t*)(ws + (ABL ? WS_Z : WS_Y));
    for (int u = W.vcu; u < 768; u += W.G) {
        const int k = u >> 8, cu = u & 255, grp = cu >> 4, i = cu & 15, bh = grp * 3 + k;
        const int qb = (k == 0) ? i : (k == 1) ? ((i + 8) & 15) : (i < 8 ? 15 - 2 * i : 30 - 2 * i);
        const int b = bh / 6, h = bh % 6; const size_t rowb = (size_t)b * SEQ, row0 = rowb + (size_t)qb * 256;
        att::attn_unit<192, 128, true, ABL>(Qp + row0 * QW + h * 192, QW, KN + rowb * 768 + h * 128, 768, 16, G + rowb * G1W + G1_KR, G1W, Vp + rowb * 768 + h * 128, 768,
                                       4 * (qb + 1), qb * 256, G + row0 * G1W + G1_GATE + h * 128, G1W, Yb + row0 * DM + h * 128, DM, lds, W.tid);
    }
}

__global__ void __launch_bounds__(512, 2) mega_fwd(Params P) {
    extern __shared__ __attribute__((aligned(16))) unsigned char lds_raw[];
    LAS unsigned char* lds = (LAS unsigned char*)lds_raw;
    Wk W; W.tid = threadIdx.x; W.lane = W.tid & 63; W.wave = __builtin_amdgcn_readfirstlane(W.tid >> 6);
    W.G = gridDim.x; { const int bx = blockIdx.x; W.vcu = (W.G % 8 == 0) ? (bx % 8) * (W.G / 8) + bx / 8 : bx; }
    volatile LAS unsigned* MISC = (volatile LAS unsigned*)(lds + LDSCTL_OFF);
    if (W.tid < 64) MISC[W.tid] = 0u;
    __syncthreads();
    const int lo = P.ph_lo, hi = P.ph_hi;
    const int vcu_s = W.vcu;
    const int wave_s = __builtin_amdgcn_readfirstlane(threadIdx.x >> 6);
    XcdBarrier bar; bar.bar = (unsigned*)(P.ws + WS_CTL) + CW_BAR; bar.x = 0; bar.st = nullptr;
    if (hi - lo > 1) bar = xcd_barrier_post((unsigned*)(P.ws + WS_CTL) + CW_BAR, MISC + 8);
#ifndef PROBE_REP
#define PROBE_REP 0
#endif
    for (int ph2 = 2 * lo; ph2 < 2 * hi; ++ph2) {
        const int ph = ph2 >> 1;
        if ((ph2 & 1) && !((PROBE_REP >> ph) & 1)) continue;
        const bool more_ = (ph + 1 < hi) || (!(ph2 & 1) && ((PROBE_REP >> ph) & 1));
        { int t_; asm volatile("v_mbcnt_lo_u32_b32 %0, -1, 0\n\tv_mbcnt_hi_u32_b32 %0, -1, %0" : "=v"(t_)); t_ += wave_s * 64; { int g_ = gridDim.x, v_ = vcu_s; asm volatile("" : "+s"(g_), "+s"(v_)); W.G = g_; W.vcu = v_; } W.tid = t_; W.lane = t_ & 63; W.wave = __builtin_amdgcn_readfirstlane(t_ >> 6); }
        int j0 = 0, j1 = 0;
#ifdef DBG_CUT
        if (ph == 100) { const bf16_t* src = (const bf16_t*)(P.ws + (size_t)DBG_OFF); const int gt_ = W.vcu * 512 + W.tid, NGT_ = W.G * 512; for (int i = gt_; i < T * DM; i += NGT_) {
#ifdef DBG_F32N
            P.out[i] = (i < DBG_F32N) ? ((const float*)src)[i] : 0.f;
#else
            P.out[i] = bf2f(src[i]);
#endif
            } continue; }
#endif
#ifndef PHM
#define PHM 0xffff
#endif
#define PHON(k) ((PHM >> (k)) & 1)
        switch (ph) {
        case 0: if (PHON(0)) phase_prologue(P, W, lds); break;
        case 1: j0 = 0; j1 = 2; break;
        case 2: j0 = 2; j1 = 4; break;
        case 3: if (PHON(3)) {
#ifdef PROBE_ABL
            if (ph2 & 1) phase_attn<PROBE_ABL>(P, W, lds); else
#endif
            phase_attn<0>(P, W, lds); } break;
        case 4: j0 = 4; j1 = 5; break;
        case 5: if (PHON(5)) phase_rowmid(P, W, lds); break;
        case 6: j0 = 5; j1 = 6; break;
        case 7: if (PHON(7)) { first_token_u0(P, W, lds); phase_conv(P, W); } break;
        case 8: j0 = 6; j1 = 8; break;
        case 9: if (PHON(9)) for (int u = W.vcu; u < 2048; u += W.G) ml::pass1_unit(P, W, lds, u); break;
        case 10: if (PHON(10)) { ml::pass2(P, W); first_token_qk(P, W, lds); } break;
        case 11: if (PHON(11)) ml::pass3_phase(P, W, lds); break;
        case 12: j0 = 8; j1 = 9; break;
        default: if (PHON(13)) phase_rowfinal(P, W); break;
        }
        if (PHON(14) && (ph == 3 || ph == 9) && !(ph2 & 1)) phase_memattn(P, W, lds, ph == 9 ? 1 : 0);
        if (PHON(1)) for (int j = j0; j < j1; ++j) {
            pg8::Gemm g; pg8::Epi E; setup_job(P, j, g, E);
            pg8::StaticOrder S; S.init(g.M, g.N, W.G, (int)blockIdx.x);
            pg8::gemm_phase<true>(lds, g, S, E, W.tid);
        }
        if (more_) xcd_barrier(bar);
    }
}

extern "C" void kernel_launch(void* const* d_in, const int* in_sizes, int n_in, void* d_out, int out_size, void* d_ws, size_t ws_size, hipStream_t stream) {
    static int grid = 0;
    if (grid == 0) {
        if (n_in != 27 || in_sizes[0] != T * DM || out_size != T * DM || ws_size < WS_END) {
            fprintf(stderr, "kernel_launch: unexpected shapes (n_in %d in0 %d out %d ws %zu)\n", n_in, n_in > 0 ? in_sizes[0] : -1, out_size, ws_size); grid = -1; return; }
        int dev = 0, cus = 0, per_cu = 0;
        if (hipGetDevice(&dev) != hipSuccess || hipDeviceGetAttribute(&cus, hipDeviceAttributeMultiprocessorCount, dev) != hipSuccess) { grid = -1; return; }
        if (hipFuncSetAttribute((const void*)mega_fwd, hipFuncAttributeMaxDynamicSharedMemorySize, LDS_BYTES) != hipSuccess) { fprintf(stderr, "kernel_launch: hipFuncSetAttribute failed\n"); grid = -1; return; }
        if (hipOccupancyMaxActiveBlocksPerMultiprocessor(&per_cu, (const void*)mega_fwd, 512, LDS_BYTES) != hipSuccess || per_cu < 1) { fprintf(stderr, "kernel_launch: occupancy query says %d\n", per_cu); }
        (void)hipGetLastError();
        grid = cus;
    }
    if (grid < 0) return;
    (void)hipMemsetAsync((char*)d_ws + WS_CTL, 0, CTL_ZERO_BYTES, stream);
    Params p{};
    const float** fp = (const float**)&p.a_pre_g;
    p.x = (const float*)d_in[0]; p.mem = (const float*)d_in[1]; p.pos = (const int*)d_in[2];
    for (int i = 0; i < 24; ++i) fp[i] = (const float*)d_in[3 + i];
    p.out = (float*)d_out; p.ws = (unsigned char*)d_ws;
#ifndef N_LAUNCH_SPLIT
#define N_LAUNCH_SPLIT 1
#endif
#ifdef DBG_CUT
    for (int ph = 0; ph < DBG_CUT; ++ph) { p.ph_lo = ph; p.ph_hi = ph + 1; hipLaunchKernelGGL(mega_fwd, dim3(grid), dim3(512), LDS_BYTES, stream, p); }
    p.ph_lo = 100; p.ph_hi = 101; hipLaunchKernelGGL(mega_fwd, dim3(grid), dim3(512), LDS_BYTES, stream, p);
#elif N_LAUNCH_SPLIT
    for (int ph = 0; ph < N_PHASES; ++ph) { p.ph_lo = ph; p.ph_hi = ph + 1; hipLaunchKernelGGL(mega_fwd, dim3(grid), dim3(512), LDS_BYTES, stream, p); }
#else
    p.ph_lo = 0; p.ph_hi = N_PHASES; hipLaunchKernelGGL(mega_fwd, dim3(grid), dim3(512), LDS_BYTES, stream, p);
#endif
}
```

```cpp
#define N_LAUNCH_SPLIT 0
#include <hip/hip_runtime.h>
#include <cstdio>
#include <cstdint>

#define LAS __attribute__((address_space(3)))
#define GAS __attribute__((address_space(1)))
typedef unsigned short bf16_t;
typedef short bf16x8 __attribute__((ext_vector_type(8)));
typedef short s16x4 __attribute__((ext_vector_type(4)));
typedef float f32x4 __attribute__((ext_vector_type(4)));
typedef float f32x16 __attribute__((ext_vector_type(16)));
typedef unsigned u32x4 __attribute__((ext_vector_type(4)));
typedef unsigned u32x2 __attribute__((ext_vector_type(2)));

constexpr int NB = 8, SEQ = 4096, DM = 1024, T = NB * SEQ;
constexpr int NMEM = 256;
constexpr float EPS = 1e-6f;
constexpr int A_IN = 1984, B_IN = 2824;
constexpr int G1W = 2048;
constexpr int G1_CKV = 0, G1_CQ = 256, G1_KR = 640, G1_QM = 768, G1_GATE = 1024;
constexpr int G2W = 2816;
constexpr int G2_U = 0, G2_O = 768, G2_QM = 1536, G2_GATE = 1792;
constexpr int QW = 1152;
constexpr float LOG2E = 1.4426950408889634f;
constexpr float QSCALE = 0.07216878364870323f * LOG2E;
constexpr float MSCALE = 0.125f * LOG2E;
constexpr float KSCALE_B = 0.10206207261596577f;

constexpr size_t MiB = 1u << 20;
constexpr size_t WS_CTL = 0, CTL_ZERO_BYTES = 64 * 1024;
constexpr size_t WS_WINA = 2 * MiB;
constexpr size_t WS_WUQ = 6 * MiB;
constexpr size_t WS_WUKV = 7 * MiB;
constexpr size_t WS_WMKV = 8 * MiB;
constexpr size_t WS_WOA = 10 * MiB;
constexpr size_t WS_WINB = 12 * MiB;
constexpr size_t WS_WQK = 18 * MiB;
constexpr size_t WS_WV = 19 * MiB;
constexpr size_t WS_WOB = 20 * MiB;
constexpr size_t WS_WG = 22 * MiB;
constexpr size_t WS_RSTD = 23 * MiB;
constexpr size_t WS_SSQA = WS_RSTD + 128 * 1024;
constexpr size_t WS_SSQB = WS_SSQA + 128 * 1024;
constexpr size_t WS_ROPE = 24 * MiB;
constexpr size_t WS_MEMN = 32 * MiB;
constexpr size_t WS_KVM = 36 * MiB;
constexpr size_t WS_IFP = 40 * MiB;
constexpr size_t WS_BL = 41 * MiB;
constexpr size_t WS_MLOC = WS_BL + 8192;
constexpr size_t WS_MST = WS_MLOC + 8192;
constexpr size_t WS_C0 = WS_MST + 8192;
constexpr size_t WS_U0 = WS_C0 + 1024;
constexpr size_t WS_DN = 42 * MiB;
constexpr size_t WS_DC = 56 * MiB;
constexpr size_t WS_XB = 64 * MiB;
constexpr size_t WS_Y = 64 * MiB;
constexpr size_t WS_G = 128 * MiB;
constexpr size_t WS_Q = 304 * MiB;
constexpr size_t WS_KN = 376 * MiB;
constexpr size_t WS_V = 424 * MiB;
constexpr size_t WS_Z = 304 * MiB;
constexpr size_t WS_UC = 304 * MiB;
constexpr size_t WS_QK = 352 * MiB;
constexpr size_t WS_VV = 400 * MiB;
constexpr size_t WS_Y2 = 448 * MiB;
constexpr size_t WS_END = 512 * MiB;

typedef float f32x2_t __attribute__((ext_vector_type(2))); typedef __bf16 bf16x2_t __attribute__((ext_vector_type(2)));
__device__ __forceinline__ unsigned cvt_pk_bf16(float lo, float hi) { f32x2_t v = {lo, hi}; bf16x2_t b = __builtin_convertvector(v, bf16x2_t); return __builtin_bit_cast(unsigned, b); }
__device__ __forceinline__ float bf2f(unsigned short b) { return __uint_as_float((unsigned)b << 16); }
__device__ __forceinline__ float bflo(unsigned w) { return __uint_as_float(w << 16); }
__device__ __forceinline__ float bfhi(unsigned w) { return __uint_as_float(w & 0xffff0000u); }
__device__ __forceinline__ unsigned short f2bf(float f) { return (unsigned short)(cvt_pk_bf16(f, f) & 0xffffu); }
__device__ __forceinline__ float wave_sum(float v) {
#pragma unroll
    for (int o = 1; o < 64; o <<= 1) v += __shfl_xor(v, o);
    return v;
}
__device__ __forceinline__ float wave_max(float v) {
#pragma unroll
    for (int o = 1; o < 64; o <<= 1) v = fmaxf(v, __shfl_xor(v, o));
    return v;
}
__device__ __forceinline__ float silu_f(float g) { return g / (1.f + __expf(-g)); }
__device__ __forceinline__ float sigmoid_f(float g) { return 1.f / (1.f + __expf(-g)); }
namespace pg8 {
constexpr int BM = 256, BK = 64, HALF = 128, HTB = HALF * BK * 2  , STAGE_BYTES = 8 * HTB, NXCD = 8, WGM = 8;
__host__ __device__ __forceinline__ int lds_byte(int r, int c) { const int st = (r >> 4) * 2 + (c >> 5), rr = r & 15, cc = c & 31, ob = rr * 64 + cc * 2; return st * 1024 + (ob ^ (((ob >> 9) & 1) << 5)); }
__host__ __device__ __forceinline__ void stage_rc(int b, int& R, int& C) { const int st = b / 1024, sb = b % 1024, swz = sb ^ (((sb >> 9) & 1) << 5); R = (st >> 1) * 16 + swz / 64; C = (st & 1) * 32 + (swz % 64) / 2; }
__host__ __device__ __forceinline__ int perm32(int rho) { const int n = rho >> 4, i = rho & 15; return 8 * (i >> 2) + 4 * n + (i & 3); }

struct Unit { int pm, pn; };
struct Gemm { const bf16_t* A; const bf16_t* Bt; int M, N, K, lda, apn; };

struct StaticOrder {
    int nM, nN, nwg, G, c;
    __host__ __device__ void init(int M, int N, int G_, int c_) { nM = M / BM; nN = N / BM; nwg = nM * nN; G = G_; c = c_; }
    __host__ __device__ bool next(int i, Unit& u) const {
        const long L = (long)i * G + c; if (L >= nwg) return false;
        int wgid = (int)L; { const int q = nwg / NXCD, r = nwg % NXCD, xcd = wgid % NXCD, off = wgid / NXCD; wgid = (xcd < r ? xcd * (q + 1) : r * (q + 1) + (xcd - r) * q) + off; }
        const int nig = WGM * nN, gid = wgid / nig, fm = gid * WGM, gsz = (nM - fm) < WGM ? (nM - fm) : WGM;
        u.pm = fm + ((wgid % nig) % gsz); u.pn = (wgid % nig) / gsz; return true;
    }
};

__device__ __forceinline__ void rope8(float (&v)[8], const float2* rp) {
#pragma unroll
    for (int j = 0; j < 4; ++j) { const float2 cs = rp[j]; const float x1 = v[2 * j], x2 = v[2 * j + 1]; v[2 * j] = x1 * cs.x - x2 * cs.y; v[2 * j + 1] = x1 * cs.y + x2 * cs.x; }
}
struct Epi {
    bf16_t* out; int ldc; int ncols;
    bf16_t* out2; int ldc2; int split;
    const float* rs; int rs_mode; float rs_invdim;
    float* ssqA; float* ssqB; int ssq_mode;
    const float2* rope; int rope_mode;
    __device__ __forceinline__ void operator()(const f32x4 (&acc)[2][2][4][2], const Unit& u, int wr, int wc, int fr, int fq) const {
#pragma unroll
        for (int ai = 0; ai < 2; ++ai)
#pragma unroll
            for (int m = 0; m < 4; ++m) {
                const int row = u.pm * BM + ai * HALF + wr * 64 + m * 16 + fr;
                float sc = 1.f;
                if (rs_mode == 1) sc = rs[row]; else if (rs_mode == 2) sc = rsqrtf(rs[row] * rs_invdim + EPS);
                float ss = 0.f;
#pragma unroll
                for (int bj = 0; bj < 2; ++bj) {
                    const int col0 = u.pn * BM + bj * HALF + wc * 32 + 8 * fq;
                    float v[8];
#pragma unroll
                    for (int j = 0; j < 4; ++j) { v[j] = acc[ai][bj][m][0][j] * sc; v[4 + j] = acc[ai][bj][m][1][j] * sc; }
                    if (ssq_mode == 1 && (u.pn < 2 || (u.pn == 2 && bj == 0))) {
#pragma unroll
                        for (int j = 0; j < 8; ++j) ss += v[j] * v[j];
                    }
                    if (rope_mode == 1) { if (col0 >= 640 && col0 < 704) rope8(v, rope + (size_t)row * 32 + ((col0 - 640) >> 1)); }
                    else if (rope_mode == 2) { const int d = col0 % 192; if (d >= 128) rope8(v, rope + (size_t)row * 32 + ((d - 128) >> 1)); }
                    if (col0 < ncols) {
                        u32x4 w; w.x = cvt_pk_bf16(v[0], v[1]); w.y = cvt_pk_bf16(v[2], v[3]); w.z = cvt_pk_bf16(v[4], v[5]); w.w = cvt_pk_bf16(v[6], v[7]);
                        if (col0 < split) *(u32x4*)(out + (size_t)row * ldc + col0) = w;
                        else *(u32x4*)(out2 + (size_t)row * ldc2 + (col0 - split)) = w;
                    }
                }
                if (ssq_mode == 1 && u.pn <= 2) {
                    ss += __shfl_xor(ss, 16); ss += __shfl_xor(ss, 32);
                    if (fq == 0) atomicAdd((u.pn == 0 ? ssqB : ssqA) + row, ss);
                }
            }
    }
};

template <bool ALIGN_EPI>
__device__ __forceinline__ void gemm_phase(LAS unsigned char* lds, const Gemm g, const StaticOrder& S, const Epi& E, const int tid) {
    const int wid = __builtin_amdgcn_readfirstlane(tid >> 6), lane = tid & 63, wr = wid >> 2, wc = wid & 3, fr = lane & 15, fq = lane >> 4;
    const int K = g.K, nt = K / BK, lda = g.lda;
    unsigned voffA[2], voffB[2];
#pragma unroll
    for (int i = 0; i < 2; ++i) { int R, C; stage_rc(tid * 16 + i * 8192, R, C); const int Rb = (R & ~31) + perm32(R & 31);
        voffA[i] = (unsigned)(R * lda + C) * 2u; voffB[i] = (unsigned)(Rb * K + C) * 2u; }
    const size_t kstep = (size_t)(BK * 2);
    const size_t hstepA = (size_t)HALF * lda * 2, hstepB = (size_t)HALF * K * 2;
    const size_t tstepA = 2 * hstepA, tstepB = 2 * hstepB;
    const unsigned ldsw = (unsigned)wid * 1024u;
    const int aoff = lds_byte(wr * 64 + fr, fq * 8), boff = lds_byte(wc * 32 + fr, fq * 8);
#define PG8_SA(b, h) (((b) * 2 + (h)) * HTB)
#define PG8_SB(b, h) ((4 + (b) * 2 + (h)) * HTB)
#define PG8_STAGE(bufoff, gbase, voff) do { _Pragma("unroll") for (int _i = 0; _i < 2; ++_i) \
        __builtin_amdgcn_global_load_lds((const unsigned*)((const char*)(gbase) + (voff)[_i]), (LAS unsigned*)(lds + (bufoff) + ldsw + _i * 8192), 16, 0, 0); } while (0)
#define PG8_LDA(dst, b, h) do { _Pragma("unroll") for (int m = 0; m < 4; ++m) _Pragma("unroll") for (int k = 0; k < 2; ++k) dst[m][k] = *(const LAS bf16x8*)(lds + PG8_SA(b, h) + aoff + m * 2048 + k * 1024); } while (0)
#define PG8_LDB(dst, b, h) do { _Pragma("unroll") for (int n = 0; n < 2; ++n) _Pragma("unroll") for (int k = 0; k < 2; ++k) dst[n][k] = *(const LAS bf16x8*)(lds + PG8_SB(b, h) + boff + n * 2048 + k * 1024); } while (0)
#define PG8_MMA(ai, bj, At, Bt) do { __builtin_amdgcn_s_setprio(1); _Pragma("unroll") for (int m = 0; m < 4; ++m) _Pragma("unroll") for (int n = 0; n < 2; ++n) _Pragma("unroll") for (int k = 0; k < 2; ++k) \
        acc[ai][bj][m][n] = __builtin_amdgcn_mfma_f32_16x16x32_bf16(Bt[n][k], At[m][k], acc[ai][bj][m][n], 0, 0, 0); __builtin_amdgcn_s_setprio(0); } while (0)
#define PG8_WAIT_V(n) asm volatile("s_waitcnt vmcnt(" #n ")" ::: "memory")
#define PG8_WAIT_L(n) asm volatile("s_waitcnt lgkmcnt(" #n ")" ::: "memory")
#define PG8_BAR __builtin_amdgcn_s_barrier()
#define PG8_SCHED __builtin_amdgcn_sched_barrier(0)
    Unit cur, nxt; int ui = 0;
    if (!S.next(0, cur)) return;
    f32x4 acc[2][2][4][2];
#pragma unroll
    for (int a = 0; a < 2; ++a)
#pragma unroll
        for (int b = 0; b < 2; ++b)
#pragma unroll
            for (int m = 0; m < 4; ++m)
#pragma unroll
                for (int n = 0; n < 2; ++n) acc[a][b][m][n] = (f32x4){0.f, 0.f, 0.f, 0.f};
    bf16x8 At[4][2], B0[2][2], B1[2][2];
    const char* cA = (const char*)g.A + (size_t)cur.pm * tstepA + (size_t)cur.pn * g.apn * 2; const char* cB = (const char*)g.Bt + (size_t)cur.pn * tstepB;
    PG8_STAGE(PG8_SB(0, 0), cB, voffB); PG8_STAGE(PG8_SB(0, 1), cB + hstepB, voffB); PG8_STAGE(PG8_SA(0, 0), cA, voffA); PG8_STAGE(PG8_SA(0, 1), cA + hstepA, voffA);
    if (wr == 1) PG8_BAR;
    PG8_WAIT_V(2); PG8_BAR;
    PG8_STAGE(PG8_SB(1, 0), cB + kstep, voffB); PG8_STAGE(PG8_SA(1, 0), cA + kstep, voffA); PG8_STAGE(PG8_SB(1, 1), cB + hstepB + kstep, voffB);
    PG8_WAIT_V(6); PG8_BAR;
    for (;;) {
        const bool has_next = S.next(ui + 1, nxt);
        const char* nA = has_next ? (const char*)g.A + (size_t)nxt.pm * tstepA + (size_t)nxt.pn * g.apn * 2 : cA; const char* nB = has_next ? (const char*)g.Bt + (size_t)nxt.pn * tstepB : cB;
        for (int t = 0; t < nt; t += 2) {
            const bool last = (t == nt - 2);
            const char* a1 = cA + (size_t)(t + 1) * kstep;
            const char* a2 = last ? nA : cA + (size_t)(t + 2) * kstep; const char* b2 = last ? nB : cB + (size_t)(t + 2) * kstep;
            const char* a3 = a2 + kstep; const char* b3 = b2 + kstep;
            PG8_LDB(B0, 0, 0); PG8_LDB(B1, 0, 1); PG8_SCHED; PG8_LDA(At, 0, 0); PG8_STAGE(PG8_SA(1, 1), a1 + hstepA, voffA);
            PG8_WAIT_V(8); PG8_WAIT_L(0); PG8_BAR; PG8_MMA(0, 0, At, B0); PG8_MMA(0, 1, At, B1); PG8_BAR; PG8_SCHED;
            PG8_LDA(At, 0, 1); PG8_STAGE(PG8_SB(0, 0), b2, voffB); PG8_STAGE(PG8_SB(0, 1), b2 + hstepB, voffB); PG8_STAGE(PG8_SA(0, 0), a2, voffA);
            PG8_WAIT_V(8); PG8_WAIT_L(0); PG8_BAR; PG8_MMA(1, 0, At, B0); PG8_MMA(1, 1, At, B1); PG8_BAR; PG8_SCHED;
            PG8_LDB(B0, 1, 0); PG8_LDB(B1, 1, 1); PG8_SCHED; PG8_LDA(At, 1, 0); PG8_STAGE(PG8_SA(0, 1), a2 + hstepA, voffA);
            PG8_WAIT_V(8); PG8_WAIT_L(0); PG8_BAR; PG8_MMA(0, 0, At, B0); PG8_MMA(0, 1, At, B1); PG8_BAR; PG8_SCHED;
            PG8_LDA(At, 1, 1); PG8_STAGE(PG8_SB(1, 0), b3, voffB); PG8_STAGE(PG8_SB(1, 1), b3 + hstepB, voffB); PG8_STAGE(PG8_SA(1, 0), a3, voffA);
            PG8_WAIT_V(8); PG8_WAIT_L(0); PG8_BAR; PG8_MMA(1, 0, At, B0); PG8_MMA(1, 1, At, B1); PG8_BAR; PG8_SCHED;
        }
        if constexpr (ALIGN_EPI) { if (wr == 0) PG8_BAR; }
        E(acc, cur, wr, wc, fr, fq);
        if (!has_next) break;
#pragma unroll
        for (int a = 0; a < 2; ++a)
#pragma unroll
            for (int b = 0; b < 2; ++b)
#pragma unroll
                for (int m = 0; m < 4; ++m)
#pragma unroll
                    for (int n = 0; n < 2; ++n) acc[a][b][m][n] = (f32x4){0.f, 0.f, 0.f, 0.f};
        cur = nxt; cA = nA; cB = nB; ++ui;
        if constexpr (ALIGN_EPI) { if (wr == 1) PG8_BAR; }
    }
    PG8_WAIT_V(0);
    if constexpr (!ALIGN_EPI) { if (wr == 0) PG8_BAR; }
    PG8_BAR;
#undef PG8_SA
#undef PG8_SB
#undef PG8_STAGE
#undef PG8_LDA
#undef PG8_LDB
#undef PG8_MMA
#undef PG8_WAIT_V
#undef PG8_WAIT_L
#undef PG8_BAR
#undef PG8_SCHED
}
}
namespace att {
#define SBAR() __builtin_amdgcn_sched_barrier(0)
__device__ __forceinline__ int crow(int r, int hi) { return (r & 3) + 8 * (r >> 2) + 4 * hi; }
template <int DQK> __device__ __forceinline__ int kaddr(int row, int c) { return row * (DQK * 2) + ((c ^ ((row >> 1) & 7)) << 4); }
template <int NCB> __device__ __forceinline__ int v_st(int k, int c) { const int kk = (k & ~0xC) | ((k & 4) << 1) | ((k & 8) >> 1); return ((kk >> 3) * NCB + (c >> 5)) * 512 + ((kk & 7) * 32 + (c & 31)) * 2; }
__device__ __forceinline__ int v_rd_base(int lane) { return ((lane & 3) << 3) | (((lane >> 2) & 3) << 6) | (((lane >> 4) & 1) << 5) | (((lane >> 5) & 1) << 8); }

__device__ __forceinline__ void mask_tile(f32x16& p0, f32x16& p1, int dq) {
    const float NEG = -__builtin_inff();
#pragma unroll
    for (int r = 0; r < 16; ++r) {
        const int c = (r & 3) + 8 * (r >> 2);
        if (dq - c < 0) p0[r] = NEG;
        if (dq - c - 32 < 0) p1[r] = NEG;
    }
}
__device__ __forceinline__ void partialSM(f32x16& p0, f32x16& p1, float& m_reg, float& alpha) {
    float pmax = p0[0];
#pragma unroll
    for (int r = 1; r < 16; ++r) pmax = fmaxf(pmax, p0[r]);
#pragma unroll
    for (int r = 0; r < 16; ++r) pmax = fmaxf(pmax, p1[r]);
    { auto rr = __builtin_amdgcn_permlane32_swap(__float_as_uint(pmax), __float_as_uint(pmax), false, false);
      pmax = fmaxf(__uint_as_float(rr[0]), __uint_as_float(rr[1])); }
    const float mn = fmaxf(m_reg, pmax);
    alpha = __builtin_amdgcn_exp2f(m_reg - mn); m_reg = mn;
#pragma unroll
    for (int r = 0; r < 16; ++r) p0[r] = __builtin_amdgcn_exp2f(p0[r] - mn);
#pragma unroll
    for (int r = 0; r < 16; ++r) p1[r] = p1[r] - mn;
}
__device__ __forceinline__ void finishSM(f32x16& p0, f32x16& p1, float alpha, float& l_reg, bf16x8& pa0, bf16x8& pa1, bf16x8& pa2, bf16x8& pa3) {
#pragma unroll
    for (int r = 0; r < 16; ++r) p1[r] = __builtin_amdgcn_exp2f(p1[r]);
    float ps = 0.f;
#pragma unroll
    for (int r = 0; r < 16; ++r) ps += p0[r];
#pragma unroll
    for (int r = 0; r < 16; ++r) ps += p1[r];
    { auto rr = __builtin_amdgcn_permlane32_swap(__float_as_uint(ps), __float_as_uint(ps), false, false);
      ps = __uint_as_float(rr[0]) + __uint_as_float(rr[1]); }
    l_reg = l_reg * alpha + ps;
#define PK4(P, B_, OUT) do { unsigned a0 = cvt_pk_bf16(P[B_+0], P[B_+1]), a1 = cvt_pk_bf16(P[B_+2], P[B_+3]);                          \
        unsigned b0 = cvt_pk_bf16(P[B_+4], P[B_+5]), b1 = cvt_pk_bf16(P[B_+6], P[B_+7]);                                             \
        auto r0 = __builtin_amdgcn_permlane32_swap(a0, b0, false, false); auto r1 = __builtin_amdgcn_permlane32_swap(a1, b1, false, false); \
        u32x4 w = {r0[0], r1[0], r0[1], r1[1]}; OUT = *reinterpret_cast<bf16x8*>(&w); } while (0)
    PK4(p0, 0, pa0); PK4(p0, 8, pa1); PK4(p1, 0, pa2); PK4(p1, 8, pa3);
#undef PK4
}
template <int DQK>
__device__ __forceinline__ void qkt(f32x16& p0, f32x16& p1, const LAS unsigned char* Kb, int r32, int hi, const bf16x8* qr) {
    constexpr int NKS = DQK / 16, ROWB = DQK * 2;
    p0 = f32x16{}; p1 = f32x16{};
    const int f = (r32 >> 1) & 7;
    const LAS unsigned char* kb[4];
#pragma unroll
    for (int dd = 0; dd < 4; ++dd) kb[dd] = Kb + r32 * ROWB + ((((2 * dd + hi) ^ f)) << 4);
#pragma unroll
    for (int d0 = 0; d0 < NKS; ++d0) { const LAS unsigned char* a = kb[d0 & 3] + (d0 >> 2) * 128;
        bf16x8 b0 = *reinterpret_cast<const LAS bf16x8*>(a);
        bf16x8 b1 = *reinterpret_cast<const LAS bf16x8*>(a + 32 * ROWB);
        p0 = __builtin_amdgcn_mfma_f32_32x32x16_bf16(b0, qr[d0], p0, 0, 0, 0);
        p1 = __builtin_amdgcn_mfma_f32_32x32x16_bf16(b1, qr[d0], p1, 0, 0, 0);
    }
}
template <int DV>
__device__ __forceinline__ void pv_tile(f32x16* o, int vb0, bf16x8 pa0, bf16x8 pa1, bf16x8 pa2, bf16x8 pa3) {
    constexpr int NCB = DV / 32, KS = 2 * NCB * 512, HF = NCB * 512;
#define TRRD(dst, off) asm volatile("ds_read_b64_tr_b16 %0, %1 offset:%2" : "=&v"(dst) : "v"(vb0), "i"(off) : "memory")
#pragma unroll
    for (int d0 = 0; d0 < NCB; ++d0) {
        s16x4 l0, l1, l2, l3, h0, h1, h2, h3;
        if (d0 == 0) { TRRD(l0, 0 * 512); TRRD(h0, 0 * 512 + HF); TRRD(l1, 0 * 512 + KS); TRRD(h1, 0 * 512 + KS + HF); TRRD(l2, 0 * 512 + 2 * KS); TRRD(h2, 0 * 512 + 2 * KS + HF); TRRD(l3, 0 * 512 + 3 * KS); TRRD(h3, 0 * 512 + 3 * KS + HF); }
        else if (d0 == 1) { TRRD(l0, 1 * 512); TRRD(h0, 1 * 512 + HF); TRRD(l1, 1 * 512 + KS); TRRD(h1, 1 * 512 + KS + HF); TRRD(l2, 1 * 512 + 2 * KS); TRRD(h2, 1 * 512 + 2 * KS + HF); TRRD(l3, 1 * 512 + 3 * KS); TRRD(h3, 1 * 512 + 3 * KS + HF); }
        else if (d0 == 2) { TRRD(l0, 2 * 512); TRRD(h0, 2 * 512 + HF); TRRD(l1, 2 * 512 + KS); TRRD(h1, 2 * 512 + KS + HF); TRRD(l2, 2 * 512 + 2 * KS); TRRD(h2, 2 * 512 + 2 * KS + HF); TRRD(l3, 2 * 512 + 3 * KS); TRRD(h3, 2 * 512 + 3 * KS + HF); }
        else { TRRD(l0, 3 * 512); TRRD(h0, 3 * 512 + HF); TRRD(l1, 3 * 512 + KS); TRRD(h1, 3 * 512 + KS + HF); TRRD(l2, 3 * 512 + 2 * KS); TRRD(h2, 3 * 512 + 2 * KS + HF); TRRD(l3, 3 * 512 + 3 * KS); TRRD(h3, 3 * 512 + 3 * KS + HF); }
        asm volatile("s_waitcnt lgkmcnt(0)" ::: "memory"); SBAR();
        o[d0] = __builtin_amdgcn_mfma_f32_32x32x16_bf16(pa0, (bf16x8){l0[0], l0[1], l0[2], l0[3], h0[0], h0[1], h0[2], h0[3]}, o[d0], 0, 0, 0);
        o[d0] = __builtin_amdgcn_mfma_f32_32x32x16_bf16(pa1, (bf16x8){l1[0], l1[1], l1[2], l1[3], h1[0], h1[1], h1[2], h1[3]}, o[d0], 0, 0, 0);
        o[d0] = __builtin_amdgcn_mfma_f32_32x32x16_bf16(pa2, (bf16x8){l2[0], l2[1], l2[2], l2[3], h2[0], h2[1], h2[2], h2[3]}, o[d0], 0, 0, 0);
        o[d0] = __builtin_amdgcn_mfma_f32_32x32x16_bf16(pa3, (bf16x8){l3[0], l3[1], l3[2], l3[3], h3[0], h3[1], h3[2], h3[3]}, o[d0], 0, 0, 0);
    }
#undef TRRD
}

template <int DQK, int DV, bool CAUSAL, int ABL = 0>
__device__ __forceinline__ void attn_unit(const bf16_t* Qb, int qp, const bf16_t* Km, int kp, int c1, const bf16_t* Ke, int kep, const bf16_t* Vb, int vp,
                                          int NT, int q0, const bf16_t* gate, int gp, bf16_t* Y, int yp, LAS unsigned char* lds, const int tid) {
    constexpr int SHM_V = 64 * DV * 2, SHM_K = 64 * DQK * 2, NCK = DQK / 8, NKS = DQK / 16, NCB = DV / 32;
    constexpr int KPT = SHM_K / 8192, VPT = SHM_V / 8192;
    const int wid = __builtin_amdgcn_readfirstlane(tid >> 6), lane = tid & 63, r32 = lane & 31, hi = lane >> 5;
    LAS unsigned char* V_lds = lds; LAS unsigned char* K_lds = lds + 3 * SHM_V; LAS float* ws = (LAS float*)(lds + 3 * SHM_V + 3 * SHM_K) + wid * 64;
    bf16x8 qr[NKS];
#pragma unroll
    for (int d0 = 0; d0 < NKS; ++d0) qr[d0] = *reinterpret_cast<const bf16x8*>(Qb + (size_t)(wid * 32 + r32) * qp + d0 * 16 + hi * 8);
    const char* kbase = (const char*)(Km < Ke ? Km : Ke);
    unsigned koff[KPT]; unsigned kstr[KPT];
#pragma unroll
    for (int i = 0; i < KPT; ++i) { const int p = (wid + 8 * i) * 64 + lane, row = p / NCK, cpos = p % NCK, c = cpos ^ ((row >> 1) & 7);
        if (c < c1) { koff[i] = (unsigned)((const char*)(Km + (size_t)row * kp + c * 8) - kbase); kstr[i] = (unsigned)kp * 128u; }
        else { koff[i] = (unsigned)((const char*)(Ke + (size_t)row * kep + (c - c1) * 8) - kbase); kstr[i] = (unsigned)kep * 128u; } }
    unsigned voff[VPT];
#pragma unroll
    for (int i = 0; i < VPT; ++i) { const int st = 2 * (wid + 8 * i) + (lane >> 5), kk = (st / NCB) * 8 + ((lane & 31) >> 2), k = (kk & ~0xC) | ((kk & 4) << 1) | ((kk & 8) >> 1), col = (st % NCB) * 32 + (lane & 3) * 8;
        voff[i] = (unsigned)(k * vp + col) * 2u; }
    const char* vbase = (const char*)Vb;
    float m_reg = -1e30f, l_reg = 0.f; f32x16 o[NCB];
#pragma unroll
    for (int d = 0; d < NCB; ++d) o[d] = f32x16{};
    const int vb0 = (int)(size_t)V_lds + v_rd_base(lane);
    const int qlo = q0 + wid * 32;
#define DMA_K(sl) do { _Pragma("unroll") for (int i = 0; i < KPT; ++i) { __builtin_amdgcn_global_load_lds((const unsigned*)(kbase + koff[i]), (LAS unsigned*)(K_lds + (sl) * SHM_K + (wid + 8 * i) * 1024), 16, 0, 0); koff[i] += kstr[i]; } } while (0)
#define DMA_V(sl) do { _Pragma("unroll") for (int i = 0; i < VPT; ++i) { __builtin_amdgcn_global_load_lds((const unsigned*)(vbase + voff[i]), (LAS unsigned*)(V_lds + (sl) * SHM_V + (wid + 8 * i) * 1024), 16, 0, 0); } vbase += (size_t)vp * 128; } while (0)
#define WAIT_BAR(N) do { asm volatile("s_waitcnt vmcnt(%0) lgkmcnt(0)\n\ts_barrier" :: "i"(N) : "memory"); } while (0)
#define MASKT(P0_, P1_, t) do { if (CAUSAL) { const int kb_ = (t) * 64; if (kb_ + 63 > qlo) mask_tile(P0_, P1_, qlo + r32 - 4 * hi - kb_); } } while (0)
#define RESC(a) do { if (__any((a) < 1.f)) { if (hi == 0) ws[r32] = (a); asm volatile("s_waitcnt lgkmcnt(0)" ::: "memory"); \
        _Pragma("unroll") for (int d_ = 0; d_ < NCB; ++d_) _Pragma("unroll") for (int r = 0; r < 16; ++r) o[d_][r] *= ws[crow(r, hi)]; } } while (0)
    f32x16 pA0, pA1, pB0, pB1; float alA = 1.f, alB = 1.f; bf16x8 pa0, pa1, pa2, pa3;
    DMA_K(0); DMA_K(1); DMA_V(0);
    WAIT_BAR(KPT + VPT);
    DMA_K(2); DMA_V(1);
    qkt<DQK>(pA0, pA1, K_lds, r32, hi, qr);
    MASKT(pA0, pA1, 0); partialSM(pA0, pA1, m_reg, alA);
    WAIT_BAR(KPT + VPT);
    int ks = 1, vs = 0, ns = 2;
#define ROT() do { vs = ks; ks = ns; ns = (ns == 2) ? 0 : ns + 1; } while (0)
#define STEP(PX0, PX1, alX, PY0, PY1, alY, t, NW) do { \
        if (!(ABL & 1)) { if ((t) + 2 < NT) DMA_K(vs); if ((t) + 1 < NT) DMA_V(ns); } \
        SBAR(); if (!(ABL & 8)) qkt<DQK>(PX0, PX1, K_lds + ks * SHM_K, r32, hi, qr); else { asm volatile("" : "+v"(PX0), "+v"(PX1)); } \
        if (!(ABL & 2)) finishSM(PY0, PY1, alY, l_reg, pa0, pa1, pa2, pa3); else { asm volatile("" : "+v"(PY0), "+v"(PY1), "+v"(pa0), "+v"(pa1), "+v"(pa2), "+v"(pa3)); } SBAR(); \
        if (!(ABL & 4)) pv_tile<DV>(o, vb0 + vs * SHM_V, pa0, pa1, pa2, pa3); \
        if (!(ABL & 2)) { MASKT(PX0, PX1, t); partialSM(PX0, PX1, m_reg, alX); } \
        if (ABL & 1) WAIT_BAR(0); else WAIT_BAR(NW); \
        RESC(alX); ROT(); } while (0)
    int t = 1;
    for (; t + 3 < NT; t += 2) {
        STEP(pB0, pB1, alB, pA0, pA1, alA, t, KPT + VPT);
        STEP(pA0, pA1, alA, pB0, pB1, alB, t + 1, KPT + VPT);
    }
    STEP(pB0, pB1, alB, pA0, pA1, alA, t, KPT + VPT);
    STEP(pA0, pA1, alA, pB0, pB1, alB, t + 1, VPT);
    STEP(pB0, pB1, alB, pA0, pA1, alA, t + 2, 0);
    finishSM(pB0, pB1, alB, l_reg, pa0, pa1, pa2, pa3); SBAR(); pv_tile<DV>(o, vb0 + vs * SHM_V, pa0, pa1, pa2, pa3);
#undef STEP
#undef ROT
#undef RESC
#undef MASKT
#undef WAIT_BAR
#undef DMA_K
#undef DMA_V
    if (hi == 0) ws[32 + r32] = l_reg;
    asm volatile("s_waitcnt lgkmcnt(0)" ::: "memory");
    constexpr int SPITCH = DV * 2 + 16;
    LAS unsigned char* stg = ((DQK == 192) ? K_lds : (lds + 3 * SHM_V + 3 * SHM_K + 2048)) + wid * (32 * SPITCH);
#pragma unroll
    for (int r = 0; r < 16; ++r) {
        const float rl = __builtin_amdgcn_rcpf(ws[32 + crow(r, hi)]);
#pragma unroll
        for (int d0 = 0; d0 < NCB; ++d0) *(LAS unsigned short*)(stg + crow(r, hi) * SPITCH + (d0 * 32 + r32) * 2) = f2bf(o[d0][r] * rl);
    }
    asm volatile("s_waitcnt lgkmcnt(0)" ::: "memory");
    constexpr int CPR = DV / 8, RPP = 64 / CPR;
#pragma unroll
    for (int i = 0; i < 32 / RPP; ++i) {
        const int row = i * RPP + lane / CPR, ch = lane % CPR, orow = wid * 32 + row;
        const u32x4 ov = *(const LAS u32x4*)(stg + row * SPITCH + ch * 16);
        const u32x4 gv = *(const u32x4*)(gate + (size_t)orow * gp + ch * 8);
        u32x4 w;
        w.x = cvt_pk_bf16(bflo(ov.x) * silu_f(bflo(gv.x)), bfhi(ov.x) * silu_f(bfhi(gv.x))); w.y = cvt_pk_bf16(bflo(ov.y) * silu_f(bflo(gv.y)), bfhi(ov.y) * silu_f(bfhi(gv.y)));
        w.z = cvt_pk_bf16(bflo(ov.z) * silu_f(bflo(gv.z)), bfhi(ov.z) * silu_f(bfhi(gv.z))); w.w = cvt_pk_bf16(bflo(ov.w) * silu_f(bflo(gv.w)), bfhi(ov.w) * silu_f(bfhi(gv.w)));
        *(u32x4*)(Y + (size_t)orow * yp + ch * 8) = w;
    }
    __syncthreads();
}
#undef SBAR
}
struct Params {
    const float* x; const float* mem; const int* pos;
    const float *a_pre_g, *a_w_in, *a_q_a_g, *a_w_uq, *a_kv_a_g, *a_w_ukv, *a_mem_g, *a_w_mem_kv, *a_w_out, *a_post_g;
    const float *b_pre_g, *b_w_in, *b_gate_bias, *b_conv_w, *b_conv_b, *b_w_q, *b_w_k, *b_w_v, *b_head_g, *b_skip, *b_mem_g, *b_w_mem_kv, *b_w_out, *b_post_g;
    float* out; unsigned char* ws; int ph_lo, ph_hi;
};
struct Wk { int tid, lane, wave, vcu, G; };
#define LDS_WAIT() asm volatile("s_waitcnt lgkmcnt(0)" ::: "memory")

__device__ __forceinline__ float wsrc(const Params& P, int mat, int k, int n) {
    switch (mat) {
    case 0: { int col; float s = 1.f;
        if (n < 256) col = 384 + n; else if (n < 512) col = n - 256; else if (n < 640) col = 256 + (n - 512);
        else if (n < 704) { const int p_ = n - 640, i = p_ >> 1; col = 640 + ((p_ & 1) ? 32 + i : i); }
        else if (n < 768) return 0.f; else if (n < 1024) { col = 704 + (n - 768); s = MSCALE; } else col = 960 + (n - 1024);
        return P.a_w_in[(size_t)k * A_IN + col] * P.a_pre_g[k] * s; }
    case 1: { if (n >= 1152) return 0.f; const int h = n / 192, d = n % 192; int col;
        if (d < 128) col = h * 192 + d; else { const int p_ = d - 128, i = p_ >> 1; col = h * 192 + 128 + ((p_ & 1) ? 32 + i : i); }
        return P.a_w_uq[(size_t)k * 1152 + col] * P.a_q_a_g[k] * QSCALE; }
    case 2: { int col; if (n < 768) col = (n / 128) * 256 + (n % 128); else { const int n2 = n - 768; col = (n2 / 128) * 256 + 128 + (n2 % 128); }
        return P.a_w_ukv[(size_t)k * 1536 + col] * P.a_kv_a_g[k]; }
    case 3: { if (n < 512) return P.a_w_mem_kv[(size_t)k * 512 + n] * P.a_mem_g[k]; return P.b_w_mem_kv[(size_t)k * 512 + (n - 512)] * P.b_mem_g[k]; }
    case 4: return P.a_w_out[(size_t)k * 1024 + n];
    case 5: { int col; float s = 1.f; if (n < 768) col = n; else if (n < 1536) col = 776 + (n - 768); else if (n < 1792) { col = 1544 + (n - 1536); s = MSCALE; } else col = 1800 + (n - 1792);
        return P.b_w_in[(size_t)k * B_IN + col] * P.b_pre_g[k] * s; }
    case 6: { const int h = n / 192, j = n % 192, pn = n / 256, kabs = k + 192 * pn - 192 * h; if (kabs < 0 || kabs >= 192) return 0.f;
        if (j < 96) return P.b_w_q[((size_t)h * 192 + kabs) * 96 + j]; return P.b_w_k[((size_t)h * 192 + kabs) * 96 + (j - 96)] * KSCALE_B; }
    case 7: { const int h = n / 192, j = n % 192, pn = n / 256, kabs = k + 192 * pn - 192 * h; if (kabs < 0 || kabs >= 192) return 0.f;
        return P.b_w_v[((size_t)h * 192 + kabs) * 192 + j]; }
    default: return P.b_w_out[(size_t)k * 1024 + n];
    }
}
__device__ __forceinline__ void tr_item(const Params& P, int mat, int K, int nblk, bf16_t* WT, LAS float* scr, int item, int lane) {
    const int kb = item / nblk, nb = item % nblk, k0 = 64 * kb, n0 = 32 * nb;
    float tv[32];
#pragma unroll
    for (int i = 0; i < 32; ++i) tv[i] = wsrc(P, mat, k0 + 2 * i + (lane >> 5), n0 + (lane & 31));
#pragma unroll
    for (int i = 0; i < 32; ++i) scr[(2 * i + (lane >> 5)) * 33 + (lane & 31)] = tv[i];
    LDS_WAIT(); asm volatile("" ::: "memory");
    const int c = lane & 7;
#pragma unroll
    for (int j = 0; j < 4; ++j) { const int n = (lane >> 3) + 8 * j; const LAS float* s = scr + (8 * c) * 33 + n;
        u32x4 o; o.x = cvt_pk_bf16(s[0 * 33], s[1 * 33]); o.y = cvt_pk_bf16(s[2 * 33], s[3 * 33]); o.z = cvt_pk_bf16(s[4 * 33], s[5 * 33]); o.w = cvt_pk_bf16(s[6 * 33], s[7 * 33]);
        *(u32x4*)(WT + (size_t)(n0 + n) * K + k0 + 8 * c) = o; }
    LDS_WAIT(); asm volatile("" ::: "memory");
}
__device__ __forceinline__ void row_to_bf16(const float* xrow, bf16_t* orow, float* rstd_out, bool normalise, int lane) {
    const f32x4* xr = (const f32x4*)xrow + lane;
    f32x4 v[4]; float s = 0.f;
#pragma unroll
    for (int j = 0; j < 4; ++j) { v[j] = xr[64 * j]; s += (v[j].x * v[j].x + v[j].y * v[j].y) + (v[j].z * v[j].z + v[j].w * v[j].w); }
    const float rstd = rsqrtf(wave_sum(s) * (1.f / DM) + EPS);
    if (rstd_out && lane == 0) *rstd_out = rstd;
    const float sc = normalise ? rstd : 1.f;
    u32x2* o8 = (u32x2*)orow + lane;
#pragma unroll
    for (int j = 0; j < 4; ++j) { u32x2 w; w.x = cvt_pk_bf16(v[j].x * sc, v[j].y * sc); w.y = cvt_pk_bf16(v[j].z * sc, v[j].w * sc); o8[64 * j] = w; }
}
__device__ __forceinline__ void phase_prologue(const Params& P, const Wk& W, LAS unsigned char* lds) {
    unsigned char* ws = P.ws;
    LAS float* scr = (LAS float*)(lds + W.wave * 8704);
    const int gw = W.vcu * 8 + W.wave, NGW = W.G * 8;
    int base = 0;
#define DO_MAT(mt, K_, N_, OFF_) do { const int nblk = (N_) / 32, nit = ((K_) / 64) * nblk; \
        int first = gw - (base % NGW); if (first < 0) first += NGW; \
        for (int r = first; r < nit; r += NGW) tr_item(P, mt, K_, nblk, (bf16_t*)(ws + (OFF_)), scr, r, W.lane); \
        base += nit; } while (0)
    DO_MAT(0, 1024, 2048, WS_WINA); DO_MAT(1, 384, 1280, WS_WUQ); DO_MAT(2, 256, 1536, WS_WUKV); DO_MAT(3, 1024, 1024, WS_WMKV); DO_MAT(4, 1024, 1024, WS_WOA);
    DO_MAT(5, 1024, 2816, WS_WINB); DO_MAT(6, 384, 768, WS_WQK); DO_MAT(7, 384, 768, WS_WV); DO_MAT(8, 1024, 1024, WS_WOB);
#undef DO_MAT
    const int gt = (W.vcu * 512 + W.tid), NGT = W.G * 512;
    for (int idx = gt; idx < 8 * 1024; idx += NGT) { const int g = idx >> 10, k = idx & 1023; ((float*)(ws + WS_WG))[idx] = P.b_w_in[(size_t)k * B_IN + 768 + g] * P.b_pre_g[k]; }
    for (int idx = gt; idx < 2 * T; idx += NGT) ((float*)(ws + WS_SSQA))[idx] = 0.f;
    for (int idx = gt; idx < T * 32; idx += NGT) { const int row = idx >> 5, i = idx & 31;
        const float inv = exp2f(-(float)i * (13.287712379549449f / 32.f));
        const float ang = (float)P.pos[row] * inv;
        double tr = (double)ang * 0.15915494309189535; tr -= floor(tr); const float tf = (float)tr;
        ((float2*)(ws + WS_ROPE))[idx] = make_float2(__builtin_amdgcn_cosf(tf), __builtin_amdgcn_sinf(tf)); }
    for (int m = gw; m < T; m += 4 * NGW) {
        f32x4 v[4][4]; float s[4];
#pragma unroll
        for (int r = 0; r < 4; ++r) { const f32x4* xr = (const f32x4*)(P.x + (size_t)(m + r * NGW) * DM) + W.lane;
#pragma unroll
            for (int j = 0; j < 4; ++j) v[r][j] = xr[64 * j]; }
#pragma unroll
        for (int r = 0; r < 4; ++r) { float a = 0.f;
#pragma unroll
            for (int j = 0; j < 4; ++j) a += (v[r][j].x * v[r][j].x + v[r][j].y * v[r][j].y) + (v[r][j].z * v[r][j].z + v[r][j].w * v[r][j].w);
            s[r] = wave_sum(a); }
#pragma unroll
        for (int r = 0; r < 4; ++r) { const int mr = m + r * NGW; if (W.lane == 0) ((float*)(ws + WS_RSTD))[mr] = rsqrtf(s[r] * (1.f / DM) + EPS);
            u32x2* o8 = (u32x2*)((bf16_t*)(ws + WS_XB) + (size_t)mr * DM) + W.lane;
#pragma unroll
            for (int j = 0; j < 4; ++j) { u32x2 w; w.x = cvt_pk_bf16(v[r][j].x, v[r][j].y); w.y = cvt_pk_bf16(v[r][j].z, v[r][j].w); o8[64 * j] = w; } }
    }
    for (int m = gw; m < NB * NMEM; m += NGW) row_to_bf16(P.mem + (size_t)m * DM, (bf16_t*)(ws + WS_MEMN) + (size_t)m * DM, nullptr, true, W.lane);
}

__device__ __forceinline__ void phase_rowmid(const Params& P, const Wk& W, LAS unsigned char* lds) {
    unsigned char* ws = P.ws;
    const int gw = W.vcu * 8 + W.wave, NGW = W.G * 8, lane = W.lane;
    const bf16_t* Z = (const bf16_t*)(ws + WS_Z);
    { const int gt_ = W.vcu * 512 + W.tid; if (gt_ < 32 * 192) ((float*)(ws + WS_U0))[gt_] = 0.f; }
    LAS float* Wg = (LAS float*)lds;
    for (int i = W.tid; i < 2048; i += 512) ((LAS f32x4*)Wg)[i] = ((const f32x4*)(ws + WS_WG))[i];
    __syncthreads();
    for (int m = gw; m < T; m += NGW) {
        const f32x4* xr = (const f32x4*)(P.x + (size_t)m * DM) + lane; const u32x2* zr = (const u32x2*)(Z + (size_t)m * DM) + lane;
        f32x4 v[4], z[4]; float s = 0.f;
#pragma unroll
        for (int j = 0; j < 4; ++j) { v[j] = xr[64 * j]; const u32x2 w = zr[64 * j]; z[j] = (f32x4){bflo(w.x), bfhi(w.x), bflo(w.y), bfhi(w.y)};
            s += (z[j].x * z[j].x + z[j].y * z[j].y) + (z[j].z * z[j].z + z[j].w * z[j].w); }
        const float rz = rsqrtf(wave_sum(s) * (1.f / DM) + EPS);
        float s1 = 0.f;
#pragma unroll
        for (int j = 0; j < 4; ++j) { const f32x4 g = ((const f32x4*)P.a_post_g)[lane + 64 * j]; v[j] = v[j] + z[j] * rz * g;
            s1 += (v[j].x * v[j].x + v[j].y * v[j].y) + (v[j].z * v[j].z + v[j].w * v[j].w); }
        const float r1 = rsqrtf(wave_sum(s1) * (1.f / DM) + EPS);
        f32x4* orow = (f32x4*)(P.out + (size_t)m * DM) + lane; u32x2* o8 = (u32x2*)((bf16_t*)(ws + WS_XB) + (size_t)m * DM) + lane;
#pragma unroll
        for (int j = 0; j < 4; ++j) { orow[64 * j] = v[j]; u32x2 w; w.x = cvt_pk_bf16(v[j].x, v[j].y); w.y = cvt_pk_bf16(v[j].z, v[j].w); o8[64 * j] = w; }
        if (lane == 0) ((float*)(ws + WS_RSTD))[m] = r1;
        float gacc[8];
#pragma unroll
        for (int g = 0; g < 8; ++g) { float a = 0.f;
#pragma unroll
            for (int j = 0; j < 4; ++j) { const f32x4 w4 = ((const LAS f32x4*)(Wg + g * 1024))[lane + 64 * j]; a += (v[j].x * w4.x + v[j].y * w4.y) + (v[j].z * w4.z + v[j].w * w4.w); }
            gacc[g] = wave_sum(a); }
        if (lane < 8) { float r = gacc[0];
#pragma unroll
            for (int g = 1; g < 8; ++g) r = (lane == g) ? gacc[g] : r;
            ((float*)(ws + WS_IFP))[(size_t)m * 8 + lane] = r * r1 + P.b_gate_bias[lane]; }
    }
}
__device__ __forceinline__ void phase_rowfinal(const Params& P, const Wk& W) {
    unsigned char* ws = P.ws;
    const int gw = W.vcu * 8 + W.wave, NGW = W.G * 8, lane = W.lane;
    const bf16_t* Z = (const bf16_t*)(ws + WS_Z);
    for (int m = gw; m < T; m += NGW) {
        f32x4* xr = (f32x4*)(P.out + (size_t)m * DM) + lane; const u32x2* zr = (const u32x2*)(Z + (size_t)m * DM) + lane;
        f32x4 v[4], z[4]; float s = 0.f;
#pragma unroll
        for (int j = 0; j < 4; ++j) { v[j] = xr[64 * j]; const u32x2 w = zr[64 * j]; z[j] = (f32x4){bflo(w.x), bfhi(w.x), bflo(w.y), bfhi(w.y)};
            s += (z[j].x * z[j].x + z[j].y * z[j].y) + (z[j].z * z[j].z + z[j].w * z[j].w); }
        const float rz = rsqrtf(wave_sum(s) * (1.f / DM) + EPS);
#pragma unroll
        for (int j = 0; j < 4; ++j) { const f32x4 g = ((const f32x4*)P.b_post_g)[lane + 64 * j]; xr[64 * j] = v[j] + z[j] * rz * g; }
    }
}
__device__ __forceinline__ void first_token_u0(const Params& P, const Wk& W, LAS unsigned char* lds, int widx) {
    unsigned char* ws = P.ws;
    const int bh = widx >> 2, sl = widx & 3, b = bh >> 2, h = bh & 3, j = W.tid % 192, sub = W.tid / 192; const size_t row = (size_t)b * SEQ;
    LAS float* hs = (LAS float*)lds;
    if (W.tid < 256) hs[W.tid] = P.out[row * DM + sl * 256 + W.tid] * P.b_pre_g[sl * 256 + W.tid] * ((const float*)(ws + WS_RSTD))[row];
    __syncthreads();
    if (W.tid < 384) {
        const float* wp = P.b_w_in + (size_t)(sl * 256 + sub * 128) * B_IN + h * 192 + j; float a = 0.f;
#pragma unroll 64
        for (int k = 0; k < 128; ++k) a += hs[sub * 128 + k] * wp[(size_t)k * B_IN];
        atomicAdd((float*)(ws + WS_U0) + bh * 192 + j, a); }
    __syncthreads();
}
__device__ __forceinline__ void first_token_qk(const Params& P, const Wk& W, LAS unsigned char* lds) {
    if (W.vcu < 224 || W.vcu >= 256) return;
    unsigned char* ws = P.ws;
    const int bh = W.vcu - 224, h = bh & 3, tid = W.tid;
    LAS float* uc0 = (LAS float*)lds; LAS float* qk0 = uc0 + 192;
    float wv[96];
    const int o = tid % 192, part = tid / 192, j = o % 96;
    if (tid < 384) { const float* Wm = (o < 96 ? P.b_w_q : P.b_w_k) + (size_t)h * 192 * 96 + (size_t)(part * 96) * 96 + j;
#pragma unroll
        for (int i = 0; i < 96; ++i) wv[i] = Wm[i * 96]; }
    if (tid < 192) { const int col = h * 192 + tid; uc0[tid] = silu_f(P.b_conv_b[col] + P.b_conv_w[3 * 768 + col] * ((const float*)(ws + WS_U0))[bh * 192 + tid]); }
    __syncthreads();
    if (tid < 384) { float a = 0.f;
#pragma unroll
        for (int i = 0; i < 96; ++i) a += uc0[part * 96 + i] * wv[i];
        qk0[part * 192 + o] = a; }
    __syncthreads();
    if (tid < 64) { float a = (qk0[tid] + qk0[192 + tid]) * (qk0[96 + tid] + qk0[288 + tid]); if (tid < 32) a += (qk0[64 + tid] + qk0[256 + tid]) * (qk0[160 + tid] + qk0[352 + tid]);
        a = wave_sum(a); if (tid == 0) ((float*)(ws + WS_C0))[bh] = a * KSCALE_B; }
    __syncthreads();
}
__device__ __forceinline__ void phase_conv(const Params& P, const Wk& W) {
    unsigned char* ws = P.ws;
    const bf16_t* G2 = (const bf16_t*)(ws + WS_G); bf16_t* UC = (bf16_t*)(ws + WS_UC);
    const int gt = W.vcu * 512 + W.tid, NGT = W.G * 512;
    for (int it = gt; it < (T / 8) * 96; it += NGT) {
        const int rg = it / 96, cc = it % 96, row0 = rg * 8, c0 = cc * 8, s0 = row0 & (SEQ - 1);
        float w[4][8], bsv[8];
#pragma unroll
        for (int j = 0; j < 4; ++j) { const f32x4 a = *(const f32x4*)(P.b_conv_w + j * 768 + c0), b = *(const f32x4*)(P.b_conv_w + j * 768 + c0 + 4);
            w[j][0] = a.x; w[j][1] = a.y; w[j][2] = a.z; w[j][3] = a.w; w[j][4] = b.x; w[j][5] = b.y; w[j][6] = b.z; w[j][7] = b.w; }
        { const f32x4 a = *(const f32x4*)(P.b_conv_b + c0), b = *(const f32x4*)(P.b_conv_b + c0 + 4); bsv[0] = a.x; bsv[1] = a.y; bsv[2] = a.z; bsv[3] = a.w; bsv[4] = b.x; bsv[5] = b.y; bsv[6] = b.z; bsv[7] = b.w; }
        float h[3][8];
#pragma unroll
        for (int j = 0; j < 3; ++j) {
            if (s0 - 3 + j >= 0) { const u32x4 q = *(const u32x4*)(G2 + (size_t)(row0 - 3 + j) * G2W + G2_U + c0);
                h[j][0] = bflo(q.x); h[j][1] = bfhi(q.x); h[j][2] = bflo(q.y); h[j][3] = bfhi(q.y); h[j][4] = bflo(q.z); h[j][5] = bfhi(q.z); h[j][6] = bflo(q.w); h[j][7] = bfhi(q.w); }
            else {
#pragma unroll
                for (int e = 0; e < 8; ++e) h[j][e] = 0.f; }
        }
#pragma unroll
        for (int r = 0; r < 8; ++r) {
            const u32x4 q = *(const u32x4*)(G2 + (size_t)(row0 + r) * G2W + G2_U + c0);
            float u[8] = {bflo(q.x), bfhi(q.x), bflo(q.y), bfhi(q.y), bflo(q.z), bfhi(q.z), bflo(q.w), bfhi(q.w)};
            float o[8];
#pragma unroll
            for (int e = 0; e < 8; ++e) { const float cv = bsv[e] + h[0][e] * w[0][e] + h[1][e] * w[1][e] + h[2][e] * w[2][e] + u[e] * w[3][e]; o[e] = silu_f(cv);
                h[0][e] = h[1][e]; h[1][e] = h[2][e]; h[2][e] = u[e]; }
            u32x4 ov; ov.x = cvt_pk_bf16(o[0], o[1]); ov.y = cvt_pk_bf16(o[2], o[3]); ov.z = cvt_pk_bf16(o[4], o[5]); ov.w = cvt_pk_bf16(o[6], o[7]);
            *(u32x4*)(UC + (size_t)(row0 + r) * 768 + c0) = ov;
        }
    }
}
namespace ml {
__device__ __forceinline__ int crow(int r, int hi) { return (r & 3) + 8 * (r >> 2) + 4 * hi; }
template <int NKS>
__device__ __forceinline__ f32x16 tile32(const LAS bf16_t* A, int lda, const LAS bf16_t* B, int ldb, int r32, int hi, f32x16 acc) {
    const LAS bf16_t* ap = A + r32 * lda + hi * 8; const LAS bf16_t* bp = B + r32 * ldb + hi * 8;
#pragma unroll
    for (int ks = 0; ks < NKS; ++ks) { const bf16x8 a = *(const LAS bf16x8*)(ap + ks * 16); const bf16x8 b = *(const LAS bf16x8*)(bp + ks * 16);
        acc = __builtin_amdgcn_mfma_f32_32x32x16_bf16(a, b, acc, 0, 0, 0); }
    return acc;
}
__device__ __forceinline__ float logsigmoid_f(float f) { return fminf(f, 0.f) - log1pf(__expf(-fabsf(f))); }
__device__ __forceinline__ float scan_add(float v, int lane) {
#pragma unroll
    for (int o = 1; o < 64; o <<= 1) { const float t = __shfl_up(v, o); if (lane >= o) v += t; }
    return v;
}
__device__ __forceinline__ float scan_max(float v, int lane) {
#pragma unroll
    for (int o = 1; o < 64; o <<= 1) { const float t = __shfl_up(v, o); if (lane >= o) v = fmaxf(v, t); }
    return v;
}
constexpr int P72 = 72, P104 = 104;
__device__ __forceinline__ float sum8(const u32x4 q) { return ((bflo(q.x) + bfhi(q.x)) + (bflo(q.y) + bfhi(q.y))) + ((bflo(q.z) + bfhi(q.z)) + (bflo(q.w) + bfhi(q.w))); }

__device__ __forceinline__ void pass1_unit(const Params& P, const Wk& W, LAS unsigned char* lds, int u) {
    unsigned char* ws = P.ws;
    const int bh = u >> 6, c = u & 63, b = bh >> 2, h = bh & 3, row0 = b * SEQ + c * 64;
    LAS bf16_t* vT = (LAS bf16_t*)lds;
    LAS bf16_t* kwT = (LAS bf16_t*)(lds + 27648);
    LAS float* wsl = (LAS float*)(lds + 41472);
    const float* ifp = (const float*)(ws + WS_IFP);
    const int tid = W.tid, lane = W.lane, wid = W.wave, r32 = lane & 31, hi = lane >> 5;
    if (wid == 0) {
        const float li = ifp[(size_t)(row0 + lane) * 8 + h], f = ifp[(size_t)(row0 + lane) * 8 + 4 + h];
        const float bcs = scan_add(logsigmoid_f(f), lane);
        const float bL = __shfl(bcs, 63);
        const float dec = bL - bcs + li;
        const float mloc = wave_max(dec);
        wsl[lane] = __expf(dec - mloc);
        if (lane == 0) { ((float*)(ws + WS_BL))[u] = bL; ((float*)(ws + WS_MLOC))[u] = mloc; }
    }
    __syncthreads();
    const bf16_t* QK = (const bf16_t*)(ws + WS_QK); const bf16_t* VV = (const bf16_t*)(ws + WS_VV);
    {
        u32x4 q[5];
#pragma unroll
        for (int i = 0; i < 5; ++i) { const int id = tid + 512 * i;
            if (id < 768) q[i] = *(const u32x4*)(QK + (size_t)(row0 + (id & 63)) * 768 + h * 192 + 96 + (id >> 6) * 8);
            else if (id < 2304) q[i] = *(const u32x4*)(VV + (size_t)(row0 + (id & 63)) * 768 + h * 192 + ((id - 768) >> 6) * 8); }
#pragma unroll
        for (int i = 0; i < 5; ++i) { const int id = tid + 512 * i, row = id & 63;
            if (id < 768) { const int cc = id >> 6; const float wv = wsl[row];
                const float e[8] = {bflo(q[i].x), bfhi(q[i].x), bflo(q[i].y), bfhi(q[i].y), bflo(q[i].z), bfhi(q[i].z), bflo(q[i].w), bfhi(q[i].w)};
#pragma unroll
                for (int j = 0; j < 8; ++j) kwT[(cc * 8 + j) * P72 + row] = f2bf(e[j] * wv);
            } else if (id < 2304) { const int cc = (id - 768) >> 6;
                const unsigned short e[8] = {(unsigned short)(q[i].x & 0xffff), (unsigned short)(q[i].x >> 16), (unsigned short)(q[i].y & 0xffff), (unsigned short)(q[i].y >> 16), (unsigned short)(q[i].z & 0xffff), (unsigned short)(q[i].z >> 16), (unsigned short)(q[i].w & 0xffff), (unsigned short)(q[i].w >> 16)};
#pragma unroll
                for (int j = 0; j < 8; ++j) vT[(cc * 8 + j) * P72 + row] = e[j]; }
        }
    }
    __syncthreads();
    bf16_t* DC = (bf16_t*)(ws + WS_DC) + (size_t)u * (192 * 96);
    for (int tt = wid; tt < 18; tt += 8) {
        const int mt = tt / 3, nt = tt % 3;
        f32x16 acc = f32x16{};
        acc = tile32<4>(vT + mt * 32 * P72, P72, kwT + nt * 32 * P72, P72, r32, hi, acc);
#pragma unroll
        for (int r = 0; r < 16; ++r) DC[(mt * 32 + crow(r, hi)) * 96 + nt * 32 + r32] = f2bf(acc[r]);
    }
    if (tid < 384) { const int dk = tid >> 2, sub = tid & 3;
        float s = sum8(*(const LAS u32x4*)(kwT + dk * P72 + sub * 8)) + sum8(*(const LAS u32x4*)(kwT + dk * P72 + (sub + 4) * 8));
        s += __shfl_xor(s, 1); s += __shfl_xor(s, 2);
        if (sub == 0) ((float*)(ws + WS_DN))[(size_t)u * 96 + dk] = s; }
    __syncthreads();
}

__device__ __forceinline__ void pass2(const Params& P, const Wk& W) {
    unsigned char* ws = P.ws;
    const float* BL = (const float*)(ws + WS_BL); const float* ML = (const float*)(ws + WS_MLOC); float* MST = (float*)(ws + WS_MST);
    const int gt = W.vcu * 512 + W.tid, NGT = W.G * 512;
    constexpr int NCE = 32 * 2304, NNE = 32 * 96;
    for (int g = gt; g < NCE + NNE; g += NGT) {
        if (g < NCE) {
            const int bh = g / 2304, e = g % 2304;
            float C[8]; float m = 0.f;
#pragma unroll
            for (int j = 0; j < 8; ++j) C[j] = 0.f;
            u32x4* base = (u32x4*)((bf16_t*)(ws + WS_DC) + (size_t)bh * 64 * 18432 + e * 8);
            for (int c0 = 0; c0 < 64; c0 += 8) {
                u32x4 d[8]; float bL[8], ml[8];
#pragma unroll
                for (int j = 0; j < 8; ++j) { d[j] = base[(size_t)(c0 + j) * (18432 / 8)]; bL[j] = BL[bh * 64 + c0 + j]; ml[j] = ML[bh * 64 + c0 + j]; }
#pragma unroll
                for (int j = 0; j < 8; ++j) {
                    u32x4 o; o.x = cvt_pk_bf16(C[0], C[1]); o.y = cvt_pk_bf16(C[2], C[3]); o.z = cvt_pk_bf16(C[4], C[5]); o.w = cvt_pk_bf16(C[6], C[7]);
                    base[(size_t)(c0 + j) * (18432 / 8)] = o;
                    if (e == 0) MST[bh * 64 + c0 + j] = m;
                    const float mn = fmaxf(bL[j] + m, ml[j]), a = __expf(bL[j] + m - mn), w = __expf(ml[j] - mn);
                    C[0] = a * C[0] + w * bflo(d[j].x); C[1] = a * C[1] + w * bfhi(d[j].x); C[2] = a * C[2] + w * bflo(d[j].y); C[3] = a * C[3] + w * bfhi(d[j].y);
                    C[4] = a * C[4] + w * bflo(d[j].z); C[5] = a * C[5] + w * bfhi(d[j].z); C[6] = a * C[6] + w * bflo(d[j].w); C[7] = a * C[7] + w * bfhi(d[j].w);
                    m = mn;
                }
            }
        } else {
            const int g2 = g - NCE, bh = g2 / 96, e = g2 % 96;
            float n = 0.f, m = 0.f; float* base = (float*)(ws + WS_DN) + (size_t)bh * 64 * 96 + e;
            for (int c0 = 0; c0 < 64; c0 += 8) { float d[8], bL[8], ml[8];
#pragma unroll
                for (int j = 0; j < 8; ++j) { d[j] = base[(c0 + j) * 96]; bL[j] = BL[bh * 64 + c0 + j]; ml[j] = ML[bh * 64 + c0 + j]; }
#pragma unroll
                for (int j = 0; j < 8; ++j) { base[(c0 + j) * 96] = n; const float mn = fmaxf(bL[j] + m, ml[j]), a = __expf(bL[j] + m - mn), w = __expf(ml[j] - mn); n = a * n + w * d[j]; m = mn; } }
        }
    }
}

__device__ __forceinline__ void pass3_phase(const Params& P, const Wk& W, LAS unsigned char* lds) {
    unsigned char* ws = P.ws;
    LAS bf16_t* Qs = (LAS bf16_t*)lds;
    LAS bf16_t* Ks = (LAS bf16_t*)(lds + 13312);
    LAS bf16_t* vT = (LAS bf16_t*)(lds + 26624);
    LAS bf16_t* CT = (LAS bf16_t*)(lds + 54272);
    LAS bf16_t* Ps = (LAS bf16_t*)(lds + 94208);
    LAS float* Hs = (LAS float*)lds;
    LAS float* sm = (LAS float*)(lds + 103424);
    LAS float* g_s = sm, *Mt = sm + 64, *wint = sm + 128, *eneg = sm + 192, *qn = sm + 256, *rden = sm + 320, *nvec = sm + 384;
    const float* ifp = (const float*)(ws + WS_IFP);
    const bf16_t* QK = (const bf16_t*)(ws + WS_QK); const bf16_t* VV = (const bf16_t*)(ws + WS_VV);
    const int tid = W.tid, lane = W.lane, wid = W.wave, r32 = lane & 31, hi = lane >> 5;
    int u = W.vcu; if (u >= 2048) return;
    u32x4 qa[3], qb[3], qc[5]; float pli = 0.f, pf = 0.f, pm = 0.f, pn = 0.f, pc0 = 0.f;
#define P3_LOAD(uu) do { const int bh_ = (uu) >> 6, c_ = (uu) & 63, b_ = bh_ >> 2, h_ = bh_ & 3, row0_ = b_ * SEQ + c_ * 64; \
        const char* CS_ = (const char*)(ws + WS_DC) + (size_t)(uu) * (192 * 96 * 2); \
        _Pragma("unroll") for (int i = 0; i < 3; ++i) { const int id = tid + 512 * i; \
            { const int which = id / 768, i2 = id % 768, row = i2 / 12, cc = i2 % 12; qa[i] = *(const u32x4*)((const char*)QK + (unsigned)(((row0_ + row) * 768 + h_ * 192 + which * 96 + cc * 8) * 2)); } \
            { const int cc = id >> 6, row = id & 63; qb[i] = *(const u32x4*)((const char*)VV + (unsigned)(((row0_ + row) * 768 + h_ * 192 + cc * 8) * 2)); } } \
        _Pragma("unroll") for (int i = 0; i < 5; ++i) { const int id = tid + 512 * i; if (id < 2304) qc[i] = *(const u32x4*)(CS_ + (unsigned)(id * 16)); } \
        if (wid == 0) { pm = ((const float*)(ws + WS_MST))[uu]; pc0 = ((const float*)(ws + WS_C0))[bh_]; pli = *(const float*)((const char*)ifp + (unsigned)(((row0_ + lane) * 8 + h_) * 4)); pf = *(const float*)((const char*)ifp + (unsigned)(((row0_ + lane) * 8 + 4 + h_) * 4)); } \
        if (tid < 96) pn = *(const float*)((const char*)(ws + WS_DN) + (unsigned)(((uu) * 96 + tid) * 4)); } while (0)
    P3_LOAD(u);
    for (;;) {
        const int bh = u >> 6, c = u & 63, b = bh >> 2, h = bh & 3, row0 = b * SEQ + c * 64;
        const int un = u + W.G;
        const float c0cur = pc0;
        if (wid == 0) {
            const float bcs = scan_add(logsigmoid_f(pf), lane);
            const float g = pli - bcs;
            const float pmx = scan_max(g, lane);
            const float M = fmaxf(pm, pmx);
            g_s[lane] = g; Mt[lane] = M; wint[lane] = __expf(pm - M); eneg[lane] = __expf(-bcs - M);
        }
#pragma unroll
        for (int i = 0; i < 3; ++i) { const int id = tid + 512 * i;
            { const int which = id / 768, i2 = id % 768, row = i2 / 12, cc = i2 % 12; *(LAS u32x4*)((which ? Ks : Qs) + row * P104 + cc * 8) = qa[i]; }
            { const int cc = id >> 6, row = id & 63;
              const unsigned short e[8] = {(unsigned short)(qb[i].x & 0xffff), (unsigned short)(qb[i].x >> 16), (unsigned short)(qb[i].y & 0xffff), (unsigned short)(qb[i].y >> 16), (unsigned short)(qb[i].z & 0xffff), (unsigned short)(qb[i].z >> 16), (unsigned short)(qb[i].w & 0xffff), (unsigned short)(qb[i].w >> 16)};
#pragma unroll
              for (int j = 0; j < 8; ++j) vT[(cc * 8 + j) * P72 + row] = e[j]; } }
#pragma unroll
        for (int i = 0; i < 5; ++i) { const int id = tid + 512 * i; if (id < 2304) { const int dv = id / 12, cc = id % 12; *(LAS u32x4*)(CT + dv * P104 + cc * 8) = qc[i]; } }
        if (tid < 96) nvec[tid] = pn;
        __syncthreads();
        if (un < 2048) P3_LOAD(un);
        __builtin_amdgcn_sched_barrier(0);
        if (wid < 4) {
            const int mt = wid >> 1, nt = wid & 1;
            f32x16 acc = f32x16{};
            acc = tile32<6>(Qs + mt * 32 * P104, P104, Ks + nt * 32 * P104, P104, r32, hi, acc);
#ifndef NO_FIRST_TOKEN
            if (c == 0 && wid == 0 && lane == 0) acc[0] = c0cur;
#endif
            const int s = nt * 32 + r32; const float gs = g_s[s];
#pragma unroll
            for (int r = 0; r < 16; ++r) { const int t = mt * 32 + crow(r, hi);
                const float w = (s <= t) ? __expf(gs - Mt[t]) : 0.f;
                Ps[t * P72 + s] = f2bf(acc[r] * w); }
        } else {
            const int t = (tid - 256) >> 2, sub = tid & 3; float a = 0.f;
#pragma unroll
            for (int j = 0; j < 3; ++j) { const int cc = sub + 4 * j; const u32x4 q = *(const LAS u32x4*)(Qs + t * P104 + cc * 8); const LAS float* nv = nvec + cc * 8;
                a += (bflo(q.x) * nv[0] + bfhi(q.x) * nv[1]) + (bflo(q.y) * nv[2] + bfhi(q.y) * nv[3]) + (bflo(q.z) * nv[4] + bfhi(q.z) * nv[5]) + (bflo(q.w) * nv[6] + bfhi(q.w) * nv[7]); }
            a += __shfl_xor(a, 1); a += __shfl_xor(a, 2);
            if (sub == 0) qn[t] = a;
        }
        __syncthreads();
        { const int t = tid >> 3, sub = tid & 7;
          float rs = sum8(*(const LAS u32x4*)(Ps + t * P72 + sub * 8));
          rs += __shfl_xor(rs, 1); rs += __shfl_xor(rs, 2); rs += __shfl_xor(rs, 4);
          if (sub == 0) { float den = wint[t] * qn[t] + rs; den = fmaxf(fabsf(den), eneg[t]); rden[t] = 1.f / den; } }
        const int te = tid >> 3, sube = tid & 7;
        const bf16_t* G2 = (const bf16_t*)(ws + WS_G) + (size_t)(row0 + te) * G2W; const bf16_t* UC = (const bf16_t*)(ws + WS_UC) + (size_t)(row0 + te) * 768;
        u32x4 eop[3], egq[3], euq[3];
#pragma unroll
        for (int j = 0; j < 3; ++j) { const int col = h * 192 + (sube + 8 * j) * 8; eop[j] = *(const u32x4*)(G2 + G2_O + col); egq[j] = *(const u32x4*)(G2 + G2_GATE + col); euq[j] = *(const u32x4*)(UC + col); }
        f32x16 accA = f32x16{}, accB = f32x16{};
        {
            const int tt = wid, mt = tt / 6, nt = tt % 6;
            accA = tile32<6>(Qs + mt * 32 * P104, P104, CT + nt * 32 * P104, P104, r32, hi, accA);
#pragma unroll
            for (int r = 0; r < 16; ++r) accA[r] *= wint[mt * 32 + crow(r, hi)];
            accA = tile32<4>(Ps + mt * 32 * P72, P72, vT + nt * 32 * P72, P72, r32, hi, accA);
        }
        if (wid < 4) {
            const int tt = wid + 8, mt = tt / 6, nt = tt % 6;
            accB = tile32<6>(Qs + mt * 32 * P104, P104, CT + nt * 32 * P104, P104, r32, hi, accB);
#pragma unroll
            for (int r = 0; r < 16; ++r) accB[r] *= wint[mt * 32 + crow(r, hi)];
            accB = tile32<4>(Ps + mt * 32 * P72, P72, vT + nt * 32 * P72, P72, r32, hi, accB);
        }
        __syncthreads();
        {
            const int tt = wid, mt = tt / 6, nt = tt % 6;
#pragma unroll
            for (int r = 0; r < 16; ++r) { const int t = mt * 32 + crow(r, hi); Hs[t * 196 + nt * 32 + r32] = accA[r] * rden[t]; }
        }
        if (wid < 4) {
            const int tt = wid + 8, mt = tt / 6, nt = tt % 6;
#pragma unroll
            for (int r = 0; r < 16; ++r) { const int t = mt * 32 + crow(r, hi); Hs[t * 196 + nt * 32 + r32] = accB[r] * rden[t]; }
        }
        __syncthreads();
        __builtin_amdgcn_sched_barrier(0);
        {
            float hv[3][8]; float ss = 0.f;
#pragma unroll
            for (int j = 0; j < 3; ++j) { const int col = (sube + 8 * j) * 8;
                const f32x4 a = *(const LAS f32x4*)(Hs + te * 196 + col), bq = *(const LAS f32x4*)(Hs + te * 196 + col + 4);
                hv[j][0] = a.x; hv[j][1] = a.y; hv[j][2] = a.z; hv[j][3] = a.w; hv[j][4] = bq.x; hv[j][5] = bq.y; hv[j][6] = bq.z; hv[j][7] = bq.w;
#pragma unroll
                for (int e = 0; e < 8; ++e) ss += hv[j][e] * hv[j][e]; }
            ss += __shfl_xor(ss, 1); ss += __shfl_xor(ss, 2); ss += __shfl_xor(ss, 4);
            const float rstd = rsqrtf(ss * (1.f / 192.f) + EPS);
            bf16_t* Y = (bf16_t*)(ws + WS_Y2) + (size_t)(row0 + te) * DM;
#pragma unroll
            for (int j = 0; j < 3; ++j) { const int col = h * 192 + (sube + 8 * j) * 8;
                const u32x4 op = eop[j], gq = egq[j], uq = euq[j];
                const float ov[8] = {bflo(op.x), bfhi(op.x), bflo(op.y), bfhi(op.y), bflo(op.z), bfhi(op.z), bflo(op.w), bfhi(op.w)};
                const float gv[8] = {bflo(gq.x), bfhi(gq.x), bflo(gq.y), bfhi(gq.y), bflo(gq.z), bfhi(gq.z), bflo(gq.w), bfhi(gq.w)};
                const float uv[8] = {bflo(uq.x), bfhi(uq.x), bflo(uq.y), bfhi(uq.y), bflo(uq.z), bfhi(uq.z), bflo(uq.w), bfhi(uq.w)};
                float o[8];
#pragma unroll
                for (int e = 0; e < 8; ++e) { const float hn = hv[j][e] * rstd * P.b_head_g[col + e]; const float mix = sigmoid_f(ov[e]) * hn + P.b_skip[col + e] * uv[e]; o[e] = mix * silu_f(gv[e]); }
                u32x4 w; w.x = cvt_pk_bf16(o[0], o[1]); w.y = cvt_pk_bf16(o[2], o[3]); w.z = cvt_pk_bf16(o[4], o[5]); w.w = cvt_pk_bf16(o[6], o[7]);
                *(u32x4*)(Y + col) = w; }
        }
        __syncthreads();
        if (un >= 2048) break;
        u = un;
    }
#undef P3_LOAD
}
}
typedef GAS unsigned gu32;
#define XB_TMO      128
#define XB_XCNT(j)  (256  + 64 * (j))
#define XB_XSUB(j)  (1280 + 64 * (j))
#define XB_XGEN(j)  (2304 + 64 * (j))
#define XB_TOP      3328
#define XB_TOPGEN   3392
#define XCD_BAR_WORDS 3456
#define XB_SPIN_CAP (1u << 18)
__device__ __forceinline__ unsigned xb_ld(unsigned* p)              { return __hip_atomic_load(p, __ATOMIC_RELAXED, __HIP_MEMORY_SCOPE_AGENT); }
__device__ __forceinline__ unsigned xb_add(unsigned* p, unsigned v) { return __hip_atomic_fetch_add(p, v, __ATOMIC_RELAXED, __HIP_MEMORY_SCOPE_AGENT); }
__device__ __forceinline__ unsigned xb_xcc_id() { return (unsigned)__builtin_amdgcn_s_getreg((3 << 11) | 20) & 0xFu; }
#define XB_SPIN(cond, bar) do { unsigned _sp = 0; while (cond) { __builtin_amdgcn_s_sleep(1); \
    if ((++_sp & 255u) == 0u) { if (xb_ld(&(bar)[XB_TMO])) break; if (_sp > XB_SPIN_CAP) { atomicAdd(&(bar)[XB_TMO], 1u); break; } } } } while (0)
struct XcdBarrier { unsigned* bar; unsigned x; volatile LAS unsigned* st; };
__device__ __forceinline__ XcdBarrier xcd_barrier_post(unsigned* bar, volatile LAS unsigned* st) {
    XcdBarrier b; b.bar = bar; b.x = xb_xcc_id(); b.st = st;
    if (threadIdx.x == 0) (void)xb_add(&bar[XB_XCNT(b.x)], 1u);
    return b;
}
__device__ __forceinline__ void xcd_barrier_complete(unsigned* bar, unsigned x, unsigned& nloc, unsigned& nx) {
    const unsigned G = gridDim.x * gridDim.y * gridDim.z;
    unsigned sum, cnt, mine, sp = 0u;
    for (;;) {
        sum = 0u; cnt = 0u; mine = 0u;
#pragma unroll
        for (unsigned j = 0; j < 16; ++j) { const unsigned c = xb_ld(&bar[XB_XCNT(j)]); sum += c; cnt += (c > 0u) ? 1u : 0u; mine = (j == x) ? c : mine; }
        if (sum == G) break;
        __builtin_amdgcn_s_sleep(1);
        if ((++sp & 255u) == 0u) { if (xb_ld(&bar[XB_TMO])) break; if (sp > XB_SPIN_CAP) { atomicAdd(&bar[XB_TMO], 1u); break; } }
    }
    nloc = mine > 0u ? mine : 1u; nx = cnt > 0u ? cnt : 1u;
}
__device__ __forceinline__ void xcd_barrier(const XcdBarrier& b) {
    asm volatile("s_waitcnt vmcnt(0)" ::: "memory");
    __syncthreads();
    if (threadIdx.x == 0) {
        unsigned* bar = b.bar;
        __builtin_amdgcn_s_waitcnt(0);
        unsigned nloc = b.st[0], nx = b.st[1];
        if (nloc == 0u) { xcd_barrier_complete(bar, b.x, nloc, nx); b.st[0] = nloc; b.st[1] = nx; }
        const unsigned old = xb_add(&bar[XB_XSUB(b.x)], 1u);
        const unsigned gen = old / nloc;
        if (old + 1u == (gen + 1u) * nloc) {
            __builtin_amdgcn_fence(__ATOMIC_RELEASE, "agent");
            asm volatile("s_waitcnt vmcnt(0)" ::: "memory");
            const unsigned og = xb_add(&bar[XB_TOP], 1u);
            const unsigned tg = og / nx;
            if (og + 1u == (tg + 1u) * nx) xb_add(&bar[XB_TOPGEN], 1u);
            else XB_SPIN(xb_ld(&bar[XB_TOPGEN]) == tg, bar);
            __builtin_amdgcn_fence(__ATOMIC_ACQUIRE, "agent");
            xb_add(&bar[XB_XGEN(b.x)], 1u);
            asm volatile("s_waitcnt vmcnt(0)" ::: "memory");
        } else {
            XB_SPIN(xb_ld(&bar[XB_XGEN(b.x)]) == gen, bar);
            __builtin_amdgcn_fence(__ATOMIC_ACQUIRE, "agent");
            asm volatile("s_waitcnt vmcnt(0)" ::: "memory");
        }
    }
    __syncthreads();
}

constexpr int RING_BYTES = 131072, LDSCTL_OFF = RING_BYTES, LDS_BYTES = 147456;
constexpr int CW_BAR = 4096;
constexpr int N_PHASES = 14;

__device__ __forceinline__ void setup_job(const Params& P, int j, pg8::Gemm& g, pg8::Epi& E) {
    unsigned char* ws = P.ws;
    E.out = nullptr; E.ldc = 0; E.ncols = 1 << 30; E.out2 = nullptr; E.ldc2 = 0; E.split = 1 << 30; E.rs = nullptr; E.rs_mode = 0; E.rs_invdim = 0.f;
    E.ssqA = nullptr; E.ssqB = nullptr; E.ssq_mode = 0; E.rope = (const float2*)(ws + WS_ROPE); E.rope_mode = 0;
    g.M = T; g.lda = 1024; g.apn = 0;
    switch (j) {
    case 0: g.A = (const bf16_t*)(ws + WS_XB); g.Bt = (const bf16_t*)(ws + WS_WINA); g.N = 2048; g.K = 1024;
        E.out = (bf16_t*)(ws + WS_G); E.ldc = G1W; E.rs = (const float*)(ws + WS_RSTD); E.rs_mode = 1; E.ssqA = (float*)(ws + WS_SSQA); E.ssqB = (float*)(ws + WS_SSQB); E.ssq_mode = 1; E.rope_mode = 1; break;
    case 1: g.A = (const bf16_t*)(ws + WS_MEMN); g.Bt = (const bf16_t*)(ws + WS_WMKV); g.M = NB * NMEM; g.N = 1024; g.K = 1024;
        E.out = (bf16_t*)(ws + WS_KVM); E.ldc = 1024; break;
    case 2: g.A = (const bf16_t*)(ws + WS_G) + G1_CQ; g.lda = G1W; g.Bt = (const bf16_t*)(ws + WS_WUQ); g.N = 1280; g.K = 384;
        E.out = (bf16_t*)(ws + WS_Q); E.ldc = QW; E.ncols = QW; E.rs = (const float*)(ws + WS_SSQA); E.rs_mode = 2; E.rs_invdim = 1.f / 384.f; E.rope_mode = 2; break;
    case 3: g.A = (const bf16_t*)(ws + WS_G) + G1_CKV; g.lda = G1W; g.Bt = (const bf16_t*)(ws + WS_WUKV); g.N = 1536; g.K = 256;
        E.out = (bf16_t*)(ws + WS_KN); E.ldc = 768; E.out2 = (bf16_t*)(ws + WS_V); E.ldc2 = 768; E.split = 768; E.rs = (const float*)(ws + WS_SSQB); E.rs_mode = 2; E.rs_invdim = 1.f / 256.f; break;
    case 4: g.A = (const bf16_t*)(ws + WS_Y); g.Bt = (const bf16_t*)(ws + WS_WOA); g.N = 1024; g.K = 1024; E.out = (bf16_t*)(ws + WS_Z); E.ldc = 1024; break;
    case 5: g.A = (const bf16_t*)(ws + WS_XB); g.Bt = (const bf16_t*)(ws + WS_WINB); g.N = G2W; g.K = 1024;
        E.out = (bf16_t*)(ws + WS_G); E.ldc = G2W; E.rs = (const float*)(ws + WS_RSTD); E.rs_mode = 1; break;
    case 6: g.A = (const bf16_t*)(ws + WS_UC); g.lda = 768; g.apn = 192; g.Bt = (const bf16_t*)(ws + WS_WQK); g.N = 768; g.K = 384; E.out = (bf16_t*)(ws + WS_QK); E.ldc = 768; break;
    case 7: g.A = (const bf16_t*)(ws + WS_G) + G2_U; g.lda = G2W; g.apn = 192; g.Bt = (const bf16_t*)(ws + WS_WV); g.N = 768; g.K = 384; E.out = (bf16_t*)(ws + WS_VV); E.ldc = 768; break;
    default: g.A = (const bf16_t*)(ws + WS_Y2); g.Bt = (const bf16_t*)(ws + WS_WOB); g.N = 1024; g.K = 1024; E.out = (bf16_t*)(ws + WS_Z); E.ldc = 1024; break;
    }
}

__device__ __forceinline__ void phase_memattn(const Params& P, const Wk& W, LAS unsigned char* lds, int L) {
    unsigned char* ws = P.ws;
    const bf16_t* G = (const bf16_t*)(ws + WS_G); const bf16_t* KVM = (const bf16_t*)(ws + WS_KVM);
    const int gpitch = L ? G2W : G1W, qm_off = L ? G2_QM : G1_QM, gate_off = L ? G2_GATE : G1_GATE;
    bf16_t* Yb = (bf16_t*)(ws + (L ? WS_Y2 : WS_Y));
    for (int u = W.vcu; u < 512; u += W.G) {
        const int rb = u >> 2, hm = u & 3, row0 = rb * 256, b = row0 / SEQ;
        const bf16_t* Km = KVM + (size_t)(b * NMEM) * 1024 + L * 512 + hm * 64;
        att::attn_unit<64, 64, false>(G + (size_t)row0 * gpitch + qm_off + hm * 64, gpitch, Km, 1024, 8, Km, 1024, Km + 256, 1024, 4, 0,
                                      G + (size_t)row0 * gpitch + gate_off + 768 + hm * 64, gpitch, Yb + (size_t)row0 * DM + 768 + hm * 64, DM, lds, W.tid);
    }
}
template <int ABL>
__device__ __forceinline__ void phase_attn(const Params& P, const Wk& W, LAS unsigned char* lds) {
    unsigned char* ws = P.ws;
    const bf16_t* G = (const bf16_t*)(ws + WS_G); const bf16_t* Qp = (const bf16_t*)(ws + WS_Q); const bf16_t* KN = (const bf16_t*)(ws + WS_KN); const bf16_t* Vp = (const bf16_t*)(ws + WS_V);
    bf16_t* Yb = (bf16_t*)(ws + (ABL ? WS_Z : WS_Y));
    for (int u = W.vcu; u < 768; u += W.G) {
        const int k = u >> 8, cu = u & 255, grp = cu >> 4, i = cu & 15, bh = grp * 3 + k;
        const int qb = (k == 0) ? i : (k == 1) ? ((i + 8) & 15) : (i < 8 ? 15 - 2 * i : 30 - 2 * i);
        const int b = bh / 6, h = bh % 6; const size_t rowb = (size_t)b * SEQ, row0 = rowb + (size_t)qb * 256;
        att::attn_unit<192, 128, true, ABL>(Qp + row0 * QW + h * 192, QW, KN + rowb * 768 + h * 128, 768, 16, G + rowb * G1W + G1_KR, G1W, Vp + rowb * 768 + h * 128, 768,
                                       4 * (qb + 1), qb * 256, G + row0 * G1W + G1_GATE + h * 128, G1W, Yb + row0 * DM + h * 128, DM, lds, W.tid);
    }
}

__global__ void __launch_bounds__(512, 2) mega_fwd(Params P) {
    extern __shared__ __attribute__((aligned(16))) unsigned char lds_raw[];
    LAS unsigned char* lds = (LAS unsigned char*)lds_raw;
    Wk W; W.tid = threadIdx.x; W.lane = W.tid & 63; W.wave = __builtin_amdgcn_readfirstlane(W.tid >> 6);
    W.G = gridDim.x; { const int bx = blockIdx.x; W.vcu = (W.G % 8 == 0) ? (bx % 8) * (W.G / 8) + bx / 8 : bx; }
    volatile LAS unsigned* MISC = (volatile LAS unsigned*)(lds + LDSCTL_OFF);
    if (W.tid < 64) MISC[W.tid] = 0u;
    __syncthreads();
    const int lo = P.ph_lo, hi = P.ph_hi;
    const int vcu_s = W.vcu;
    const int wave_s = __builtin_amdgcn_readfirstlane(threadIdx.x >> 6);
    XcdBarrier bar; bar.bar = (unsigned*)(P.ws + WS_CTL) + CW_BAR; bar.x = 0; bar.st = nullptr;
    if (hi - lo > 1) bar = xcd_barrier_post((unsigned*)(P.ws + WS_CTL) + CW_BAR, MISC + 8);
#ifndef PROBE_REP
#define PROBE_REP 0
#endif
#ifdef PROBE_PAIR
    bool pair_done = false;
#endif
    for (int ph2 = 2 * lo; ph2 < 2 * hi; ++ph2) {
        const int ph = ph2 >> 1;
        if ((ph2 & 1) && !((PROBE_REP >> ph) & 1)) continue;
        const bool more_ = (ph + 1 < hi) || (!(ph2 & 1) && ((PROBE_REP >> ph) & 1));
        { int t_; asm volatile("v_mbcnt_lo_u32_b32 %0, -1, 0\n\tv_mbcnt_hi_u32_b32 %0, -1, %0" : "=v"(t_)); t_ += wave_s * 64; { int g_ = gridDim.x, v_ = vcu_s; asm volatile("" : "+s"(g_), "+s"(v_)); W.G = g_; W.vcu = v_; } W.tid = t_; W.lane = t_ & 63; W.wave = __builtin_amdgcn_readfirstlane(t_ >> 6); }
        int j0 = 0, j1 = 0;
#ifdef DBG_CUT
        if (ph == 100) { const bf16_t* src = (const bf16_t*)(P.ws + (size_t)DBG_OFF); const int gt_ = W.vcu * 512 + W.tid, NGT_ = W.G * 512; for (int i = gt_; i < T * DM; i += NGT_) {
#ifdef DBG_F32N
            P.out[i] = (i < DBG_F32N) ? ((const float*)src)[i] : 0.f;
#else
            P.out[i] = bf2f(src[i]);
#endif
            } continue; }
#endif
#ifndef PHM
#define PHM 0xffff
#endif
#define PHON(k) ((PHM >> (k)) & 1)
        switch (ph) {
        case 0: if (PHON(0)) phase_prologue(P, W, lds); break;
        case 1: j0 = 0; j1 = 1; break;
        case 2: j0 = 1; j1 = 4; break;
        case 3: if (PHON(3)) {
#ifdef PROBE_ABL
            if (ph2 & 1) phase_attn<PROBE_ABL>(P, W, lds); else
#endif
            phase_attn<0>(P, W, lds); } break;
        case 4: j0 = 4; j1 = 5; break;
        case 5: if (PHON(5)) phase_rowmid(P, W, lds); break;
        case 6: j0 = 5; j1 = 6; break;
        case 7: if (PHON(7)) phase_conv(P, W); break;
        case 8: j0 = 6; j1 = 8; break;
        case 9: if (PHON(9)) for (int u = W.vcu; u < 2048; u += W.G) ml::pass1_unit(P, W, lds, u); break;
        case 10: if (PHON(10)) { ml::pass2(P, W);
#ifndef NO_FIRST_TOKEN
            first_token_qk(P, W, lds);
#endif
            } break;
        case 11: if (PHON(11)) ml::pass3_phase(P, W, lds); break;
        case 12: j0 = 8; j1 = 9; break;
        default: if (PHON(13)) phase_rowfinal(P, W); break;
        }
        if (PHON(14) && (ph == 3 || ph == 9) && !(ph2 & 1)) phase_memattn(P, W, lds, ph == 9 ? 1 : 0);
        if (PHON(1)) for (int j = j0; j < j1; ++j) {
            pg8::Gemm g; pg8::Epi E; setup_job(P, j, g, E);
            const int shift = (j == 1) ? 32 : (j == 7) ? 128 : 0;
            pg8::StaticOrder S; S.init(g.M, g.N, W.G, (int)((blockIdx.x + shift) % W.G));
            pg8::gemm_phase<true>(lds, g, S, E, W.tid);
        }
#ifndef NO_FIRST_TOKEN
        if (ph == 6 && (int)blockIdx.x >= 128 && (int)blockIdx.x < 256) first_token_u0(P, W, lds, (int)blockIdx.x - 128);
#endif
        if (more_) xcd_barrier(bar);
#ifdef PROBE_PAIR
        if (ph == PROBE_PAIR + 1 && !pair_done) { pair_done = true; ph2 = 2 * PROBE_PAIR - 1; }
#endif
    }
}

extern "C" void kernel_launch(void* const* d_in, const int* in_sizes, int n_in, void* d_out, int out_size, void* d_ws, size_t ws_size, hipStream_t stream) {
    static int grid = 0;
    if (grid == 0) {
        if (n_in != 27 || in_sizes[0] != T * DM || out_size != T * DM || ws_size < WS_END) {
            fprintf(stderr, "kernel_launch: unexpected shapes (n_in %d in0 %d out %d ws %zu)\n", n_in, n_in > 0 ? in_sizes[0] : -1, out_size, ws_size); grid = -1; return; }
        int dev = 0, cus = 0, per_cu = 0;
        if (hipGetDevice(&dev) != hipSuccess || hipDeviceGetAttribute(&cus, hipDeviceAttributeMultiprocessorCount, dev) != hipSuccess) { grid = -1; return; }
        if (hipFuncSetAttribute((const void*)mega_fwd, hipFuncAttributeMaxDynamicSharedMemorySize, LDS_BYTES) != hipSuccess) { fprintf(stderr, "kernel_launch: hipFuncSetAttribute failed\n"); grid = -1; return; }
        if (hipOccupancyMaxActiveBlocksPerMultiprocessor(&per_cu, (const void*)mega_fwd, 512, LDS_BYTES) != hipSuccess || per_cu < 1) { fprintf(stderr, "kernel_launch: occupancy query says %d\n", per_cu); }
        (void)hipGetLastError();
        grid = cus;
    }
    if (grid < 0) return;
    (void)hipMemsetAsync((char*)d_ws + WS_CTL, 0, CTL_ZERO_BYTES, stream);
    Params p{};
    const float** fp = (const float**)&p.a_pre_g;
    p.x = (const float*)d_in[0]; p.mem = (const float*)d_in[1]; p.pos = (const int*)d_in[2];
    for (int i = 0; i < 24; ++i) fp[i] = (const float*)d_in[3 + i];
    p.out = (float*)d_out; p.ws = (unsigned char*)d_ws;
#ifndef N_LAUNCH_SPLIT
#define N_LAUNCH_SPLIT 1
#endif
#ifdef DBG_CUT
    for (int ph = 0; ph < DBG_CUT; ++ph) { p.ph_lo = ph; p.ph_hi = ph + 1; hipLaunchKernelGGL(mega_fwd, dim3(grid), dim3(512), LDS_BYTES, stream, p); }
    p.ph_lo = 100; p.ph_hi = 101; hipLaunchKernelGGL(mega_fwd, dim3(grid), dim3(512), LDS_BYTES, stream, p);
#elif N_LAUNCH_SPLIT
    for (int ph = 0; ph < N_PHASES; ++ph) { p.ph_lo = ph; p.ph_hi = ph + 1; hipLaunchKernelGGL(mega_fwd, dim3(grid), dim3(512), LDS_BYTES, stream, p); }
#else
    p.ph_lo = 0; p.ph_hi = N_PHASES; hipLaunchKernelGGL(mega_fwd, dim3(grid), dim3(512), LDS_BYTES, stream, p);
#endif
}
```

```cpp
#include <hip/hip_runtime.h>
#include <cstdio>
#include <cstdint>

#define LAS __attribute__((address_space(3)))
#define GAS __attribute__((address_space(1)))
typedef unsigned short bf16_t;
typedef short bf16x8 __attribute__((ext_vector_type(8)));
typedef short s16x4 __attribute__((ext_vector_type(4)));
typedef float f32x4 __attribute__((ext_vector_type(4)));
typedef float f32x16 __attribute__((ext_vector_type(16)));
typedef unsigned u32x4 __attribute__((ext_vector_type(4)));
typedef unsigned u32x2 __attribute__((ext_vector_type(2)));

constexpr int NB = 8, SEQ = 4096, DM = 1024, T = NB * SEQ;
constexpr int NMEM = 256;
constexpr float EPS = 1e-6f;
constexpr int A_IN = 1984, B_IN = 2824;
constexpr int G1W = 2048;
constexpr int G1_CKV = 0, G1_CQ = 256, G1_KR = 640, G1_QM = 768, G1_GATE = 1024;
constexpr int G2W = 2816;
constexpr int G2_U = 0, G2_O = 768, G2_QM = 1536, G2_GATE = 1792;
constexpr int QW = 1152;
constexpr float LOG2E = 1.4426950408889634f;
constexpr float QSCALE = 0.07216878364870323f * LOG2E;
constexpr float MSCALE = 0.125f * LOG2E;
constexpr float KSCALE_B = 0.10206207261596577f;

constexpr size_t MiB = 1u << 20;
constexpr size_t WS_CTL = 0, CTL_ZERO_BYTES = 512 * 1024;
constexpr size_t WS_WINA = 2 * MiB;
constexpr size_t WS_WUQ = 6 * MiB;
constexpr size_t WS_WUKV = 7 * MiB;
constexpr size_t WS_WMKV = 8 * MiB;
constexpr size_t WS_WOA = 10 * MiB;
constexpr size_t WS_WINB = 12 * MiB;
constexpr size_t WS_WQK = 18 * MiB;
constexpr size_t WS_WV = 19 * MiB;
constexpr size_t WS_WOB = 20 * MiB;
constexpr size_t WS_WG = 22 * MiB;
constexpr size_t WS_RSTD = 23 * MiB;
constexpr size_t WS_SSQA = WS_RSTD + 128 * 1024;
constexpr size_t WS_SSQB = WS_SSQA + 128 * 1024;
constexpr size_t WS_ROPE = 24 * MiB;
constexpr size_t WS_MEMN = 32 * MiB;
constexpr size_t WS_KVM = 36 * MiB;
constexpr size_t WS_IFP = 40 * MiB;
constexpr size_t WS_BL = 41 * MiB;
constexpr size_t WS_MLOC = WS_BL + 8192;
constexpr size_t WS_MST = WS_MLOC + 8192;
constexpr size_t WS_C0 = WS_MST + 8192;
constexpr size_t WS_U0 = WS_C0 + 1024;
constexpr size_t WS_RS = 46 * MiB;
constexpr size_t WS_RN = 45 * MiB + 256 * 1024;
constexpr size_t WS_RBL = 45 * MiB + 512 * 1024;
constexpr size_t WS_X1F = 45 * MiB;
constexpr size_t WS_XSL = 44 * MiB;
constexpr size_t WS_DN = 42 * MiB;
constexpr size_t WS_DC = 56 * MiB;
constexpr size_t WS_XB = 64 * MiB;
constexpr size_t WS_Y = 64 * MiB;
constexpr size_t WS_G = 128 * MiB;
constexpr size_t WS_Q = 304 * MiB;
constexpr size_t WS_KN = 376 * MiB;
constexpr size_t WS_V = 424 * MiB;
constexpr size_t WS_Z = 304 * MiB;
constexpr size_t WS_UC = 304 * MiB;
constexpr size_t WS_QK = 352 * MiB;
constexpr size_t WS_VV = 400 * MiB;
constexpr size_t WS_Y2 = 448 * MiB;
constexpr size_t WS_END = 512 * MiB;

typedef float f32x2_t __attribute__((ext_vector_type(2))); typedef __bf16 bf16x2_t __attribute__((ext_vector_type(2)));
__device__ __forceinline__ unsigned cvt_pk_bf16(float lo, float hi) { f32x2_t v = {lo, hi}; bf16x2_t b = __builtin_convertvector(v, bf16x2_t); return __builtin_bit_cast(unsigned, b); }
__device__ __forceinline__ float bf2f(unsigned short b) { return __uint_as_float((unsigned)b << 16); }
__device__ __forceinline__ float bflo(unsigned w) { return __uint_as_float(w << 16); }
__device__ __forceinline__ float bfhi(unsigned w) { return __uint_as_float(w & 0xffff0000u); }
__device__ __forceinline__ unsigned short f2bf(float f) { return (unsigned short)(cvt_pk_bf16(f, f) & 0xffffu); }
__device__ __forceinline__ float wave_sum(float v) {
#pragma unroll
    for (int o = 1; o < 64; o <<= 1) v += __shfl_xor(v, o);
    return v;
}
__device__ __forceinline__ float wave_max(float v) {
#pragma unroll
    for (int o = 1; o < 64; o <<= 1) v = fmaxf(v, __shfl_xor(v, o));
    return v;
}
__device__ __forceinline__ float silu_f(float g) { return g / (1.f + __expf(-g)); }
__device__ __forceinline__ float sigmoid_f(float g) { return 1.f / (1.f + __expf(-g)); }
namespace pg8 {
constexpr int BM = 256, BK = 64, HALF = 128, HTB = HALF * BK * 2  , STAGE_BYTES = 8 * HTB, NXCD = 8, WGM = 8;
__host__ __device__ __forceinline__ int lds_byte(int r, int c) { const int st = (r >> 4) * 2 + (c >> 5), rr = r & 15, cc = c & 31, ob = rr * 64 + cc * 2; return st * 1024 + (ob ^ (((ob >> 9) & 1) << 5)); }
__host__ __device__ __forceinline__ void stage_rc(int b, int& R, int& C) { const int st = b / 1024, sb = b % 1024, swz = sb ^ (((sb >> 9) & 1) << 5); R = (st >> 1) * 16 + swz / 64; C = (st & 1) * 32 + (swz % 64) / 2; }
__host__ __device__ __forceinline__ int perm32(int rho) { const int n = rho >> 4, i = rho & 15; return 8 * (i >> 2) + 4 * n + (i & 3); }

struct Unit { int pm, pn; };
struct Gemm { const bf16_t* A; const bf16_t* Bt; int M, N, K, lda, apn; };

struct StaticOrder {
    int nM, nN, nwg, G, c, i0, nmax;
    int give_lo;
    __host__ __device__ void init(int M, int N, int G_, int c_) { nM = M / BM; nN = N / BM; nwg = nM * nN; G = G_; c = c_; i0 = 0; nmax = 1 << 30; give_lo = -1; }
    __host__ __device__ bool next(int i, Unit& u) const {
        if (i >= nmax) return false;
        long L = (long)(i + i0) * G + c;
        if (give_lo >= 0) { if (c >= give_lo && c < give_lo + 32 && i == 1) return false; if (c >= give_lo + 32 && c < give_lo + 64 && i == 2) L = (long)G + (c - 32); }
        if (L >= nwg) return false;
        int wgid = (int)L; { const int q = nwg / NXCD, r = nwg % NXCD, xcd = wgid % NXCD, off = wgid / NXCD; wgid = (xcd < r ? xcd * (q + 1) : r * (q + 1) + (xcd - r) * q) + off; }
        const int nig = WGM * nN, gid = wgid / nig, fm = gid * WGM, gsz = (nM - fm) < WGM ? (nM - fm) : WGM;
        u.pm = fm + ((wgid % nig) % gsz); u.pn = (wgid % nig) / gsz; return true;
    }
};

__device__ __forceinline__ void rope8(float (&v)[8], const float2* rp) {
#pragma unroll
    for (int j = 0; j < 4; ++j) { const float2 cs = rp[j]; const float x1 = v[2 * j], x2 = v[2 * j + 1]; v[2 * j] = x1 * cs.x - x2 * cs.y; v[2 * j + 1] = x1 * cs.y + x2 * cs.x; }
}
struct Epi {
    bf16_t* out; int ldc; int ncols;
    bf16_t* out2; int ldc2; int split;
    const float* rs; int rs_mode; float rs_invdim;
    float* ssqA; float* ssqB; int ssq_mode;
    const float2* rope; int rope_mode;
    int hm_mode;
    int after; const float* fbase; float* fout; const float* fgain; unsigned* xslots; unsigned* xcnt; unsigned* xtmo;
    __device__ __forceinline__ void fused(const f32x4 (&acc)[2][2][4][2], const Unit& u, int wr, int wc, int fr, int fq, LAS unsigned char* lds, int wid, int lane) const {
        LAS float* Pp = (LAS float*)lds;
        LAS float* Sr = (LAS float*)(lds + 4096);
        LAS unsigned* flag = (LAS unsigned*)(lds + 4096 + 1024);
#pragma unroll
        for (int ai = 0; ai < 2; ++ai)
#pragma unroll
            for (int m = 0; m < 4; ++m) { float s = 0.f;
#pragma unroll
                for (int bj = 0; bj < 2; ++bj)
#pragma unroll
                    for (int n = 0; n < 2; ++n) { const f32x4 x = acc[ai][bj][m][n]; s += (x[0] * x[0] + x[1] * x[1]) + (x[2] * x[2] + x[3] * x[3]); }
                s += __shfl_xor(s, 16); s += __shfl_xor(s, 32);
                if (fq == 0) Pp[(ai * HALF + wr * 64 + m * 16 + fr) * 4 + wc] = s; }
        asm volatile("s_waitcnt lgkmcnt(0)" ::: "memory"); __builtin_amdgcn_s_barrier(); asm volatile("" ::: "memory");
        const int row = wid * 32 + (lane & 31);
        if (lane < 32) { const float t = (Pp[row * 4 + 0] + Pp[row * 4 + 1]) + (Pp[row * 4 + 2] + Pp[row * 4 + 3]);
            __hip_atomic_store(xslots + ((size_t)(u.pm * BM + row) * 4 + u.pn), __float_as_uint(t), __ATOMIC_RELAXED, __HIP_MEMORY_SCOPE_AGENT); }
        asm volatile("s_waitcnt vmcnt(0)" ::: "memory");
        if (lane == 0) __hip_atomic_fetch_add(xcnt + 64 * u.pm, 1u, __ATOMIC_RELAXED, __HIP_MEMORY_SCOPE_AGENT);
        if (wid == 0) { bool dead = false; const unsigned long long t0 = __builtin_amdgcn_s_memrealtime();
            for (;;) {
                if ((unsigned)__builtin_amdgcn_readfirstlane(__hip_atomic_load(xcnt + 64 * u.pm, __ATOMIC_RELAXED, __HIP_MEMORY_SCOPE_AGENT)) >= 32u) break;
                if (__builtin_amdgcn_s_memrealtime() - t0 > 2000000ull) { if (lane == 0) __hip_atomic_store(xtmo, 1u, __ATOMIC_RELAXED, __HIP_MEMORY_SCOPE_AGENT); dead = true; break; }
                __builtin_amdgcn_s_sleep(2); }
            __builtin_amdgcn_fence(__ATOMIC_ACQUIRE, "agent");
            if (lane == 0) flag[0] = dead ? 1u : 0u; }
        asm volatile("s_waitcnt vmcnt(0) lgkmcnt(0)" ::: "memory"); __builtin_amdgcn_s_barrier(); asm volatile("" ::: "memory");
        const bool bad = flag[0] != 0u;
        if (lane < 32) { const unsigned* sl = xslots + (size_t)(u.pm * BM + row) * 4; float q = 0.f;
#pragma unroll
            for (int t = 0; t < 4; ++t) q += __uint_as_float(__hip_atomic_load(sl + t, __ATOMIC_RELAXED, __HIP_MEMORY_SCOPE_AGENT));
            Sr[row] = rsqrtf(q * (1.f / 1024.f) + EPS); }
        asm volatile("s_waitcnt vmcnt(0) lgkmcnt(0)" ::: "memory"); __builtin_amdgcn_s_barrier(); asm volatile("" ::: "memory");
        const float qnan = __builtin_nanf("");
#pragma unroll
        for (int ai = 0; ai < 2; ++ai)
#pragma unroll
            for (int m = 0; m < 4; ++m) { const int r = ai * HALF + wr * 64 + m * 16 + fr; const float rs_ = bad ? qnan : Sr[r];
#pragma unroll
                for (int bj = 0; bj < 2; ++bj) { const int col0 = u.pn * BM + bj * HALF + wc * 32 + 8 * fq; const size_t off = (size_t)(u.pm * BM + r) * 1024 + col0;
                    *(f32x4*)(fout + off) = *(const f32x4*)(fbase + off) + acc[ai][bj][m][0] * rs_ * *(const f32x4*)(fgain + col0);
                    *(f32x4*)(fout + off + 4) = *(const f32x4*)(fbase + off + 4) + acc[ai][bj][m][1] * rs_ * *(const f32x4*)(fgain + col0 + 4); } }
        asm volatile("s_waitcnt lgkmcnt(0)" ::: "memory"); __builtin_amdgcn_s_barrier(); asm volatile("" ::: "memory");
    }
    __device__ __forceinline__ void operator()(const f32x4 (&acc)[2][2][4][2], const Unit& u, int wr, int wc, int fr, int fq) const {
#pragma unroll
        for (int ai = 0; ai < 2; ++ai)
#pragma unroll
            for (int m = 0; m < 4; ++m) {
                const int row = u.pm * BM + ai * HALF + wr * 64 + m * 16 + fr;
                float sc = 1.f;
                if (rs_mode == 1) sc = rs[row]; else if (rs_mode == 2) sc = rsqrtf(rs[row] * rs_invdim + EPS);
                float ss = 0.f;
#pragma unroll
                for (int bj = 0; bj < 2; ++bj) {
                    const int col0 = u.pn * BM + bj * HALF + wc * 32 + 8 * fq;
                    float v[8];
#pragma unroll
                    for (int j = 0; j < 4; ++j) { v[j] = acc[ai][bj][m][0][j] * sc; v[4 + j] = acc[ai][bj][m][1][j] * sc; }
                    if (ssq_mode == 1 && (u.pn < 2 || (u.pn == 2 && bj == 0))) {
#pragma unroll
                        for (int j = 0; j < 8; ++j) ss += v[j] * v[j];
                    }
                    if (rope_mode == 1) { if (col0 >= 640 && col0 < 704) rope8(v, rope + (size_t)row * 32 + ((col0 - 640) >> 1)); }
                    else if (rope_mode == 2) { const int d = col0 % 192; if (d >= 128) rope8(v, rope + (size_t)row * 32 + ((d - 128) >> 1)); }
                    if (col0 < ncols) {
                        u32x4 w; w.x = cvt_pk_bf16(v[0], v[1]); w.y = cvt_pk_bf16(v[2], v[3]); w.z = cvt_pk_bf16(v[4], v[5]); w.w = cvt_pk_bf16(v[6], v[7]);
                        if (hm_mode) { const int hh = col0 / 192, jj = col0 - hh * 192; *(u32x4*)(out + ((size_t)((row >> 12) * 4 + hh) * SEQ + (row & (SEQ - 1))) * 192 + jj) = w; }
                        else if (col0 < split) *(u32x4*)(out + (size_t)row * ldc + col0) = w;
                        else *(u32x4*)(out2 + (size_t)row * ldc2 + (col0 - split)) = w;
                    }
                }
                if (ssq_mode == 1 && u.pn <= 2) {
                    ss += __shfl_xor(ss, 16); ss += __shfl_xor(ss, 32);
                    if (fq == 0) atomicAdd((u.pn == 0 ? ssqB : ssqA) + row, ss);
                }
            }
    }
};

template <bool ALIGN_EPI>
__device__ __forceinline__ void gemm_phase(LAS unsigned char* lds, const Gemm g, const StaticOrder& S, const Epi& E, const int tid) {
    const int wid = __builtin_amdgcn_readfirstlane(tid >> 6), lane = tid & 63, wr = wid >> 2, wc = wid & 3, fr = lane & 15, fq = lane >> 4;
    const int K = g.K, nt = K / BK, lda = g.lda;
    unsigned voffA[2], voffB[2];
#pragma unroll
    for (int i = 0; i < 2; ++i) { int R, C; stage_rc(tid * 16 + i * 8192, R, C); const int Rb = (R & ~31) + perm32(R & 31);
        voffA[i] = (unsigned)(R * lda + C) * 2u; voffB[i] = (unsigned)(Rb * K + C) * 2u; }
    const size_t kstep = (size_t)(BK * 2);
    const size_t hstepA = (size_t)HALF * lda * 2, hstepB = (size_t)HALF * K * 2;
    const size_t tstepA = 2 * hstepA, tstepB = 2 * hstepB;
    const unsigned ldsw = (unsigned)wid * 1024u;
    const int aoff = lds_byte(wr * 64 + fr, fq * 8), boff = lds_byte(wc * 32 + fr, fq * 8);
#define PG8_SA(b, h) (((b) * 2 + (h)) * HTB)
#define PG8_SB(b, h) ((4 + (b) * 2 + (h)) * HTB)
#define PG8_STAGE(bufoff, gbase, voff) do { _Pragma("unroll") for (int _i = 0; _i < 2; ++_i) \
        __builtin_amdgcn_global_load_lds((const unsigned*)((const char*)(gbase) + (voff)[_i]), (LAS unsigned*)(lds + (bufoff) + ldsw + _i * 8192), 16, 0, 0); } while (0)
#define PG8_LDA(dst, b, h) do { _Pragma("unroll") for (int m = 0; m < 4; ++m) _Pragma("unroll") for (int k = 0; k < 2; ++k) dst[m][k] = *(const LAS bf16x8*)(lds + PG8_SA(b, h) + aoff + m * 2048 + k * 1024); } while (0)
#define PG8_LDB(dst, b, h) do { _Pragma("unroll") for (int n = 0; n < 2; ++n) _Pragma("unroll") for (int k = 0; k < 2; ++k) dst[n][k] = *(const LAS bf16x8*)(lds + PG8_SB(b, h) + boff + n * 2048 + k * 1024); } while (0)
#define PG8_MMA(ai, bj, At, Bt) do { __builtin_amdgcn_s_setprio(1); _Pragma("unroll") for (int m = 0; m < 4; ++m) _Pragma("unroll") for (int n = 0; n < 2; ++n) _Pragma("unroll") for (int k = 0; k < 2; ++k) \
        acc[ai][bj][m][n] = __builtin_amdgcn_mfma_f32_16x16x32_bf16(Bt[n][k], At[m][k], acc[ai][bj][m][n], 0, 0, 0); __builtin_amdgcn_s_setprio(0); } while (0)
#define PG8_WAIT_V(n) asm volatile("s_waitcnt vmcnt(" #n ")" ::: "memory")
#define PG8_WAIT_L(n) asm volatile("s_waitcnt lgkmcnt(" #n ")" ::: "memory")
#define PG8_BAR __builtin_amdgcn_s_barrier()
#define PG8_SCHED __builtin_amdgcn_sched_barrier(0)
    Unit cur, nxt; int ui = 0;
    if (!S.next(0, cur)) return;
    f32x4 acc[2][2][4][2];
#pragma unroll
    for (int a = 0; a < 2; ++a)
#pragma unroll
        for (int b = 0; b < 2; ++b)
#pragma unroll
            for (int m = 0; m < 4; ++m)
#pragma unroll
                for (int n = 0; n < 2; ++n) acc[a][b][m][n] = (f32x4){0.f, 0.f, 0.f, 0.f};
    bf16x8 At[4][2], B0[2][2], B1[2][2];
    const char* cA = (const char*)g.A + (size_t)cur.pm * tstepA + (size_t)cur.pn * g.apn * 2; const char* cB = (const char*)g.Bt + (size_t)cur.pn * tstepB;
    PG8_STAGE(PG8_SB(0, 0), cB, voffB); PG8_STAGE(PG8_SB(0, 1), cB + hstepB, voffB); PG8_STAGE(PG8_SA(0, 0), cA, voffA); PG8_STAGE(PG8_SA(0, 1), cA + hstepA, voffA);
    if (wr == 1) PG8_BAR;
    PG8_WAIT_V(2); PG8_BAR;
    PG8_STAGE(PG8_SB(1, 0), cB + kstep, voffB); PG8_STAGE(PG8_SA(1, 0), cA + kstep, voffA); PG8_STAGE(PG8_SB(1, 1), cB + hstepB + kstep, voffB);
    PG8_WAIT_V(6); PG8_BAR;
    for (;;) {
        const bool has_next = S.next(ui + 1, nxt);
        const char* nA = has_next ? (const char*)g.A + (size_t)nxt.pm * tstepA + (size_t)nxt.pn * g.apn * 2 : cA; const char* nB = has_next ? (const char*)g.Bt + (size_t)nxt.pn * tstepB : cB;
        for (int t = 0; t < nt; t += 2) {
            const bool last = (t == nt - 2);
            const char* a1 = cA + (size_t)(t + 1) * kstep;
            const char* a2 = last ? nA : cA + (size_t)(t + 2) * kstep; const char* b2 = last ? nB : cB + (size_t)(t + 2) * kstep;
            const char* a3 = a2 + kstep; const char* b3 = b2 + kstep;
            PG8_LDB(B0, 0, 0); PG8_LDB(B1, 0, 1); PG8_SCHED; PG8_LDA(At, 0, 0); PG8_STAGE(PG8_SA(1, 1), a1 + hstepA, voffA);
            PG8_WAIT_V(8); PG8_WAIT_L(0); PG8_BAR; PG8_MMA(0, 0, At, B0); PG8_MMA(0, 1, At, B1); PG8_BAR; PG8_SCHED;
            PG8_LDA(At, 0, 1); PG8_STAGE(PG8_SB(0, 0), b2, voffB); PG8_STAGE(PG8_SB(0, 1), b2 + hstepB, voffB); PG8_STAGE(PG8_SA(0, 0), a2, voffA);
            PG8_WAIT_V(8); PG8_WAIT_L(0); PG8_BAR; PG8_MMA(1, 0, At, B0); PG8_MMA(1, 1, At, B1); PG8_BAR; PG8_SCHED;
            PG8_LDB(B0, 1, 0); PG8_LDB(B1, 1, 1); PG8_SCHED; PG8_LDA(At, 1, 0); PG8_STAGE(PG8_SA(0, 1), a2 + hstepA, voffA);
            PG8_WAIT_V(8); PG8_WAIT_L(0); PG8_BAR; PG8_MMA(0, 0, At, B0); PG8_MMA(0, 1, At, B1); PG8_BAR; PG8_SCHED;
            PG8_LDA(At, 1, 1); PG8_STAGE(PG8_SB(1, 0), b3, voffB); PG8_STAGE(PG8_SB(1, 1), b3 + hstepB, voffB); PG8_STAGE(PG8_SA(1, 0), a3, voffA);
            PG8_WAIT_V(8); PG8_WAIT_L(0); PG8_BAR; PG8_MMA(1, 0, At, B0); PG8_MMA(1, 1, At, B1); PG8_BAR; PG8_SCHED;
        }
        if constexpr (ALIGN_EPI) { if (wr == 0) PG8_BAR; }
#ifdef FUSED_FINAL
        if (!E.after) E(acc, cur, wr, wc, fr, fq);
#else
        E(acc, cur, wr, wc, fr, fq);
#endif
        if (!has_next) break;
#pragma unroll
        for (int a = 0; a < 2; ++a)
#pragma unroll
            for (int b = 0; b < 2; ++b)
#pragma unroll
                for (int m = 0; m < 4; ++m)
#pragma unroll
                    for (int n = 0; n < 2; ++n) acc[a][b][m][n] = (f32x4){0.f, 0.f, 0.f, 0.f};
        cur = nxt; cA = nA; cB = nB; ++ui;
        if constexpr (ALIGN_EPI) { if (wr == 1) PG8_BAR; }
    }
    PG8_WAIT_V(0);
    if constexpr (!ALIGN_EPI) { if (wr == 0) PG8_BAR; }
    PG8_BAR;
#ifdef FUSED_FINAL
    if (E.after) E.fused(acc, cur, wr, wc, fr, fq, lds, wid, lane);
#endif
#undef PG8_SA
#undef PG8_SB
#undef PG8_STAGE
#undef PG8_LDA
#undef PG8_LDB
#undef PG8_MMA
#undef PG8_WAIT_V
#undef PG8_WAIT_L
#undef PG8_BAR
#undef PG8_SCHED
}
}
namespace att {
#define SBAR() __builtin_amdgcn_sched_barrier(0)
__device__ __forceinline__ int crow(int r, int hi) { return (r & 3) + 8 * (r >> 2) + 4 * hi; }
template <int DQK> __device__ __forceinline__ int kaddr(int row, int c) { return row * (DQK * 2) + ((c ^ ((row >> 1) & 7)) << 4); }
template <int NCB> __device__ __forceinline__ int v_st(int k, int c) { const int kk = (k & ~0xC) | ((k & 4) << 1) | ((k & 8) >> 1); return ((kk >> 3) * NCB + (c >> 5)) * 512 + ((kk & 7) * 32 + (c & 31)) * 2; }
__device__ __forceinline__ int v_rd_base(int lane) { return ((lane & 3) << 3) | (((lane >> 2) & 3) << 6) | (((lane >> 4) & 1) << 5) | (((lane >> 5) & 1) << 8); }

__device__ __forceinline__ void mask_tile(f32x16& p0, f32x16& p1, int dq) {
    const float NEG = -__builtin_inff();
#pragma unroll
    for (int r = 0; r < 16; ++r) {
        const int c = (r & 3) + 8 * (r >> 2);
        if (dq - c < 0) p0[r] = NEG;
        if (dq - c - 32 < 0) p1[r] = NEG;
    }
}
constexpr float DEFER_THR = 8.f;
template <bool FIRST>
__device__ __forceinline__ void partialSM(f32x16& p0, f32x16& p1, float& m_reg, float& alpha) {
    float pmax = p0[0];
#pragma unroll
    for (int r = 1; r < 16; ++r) pmax = fmaxf(pmax, p0[r]);
#pragma unroll
    for (int r = 0; r < 16; ++r) pmax = fmaxf(pmax, p1[r]);
    { auto rr = __builtin_amdgcn_permlane32_swap(__float_as_uint(pmax), __float_as_uint(pmax), false, false);
      pmax = fmaxf(__uint_as_float(rr[0]), __uint_as_float(rr[1])); }
    alpha = 1.f;
    if (FIRST || !__all(pmax <= DEFER_THR)) {
        const float dl = FIRST ? pmax : fmaxf(pmax, 0.f);
        m_reg += dl; alpha = __builtin_amdgcn_exp2f(-dl);
#pragma unroll
        for (int r = 0; r < 16; ++r) { p0[r] -= dl; p1[r] -= dl; }
    }
#pragma unroll
    for (int r = 0; r < 16; ++r) p0[r] = __builtin_amdgcn_exp2f(p0[r]);
}
__device__ __forceinline__ void finishSM(f32x16& p0, f32x16& p1, float alpha, float& l_reg, bf16x8& pa0, bf16x8& pa1, bf16x8& pa2, bf16x8& pa3) {
#pragma unroll
    for (int r = 0; r < 16; ++r) p1[r] = __builtin_amdgcn_exp2f(p1[r]);
    float ps = 0.f;
#pragma unroll
    for (int r = 0; r < 16; ++r) ps += p0[r];
#pragma unroll
    for (int r = 0; r < 16; ++r) ps += p1[r];
    { auto rr = __builtin_amdgcn_permlane32_swap(__float_as_uint(ps), __float_as_uint(ps), false, false);
      ps = __uint_as_float(rr[0]) + __uint_as_float(rr[1]); }
    l_reg = l_reg * alpha + ps;
#define PK4(P, B_, OUT) do { unsigned a0 = cvt_pk_bf16(P[B_+0], P[B_+1]), a1 = cvt_pk_bf16(P[B_+2], P[B_+3]);                          \
        unsigned b0 = cvt_pk_bf16(P[B_+4], P[B_+5]), b1 = cvt_pk_bf16(P[B_+6], P[B_+7]);                                             \
        auto r0 = __builtin_amdgcn_permlane32_swap(a0, b0, false, false); auto r1 = __builtin_amdgcn_permlane32_swap(a1, b1, false, false); \
        u32x4 w = {r0[0], r1[0], r0[1], r1[1]}; OUT = *reinterpret_cast<bf16x8*>(&w); } while (0)
    PK4(p0, 0, pa0); PK4(p0, 8, pa1); PK4(p1, 0, pa2); PK4(p1, 8, pa3);
#undef PK4
}
template <int DQK, bool NOLDS = false>
__device__ __forceinline__ void qkt(f32x16& p0, f32x16& p1, const LAS unsigned char* Kb, int r32, int hi, const bf16x8* qr, const float negm) {
    constexpr int NKS = DQK / 16, ROWB = DQK * 2;
#pragma unroll
    for (int r = 0; r < 16; ++r) { p0[r] = negm; p1[r] = negm; }
    if (NOLDS) {
#pragma unroll
        for (int d0 = 0; d0 < NKS; ++d0) { p0 = __builtin_amdgcn_mfma_f32_32x32x16_bf16(qr[(d0 + 1) % NKS], qr[d0], p0, 0, 0, 0); p1 = __builtin_amdgcn_mfma_f32_32x32x16_bf16(qr[(d0 + 2) % NKS], qr[d0], p1, 0, 0, 0); }
        return; }
    const int f = (r32 >> 1) & 7;
    const LAS unsigned char* kb[4];
#pragma unroll
    for (int dd = 0; dd < 4; ++dd) kb[dd] = Kb + r32 * ROWB + ((((2 * dd + hi) ^ f)) << 4);
#pragma unroll
    for (int d0 = 0; d0 < NKS; ++d0) { const LAS unsigned char* a_ = kb[d0 & 3] + (d0 >> 2) * 128;
        const bf16x8 b0 = *reinterpret_cast<const LAS bf16x8*>(a_);
        const bf16x8 b1 = *reinterpret_cast<const LAS bf16x8*>(a_ + 32 * ROWB);
        p0 = __builtin_amdgcn_mfma_f32_32x32x16_bf16(b0, qr[d0], p0, 0, 0, 0);
        p1 = __builtin_amdgcn_mfma_f32_32x32x16_bf16(b1, qr[d0], p1, 0, 0, 0); }
}
template <int DQK> __device__ __forceinline__ void qkt_sched() {
    constexpr int NKS = DQK / 16;
    __builtin_amdgcn_sched_group_barrier(0x100, 4, 0);
#pragma unroll
    for (int d0 = 0; d0 < NKS; ++d0) {
        __builtin_amdgcn_sched_group_barrier(0x008, 2, 0);
        __builtin_amdgcn_sched_group_barrier(0x002, 120 / NKS, 0);
        if (d0 + 2 < NKS) __builtin_amdgcn_sched_group_barrier(0x100, 2, 0);
    }
}
template <int DV>
__device__ __forceinline__ void pv_tile(f32x16* o, int vb0, bf16x8 pa0, bf16x8 pa1, bf16x8 pa2, bf16x8 pa3) {
    constexpr int NCB = DV / 32, KS = 2 * NCB * 512, HF = NCB * 512;
#define TRRD(dst, off) asm volatile("ds_read_b64_tr_b16 %0, %1 offset:%2" : "=&v"(dst) : "v"(vb0), "i"(off) : "memory")
#pragma unroll
    for (int d0 = 0; d0 < NCB; ++d0) {
        s16x4 l0, l1, l2, l3, h0, h1, h2, h3;
        if (d0 == 0) { TRRD(l0, 0 * 512); TRRD(h0, 0 * 512 + HF); TRRD(l1, 0 * 512 + KS); TRRD(h1, 0 * 512 + KS + HF); TRRD(l2, 0 * 512 + 2 * KS); TRRD(h2, 0 * 512 + 2 * KS + HF); TRRD(l3, 0 * 512 + 3 * KS); TRRD(h3, 0 * 512 + 3 * KS + HF); }
        else if (d0 == 1) { TRRD(l0, 1 * 512); TRRD(h0, 1 * 512 + HF); TRRD(l1, 1 * 512 + KS); TRRD(h1, 1 * 512 + KS + HF); TRRD(l2, 1 * 512 + 2 * KS); TRRD(h2, 1 * 512 + 2 * KS + HF); TRRD(l3, 1 * 512 + 3 * KS); TRRD(h3, 1 * 512 + 3 * KS + HF); }
        else if (d0 == 2) { TRRD(l0, 2 * 512); TRRD(h0, 2 * 512 + HF); TRRD(l1, 2 * 512 + KS); TRRD(h1, 2 * 512 + KS + HF); TRRD(l2, 2 * 512 + 2 * KS); TRRD(h2, 2 * 512 + 2 * KS + HF); TRRD(l3, 2 * 512 + 3 * KS); TRRD(h3, 2 * 512 + 3 * KS + HF); }
        else { TRRD(l0, 3 * 512); TRRD(h0, 3 * 512 + HF); TRRD(l1, 3 * 512 + KS); TRRD(h1, 3 * 512 + KS + HF); TRRD(l2, 3 * 512 + 2 * KS); TRRD(h2, 3 * 512 + 2 * KS + HF); TRRD(l3, 3 * 512 + 3 * KS); TRRD(h3, 3 * 512 + 3 * KS + HF); }
        asm volatile("s_waitcnt lgkmcnt(0)" ::: "memory"); SBAR();
        o[d0] = __builtin_amdgcn_mfma_f32_32x32x16_bf16(pa0, (bf16x8){l0[0], l0[1], l0[2], l0[3], h0[0], h0[1], h0[2], h0[3]}, o[d0], 0, 0, 0);
        o[d0] = __builtin_amdgcn_mfma_f32_32x32x16_bf16(pa1, (bf16x8){l1[0], l1[1], l1[2], l1[3], h1[0], h1[1], h1[2], h1[3]}, o[d0], 0, 0, 0);
        o[d0] = __builtin_amdgcn_mfma_f32_32x32x16_bf16(pa2, (bf16x8){l2[0], l2[1], l2[2], l2[3], h2[0], h2[1], h2[2], h2[3]}, o[d0], 0, 0, 0);
        o[d0] = __builtin_amdgcn_mfma_f32_32x32x16_bf16(pa3, (bf16x8){l3[0], l3[1], l3[2], l3[3], h3[0], h3[1], h3[2], h3[3]}, o[d0], 0, 0, 0);
    }
#undef TRRD
}

template <int DQK, int DV, bool CAUSAL, int ABL = 0>
__device__ __forceinline__ void attn_unit(const bf16_t* Qb, int qp, const bf16_t* Km, int kp, int c1, const bf16_t* Ke, int kep, const bf16_t* Vb, int vp,
                                          int NT, int q0, const bf16_t* gate, int gp, bf16_t* Y, int yp, LAS unsigned char* lds, const int tid) {
    constexpr int SHM_V = 64 * DV * 2, SHM_K = 64 * DQK * 2, NCK = DQK / 8, NKS = DQK / 16, NCB = DV / 32;
    constexpr int KPT = SHM_K / 8192, VPT = SHM_V / 8192;
    const int wid = __builtin_amdgcn_readfirstlane(tid >> 6), lane = tid & 63, r32 = lane & 31, hi = lane >> 5;
    LAS unsigned char* V_lds = lds; LAS unsigned char* K_lds = lds + 3 * SHM_V; LAS float* ws = (LAS float*)(lds + 3 * SHM_V + 3 * SHM_K) + wid * 64;
    bf16x8 qr[NKS];
#pragma unroll
    for (int d0 = 0; d0 < NKS; ++d0) qr[d0] = *reinterpret_cast<const bf16x8*>(Qb + (size_t)(wid * 32 + r32) * qp + d0 * 16 + hi * 8);
    const char* kbase = (const char*)(Km < Ke ? Km : Ke);
    unsigned koff[KPT]; unsigned kstr[KPT];
#pragma unroll
    for (int i = 0; i < KPT; ++i) { const int p = (wid + 8 * i) * 64 + lane, row = p / NCK, cpos = p % NCK, c = cpos ^ ((row >> 1) & 7);
        if (c < c1) { koff[i] = (unsigned)((const char*)(Km + (size_t)row * kp + c * 8) - kbase); kstr[i] = (unsigned)kp * 128u; }
        else { koff[i] = (unsigned)((const char*)(Ke + (size_t)row * kep + (c - c1) * 8) - kbase); kstr[i] = (unsigned)kep * 128u; } }
    unsigned voff[VPT];
#pragma unroll
    for (int i = 0; i < VPT; ++i) { const int st = 2 * (wid + 8 * i) + (lane >> 5), kk = (st / NCB) * 8 + ((lane & 31) >> 2), k = (kk & ~0xC) | ((kk & 4) << 1) | ((kk & 8) >> 1), col = (st % NCB) * 32 + (lane & 3) * 8;
        voff[i] = (unsigned)(k * vp + col) * 2u; }
    const char* vbase = (const char*)Vb;
    float m_reg = 0.f, l_reg = 0.f; f32x16 o[NCB];
#pragma unroll
    for (int d = 0; d < NCB; ++d) o[d] = f32x16{};
    const int vb0 = (int)(size_t)V_lds + v_rd_base(lane);
    const int qlo = q0 + wid * 32;
#define DMA_K(sl) do { _Pragma("unroll") for (int i = 0; i < KPT; ++i) { __builtin_amdgcn_global_load_lds((const unsigned*)(kbase + koff[i]), (LAS unsigned*)(K_lds + (sl) * SHM_K + (wid + 8 * i) * 1024), 16, 0, 0); koff[i] += kstr[i]; } } while (0)
#define DMA_V(sl) do { _Pragma("unroll") for (int i = 0; i < VPT; ++i) { __builtin_amdgcn_global_load_lds((const unsigned*)(vbase + voff[i]), (LAS unsigned*)(V_lds + (sl) * SHM_V + (wid + 8 * i) * 1024), 16, 0, 0); } vbase += (size_t)vp * 128; } while (0)
#define WAIT_BAR(N) do { asm volatile("s_waitcnt vmcnt(%0) lgkmcnt(0)\n\ts_barrier" :: "i"(N) : "memory"); } while (0)
#define BAR_ONLY() do { asm volatile("s_waitcnt lgkmcnt(0)\n\ts_barrier" ::: "memory"); } while (0)
#define MASKT(P0_, P1_, t) do { if (CAUSAL) { const int kb_ = (t) * 64; if (kb_ + 63 > qlo) mask_tile(P0_, P1_, qlo + r32 - 4 * hi - kb_); } } while (0)
#define RESC(a) do { if (__any((a) < 1.f)) { if (hi == 0) ws[r32] = (a); asm volatile("s_waitcnt lgkmcnt(0)" ::: "memory"); \
        _Pragma("unroll") for (int d_ = 0; d_ < NCB; ++d_) _Pragma("unroll") for (int r = 0; r < 16; ++r) o[d_][r] *= ws[crow(r, hi)]; } } while (0)
    f32x16 pA0, pA1, pB0, pB1; float alA = 1.f, alB = 1.f; bf16x8 pa0, pa1, pa2, pa3;
    const bool lag = wid >= 4;
    DMA_K(0); DMA_K(1); DMA_V(0);
    WAIT_BAR(KPT + VPT);
    if (lag) BAR_ONLY();
    int ks = 0, vs = 2, ns = 1;
#define ROT() do { vs = ks; ks = ns; ns = (ns == 2) ? 0 : ns + 1; } while (0)
#define CLOSE(t) do { if ((t) + 3 < NT) WAIT_BAR(KPT + VPT); else WAIT_BAR(0); } while (0)
#define STEP(PX0, PX1, alX, PY0, PY1, alY, t, FIRST) do { \
        if ((t) + 2 < NT) DMA_K(vs); \
        SBAR(); qkt<DQK>(PX0, PX1, K_lds + ks * SHM_K, r32, hi, qr, FIRST ? 0.f : -m_reg); \
        if (!FIRST) finishSM(PY0, PY1, alY, l_reg, pa0, pa1, pa2, pa3); SBAR(); \
        CLOSE(t); \
        if ((t) + 1 < NT) DMA_V(ns); \
        if (!FIRST) pv_tile<DV>(o, vb0 + vs * SHM_V, pa0, pa1, pa2, pa3); \
        MASKT(PX0, PX1, t); partialSM<FIRST>(PX0, PX1, m_reg, alX); if (FIRST) alX = 1.f; \
        CLOSE(t); \
        RESC(alX); ROT(); } while (0)
    STEP(pA0, pA1, alA, pB0, pB1, alB, 0, true);
    for (int t = 1; t + 1 < NT; t += 2) {
        STEP(pB0, pB1, alB, pA0, pA1, alA, t, false);
        STEP(pA0, pA1, alA, pB0, pB1, alB, t + 1, false);
    }
    STEP(pB0, pB1, alB, pA0, pA1, alA, NT - 1, false);
    if (!lag) BAR_ONLY();
    finishSM(pB0, pB1, alB, l_reg, pa0, pa1, pa2, pa3); SBAR(); pv_tile<DV>(o, vb0 + vs * SHM_V, pa0, pa1, pa2, pa3);
#undef CLOSE
#undef STEP
#undef ROT
#undef RESC
#undef MASKT
#undef WAIT_BAR
#undef BAR_ONLY
#undef DMA_K
#undef DMA_V
    if (hi == 0) ws[32 + r32] = l_reg;
    asm volatile("s_waitcnt lgkmcnt(0)" ::: "memory");
    constexpr int SPITCH = DV * 2 + 16;
    LAS unsigned char* stg = ((DQK == 192) ? K_lds : (lds + 3 * SHM_V + 3 * SHM_K + 2048)) + wid * (32 * SPITCH);
#pragma unroll
    for (int r = 0; r < 16; ++r) {
        const float rl = __builtin_amdgcn_rcpf(ws[32 + crow(r, hi)]);
#pragma unroll
        for (int d0 = 0; d0 < NCB; ++d0) *(LAS unsigned short*)(stg + crow(r, hi) * SPITCH + (d0 * 32 + r32) * 2) = f2bf(o[d0][r] * rl);
    }
    asm volatile("s_waitcnt lgkmcnt(0)" ::: "memory");
    constexpr int CPR = DV / 8, RPP = 64 / CPR;
#pragma unroll
    for (int i = 0; i < 32 / RPP; ++i) {
        const int row = i * RPP + lane / CPR, ch = lane % CPR, orow = wid * 32 + row;
        const u32x4 ov = *(const LAS u32x4*)(stg + row * SPITCH + ch * 16);
        const u32x4 gv = *(const u32x4*)(gate + (size_t)orow * gp + ch * 8);
        u32x4 w;
        w.x = cvt_pk_bf16(bflo(ov.x) * silu_f(bflo(gv.x)), bfhi(ov.x) * silu_f(bfhi(gv.x))); w.y = cvt_pk_bf16(bflo(ov.y) * silu_f(bflo(gv.y)), bfhi(ov.y) * silu_f(bfhi(gv.y)));
        w.z = cvt_pk_bf16(bflo(ov.z) * silu_f(bflo(gv.z)), bfhi(ov.z) * silu_f(bfhi(gv.z))); w.w = cvt_pk_bf16(bflo(ov.w) * silu_f(bflo(gv.w)), bfhi(ov.w) * silu_f(bfhi(gv.w)));
        *(u32x4*)(Y + (size_t)orow * yp + ch * 8) = w;
    }
    __syncthreads();
}
#undef SBAR
}
struct Params {
    const float* x; const float* mem; const int* pos;
    const float *a_pre_g, *a_w_in, *a_q_a_g, *a_w_uq, *a_kv_a_g, *a_w_ukv, *a_mem_g, *a_w_mem_kv, *a_w_out, *a_post_g;
    const float *b_pre_g, *b_w_in, *b_gate_bias, *b_conv_w, *b_conv_b, *b_w_q, *b_w_k, *b_w_v, *b_head_g, *b_skip, *b_mem_g, *b_w_mem_kv, *b_w_out, *b_post_g;
    float* out; unsigned char* ws; int ph_lo, ph_hi;
};
struct Wk { int tid, lane, wave, vcu, G; };
#define LDS_WAIT() asm volatile("s_waitcnt lgkmcnt(0)" ::: "memory")

__device__ __forceinline__ float wsrc(const Params& P, int mat, int k, int n) {
    switch (mat) {
    case 0: { int col; float s = 1.f;
        if (n < 256) col = 384 + n; else if (n < 512) col = n - 256; else if (n < 640) col = 256 + (n - 512);
        else if (n < 704) { const int p_ = n - 640, i = p_ >> 1; col = 640 + ((p_ & 1) ? 32 + i : i); }
        else if (n < 768) return 0.f; else if (n < 1024) { col = 704 + (n - 768); s = MSCALE; } else col = 960 + (n - 1024);
        return P.a_w_in[(size_t)k * A_IN + col] * P.a_pre_g[k] * s; }
    case 1: { if (n >= 1152) return 0.f; const int h = n / 192, d = n % 192; int col;
        if (d < 128) col = h * 192 + d; else { const int p_ = d - 128, i = p_ >> 1; col = h * 192 + 128 + ((p_ & 1) ? 32 + i : i); }
        return P.a_w_uq[(size_t)k * 1152 + col] * P.a_q_a_g[k] * QSCALE; }
    case 2: { int col; if (n < 768) col = (n / 128) * 256 + (n % 128); else { const int n2 = n - 768; col = (n2 / 128) * 256 + 128 + (n2 % 128); }
        return P.a_w_ukv[(size_t)k * 1536 + col] * P.a_kv_a_g[k]; }
    case 3: { if (n < 512) return P.a_w_mem_kv[(size_t)k * 512 + n] * P.a_mem_g[k]; return P.b_w_mem_kv[(size_t)k * 512 + (n - 512)] * P.b_mem_g[k]; }
    case 4: return P.a_w_out[(size_t)k * 1024 + n];
    case 5: { int col; float s = 1.f; if (n < 768) col = n; else if (n < 1536) col = 776 + (n - 768); else if (n < 1792) { col = 1544 + (n - 1536); s = MSCALE; } else col = 1800 + (n - 1792);
        return P.b_w_in[(size_t)k * B_IN + col] * P.b_pre_g[k] * s; }
    case 6: { const int h = n / 192, j = n % 192, pn = n / 256, kabs = k + 192 * pn - 192 * h; if (kabs < 0 || kabs >= 192) return 0.f;
        if (j < 96) return P.b_w_q[((size_t)h * 192 + kabs) * 96 + j]; return P.b_w_k[((size_t)h * 192 + kabs) * 96 + (j - 96)] * KSCALE_B; }
    case 7: { const int h = n / 192, j = n % 192, pn = n / 256, kabs = k + 192 * pn - 192 * h; if (kabs < 0 || kabs >= 192) return 0.f;
        return P.b_w_v[((size_t)h * 192 + kabs) * 192 + j]; }
    default: return P.b_w_out[(size_t)k * 1024 + n];
    }
}
__device__ __forceinline__ void tr_item(const Params& P, int mat, int K, int nblk, bf16_t* WT, LAS float* scr, int item, int lane) {
    const int kb = item / nblk, nb = item % nblk, k0 = 64 * kb, n0 = 32 * nb;
    float tv[32];
#pragma unroll
    for (int i = 0; i < 32; ++i) tv[i] = wsrc(P, mat, k0 + 2 * i + (lane >> 5), n0 + (lane & 31));
#pragma unroll
    for (int i = 0; i < 32; ++i) scr[(2 * i + (lane >> 5)) * 33 + (lane & 31)] = tv[i];
    LDS_WAIT(); asm volatile("" ::: "memory");
    const int c = lane & 7;
#pragma unroll
    for (int j = 0; j < 4; ++j) { const int n = (lane >> 3) + 8 * j; const LAS float* s = scr + (8 * c) * 33 + n;
        u32x4 o; o.x = cvt_pk_bf16(s[0 * 33], s[1 * 33]); o.y = cvt_pk_bf16(s[2 * 33], s[3 * 33]); o.z = cvt_pk_bf16(s[4 * 33], s[5 * 33]); o.w = cvt_pk_bf16(s[6 * 33], s[7 * 33]);
        *(u32x4*)(WT + (size_t)(n0 + n) * K + k0 + 8 * c) = o; }
    LDS_WAIT(); asm volatile("" ::: "memory");
}
__device__ __forceinline__ void row_to_bf16(const float* xrow, bf16_t* orow, float* rstd_out, bool normalise, int lane) {
    const f32x4* xr = (const f32x4*)xrow + lane;
    f32x4 v[4]; float s = 0.f;
#pragma unroll
    for (int j = 0; j < 4; ++j) { v[j] = xr[64 * j]; s += (v[j].x * v[j].x + v[j].y * v[j].y) + (v[j].z * v[j].z + v[j].w * v[j].w); }
    const float rstd = rsqrtf(wave_sum(s) * (1.f / DM) + EPS);
    if (rstd_out && lane == 0) *rstd_out = rstd;
    const float sc = normalise ? rstd : 1.f;
    u32x2* o8 = (u32x2*)orow + lane;
#pragma unroll
    for (int j = 0; j < 4; ++j) { u32x2 w; w.x = cvt_pk_bf16(v[j].x * sc, v[j].y * sc); w.y = cvt_pk_bf16(v[j].z * sc, v[j].w * sc); o8[64 * j] = w; }
}
__device__ __forceinline__ void phase_prologue(const Params& P, const Wk& W, LAS unsigned char* lds) {
    unsigned char* ws = P.ws;
    LAS float* scr = (LAS float*)(lds + W.wave * 8704);
    const int gw = W.vcu * 8 + W.wave, NGW = W.G * 8;
#ifndef PROBE_P0
#define PROBE_P0 0
#endif
    for (int rep_ = 0; rep_ < (PROBE_P0 == 1 ? 2 : 1); ++rep_) {
    int base = 0;
#define DO_MAT(mt, K_, N_, OFF_) do { const int nblk = (N_) / 32, nit = ((K_) / 64) * nblk; \
        int first = gw - (base % NGW); if (first < 0) first += NGW; \
        for (int r = first; r < nit; r += NGW) tr_item(P, mt, K_, nblk, (bf16_t*)(ws + (OFF_)), scr, r, W.lane); \
        base += nit; } while (0)
    DO_MAT(0, 1024, 2048, WS_WINA); DO_MAT(1, 384, 1280, WS_WUQ); DO_MAT(2, 256, 1536, WS_WUKV); DO_MAT(3, 1024, 1024, WS_WMKV); DO_MAT(4, 1024, 1024, WS_WOA);
    DO_MAT(5, 1024, 2816, WS_WINB); DO_MAT(6, 384, 768, WS_WQK); DO_MAT(7, 384, 768, WS_WV); DO_MAT(8, 1024, 1024, WS_WOB);
#undef DO_MAT
    }
    const int gt = (W.vcu * 512 + W.tid), NGT = W.G * 512;
    for (int idx = gt; idx < 8 * 1024; idx += NGT) { const int g = idx >> 10, k = idx & 1023; ((float*)(ws + WS_WG))[idx] = P.b_w_in[(size_t)k * B_IN + 768 + g] * P.b_pre_g[k]; }
    for (int idx = gt; idx < 2 * T; idx += NGT) ((float*)(ws + WS_SSQA))[idx] = 0.f;
    for (int rep_ = 0; rep_ < (PROBE_P0 == 2 ? 2 : 1); ++rep_)
    for (int idx = gt; idx < T * 32; idx += NGT) { const int row = idx >> 5, i = idx & 31;
        const float inv = exp2f(-(float)i * (13.287712379549449f / 32.f));
        const float ang = (float)P.pos[row] * inv;
        double tr = (double)ang * 0.15915494309189535; tr -= floor(tr); const float tf = (float)tr;
        ((float2*)(ws + WS_ROPE))[idx] = make_float2(__builtin_amdgcn_cosf(tf), __builtin_amdgcn_sinf(tf)); }
    for (int rep_ = 0; rep_ < (PROBE_P0 == 3 ? 2 : 1); ++rep_)
    for (int m = gw; m < T; m += 4 * NGW) {
        f32x4 v[4][4]; float s[4];
#pragma unroll
        for (int r = 0; r < 4; ++r) { const f32x4* xr = (const f32x4*)(P.x + (size_t)(m + r * NGW) * DM) + W.lane;
#pragma unroll
            for (int j = 0; j < 4; ++j) v[r][j] = xr[64 * j]; }
#pragma unroll
        for (int r = 0; r < 4; ++r) { float a = 0.f;
#pragma unroll
            for (int j = 0; j < 4; ++j) a += (v[r][j].x * v[r][j].x + v[r][j].y * v[r][j].y) + (v[r][j].z * v[r][j].z + v[r][j].w * v[r][j].w);
            s[r] = wave_sum(a); }
#pragma unroll
        for (int r = 0; r < 4; ++r) { const int mr = m + r * NGW; if (W.lane == 0) ((float*)(ws + WS_RSTD))[mr] = rsqrtf(s[r] * (1.f / DM) + EPS);
            u32x2* o8 = (u32x2*)((bf16_t*)(ws + WS_XB) + (size_t)mr * DM) + W.lane;
#pragma unroll
            for (int j = 0; j < 4; ++j) { u32x2 w; w.x = cvt_pk_bf16(v[r][j].x, v[r][j].y); w.y = cvt_pk_bf16(v[r][j].z, v[r][j].w); o8[64 * j] = w; } }
    }
    for (int m = gw; m < NB * NMEM; m += NGW) row_to_bf16(P.mem + (size_t)m * DM, (bf16_t*)(ws + WS_MEMN) + (size_t)m * DM, nullptr, true, W.lane);
}

__device__ __forceinline__ void phase_rowmid(const Params& P, const Wk& W, LAS unsigned char* lds) {
    unsigned char* ws = P.ws;
    const int gw = W.vcu * 8 + W.wave, NGW = W.G * 8, lane = W.lane;
    const bf16_t* Z = (const bf16_t*)(ws + WS_Z);
    { const int gt_ = W.vcu * 512 + W.tid; if (gt_ < 32 * 192) ((float*)(ws + WS_U0))[gt_] = 0.f; }
    LAS float* Wg = (LAS float*)lds;
    for (int i = W.tid; i < 2048; i += 512) ((LAS f32x4*)Wg)[i] = ((const f32x4*)(ws + WS_WG))[i];
    __syncthreads();
    for (int m = gw; m < T; m += NGW) {
        const f32x4* xr = (const f32x4*)(P.x + (size_t)m * DM) + lane; const u32x2* zr = (const u32x2*)(Z + (size_t)m * DM) + lane;
        f32x4 v[4], z[4]; float s = 0.f;
#pragma unroll
        for (int j = 0; j < 4; ++j) { v[j] = xr[64 * j]; const u32x2 w = zr[64 * j]; z[j] = (f32x4){bflo(w.x), bfhi(w.x), bflo(w.y), bfhi(w.y)};
            s += (z[j].x * z[j].x + z[j].y * z[j].y) + (z[j].z * z[j].z + z[j].w * z[j].w); }
        const float rz = rsqrtf(wave_sum(s) * (1.f / DM) + EPS);
        float s1 = 0.f;
#pragma unroll
        for (int j = 0; j < 4; ++j) { const f32x4 g = ((const f32x4*)P.a_post_g)[lane + 64 * j]; v[j] = v[j] + z[j] * rz * g;
            s1 += (v[j].x * v[j].x + v[j].y * v[j].y) + (v[j].z * v[j].z + v[j].w * v[j].w); }
        const float r1 = rsqrtf(wave_sum(s1) * (1.f / DM) + EPS);
        f32x4* orow = (f32x4*)(P.out + (size_t)m * DM) + lane; u32x2* o8 = (u32x2*)((bf16_t*)(ws + WS_XB) + (size_t)m * DM) + lane;
#pragma unroll
        for (int j = 0; j < 4; ++j) { orow[64 * j] = v[j]; u32x2 w; w.x = cvt_pk_bf16(v[j].x, v[j].y); w.y = cvt_pk_bf16(v[j].z, v[j].w); o8[64 * j] = w; }
        if (lane == 0) ((float*)(ws + WS_RSTD))[m] = r1;
        float ga[8];
#pragma unroll
        for (int g = 0; g < 8; ++g) { float a = 0.f;
#pragma unroll
            for (int j = 0; j < 4; ++j) { const f32x4 w4 = ((const LAS f32x4*)(Wg + g * 1024))[lane + 64 * j]; a += (v[j].x * w4.x + v[j].y * w4.y) + (v[j].z * w4.z + v[j].w * w4.w); }
            ga[g] = a; }
        float gb[4], gc[2], gd;
        { const bool up = (lane & 32) != 0;
#pragma unroll
          for (int i = 0; i < 4; ++i) { const float snd = up ? ga[i] : ga[4 + i]; const float kp = up ? ga[4 + i] : ga[i]; gb[i] = kp + __shfl_xor(snd, 32); } }
        { const bool up = (lane & 16) != 0;
#pragma unroll
          for (int i = 0; i < 2; ++i) { const float snd = up ? gb[i] : gb[2 + i]; const float kp = up ? gb[2 + i] : gb[i]; gc[i] = kp + __shfl_xor(snd, 16); } }
        { const bool up = (lane & 8) != 0; const float snd = up ? gc[0] : gc[1]; const float kp = up ? gc[1] : gc[0]; gd = kp + __shfl_xor(snd, 8); }
        gd += __shfl_xor(gd, 4); gd += __shfl_xor(gd, 2); gd += __shfl_xor(gd, 1);
        if ((lane & 7) == 0) { const int g = lane >> 3;
            ((float*)(ws + WS_IFP))[(size_t)m * 8 + g] = gd * r1 + P.b_gate_bias[g]; }
    }
}
__device__ __forceinline__ void phase_rowfinal(const Params& P, const Wk& W) {
    unsigned char* ws = P.ws;
    const int gw = W.vcu * 8 + W.wave, NGW = W.G * 8, lane = W.lane;
    const bf16_t* Z = (const bf16_t*)(ws + WS_Z);
    for (int m = gw; m < T; m += NGW) {
        f32x4* xr = (f32x4*)(P.out + (size_t)m * DM) + lane; const u32x2* zr = (const u32x2*)(Z + (size_t)m * DM) + lane;
        f32x4 v[4], z[4]; float s = 0.f;
#pragma unroll
        for (int j = 0; j < 4; ++j) { v[j] = xr[64 * j]; const u32x2 w = zr[64 * j]; z[j] = (f32x4){bflo(w.x), bfhi(w.x), bflo(w.y), bfhi(w.y)};
            s += (z[j].x * z[j].x + z[j].y * z[j].y) + (z[j].z * z[j].z + z[j].w * z[j].w); }
        const float rz = rsqrtf(wave_sum(s) * (1.f / DM) + EPS);
#pragma unroll
        for (int j = 0; j < 4; ++j) { const f32x4 g = ((const f32x4*)P.b_post_g)[lane + 64 * j]; xr[64 * j] = v[j] + z[j] * rz * g; }
    }
}
__device__ __forceinline__ void first_token_u0(const Params& P, const Wk& W, LAS unsigned char* lds, int widx) {
    unsigned char* ws = P.ws;
    const int bh = widx >> 2, sl = widx & 3, b = bh >> 2, h = bh & 3, j = W.tid % 192, sub = W.tid / 192; const size_t row = (size_t)b * SEQ;
    LAS float* hs = (LAS float*)lds;
    if (W.tid < 256) hs[W.tid] = P.out[row * DM + sl * 256 + W.tid] * P.b_pre_g[sl * 256 + W.tid] * ((const float*)(ws + WS_RSTD))[row];
    __syncthreads();
    if (W.tid < 384) {
        const float* wp = P.b_w_in + (size_t)(sl * 256 + sub * 128) * B_IN + h * 192 + j; float a = 0.f;
#pragma unroll 64
        for (int k = 0; k < 128; ++k) a += hs[sub * 128 + k] * wp[(size_t)k * B_IN];
        atomicAdd((float*)(ws + WS_U0) + bh * 192 + j, a); }
    __syncthreads();
}
__device__ __forceinline__ void first_token_qk(const Params& P, const Wk& W, LAS unsigned char* lds) {
    unsigned char* ws = P.ws;
    const int first = W.G > 32 ? W.G - 32 : 0, nwk = W.G > 32 ? 32 : W.G;
    if (W.vcu < first) return;
    for (int bh = W.vcu - first; bh < 32; bh += nwk) {
    const int h = bh & 3, tid = W.tid;
    LAS float* uc0 = (LAS float*)lds; LAS float* qk0 = uc0 + 192;
    float wv[96];
    const int o = tid % 192, part = tid / 192, j = o % 96;
    if (tid < 384) { const float* Wm = (o < 96 ? P.b_w_q : P.b_w_k) + (size_t)h * 192 * 96 + (size_t)(part * 96) * 96 + j;
#pragma unroll
        for (int i = 0; i < 96; ++i) wv[i] = Wm[i * 96]; }
    if (tid < 192) { const int col = h * 192 + tid; uc0[tid] = silu_f(P.b_conv_b[col] + P.b_conv_w[3 * 768 + col] * ((const float*)(ws + WS_U0))[bh * 192 + tid]); }
    __syncthreads();
    if (tid < 384) { float a = 0.f;
#pragma unroll
        for (int i = 0; i < 96; ++i) a += uc0[part * 96 + i] * wv[i];
        qk0[part * 192 + o] = a; }
    __syncthreads();
    if (tid < 64) { float a = (qk0[tid] + qk0[192 + tid]) * (qk0[96 + tid] + qk0[288 + tid]); if (tid < 32) a += (qk0[64 + tid] + qk0[256 + tid]) * (qk0[160 + tid] + qk0[352 + tid]);
        a = wave_sum(a); if (tid == 0) ((float*)(ws + WS_C0))[bh] = a * KSCALE_B; }
    __syncthreads();
    }
}
__device__ __forceinline__ void phase_conv(const Params& P, const Wk& W) {
    unsigned char* ws = P.ws;
    const bf16_t* G2 = (const bf16_t*)(ws + WS_G); bf16_t* UC = (bf16_t*)(ws + WS_UC);
    const int gt = W.vcu * 512 + W.tid, NGT = W.G * 512;
    for (int it = gt; it < (T / 8) * 96; it += NGT) {
        const int rg = it / 96, cc = it % 96, row0 = rg * 8, c0 = cc * 8, s0 = row0 & (SEQ - 1);
        float w[4][8], bsv[8];
#pragma unroll
        for (int j = 0; j < 4; ++j) { const f32x4 a = *(const f32x4*)(P.b_conv_w + j * 768 + c0), b = *(const f32x4*)(P.b_conv_w + j * 768 + c0 + 4);
            w[j][0] = a.x; w[j][1] = a.y; w[j][2] = a.z; w[j][3] = a.w; w[j][4] = b.x; w[j][5] = b.y; w[j][6] = b.z; w[j][7] = b.w; }
        { const f32x4 a = *(const f32x4*)(P.b_conv_b + c0), b = *(const f32x4*)(P.b_conv_b + c0 + 4); bsv[0] = a.x; bsv[1] = a.y; bsv[2] = a.z; bsv[3] = a.w; bsv[4] = b.x; bsv[5] = b.y; bsv[6] = b.z; bsv[7] = b.w; }
        float h[3][8];
#pragma unroll
        for (int j = 0; j < 3; ++j) {
            if (s0 - 3 + j >= 0) { const u32x4 q = *(const u32x4*)(G2 + (size_t)(row0 - 3 + j) * G2W + G2_U + c0);
                h[j][0] = bflo(q.x); h[j][1] = bfhi(q.x); h[j][2] = bflo(q.y); h[j][3] = bfhi(q.y); h[j][4] = bflo(q.z); h[j][5] = bfhi(q.z); h[j][6] = bflo(q.w); h[j][7] = bfhi(q.w); }
            else {
#pragma unroll
                for (int e = 0; e < 8; ++e) h[j][e] = 0.f; }
        }
#pragma unroll
        for (int r = 0; r < 8; ++r) {
            const u32x4 q = *(const u32x4*)(G2 + (size_t)(row0 + r) * G2W + G2_U + c0);
            float u[8] = {bflo(q.x), bfhi(q.x), bflo(q.y), bfhi(q.y), bflo(q.z), bfhi(q.z), bflo(q.w), bfhi(q.w)};
            float o[8];
#pragma unroll
            for (int e = 0; e < 8; ++e) { const float cv = bsv[e] + h[0][e] * w[0][e] + h[1][e] * w[1][e] + h[2][e] * w[2][e] + u[e] * w[3][e]; o[e] = silu_f(cv);
                h[0][e] = h[1][e]; h[1][e] = h[2][e]; h[2][e] = u[e]; }
            u32x4 ov; ov.x = cvt_pk_bf16(o[0], o[1]); ov.y = cvt_pk_bf16(o[2], o[3]); ov.z = cvt_pk_bf16(o[4], o[5]); ov.w = cvt_pk_bf16(o[6], o[7]);
            *(u32x4*)(UC + (size_t)(row0 + r) * 768 + c0) = ov;
        }
    }
}
namespace ml {
__device__ __forceinline__ int crow(int r, int hi) { return (r & 3) + 8 * (r >> 2) + 4 * hi; }
template <int NKS>
__device__ __forceinline__ f32x16 tile32(const LAS bf16_t* A, int lda, const LAS bf16_t* B, int ldb, int r32, int hi, f32x16 acc) {
    const LAS bf16_t* ap = A + r32 * lda + hi * 8; const LAS bf16_t* bp = B + r32 * ldb + hi * 8;
#pragma unroll
    for (int ks = 0; ks < NKS; ++ks) { const bf16x8 a = *(const LAS bf16x8*)(ap + ks * 16); const bf16x8 b = *(const LAS bf16x8*)(bp + ks * 16);
        acc = __builtin_amdgcn_mfma_f32_32x32x16_bf16(a, b, acc, 0, 0, 0); }
    return acc;
}
__device__ __forceinline__ float logsigmoid_f(float f) { return fminf(f, 0.f) - log1pf(__expf(-fabsf(f))); }
__device__ __forceinline__ float scan_add(float v, int lane) {
#pragma unroll
    for (int o = 1; o < 64; o <<= 1) { const float t = __shfl_up(v, o); if (lane >= o) v += t; }
    return v;
}
__device__ __forceinline__ float scan_max(float v, int lane) {
#pragma unroll
    for (int o = 1; o < 64; o <<= 1) { const float t = __shfl_up(v, o); if (lane >= o) v = fmaxf(v, t); }
    return v;
}
constexpr int P72 = 72, P104 = 104;
__device__ __forceinline__ int unit_of(const Wk& W, int k) { const int run = W.vcu + (k >> 3) * W.G; return run < 256 ? run * 8 + (k & 7) : -1; }
__device__ __forceinline__ float sum8(const u32x4 q) { return ((bflo(q.x) + bfhi(q.x)) + (bflo(q.y) + bfhi(q.y))) + ((bflo(q.z) + bfhi(q.z)) + (bflo(q.w) + bfhi(q.w))); }

__device__ __forceinline__ void pass1_phase(const Params& P, const Wk& W, LAS unsigned char* lds) {
    unsigned char* ws = P.ws;
    LAS bf16_t* vT = (LAS bf16_t*)lds;
    LAS bf16_t* kwT = (LAS bf16_t*)(lds + 27648);
    LAS float* wsl = (LAS float*)(lds + 41472);
    LAS bf16_t* Cs = (LAS bf16_t*)(lds + 41792);
    const float* ifp = (const float*)(ws + WS_IFP);
    const bf16_t* QK = (const bf16_t*)(ws + WS_QK); const bf16_t* VV = (const bf16_t*)(ws + WS_VV);
    const int tid = W.tid, lane = W.lane, wid = W.wave, r32 = lane & 31, hi = lane >> 5;
    int kq = 0; int u = unit_of(W, 0); if (u < 0) return;
    u32x4 q[5]; float pli = 0.f, pf = 0.f;
    f32x16 T0 = f32x16{}, T1 = f32x16{}, T2 = f32x16{}; float mt_run = -1e30f, bl_run = 0.f, tn_run = 0.f;
#define P1_LOAD(uu) do { const int bh_ = (uu) >> 6, c_ = (uu) & 63, b_ = bh_ >> 2, h_ = bh_ & 3, row0_ = b_ * SEQ + c_ * 64; \
        _Pragma("unroll") for (int i = 0; i < 5; ++i) { const int id = tid + 512 * i; \
            if (id < 768) q[i] = *(const u32x4*)((const char*)QK + (unsigned)((((bh_ * SEQ) + c_ * 64 + (id & 63)) * 192 + 96 + (id >> 6) * 8) * 2)); \
            else if (id < 2304) q[i] = *(const u32x4*)((const char*)VV + (unsigned)((((bh_ * SEQ) + c_ * 64 + (id & 63)) * 192 + ((id - 768) >> 6) * 8) * 2)); } \
        if (wid == 0) { pli = *(const float*)((const char*)ifp + (unsigned)(((row0_ + lane) * 8 + h_) * 4)); pf = *(const float*)((const char*)ifp + (unsigned)(((row0_ + lane) * 8 + 4 + h_) * 4)); } } while (0)
    P1_LOAD(u);
    for (;;) {
        const int un = unit_of(W, kq + 1);
        if (wid == 0) {
            const float bcs = scan_add(logsigmoid_f(pf), lane);
            const float bL = __shfl(bcs, 63);
            const float dec = bL - bcs + pli;
            const float mloc = wave_max(dec);
            wsl[lane] = __expf(dec - mloc);
            if (lane == 0) { ((float*)(ws + WS_BL))[u] = bL; ((float*)(ws + WS_MLOC))[u] = mloc; wsl[64] = bL; wsl[65] = mloc; }
        }
        __syncthreads();
        float a_run, w_run; { const float bL = wsl[64], ml = wsl[65]; const float mn = fmaxf(bL + mt_run, ml); a_run = __expf(bL + mt_run - mn); w_run = __expf(ml - mn); mt_run = mn; bl_run += bL; }
#pragma unroll
        for (int i = 0; i < 5; ++i) { const int id = tid + 512 * i, row = id & 63;
            if (id < 768) { const int cc = id >> 6; const float wv = wsl[row];
                const float e[8] = {bflo(q[i].x), bfhi(q[i].x), bflo(q[i].y), bfhi(q[i].y), bflo(q[i].z), bfhi(q[i].z), bflo(q[i].w), bfhi(q[i].w)};
#pragma unroll
                for (int j = 0; j < 8; ++j) kwT[(cc * 8 + j) * P72 + row] = f2bf(e[j] * wv);
            } else if (id < 2304) { const int cc = (id - 768) >> 6;
                const unsigned short e[8] = {(unsigned short)(q[i].x & 0xffff), (unsigned short)(q[i].x >> 16), (unsigned short)(q[i].y & 0xffff), (unsigned short)(q[i].y >> 16), (unsigned short)(q[i].z & 0xffff), (unsigned short)(q[i].z >> 16), (unsigned short)(q[i].w & 0xffff), (unsigned short)(q[i].w >> 16)};
#pragma unroll
                for (int j = 0; j < 8; ++j) vT[(cc * 8 + j) * P72 + row] = e[j]; }
        }
        __syncthreads();
        if (un >= 0) P1_LOAD(un);
        for (int tt = wid; tt < 18; tt += 8) {
            const int mt = tt / 3, nt = tt % 3;
            f32x16 acc = f32x16{};
            acc = tile32<4>(vT + mt * 32 * P72, P72, kwT + nt * 32 * P72, P72, r32, hi, acc);
            if (tt < 8) T0 = T0 * a_run + acc * w_run; else if (tt < 16) T1 = T1 * a_run + acc * w_run; else T2 = T2 * a_run + acc * w_run;
#pragma unroll
            for (int r = 0; r < 16; ++r) Cs[(mt * 32 + crow(r, hi)) * P104 + nt * 32 + r32] = f2bf(acc[r]);
        }
        if (tid < 384) { const int dk = tid >> 2, sub = tid & 3;
            float sd = sum8(*(const LAS u32x4*)(kwT + dk * P72 + sub * 8)) + sum8(*(const LAS u32x4*)(kwT + dk * P72 + (sub + 4) * 8));
            sd += __shfl_xor(sd, 1); sd += __shfl_xor(sd, 2);
            if (sub == 0) { ((float*)(ws + WS_DN))[(size_t)u * 96 + dk] = sd; tn_run = tn_run * a_run + sd * w_run; } }
        __syncthreads();
        { char* DCb = (char*)(ws + WS_DC) + (size_t)u * (192 * 96 * 2);
#pragma unroll
          for (int i = 0; i < 5; ++i) { const int id = tid + 512 * i; if (id < 2304) { const int dv = id / 12, cc = id % 12; *(u32x4*)(DCb + (unsigned)(id * 16)) = *(const LAS u32x4*)(Cs + dv * P104 + cc * 8); } } }
        if ((kq & 7) == 7) {
            const int run = u >> 3;
            __syncthreads();
#pragma unroll
            for (int k3 = 0; k3 < 3; ++k3) { const int tt = wid + 8 * k3; if (tt < 18) { const int mt = tt / 3, nt = tt % 3; const f32x16 Tv = (k3 == 0) ? T0 : (k3 == 1) ? T1 : T2;
#pragma unroll
                for (int r = 0; r < 16; ++r) Cs[(mt * 32 + crow(r, hi)) * P104 + nt * 32 + r32] = f2bf(Tv[r]); } }
            if (tid < 384 && (tid & 3) == 0) ((float*)(ws + WS_RN))[run * 96 + (tid >> 2)] = tn_run;
            if (tid == 0) { ((float*)(ws + WS_RBL))[run] = bl_run; ((float*)(ws + WS_RBL))[256 + run] = mt_run; }
            __syncthreads();
            { char* RSb = (char*)(ws + WS_RS) + (size_t)run * (192 * 96 * 2);
#pragma unroll
              for (int i = 0; i < 5; ++i) { const int id = tid + 512 * i; if (id < 2304) { const int dv = id / 12, cc = id % 12; *(u32x4*)(RSb + (unsigned)(id * 16)) = *(const LAS u32x4*)(Cs + dv * P104 + cc * 8); } } }
            T0 = f32x16{}; T1 = f32x16{}; T2 = f32x16{}; mt_run = -1e30f; bl_run = 0.f; tn_run = 0.f;
        }
        if (un < 0) break;
        u = un; ++kq;
    }
#undef P1_LOAD
    __syncthreads();
}

__device__ __forceinline__ void pass2(const Params& P, const Wk& W) {
    unsigned char* ws = P.ws;
    const float* BL = (const float*)(ws + WS_RBL); const float* ML = BL + 256; float* MS = (float*)(ws + WS_RBL) + 512;
    const int gt = (W.wave * W.G + W.vcu) * 64 + W.lane, NGT = W.G * 512;
    constexpr int NCE = 32 * 2304, NNE = 32 * 96;
    for (int g = gt; g < NCE + NNE; g += NGT) {
        if (g < NCE) {
            const int bh = g / 2304, e = g % 2304;
            float C[8]; float m = 0.f; float z0 = 0.f; asm volatile("" : "+v"(z0));
#pragma unroll
            for (int j = 0; j < 8; ++j) C[j] = z0;
            u32x4* base = (u32x4*)((bf16_t*)(ws + WS_RS) + (size_t)bh * 8 * 18432 + e * 8);
            u32x4 d[8]; float bL[8], ml[8];
#pragma unroll
            for (int j = 0; j < 8; ++j) { d[j] = base[(size_t)j * (18432 / 8)]; bL[j] = BL[bh * 8 + j]; ml[j] = ML[bh * 8 + j]; }
#pragma unroll
            for (int j = 0; j < 8; ++j) {
                u32x4 o; o.x = cvt_pk_bf16(C[0], C[1]); o.y = cvt_pk_bf16(C[2], C[3]); o.z = cvt_pk_bf16(C[4], C[5]); o.w = cvt_pk_bf16(C[6], C[7]);
                base[(size_t)j * (18432 / 8)] = o;
                if (e == 0) MS[bh * 8 + j] = m;
                const float mn = fmaxf(bL[j] + m, ml[j]), a = __expf(bL[j] + m - mn), w = __expf(ml[j] - mn);
                C[0] = a * C[0] + w * bflo(d[j].x); C[1] = a * C[1] + w * bfhi(d[j].x); C[2] = a * C[2] + w * bflo(d[j].y); C[3] = a * C[3] + w * bfhi(d[j].y);
                C[4] = a * C[4] + w * bflo(d[j].z); C[5] = a * C[5] + w * bfhi(d[j].z); C[6] = a * C[6] + w * bflo(d[j].w); C[7] = a * C[7] + w * bfhi(d[j].w);
                m = mn;
            }
        } else {
            const int g2 = g - NCE, bh = g2 / 96, e = g2 % 96;
            float n = 0.f, m = 0.f; float* base = (float*)(ws + WS_RN) + (size_t)bh * 8 * 96 + e;
            float d[8], bL[8], ml[8];
#pragma unroll
            for (int j = 0; j < 8; ++j) { d[j] = base[j * 96]; bL[j] = BL[bh * 8 + j]; ml[j] = ML[bh * 8 + j]; }
#pragma unroll
            for (int j = 0; j < 8; ++j) { base[j * 96] = n; const float mn = fmaxf(bL[j] + m, ml[j]), a = __expf(bL[j] + m - mn), w = __expf(ml[j] - mn); n = a * n + w * d[j]; m = mn; }
        }
    }
}

__device__ __forceinline__ void pass3_phase(const Params& P, const Wk& W, LAS unsigned char* lds) {
    unsigned char* ws = P.ws;
    LAS bf16_t* Qs = (LAS bf16_t*)lds;
    LAS bf16_t* Ks = (LAS bf16_t*)(lds + 13312);
    LAS bf16_t* vT = (LAS bf16_t*)(lds + 26624);
    LAS bf16_t* CT = (LAS bf16_t*)(lds + 54272);
    LAS bf16_t* Ps = (LAS bf16_t*)(lds + 94208);
    LAS float* Hs = (LAS float*)lds;
    LAS float* sm = (LAS float*)(lds + 103424);
    LAS float* g_s = sm, *Mt = sm + 64, *wint = sm + 128, *eneg = sm + 192, *qn = sm + 256, *rden = sm + 320, *nvec = sm + 384;
    const float* ifp = (const float*)(ws + WS_IFP);
    const bf16_t* QK = (const bf16_t*)(ws + WS_QK); const bf16_t* VV = (const bf16_t*)(ws + WS_VV);
    const int tid = W.tid, lane = W.lane, wid = W.wave, r32 = lane & 31, hi = lane >> 5;
    int kq = 0; int u = unit_of(W, 0); if (u < 0) return;
    u32x4 qa[3], qb[3], qc[5]; float pli = 0.f, pf = 0.f, pn = 0.f, pc0 = 0.f, pbl = 0.f, pml = 0.f;
    u32x4 Cr[5]; float n_reg = 0.f, m_cur = 0.f;
#define P3_LOAD(uu) do { const int bh_ = (uu) >> 6, c_ = (uu) & 63, b_ = bh_ >> 2, h_ = bh_ & 3, row0_ = b_ * SEQ + c_ * 64; \
        const char* CS_ = (const char*)(ws + WS_DC) + (size_t)(uu) * (192 * 96 * 2); \
        _Pragma("unroll") for (int i = 0; i < 3; ++i) { const int id = tid + 512 * i; \
            { const int which = id / 768, i2 = id % 768, row = i2 / 12, cc = i2 % 12; qa[i] = *(const u32x4*)((const char*)QK + (unsigned)((((bh_ * SEQ) + c_ * 64 + row) * 192 + which * 96 + cc * 8) * 2)); } \
            { const int cc = id >> 6, row = id & 63; qb[i] = *(const u32x4*)((const char*)VV + (unsigned)((((bh_ * SEQ) + c_ * 64 + row) * 192 + cc * 8) * 2)); } } \
        _Pragma("unroll") for (int i = 0; i < 5; ++i) { const int id = tid + 512 * i; if (id < 2304) qc[i] = *(const u32x4*)(CS_ + (unsigned)(id * 16)); } \
        pbl = ((const float*)(ws + WS_BL))[uu]; pml = ((const float*)(ws + WS_MLOC))[uu]; \
        if (wid == 0) { pc0 = ((const float*)(ws + WS_C0))[bh_]; pli = *(const float*)((const char*)ifp + (unsigned)(((row0_ + lane) * 8 + h_) * 4)); pf = *(const float*)((const char*)ifp + (unsigned)(((row0_ + lane) * 8 + 4 + h_) * 4)); } \
        if (tid < 96) pn = *(const float*)((const char*)(ws + WS_DN) + (unsigned)(((uu) * 96 + tid) * 4)); } while (0)
    P3_LOAD(u);
    for (;;) {
        const int bh = u >> 6, c = u & 63, b = bh >> 2, h = bh & 3, row0 = b * SEQ + c * 64;
        const int un = unit_of(W, kq + 1);
        const float c0cur = pc0;
        int tid_l = W.tid; asm volatile("" : "+v"(tid_l));
        const int tid = tid_l, lane = tid & 63, r32 = lane & 31, hi = lane >> 5;
        if ((kq & 7) == 0) {
            const int run = u >> 3; const char* RSb = (const char*)(ws + WS_RS) + (size_t)run * (192 * 96 * 2);
#pragma unroll
            for (int i = 0; i < 5; ++i) { const int id = tid + 512 * i; if (id < 2304) Cr[i] = *(const u32x4*)(RSb + (unsigned)(id * 16)); }
            if (tid < 96) n_reg = ((const float*)(ws + WS_RN))[run * 96 + tid];
            m_cur = ((const float*)(ws + WS_RBL))[512 + run];
        }
        if (wid == 0) {
            const float bcs = scan_add(logsigmoid_f(pf), lane);
            const float g = pli - bcs;
            const float pmx = scan_max(g, lane);
            const float M = fmaxf(m_cur, pmx);
            g_s[lane] = g; Mt[lane] = M; wint[lane] = __expf(m_cur - M); eneg[lane] = __expf(-bcs - M);
        }
#pragma unroll
        for (int i = 0; i < 3; ++i) { const int id = tid + 512 * i;
            { const int which = id / 768, i2 = id % 768, row = i2 / 12, cc = i2 % 12; *(LAS u32x4*)((which ? Ks : Qs) + row * P104 + cc * 8) = qa[i]; }
            { const int cc = id >> 6, row = id & 63;
              const unsigned short e[8] = {(unsigned short)(qb[i].x & 0xffff), (unsigned short)(qb[i].x >> 16), (unsigned short)(qb[i].y & 0xffff), (unsigned short)(qb[i].y >> 16), (unsigned short)(qb[i].z & 0xffff), (unsigned short)(qb[i].z >> 16), (unsigned short)(qb[i].w & 0xffff), (unsigned short)(qb[i].w >> 16)};
#pragma unroll
              for (int j = 0; j < 8; ++j) vT[(cc * 8 + j) * P72 + row] = e[j]; } }
        {
            const float mn = fmaxf(pbl + m_cur, pml), a_ = __expf(pbl + m_cur - mn), w_ = __expf(pml - mn);
#pragma unroll
            for (int i = 0; i < 5; ++i) { const int id = tid + 512 * i; if (id < 2304) { const int dv = id / 12, cc = id % 12;
                const u32x4 cq = Cr[i], d = qc[i];
                *(LAS u32x4*)(CT + dv * P104 + cc * 8) = cq;
                u32x4 o;
                o.x = cvt_pk_bf16(a_ * bflo(cq.x) + w_ * bflo(d.x), a_ * bfhi(cq.x) + w_ * bfhi(d.x)); o.y = cvt_pk_bf16(a_ * bflo(cq.y) + w_ * bflo(d.y), a_ * bfhi(cq.y) + w_ * bfhi(d.y));
                o.z = cvt_pk_bf16(a_ * bflo(cq.z) + w_ * bflo(d.z), a_ * bfhi(cq.z) + w_ * bfhi(d.z)); o.w = cvt_pk_bf16(a_ * bflo(cq.w) + w_ * bflo(d.w), a_ * bfhi(cq.w) + w_ * bfhi(d.w));
                Cr[i] = o; } }
            if (tid < 96) { nvec[tid] = n_reg; n_reg = a_ * n_reg + w_ * pn; }
            m_cur = mn;
        }
        __syncthreads();
        if (un >= 0) P3_LOAD(un);
        __builtin_amdgcn_sched_barrier(0);
        if (wid < 4) {
            const int mt = wid >> 1, nt = wid & 1;
            f32x16 acc = f32x16{};
            acc = tile32<6>(Qs + mt * 32 * P104, P104, Ks + nt * 32 * P104, P104, r32, hi, acc);
#ifndef NO_FIRST_TOKEN
            if (c == 0 && wid == 0 && lane == 0) acc[0] = c0cur;
#endif
            const int s = nt * 32 + r32; const float gs = g_s[s];
#pragma unroll
            for (int r = 0; r < 16; ++r) { const int t = mt * 32 + crow(r, hi);
                const float w = (s <= t) ? __expf(gs - Mt[t]) : 0.f;
                Ps[t * P72 + s] = f2bf(acc[r] * w); }
        } else {
            const int t = (tid - 256) >> 2, sub = tid & 3; float a = 0.f;
#pragma unroll
            for (int j = 0; j < 3; ++j) { const int cc = sub + 4 * j; const u32x4 q = *(const LAS u32x4*)(Qs + t * P104 + cc * 8); const LAS float* nv = nvec + cc * 8;
                a += (bflo(q.x) * nv[0] + bfhi(q.x) * nv[1]) + (bflo(q.y) * nv[2] + bfhi(q.y) * nv[3]) + (bflo(q.z) * nv[4] + bfhi(q.z) * nv[5]) + (bflo(q.w) * nv[6] + bfhi(q.w) * nv[7]); }
            a += __shfl_xor(a, 1); a += __shfl_xor(a, 2);
            if (sub == 0) qn[t] = a;
        }
        __syncthreads();
        { const int t = tid >> 3, sub = tid & 7;
          float rs = sum8(*(const LAS u32x4*)(Ps + t * P72 + sub * 8));
          rs += __shfl_xor(rs, 1); rs += __shfl_xor(rs, 2); rs += __shfl_xor(rs, 4);
          if (sub == 0) { float den = wint[t] * qn[t] + rs; den = fmaxf(fabsf(den), eneg[t]); rden[t] = 1.f / den; } }
        const int te = tid >> 3, sube = tid & 7;
        const bf16_t* G2 = (const bf16_t*)(ws + WS_G) + (size_t)(row0 + te) * G2W; const bf16_t* UC = (const bf16_t*)(ws + WS_UC) + (size_t)(row0 + te) * 768;
        u32x4 eop[3], egq[3], euq[3];
#pragma unroll
        for (int j = 0; j < 3; ++j) { const int col = h * 192 + (sube + 8 * j) * 8; eop[j] = *(const u32x4*)(G2 + G2_O + col); egq[j] = *(const u32x4*)(G2 + G2_GATE + col); euq[j] = *(const u32x4*)(UC + col); }
        f32x16 accA = f32x16{}, accB = f32x16{};
        {
            const int tt = (wid < 4) ? (8 + wid) : (wid - 4), mt = tt / 6, nt = tt % 6;
            accA = tile32<6>(Qs + mt * 32 * P104, P104, CT + nt * 32 * P104, P104, r32, hi, accA);
#pragma unroll
            for (int r = 0; r < 16; ++r) accA[r] *= wint[mt * 32 + crow(r, hi)];
            accA = tile32<4>(Ps + mt * 32 * P72, P72, vT + nt * 32 * P72, P72, r32, hi, accA);
        }
        if (wid >= 4) {
            const int tt = wid, mt = tt / 6, nt = tt % 6;
            accB = tile32<6>(Qs + mt * 32 * P104, P104, CT + nt * 32 * P104, P104, r32, hi, accB);
#pragma unroll
            for (int r = 0; r < 16; ++r) accB[r] *= wint[mt * 32 + crow(r, hi)];
            accB = tile32<4>(Ps + mt * 32 * P72, P72, vT + nt * 32 * P72, P72, r32, hi, accB);
        }
        __syncthreads();
        {
            const int tt = (wid < 4) ? (8 + wid) : (wid - 4), mt = tt / 6, nt = tt % 6;
#pragma unroll
            for (int r = 0; r < 16; ++r) { const int t = mt * 32 + crow(r, hi); Hs[t * 196 + nt * 32 + r32] = accA[r] * rden[t]; }
        }
        if (wid >= 4) {
            const int tt = wid, mt = tt / 6, nt = tt % 6;
#pragma unroll
            for (int r = 0; r < 16; ++r) { const int t = mt * 32 + crow(r, hi); Hs[t * 196 + nt * 32 + r32] = accB[r] * rden[t]; }
        }
        __syncthreads();
        __builtin_amdgcn_sched_barrier(0);
        {
            float hv[3][8]; float ss = 0.f;
#pragma unroll
            for (int j = 0; j < 3; ++j) { const int col = (sube + 8 * j) * 8;
                const f32x4 a = *(const LAS f32x4*)(Hs + te * 196 + col), bq = *(const LAS f32x4*)(Hs + te * 196 + col + 4);
                hv[j][0] = a.x; hv[j][1] = a.y; hv[j][2] = a.z; hv[j][3] = a.w; hv[j][4] = bq.x; hv[j][5] = bq.y; hv[j][6] = bq.z; hv[j][7] = bq.w;
#pragma unroll
                for (int e = 0; e < 8; ++e) ss += hv[j][e] * hv[j][e]; }
            ss += __shfl_xor(ss, 1); ss += __shfl_xor(ss, 2); ss += __shfl_xor(ss, 4);
            const float rstd = rsqrtf(ss * (1.f / 192.f) + EPS);
            bf16_t* Y = (bf16_t*)(ws + WS_Y2) + (size_t)(row0 + te) * DM;
#pragma unroll
            for (int j = 0; j < 3; ++j) { const int col = h * 192 + (sube + 8 * j) * 8;
                const u32x4 op = eop[j], gq = egq[j], uq = euq[j];
                const float ov[8] = {bflo(op.x), bfhi(op.x), bflo(op.y), bfhi(op.y), bflo(op.z), bfhi(op.z), bflo(op.w), bfhi(op.w)};
                const float gv[8] = {bflo(gq.x), bfhi(gq.x), bflo(gq.y), bfhi(gq.y), bflo(gq.z), bfhi(gq.z), bflo(gq.w), bfhi(gq.w)};
                const float uv[8] = {bflo(uq.x), bfhi(uq.x), bflo(uq.y), bfhi(uq.y), bflo(uq.z), bfhi(uq.z), bflo(uq.w), bfhi(uq.w)};
                float o[8];
#pragma unroll
                for (int e = 0; e < 8; ++e) { const float hn = hv[j][e] * rstd * P.b_head_g[col + e]; const float mix = sigmoid_f(ov[e]) * hn + P.b_skip[col + e] * uv[e]; o[e] = mix * silu_f(gv[e]); }
                u32x4 w; w.x = cvt_pk_bf16(o[0], o[1]); w.y = cvt_pk_bf16(o[2], o[3]); w.z = cvt_pk_bf16(o[4], o[5]); w.w = cvt_pk_bf16(o[6], o[7]);
                *(u32x4*)(Y + col) = w; }
        }
        __syncthreads();
        if (un < 0) break;
        u = un; ++kq;
    }
#undef P3_LOAD
}
}
typedef GAS unsigned gu32;
#define XB_TMO      128
#define XB_XCNT(j)  (256  + 64 * (j))
#define XB_XSUB(j)  (1280 + 64 * (j))
#define XB_XGEN(j)  (2304 + 64 * (j))
#define XB_TOP      3328
#define XB_TOPGEN   3392
#define XCD_BAR_WORDS 3456
#define XB_SPIN_CAP (1u << 18)
__device__ __forceinline__ unsigned xb_ld(unsigned* p)              { return __hip_atomic_load(p, __ATOMIC_RELAXED, __HIP_MEMORY_SCOPE_AGENT); }
__device__ __forceinline__ unsigned xb_add(unsigned* p, unsigned v) { return __hip_atomic_fetch_add(p, v, __ATOMIC_RELAXED, __HIP_MEMORY_SCOPE_AGENT); }
__device__ __forceinline__ unsigned xb_xcc_id() { return (unsigned)__builtin_amdgcn_s_getreg((3 << 11) | 20) & 0xFu; }
#define XB_SPIN(cond, bar) do { unsigned _sp = 0; while (cond) { __builtin_amdgcn_s_sleep(1); \
    if ((++_sp & 255u) == 0u) { if (xb_ld(&(bar)[XB_TMO])) break; if (_sp > XB_SPIN_CAP) { atomicAdd(&(bar)[XB_TMO], 1u); break; } } } } while (0)
struct XcdBarrier { unsigned* bar; unsigned x; volatile LAS unsigned* st; };
__device__ __forceinline__ XcdBarrier xcd_barrier_post(unsigned* bar, volatile LAS unsigned* st) {
    XcdBarrier b; b.bar = bar; b.x = xb_xcc_id(); b.st = st;
    if (threadIdx.x == 0) (void)xb_add(&bar[XB_XCNT(b.x)], 1u);
    return b;
}
__device__ __forceinline__ void xcd_barrier_complete(unsigned* bar, unsigned x, unsigned& nloc, unsigned& nx) {
    const unsigned G = gridDim.x * gridDim.y * gridDim.z;
    unsigned sum, cnt, mine, sp = 0u;
    for (;;) {
        sum = 0u; cnt = 0u; mine = 0u;
#pragma unroll
        for (unsigned j = 0; j < 16; ++j) { const unsigned c = xb_ld(&bar[XB_XCNT(j)]); sum += c; cnt += (c > 0u) ? 1u : 0u; mine = (j == x) ? c : mine; }
        if (sum == G) break;
        __builtin_amdgcn_s_sleep(1);
        if ((++sp & 255u) == 0u) { if (xb_ld(&bar[XB_TMO])) break; if (sp > XB_SPIN_CAP) { atomicAdd(&bar[XB_TMO], 1u); break; } }
    }
    nloc = mine > 0u ? mine : 1u; nx = cnt > 0u ? cnt : 1u;
}
__device__ __forceinline__ void xcd_barrier(const XcdBarrier& b) {
    asm volatile("s_waitcnt vmcnt(0)" ::: "memory");
    __syncthreads();
    if (threadIdx.x == 0) {
        unsigned* bar = b.bar;
        __builtin_amdgcn_s_waitcnt(0);
        unsigned nloc = b.st[0], nx = b.st[1];
        if (nloc == 0u) { xcd_barrier_complete(bar, b.x, nloc, nx); b.st[0] = nloc; b.st[1] = nx; }
        const unsigned old = xb_add(&bar[XB_XSUB(b.x)], 1u);
        const unsigned gen = old / nloc;
        if (old + 1u == (gen + 1u) * nloc) {
            __builtin_amdgcn_fence(__ATOMIC_RELEASE, "agent");
            asm volatile("s_waitcnt vmcnt(0)" ::: "memory");
            const unsigned og = xb_add(&bar[XB_TOP], 1u);
            const unsigned tg = og / nx;
            if (og + 1u == (tg + 1u) * nx) xb_add(&bar[XB_TOPGEN], 1u);
            else XB_SPIN(xb_ld(&bar[XB_TOPGEN]) == tg, bar);
            __builtin_amdgcn_fence(__ATOMIC_ACQUIRE, "agent");
            xb_add(&bar[XB_XGEN(b.x)], 1u);
            asm volatile("s_waitcnt vmcnt(0)" ::: "memory");
        } else {
            XB_SPIN(xb_ld(&bar[XB_XGEN(b.x)]) == gen, bar);
            __builtin_amdgcn_fence(__ATOMIC_ACQUIRE, "agent");
            asm volatile("s_waitcnt vmcnt(0)" ::: "memory");
        }
    }
    __syncthreads();
}

constexpr int RING_BYTES = 131072, LDSCTL_OFF = RING_BYTES, LDS_BYTES = 147456;
constexpr int CW_BAR = 4096;
constexpr int CW_XCNT = 16384;
constexpr int CW_XTMO = 8192;
#ifdef FUSED_FINAL
constexpr int N_PHASES = 13;
#else
constexpr int N_PHASES = 14;
#endif

__device__ __forceinline__ void setup_job(const Params& P, int j, pg8::Gemm& g, pg8::Epi& E) {
    unsigned char* ws = P.ws;
    E.out = nullptr; E.ldc = 0; E.ncols = 1 << 30; E.out2 = nullptr; E.ldc2 = 0; E.split = 1 << 30; E.rs = nullptr; E.rs_mode = 0; E.rs_invdim = 0.f;
    E.ssqA = nullptr; E.ssqB = nullptr; E.ssq_mode = 0; E.rope = (const float2*)(ws + WS_ROPE); E.rope_mode = 0; E.hm_mode = 0;
    E.after = 0; E.fbase = nullptr; E.fout = nullptr; E.fgain = nullptr; E.xslots = (unsigned*)(ws + WS_XSL); E.xcnt = (unsigned*)(ws + WS_CTL) + CW_XCNT; E.xtmo = (unsigned*)(ws + WS_CTL) + CW_XTMO;
    g.M = T; g.lda = 1024; g.apn = 0;
    switch (j) {
    case 0: g.A = (const bf16_t*)(ws + WS_XB); g.Bt = (const bf16_t*)(ws + WS_WINA); g.N = 2048; g.K = 1024;
        E.out = (bf16_t*)(ws + WS_G); E.ldc = G1W; E.rs = (const float*)(ws + WS_RSTD); E.rs_mode = 1; E.ssqA = (float*)(ws + WS_SSQA); E.ssqB = (float*)(ws + WS_SSQB); E.ssq_mode = 1; E.rope_mode = 1; break;
    case 1: g.A = (const bf16_t*)(ws + WS_MEMN); g.Bt = (const bf16_t*)(ws + WS_WMKV); g.M = NB * NMEM; g.N = 1024; g.K = 1024;
        E.out = (bf16_t*)(ws + WS_KVM); E.ldc = 1024; break;
    case 2: g.A = (const bf16_t*)(ws + WS_G) + G1_CQ; g.lda = G1W; g.Bt = (const bf16_t*)(ws + WS_WUQ); g.N = 1280; g.K = 384;
        E.out = (bf16_t*)(ws + WS_Q); E.ldc = QW; E.ncols = QW; E.rs = (const float*)(ws + WS_SSQA); E.rs_mode = 2; E.rs_invdim = 1.f / 384.f; E.rope_mode = 2; break;
    case 3: g.A = (const bf16_t*)(ws + WS_G) + G1_CKV; g.lda = G1W; g.Bt = (const bf16_t*)(ws + WS_WUKV); g.N = 1536; g.K = 256;
        E.out = (bf16_t*)(ws + WS_KN); E.ldc = 768; E.out2 = (bf16_t*)(ws + WS_V); E.ldc2 = 768; E.split = 768; E.rs = (const float*)(ws + WS_SSQB); E.rs_mode = 2; E.rs_invdim = 1.f / 256.f; break;
    case 4: g.A = (const bf16_t*)(ws + WS_Y); g.Bt = (const bf16_t*)(ws + WS_WOA); g.N = 1024; g.K = 1024; E.out = (bf16_t*)(ws + WS_Z); E.ldc = 1024; break;
    case 5: g.A = (const bf16_t*)(ws + WS_XB); g.Bt = (const bf16_t*)(ws + WS_WINB); g.N = G2W; g.K = 1024;
        E.out = (bf16_t*)(ws + WS_G); E.ldc = G2W; E.rs = (const float*)(ws + WS_RSTD); E.rs_mode = 1; break;
    case 6: g.A = (const bf16_t*)(ws + WS_UC); g.lda = 768; g.apn = 192; g.Bt = (const bf16_t*)(ws + WS_WQK); g.N = 768; g.K = 384; E.out = (bf16_t*)(ws + WS_QK); E.ldc = 768; E.hm_mode = 1; break;
    case 7: g.A = (const bf16_t*)(ws + WS_G) + G2_U; g.lda = G2W; g.apn = 192; g.Bt = (const bf16_t*)(ws + WS_WV); g.N = 768; g.K = 384; E.out = (bf16_t*)(ws + WS_VV); E.ldc = 768; E.hm_mode = 1; break;
    default: g.A = (const bf16_t*)(ws + WS_Y2); g.Bt = (const bf16_t*)(ws + WS_WOB); g.N = 1024; g.K = 1024;
#ifdef FUSED_FINAL
        E.after = 1; E.fbase = P.out; E.fout = P.out; E.fgain = P.b_post_g; E.xcnt = (unsigned*)(ws + WS_CTL) + CW_XCNT + (j - 8) * 128 * 64;
#else
        E.out = (bf16_t*)(ws + WS_Z); E.ldc = 1024;
#endif
        break;
    }
}

__device__ __forceinline__ void phase_memattn(const Params& P, const Wk& W, LAS unsigned char* lds, int L) {
    unsigned char* ws = P.ws;
    const bf16_t* G = (const bf16_t*)(ws + WS_G); const bf16_t* KVM = (const bf16_t*)(ws + WS_KVM);
    const int gpitch = L ? G2W : G1W, qm_off = L ? G2_QM : G1_QM, gate_off = L ? G2_GATE : G1_GATE;
    bf16_t* Yb = (bf16_t*)(ws + (L ? WS_Y2 : WS_Y));
    for (int u = W.vcu; u < 512; u += W.G) {
        const int rb = u >> 2, hm = u & 3, row0 = rb * 256, b = row0 / SEQ;
        const bf16_t* Km = KVM + (size_t)(b * NMEM) * 1024 + L * 512 + hm * 64;
        att::attn_unit<64, 64, false>(G + (size_t)row0 * gpitch + qm_off + hm * 64, gpitch, Km, 1024, 8, Km, 1024, Km + 256, 1024, 4, 0,
                                      G + (size_t)row0 * gpitch + gate_off + 768 + hm * 64, gpitch, Yb + (size_t)row0 * DM + 768 + hm * 64, DM, lds, W.tid);
    }
}
template <int ABL>
__device__ __forceinline__ void phase_attn(const Params& P, const Wk& W, LAS unsigned char* lds) {
    unsigned char* ws = P.ws;
    const bf16_t* G = (const bf16_t*)(ws + WS_G); const bf16_t* Qp = (const bf16_t*)(ws + WS_Q); const bf16_t* KN = (const bf16_t*)(ws + WS_KN); const bf16_t* Vp = (const bf16_t*)(ws + WS_V);
    bf16_t* Yb = (bf16_t*)(ws + (ABL ? WS_Z : WS_Y));
    for (int u = W.vcu; u < 768; u += W.G) {
        const int k = u >> 8, cu = u & 255, grp = cu >> 4, i = cu & 15, bh = grp * 3 + k;
        const int qb = (k == 0) ? i : (k == 1) ? ((i + 8) & 15) : (i < 8 ? 15 - 2 * i : 30 - 2 * i);
        const int b = bh / 6, h = bh % 6; const size_t rowb = (size_t)b * SEQ, row0 = rowb + (size_t)qb * 256;
        int tid_u = W.tid; asm volatile("" : "+v"(tid_u));
        att::attn_unit<192, 128, true, ABL>(Qp + row0 * QW + h * 192, QW, KN + rowb * 768 + h * 128, 768, 16, G + rowb * G1W + G1_KR, G1W, Vp + rowb * 768 + h * 128, 768,
                                       4 * (qb + 1), qb * 256, G + row0 * G1W + G1_GATE + h * 128, G1W, Yb + row0 * DM + h * 128, DM, lds, tid_u);
    }
}

__global__ void __launch_bounds__(512, 2) mega_fwd(Params P) {
    extern __shared__ __attribute__((aligned(16))) unsigned char lds_raw[];
    LAS unsigned char* lds = (LAS unsigned char*)lds_raw;
    Wk W; W.tid = threadIdx.x; W.lane = W.tid & 63; W.wave = __builtin_amdgcn_readfirstlane(W.tid >> 6);
    W.G = gridDim.x; { const int bx = blockIdx.x; W.vcu = (W.G % 8 == 0) ? (bx % 8) * (W.G / 8) + bx / 8 : bx; }
    volatile LAS unsigned* MISC = (volatile LAS unsigned*)(lds + LDSCTL_OFF);
    if (W.tid < 64) MISC[W.tid] = 0u;
    __syncthreads();
    const int lo = P.ph_lo, hi = P.ph_hi;
    const int vcu_s = W.vcu;
    const int wave_s = __builtin_amdgcn_readfirstlane(threadIdx.x >> 6);
    XcdBarrier bar; bar.bar = (unsigned*)(P.ws + WS_CTL) + CW_BAR; bar.x = 0; bar.st = nullptr;
    if (hi - lo > 1) bar = xcd_barrier_post((unsigned*)(P.ws + WS_CTL) + CW_BAR, MISC + 8);
#ifndef PROBE_REP
#define PROBE_REP 0
#endif
#ifdef PROBE_PAIR
    bool pair_done = false;
#endif
    for (int ph2 = 2 * lo; ph2 < 2 * hi; ++ph2) {
        const int ph = ph2 >> 1;
        if ((ph2 & 1) && !((PROBE_REP >> ph) & 1)) continue;
        const bool more_ = (ph + 1 < hi) || (!(ph2 & 1) && ((PROBE_REP >> ph) & 1));
        { int t_; asm volatile("v_mbcnt_lo_u32_b32 %0, -1, 0\n\tv_mbcnt_hi_u32_b32 %0, -1, %0" : "=v"(t_)); t_ += wave_s * 64; { int g_ = gridDim.x, v_ = vcu_s; asm volatile("" : "+s"(g_), "+s"(v_)); W.G = g_; W.vcu = v_; } W.tid = t_; W.lane = t_ & 63; W.wave = __builtin_amdgcn_readfirstlane(t_ >> 6); }
        int j0 = 0, j1 = 0;
#ifdef DBG_CUT
        if (ph == 100) { const bf16_t* src = (const bf16_t*)(P.ws + (size_t)DBG_OFF); const int gt_ = W.vcu * 512 + W.tid, NGT_ = W.G * 512; for (int i = gt_; i < T * DM; i += NGT_) {
#ifdef DBG_F32N
            P.out[i] = (i < DBG_F32N) ? ((const float*)src)[i] : 0.f;
#else
            P.out[i] = bf2f(src[i]);
#endif
            } continue; }
#endif
#ifndef PHM
#define PHM 0xffff
#endif
#define PHON(k) ((PHM >> (k)) & 1)
        switch (ph) {
        case 0: if (PHON(0)) phase_prologue(P, W, lds); break;
        case 1: j0 = 0; j1 = 1; break;
        case 2: j0 = 1; j1 = 4; break;
        case 3: if (PHON(3)) {
#ifdef PROBE_ABL
            if (ph2 & 1) phase_attn<PROBE_ABL>(P, W, lds); else
#endif
            phase_attn<0>(P, W, lds); } break;
        case 4: j0 = 4; j1 = 5; break;
        case 5: if (PHON(5)) phase_rowmid(P, W, lds); break;
        case 6: j0 = 5; j1 = 6; break;
        case 7: if (PHON(7)) phase_conv(P, W); break;
        case 8: j0 = 6; j1 = 8; break;
        case 9: if (PHON(9)) ml::pass1_phase(P, W, lds); break;
        case 10: if (PHON(10)) { ml::pass2(P, W);
#ifndef NO_FIRST_TOKEN
            first_token_qk(P, W, lds);
#endif
            } break;
        case 11: if (PHON(11)) ml::pass3_phase(P, W, lds); break;
#ifdef FUSED_FINAL
        case 12: j0 = 8; j1 = 10; break;
        default: break;
#else
        case 12: j0 = 8; j1 = 9; break;
        default: if (PHON(13)) phase_rowfinal(P, W); break;
#endif
        }
        if (PHON(14) && (ph == 3 || ph == 9) && !(ph2 & 1)) phase_memattn(P, W, lds, ph == 9 ? 1 : 0);
        if (PHON(1)) for (int j = j0; j < j1; ++j) {
            pg8::Gemm g; pg8::Epi E; setup_job(P, j, g, E);
            const int shift = (j == 1) ? 128 : (j == 7) ? 128 : 0;
            pg8::StaticOrder S; S.init(g.M, g.N, W.G, (int)((blockIdx.x + shift) % W.G));
#ifdef FUSED_FINAL
            if (j >= 8) { S.i0 = j - 8; S.nmax = 1; }
#endif
            if (j == 2 && W.G == 256) S.give_lo = 128;
            pg8::gemm_phase<true>(lds, g, S, E, W.tid);
        }
#ifndef NO_FIRST_TOKEN
        if (ph == 6) { const int half = W.G / 2, nwk = W.G - half;
            if ((int)blockIdx.x >= half) for (int widx = (int)blockIdx.x - half; widx < 128; widx += nwk) first_token_u0(P, W, lds, widx); }
#endif
        if (more_) xcd_barrier(bar);
#ifdef PROBE_PAIR
        if (ph == PROBE_PAIR + 1 && !pair_done) { pair_done = true; ph2 = 2 * PROBE_PAIR - 1; }
#endif
    }
}

extern "C" void kernel_launch(void* const* d_in, const int* in_sizes, int n_in, void* d_out, int out_size, void* d_ws, size_t ws_size, hipStream_t stream) {
    static int grid = 0;
    if (grid == 0) {
        if (n_in != 27 || in_sizes[0] != T * DM || out_size != T * DM || ws_size < WS_END) {
            fprintf(stderr, "kernel_launch: unexpected shapes (n_in %d in0 %d out %d ws %zu)\n", n_in, n_in > 0 ? in_sizes[0] : -1, out_size, ws_size); grid = -1; return; }
        int dev = 0, cus = 0, per_cu = 0;
        if (hipGetDevice(&dev) != hipSuccess || hipDeviceGetAttribute(&cus, hipDeviceAttributeMultiprocessorCount, dev) != hipSuccess) { grid = -1; return; }
        if (hipFuncSetAttribute((const void*)mega_fwd, hipFuncAttributeMaxDynamicSharedMemorySize, LDS_BYTES) != hipSuccess) { fprintf(stderr, "kernel_launch: hipFuncSetAttribute failed\n"); grid = -1; return; }
        if (hipOccupancyMaxActiveBlocksPerMultiprocessor(&per_cu, (const void*)mega_fwd, 512, LDS_BYTES) != hipSuccess || per_cu < 1) { fprintf(stderr, "kernel_launch: occupancy query says %d\n", per_cu); }
        (void)hipGetLastError();
        grid = cus;
    }
    if (grid < 0) return;
    (void)hipMemsetAsync((char*)d_ws + WS_CTL, 0, CTL_ZERO_BYTES, stream);
    Params p{};
    const float** fp = (const float**)&p.a_pre_g;
    p.x = (const float*)d_in[0]; p.mem = (const float*)d_in[1]; p.pos = (const int*)d_in[2];
    for (int i = 0; i < 24; ++i) fp[i] = (const float*)d_in[3 + i];
    p.out = (float*)d_out; p.ws = (unsigned char*)d_ws;
#ifndef N_LAUNCH_SPLIT
#define N_LAUNCH_SPLIT 0
#endif
#ifdef DBG_CUT
    for (int ph = 0; ph < DBG_CUT; ++ph) { p.ph_lo = ph; p.ph_hi = ph + 1; hipLaunchKernelGGL(mega_fwd, dim3(grid), dim3(512), LDS_BYTES, stream, p); }
    p.ph_lo = 100; p.ph_hi = 101; hipLaunchKernelGGL(mega_fwd, dim3(grid), dim3(512), LDS_BYTES, stream, p);
#elif N_LAUNCH_SPLIT
    for (int ph = 0; ph < N_PHASES; ++ph) { p.ph_lo = ph; p.ph_hi = ph + 1; hipLaunchKernelGGL(mega_fwd, dim3(grid), dim3(512), LDS_BYTES, stream, p); }
#else
    p.ph_lo = 0; p.ph_hi = N_PHASES; hipLaunchKernelGGL(mega_fwd, dim3(grid), dim3(512), LDS_BYTES, stream, p);
#endif
}
```

```cpp
#include <hip/hip_runtime.h>
#include <cstdio>
#include <cstdint>

#define LAS __attribute__((address_space(3)))
#define GAS __attribute__((address_space(1)))
typedef unsigned short bf16_t;
typedef short bf16x8 __attribute__((ext_vector_type(8)));
typedef short s16x4 __attribute__((ext_vector_type(4)));
typedef float f32x4 __attribute__((ext_vector_type(4)));
typedef float f32x16 __attribute__((ext_vector_type(16)));
typedef unsigned u32x4 __attribute__((ext_vector_type(4)));
typedef unsigned u32x2 __attribute__((ext_vector_type(2)));

constexpr int NB = 8, SEQ = 4096, DM = 1024, T = NB * SEQ;
constexpr int NMEM = 256;
constexpr float EPS = 1e-6f;
constexpr int A_IN = 1984, B_IN = 2824;
constexpr int G1W = 2048;
constexpr int G1_CKV = 0, G1_CQ = 256, G1_KR = 640, G1_QM = 768, G1_GATE = 1024;
constexpr int G2W = 2816;
constexpr int G2_U = 0, G2_O = 768, G2_QM = 1536, G2_GATE = 1792;
constexpr int QW = 1152;
constexpr float LOG2E = 1.4426950408889634f;
constexpr float QSCALE = 0.07216878364870323f * LOG2E;
constexpr float MSCALE = 0.125f * LOG2E;
constexpr float KSCALE_B = 0.10206207261596577f;

constexpr size_t MiB = 1u << 20;
constexpr size_t WS_CTL = 0, CTL_ZERO_BYTES = 512 * 1024;
constexpr size_t WS_WINA = 2 * MiB;
constexpr size_t WS_WUQ = 6 * MiB;
constexpr size_t WS_WUKV = 7 * MiB;
constexpr size_t WS_WMKV = 8 * MiB;
constexpr size_t WS_WOA = 10 * MiB;
constexpr size_t WS_WINB = 12 * MiB;
constexpr size_t WS_WQK = 18 * MiB;
constexpr size_t WS_WV = 19 * MiB;
constexpr size_t WS_WOB = 20 * MiB;
constexpr size_t WS_WG = 22 * MiB;
constexpr size_t WS_RSTD = 23 * MiB;
constexpr size_t WS_SSQA = WS_RSTD + 128 * 1024;
constexpr size_t WS_SSQB = WS_SSQA + 128 * 1024;
constexpr size_t WS_ROPE = 24 * MiB;
constexpr size_t WS_MEMN = 32 * MiB;
constexpr size_t WS_KVM = 36 * MiB;
constexpr size_t WS_IFP = 40 * MiB;
constexpr size_t WS_BL = 41 * MiB;
constexpr size_t WS_MLOC = WS_BL + 8192;
constexpr size_t WS_MST = WS_MLOC + 8192;
constexpr size_t WS_C0 = WS_MST + 8192;
constexpr size_t WS_U0 = WS_C0 + 1024;
constexpr size_t WS_RS = 46 * MiB;
constexpr size_t WS_RN = 45 * MiB + 256 * 1024;
constexpr size_t WS_RBL = 45 * MiB + 512 * 1024;
constexpr size_t WS_X1F = 45 * MiB;
constexpr size_t WS_XSL = 44 * MiB;
constexpr size_t WS_DN = 42 * MiB;
constexpr size_t WS_DC = 56 * MiB;
constexpr size_t WS_XB = 64 * MiB;
constexpr size_t WS_Y = 64 * MiB;
constexpr size_t WS_G = 128 * MiB;
constexpr size_t WS_Q = 304 * MiB;
constexpr size_t WS_KN = 376 * MiB;
constexpr size_t WS_V = 424 * MiB;
constexpr size_t WS_Z = 304 * MiB;
constexpr size_t WS_UC = 304 * MiB;
constexpr size_t WS_QK = 352 * MiB;
constexpr size_t WS_VV = 400 * MiB;
constexpr size_t WS_Y2 = 448 * MiB;
constexpr size_t WS_END = 512 * MiB;

typedef float f32x2_t __attribute__((ext_vector_type(2))); typedef __bf16 bf16x2_t __attribute__((ext_vector_type(2)));
__device__ __forceinline__ unsigned cvt_pk_bf16(float lo, float hi) { f32x2_t v = {lo, hi}; bf16x2_t b = __builtin_convertvector(v, bf16x2_t); return __builtin_bit_cast(unsigned, b); }
__device__ __forceinline__ float bf2f(unsigned short b) { return __uint_as_float((unsigned)b << 16); }
__device__ __forceinline__ float bflo(unsigned w) { return __uint_as_float(w << 16); }
__device__ __forceinline__ float bfhi(unsigned w) { return __uint_as_float(w & 0xffff0000u); }
__device__ __forceinline__ unsigned short f2bf(float f) { return (unsigned short)(cvt_pk_bf16(f, f) & 0xffffu); }
__device__ __forceinline__ float wave_sum(float v) {
#pragma unroll
    for (int o = 1; o < 64; o <<= 1) v += __shfl_xor(v, o);
    return v;
}
__device__ __forceinline__ float wave_max(float v) {
#pragma unroll
    for (int o = 1; o < 64; o <<= 1) v = fmaxf(v, __shfl_xor(v, o));
    return v;
}
__device__ __forceinline__ float silu_f(float g) { return g * __builtin_amdgcn_rcpf(1.f + __expf(-g)); }
__device__ __forceinline__ float sigmoid_f(float g) { return __builtin_amdgcn_rcpf(1.f + __expf(-g)); }
namespace pg8 {
constexpr int BM = 256, BK = 64, HALF = 128, HTB = HALF * BK * 2  , STAGE_BYTES = 8 * HTB, NXCD = 8, WGM = 8;
__host__ __device__ __forceinline__ int lds_byte(int r, int c) { const int st = (r >> 4) * 2 + (c >> 5), rr = r & 15, cc = c & 31, ob = rr * 64 + cc * 2; return st * 1024 + (ob ^ (((ob >> 9) & 1) << 5)); }
__host__ __device__ __forceinline__ void stage_rc(int b, int& R, int& C) { const int st = b / 1024, sb = b % 1024, swz = sb ^ (((sb >> 9) & 1) << 5); R = (st >> 1) * 16 + swz / 64; C = (st & 1) * 32 + (swz % 64) / 2; }
__host__ __device__ __forceinline__ int perm32(int rho) { const int n = rho >> 4, i = rho & 15; return 8 * (i >> 2) + 4 * n + (i & 3); }

struct Unit { int pm, pn; };
struct Gemm { const bf16_t* A; const bf16_t* Bt; int M, N, K, lda, apn; };

struct StaticOrder {
    int nM, nN, nwg, G, c, i0, nmax;
    int give_lo;
    __host__ __device__ void init(int M, int N, int G_, int c_) { nM = M / BM; nN = N / BM; nwg = nM * nN; G = G_; c = c_; i0 = 0; nmax = 1 << 30; give_lo = -1; }
    __host__ __device__ bool next(int i, Unit& u) const {
        if (i >= nmax) return false;
        long L = (long)(i + i0) * G + c;
        if (give_lo >= 0) { if (c >= give_lo && c < give_lo + 32 && i == 1) return false; if (c >= give_lo + 32 && c < give_lo + 64 && i == 2) L = (long)G + (c - 32); }
        if (L >= nwg) return false;
        int wgid = (int)L; { const int q = nwg / NXCD, r = nwg % NXCD, xcd = wgid % NXCD, off = wgid / NXCD; wgid = (xcd < r ? xcd * (q + 1) : r * (q + 1) + (xcd - r) * q) + off; }
        const int nig = WGM * nN, gid = wgid / nig, fm = gid * WGM, gsz = (nM - fm) < WGM ? (nM - fm) : WGM;
        u.pm = fm + ((wgid % nig) % gsz); u.pn = (wgid % nig) / gsz; return true;
    }
};

__device__ __forceinline__ void rope8(float (&v)[8], const float2* rp) {
#pragma unroll
    for (int j = 0; j < 4; ++j) { const float2 cs = rp[j]; const float x1 = v[2 * j], x2 = v[2 * j + 1]; v[2 * j] = x1 * cs.x - x2 * cs.y; v[2 * j + 1] = x1 * cs.y + x2 * cs.x; }
}
struct Epi {
    bf16_t* out; int ldc; int ncols;
    bf16_t* out2; int ldc2; int split;
    const float* rs; int rs_mode; float rs_invdim;
    float* ssqA; float* ssqB; int ssq_mode;
    const float2* rope; int rope_mode;
    int hm_mode;
    int after; const float* fbase; float* fout; const float* fgain; unsigned* xslots; unsigned* xcnt; unsigned* xtmo;
    __device__ __forceinline__ void fused(const f32x4 (&acc)[2][2][4][2], const Unit& u, int wr, int wc, int fr, int fq, LAS unsigned char* lds, int wid, int lane) const {
        LAS float* Pp = (LAS float*)lds;
        LAS float* Sr = (LAS float*)(lds + 4096);
        LAS unsigned* flag = (LAS unsigned*)(lds + 4096 + 1024);
#pragma unroll
        for (int ai = 0; ai < 2; ++ai)
#pragma unroll
            for (int m = 0; m < 4; ++m) { float s = 0.f;
#pragma unroll
                for (int bj = 0; bj < 2; ++bj)
#pragma unroll
                    for (int n = 0; n < 2; ++n) { const f32x4 x = acc[ai][bj][m][n]; s += (x[0] * x[0] + x[1] * x[1]) + (x[2] * x[2] + x[3] * x[3]); }
                s += __shfl_xor(s, 16); s += __shfl_xor(s, 32);
                if (fq == 0) Pp[(ai * HALF + wr * 64 + m * 16 + fr) * 4 + wc] = s; }
        asm volatile("s_waitcnt lgkmcnt(0)" ::: "memory"); __builtin_amdgcn_s_barrier(); asm volatile("" ::: "memory");
        const int row = wid * 32 + (lane & 31);
        if (lane < 32) { const float t = (Pp[row * 4 + 0] + Pp[row * 4 + 1]) + (Pp[row * 4 + 2] + Pp[row * 4 + 3]);
            __hip_atomic_store(xslots + ((size_t)(u.pm * BM + row) * 4 + u.pn), __float_as_uint(t), __ATOMIC_RELAXED, __HIP_MEMORY_SCOPE_AGENT); }
        asm volatile("s_waitcnt vmcnt(0)" ::: "memory");
        if (lane == 0) __hip_atomic_fetch_add(xcnt + 64 * u.pm, 1u, __ATOMIC_RELAXED, __HIP_MEMORY_SCOPE_AGENT);
        if (wid == 0) { bool dead = false; const unsigned long long t0 = __builtin_amdgcn_s_memrealtime();
            for (;;) {
                if ((unsigned)__builtin_amdgcn_readfirstlane(__hip_atomic_load(xcnt + 64 * u.pm, __ATOMIC_RELAXED, __HIP_MEMORY_SCOPE_AGENT)) >= 32u) break;
                if (__builtin_amdgcn_s_memrealtime() - t0 > 2000000ull) { if (lane == 0) __hip_atomic_store(xtmo, 1u, __ATOMIC_RELAXED, __HIP_MEMORY_SCOPE_AGENT); dead = true; break; }
                __builtin_amdgcn_s_sleep(2); }
            __builtin_amdgcn_fence(__ATOMIC_ACQUIRE, "agent");
            if (lane == 0) flag[0] = dead ? 1u : 0u; }
        asm volatile("s_waitcnt vmcnt(0) lgkmcnt(0)" ::: "memory"); __builtin_amdgcn_s_barrier(); asm volatile("" ::: "memory");
        const bool bad = flag[0] != 0u;
        if (lane < 32) { const unsigned* sl = xslots + (size_t)(u.pm * BM + row) * 4; float q = 0.f;
#pragma unroll
            for (int t = 0; t < 4; ++t) q += __uint_as_float(__hip_atomic_load(sl + t, __ATOMIC_RELAXED, __HIP_MEMORY_SCOPE_AGENT));
            Sr[row] = rsqrtf(q * (1.f / 1024.f) + EPS); }
        asm volatile("s_waitcnt vmcnt(0) lgkmcnt(0)" ::: "memory"); __builtin_amdgcn_s_barrier(); asm volatile("" ::: "memory");
        const float qnan = __builtin_nanf("");
#pragma unroll
        for (int ai = 0; ai < 2; ++ai)
#pragma unroll
            for (int m = 0; m < 4; ++m) { const int r = ai * HALF + wr * 64 + m * 16 + fr; const float rs_ = bad ? qnan : Sr[r];
#pragma unroll
                for (int bj = 0; bj < 2; ++bj) { const int col0 = u.pn * BM + bj * HALF + wc * 32 + 8 * fq; const size_t off = (size_t)(u.pm * BM + r) * 1024 + col0;
                    *(f32x4*)(fout + off) = *(const f32x4*)(fbase + off) + acc[ai][bj][m][0] * rs_ * *(const f32x4*)(fgain + col0);
                    *(f32x4*)(fout + off + 4) = *(const f32x4*)(fbase + off + 4) + acc[ai][bj][m][1] * rs_ * *(const f32x4*)(fgain + col0 + 4); } }
        asm volatile("s_waitcnt lgkmcnt(0)" ::: "memory"); __builtin_amdgcn_s_barrier(); asm volatile("" ::: "memory");
    }
    __device__ __forceinline__ void operator()(const f32x4 (&acc)[2][2][4][2], const Unit& u, int wr, int wc, int fr, int fq) const {
#pragma unroll
        for (int ai = 0; ai < 2; ++ai)
#pragma unroll
            for (int m = 0; m < 4; ++m) {
                const int row = u.pm * BM + ai * HALF + wr * 64 + m * 16 + fr;
                float sc = 1.f;
                if (rs_mode == 1) sc = rs[row]; else if (rs_mode == 2) sc = rsqrtf(rs[row] * rs_invdim + EPS);
                float ss = 0.f;
#pragma unroll
                for (int bj = 0; bj < 2; ++bj) {
                    const int col0 = u.pn * BM + bj * HALF + wc * 32 + 8 * fq;
                    float v[8];
#pragma unroll
                    for (int j = 0; j < 4; ++j) { v[j] = acc[ai][bj][m][0][j] * sc; v[4 + j] = acc[ai][bj][m][1][j] * sc; }
                    if (ssq_mode == 1 && (u.pn < 2 || (u.pn == 2 && bj == 0))) {
#pragma unroll
                        for (int j = 0; j < 8; ++j) ss += v[j] * v[j];
                    }
                    if (rope_mode == 1) { if (col0 >= 640 && col0 < 704) rope8(v, rope + (size_t)row * 32 + ((col0 - 640) >> 1)); }
                    else if (rope_mode == 2) { const int d = col0 % 192; if (d >= 128) rope8(v, rope + (size_t)row * 32 + ((d - 128) >> 1)); }
                    if (col0 < ncols) {
                        u32x4 w; w.x = cvt_pk_bf16(v[0], v[1]); w.y = cvt_pk_bf16(v[2], v[3]); w.z = cvt_pk_bf16(v[4], v[5]); w.w = cvt_pk_bf16(v[6], v[7]);
                        if (hm_mode) { const int hh = col0 / 192, jj = col0 - hh * 192; *(u32x4*)(out + ((size_t)((row >> 12) * 4 + hh) * SEQ + (row & (SEQ - 1))) * 192 + jj) = w; }
                        else if (col0 < split) *(u32x4*)(out + (size_t)row * ldc + col0) = w;
                        else *(u32x4*)(out2 + (size_t)row * ldc2 + (col0 - split)) = w;
                    }
                }
                if (ssq_mode == 1 && u.pn <= 2) {
                    ss += __shfl_xor(ss, 16); ss += __shfl_xor(ss, 32);
                    if (fq == 0) atomicAdd((u.pn == 0 ? ssqB : ssqA) + row, ss);
                }
            }
    }
};

template <bool ALIGN_EPI>
__device__ __forceinline__ void gemm_phase(LAS unsigned char* lds, const Gemm g, const StaticOrder& S, const Epi& E, const int tid) {
    const int wid = __builtin_amdgcn_readfirstlane(tid >> 6), lane = tid & 63, wr = wid >> 2, wc = wid & 3, fr = lane & 15, fq = lane >> 4;
    const int K = g.K, nt = K / BK, lda = g.lda;
    unsigned voffA[2], voffB[2];
#pragma unroll
    for (int i = 0; i < 2; ++i) { int R, C; stage_rc(tid * 16 + i * 8192, R, C); const int Rb = (R & ~31) + perm32(R & 31);
        voffA[i] = (unsigned)(R * lda + C) * 2u; voffB[i] = (unsigned)(Rb * K + C) * 2u; }
    const size_t kstep = (size_t)(BK * 2);
    const size_t hstepA = (size_t)HALF * lda * 2, hstepB = (size_t)HALF * K * 2;
    const size_t tstepA = 2 * hstepA, tstepB = 2 * hstepB;
    const unsigned ldsw = (unsigned)wid * 1024u;
    const int aoff = lds_byte(wr * 64 + fr, fq * 8), boff = lds_byte(wc * 32 + fr, fq * 8);
#define PG8_SA(b, h) (((b) * 2 + (h)) * HTB)
#define PG8_SB(b, h) ((4 + (b) * 2 + (h)) * HTB)
#define PG8_STAGE(bufoff, gbase, voff) do { _Pragma("unroll") for (int _i = 0; _i < 2; ++_i) \
        __builtin_amdgcn_global_load_lds((const unsigned*)((const char*)(gbase) + (voff)[_i]), (LAS unsigned*)(lds + (bufoff) + ldsw + _i * 8192), 16, 0, 0); } while (0)
#define PG8_LDA(dst, b, h) do { _Pragma("unroll") for (int m = 0; m < 4; ++m) _Pragma("unroll") for (int k = 0; k < 2; ++k) dst[m][k] = *(const LAS bf16x8*)(lds + PG8_SA(b, h) + aoff + m * 2048 + k * 1024); } while (0)
#define PG8_LDB(dst, b, h) do { _Pragma("unroll") for (int n = 0; n < 2; ++n) _Pragma("unroll") for (int k = 0; k < 2; ++k) dst[n][k] = *(const LAS bf16x8*)(lds + PG8_SB(b, h) + boff + n * 2048 + k * 1024); } while (0)
#define PG8_MMA(ai, bj, At, Bt) do { __builtin_amdgcn_s_setprio(1); _Pragma("unroll") for (int m = 0; m < 4; ++m) _Pragma("unroll") for (int n = 0; n < 2; ++n) _Pragma("unroll") for (int k = 0; k < 2; ++k) \
        acc[ai][bj][m][n] = __builtin_amdgcn_mfma_f32_16x16x32_bf16(Bt[n][k], At[m][k], acc[ai][bj][m][n], 0, 0, 0); __builtin_amdgcn_s_setprio(0); } while (0)
#define PG8_WAIT_V(n) asm volatile("s_waitcnt vmcnt(" #n ")" ::: "memory")
#define PG8_WAIT_L(n) asm volatile("s_waitcnt lgkmcnt(" #n ")" ::: "memory")
#define PG8_BAR __builtin_amdgcn_s_barrier()
#define PG8_SCHED __builtin_amdgcn_sched_barrier(0)
    Unit cur, nxt; int ui = 0;
    if (!S.next(0, cur)) return;
    f32x4 acc[2][2][4][2];
#pragma unroll
    for (int a = 0; a < 2; ++a)
#pragma unroll
        for (int b = 0; b < 2; ++b)
#pragma unroll
            for (int m = 0; m < 4; ++m)
#pragma unroll
                for (int n = 0; n < 2; ++n) acc[a][b][m][n] = (f32x4){0.f, 0.f, 0.f, 0.f};
    bf16x8 At[4][2], B0[2][2], B1[2][2];
    const char* cA = (const char*)g.A + (size_t)cur.pm * tstepA + (size_t)cur.pn * g.apn * 2; const char* cB = (const char*)g.Bt + (size_t)cur.pn * tstepB;
    PG8_STAGE(PG8_SB(0, 0), cB, voffB); PG8_STAGE(PG8_SB(0, 1), cB + hstepB, voffB); PG8_STAGE(PG8_SA(0, 0), cA, voffA); PG8_STAGE(PG8_SA(0, 1), cA + hstepA, voffA);
    if (wr == 1) PG8_BAR;
    PG8_WAIT_V(2); PG8_BAR;
    PG8_STAGE(PG8_SB(1, 0), cB + kstep, voffB); PG8_STAGE(PG8_SA(1, 0), cA + kstep, voffA); PG8_STAGE(PG8_SB(1, 1), cB + hstepB + kstep, voffB);
    PG8_WAIT_V(6); PG8_BAR;
    for (;;) {
        const bool has_next = S.next(ui + 1, nxt);
        const char* nA = has_next ? (const char*)g.A + (size_t)nxt.pm * tstepA + (size_t)nxt.pn * g.apn * 2 : cA; const char* nB = has_next ? (const char*)g.Bt + (size_t)nxt.pn * tstepB : cB;
        for (int t = 0; t < nt; t += 2) {
            const bool last = (t == nt - 2);
            const char* a1 = cA + (size_t)(t + 1) * kstep;
            const char* a2 = last ? nA : cA + (size_t)(t + 2) * kstep; const char* b2 = last ? nB : cB + (size_t)(t + 2) * kstep;
            const char* a3 = a2 + kstep; const char* b3 = b2 + kstep;
            PG8_LDB(B0, 0, 0); PG8_LDB(B1, 0, 1); PG8_SCHED; PG8_LDA(At, 0, 0); PG8_STAGE(PG8_SA(1, 1), a1 + hstepA, voffA);
            PG8_WAIT_V(8); PG8_WAIT_L(0); PG8_BAR; PG8_MMA(0, 0, At, B0); PG8_MMA(0, 1, At, B1); PG8_BAR; PG8_SCHED;
            PG8_LDA(At, 0, 1); PG8_STAGE(PG8_SB(0, 0), b2, voffB); PG8_STAGE(PG8_SB(0, 1), b2 + hstepB, voffB); PG8_STAGE(PG8_SA(0, 0), a2, voffA);
            PG8_WAIT_V(8); PG8_WAIT_L(0); PG8_BAR; PG8_MMA(1, 0, At, B0); PG8_MMA(1, 1, At, B1); PG8_BAR; PG8_SCHED;
            PG8_LDB(B0, 1, 0); PG8_LDB(B1, 1, 1); PG8_SCHED; PG8_LDA(At, 1, 0); PG8_STAGE(PG8_SA(0, 1), a2 + hstepA, voffA);
            PG8_WAIT_V(8); PG8_WAIT_L(0); PG8_BAR; PG8_MMA(0, 0, At, B0); PG8_MMA(0, 1, At, B1); PG8_BAR; PG8_SCHED;
            PG8_LDA(At, 1, 1); PG8_STAGE(PG8_SB(1, 0), b3, voffB); PG8_STAGE(PG8_SB(1, 1), b3 + hstepB, voffB); PG8_STAGE(PG8_SA(1, 0), a3, voffA);
            PG8_WAIT_V(8); PG8_WAIT_L(0); PG8_BAR; PG8_MMA(1, 0, At, B0); PG8_MMA(1, 1, At, B1); PG8_BAR; PG8_SCHED;
        }
        if constexpr (ALIGN_EPI) { if (wr == 0) PG8_BAR; }
#ifdef FUSED_FINAL
        if (!E.after) E(acc, cur, wr, wc, fr, fq);
#else
        E(acc, cur, wr, wc, fr, fq);
#endif
        if (!has_next) break;
#pragma unroll
        for (int a = 0; a < 2; ++a)
#pragma unroll
            for (int b = 0; b < 2; ++b)
#pragma unroll
                for (int m = 0; m < 4; ++m)
#pragma unroll
                    for (int n = 0; n < 2; ++n) acc[a][b][m][n] = (f32x4){0.f, 0.f, 0.f, 0.f};
        cur = nxt; cA = nA; cB = nB; ++ui;
        if constexpr (ALIGN_EPI) { if (wr == 1) PG8_BAR; }
    }
    PG8_WAIT_V(0);
    if constexpr (!ALIGN_EPI) { if (wr == 0) PG8_BAR; }
    PG8_BAR;
#ifdef FUSED_FINAL
    if (E.after) E.fused(acc, cur, wr, wc, fr, fq, lds, wid, lane);
#endif
#undef PG8_SA
#undef PG8_SB
#undef PG8_STAGE
#undef PG8_LDA
#undef PG8_LDB
#undef PG8_MMA
#undef PG8_WAIT_V
#undef PG8_WAIT_L
#undef PG8_BAR
#undef PG8_SCHED
}
}
namespace att {
#define SBAR() __builtin_amdgcn_sched_barrier(0)
__device__ __forceinline__ int crow(int r, int hi) { return (r & 3) + 8 * (r >> 2) + 4 * hi; }
template <int DQK> __device__ __forceinline__ int kaddr(int row, int c) { return row * (DQK * 2) + ((c ^ ((row >> 1) & 7)) << 4); }
template <int NCB> __device__ __forceinline__ int v_st(int k, int c) { const int kk = (k & ~0xC) | ((k & 4) << 1) | ((k & 8) >> 1); return ((kk >> 3) * NCB + (c >> 5)) * 512 + ((kk & 7) * 32 + (c & 31)) * 2; }
__device__ __forceinline__ int v_rd_base(int lane) { return ((lane & 3) << 3) | (((lane >> 2) & 3) << 6) | (((lane >> 4) & 1) << 5) | (((lane >> 5) & 1) << 8); }

__device__ __forceinline__ void mask_tile(f32x16& p0, f32x16& p1, int dq) {
    const float NEG = -__builtin_inff();
#pragma unroll
    for (int r = 0; r < 16; ++r) {
        const int c = (r & 3) + 8 * (r >> 2);
        if (dq - c < 0) p0[r] = NEG;
        if (dq - c - 32 < 0) p1[r] = NEG;
    }
}
constexpr float DEFER_THR = 8.f;
template <bool FIRST>
__device__ __forceinline__ void partialSM(f32x16& p0, f32x16& p1, float& m_reg, float& alpha) {
    float pmax = p0[0];
#pragma unroll
    for (int r = 1; r < 16; ++r) pmax = fmaxf(pmax, p0[r]);
#pragma unroll
    for (int r = 0; r < 16; ++r) pmax = fmaxf(pmax, p1[r]);
    { auto rr = __builtin_amdgcn_permlane32_swap(__float_as_uint(pmax), __float_as_uint(pmax), false, false);
      pmax = fmaxf(__uint_as_float(rr[0]), __uint_as_float(rr[1])); }
    alpha = 1.f;
    if (FIRST || !__all(pmax <= DEFER_THR)) {
        const float dl = FIRST ? pmax : fmaxf(pmax, 0.f);
        m_reg += dl; alpha = __builtin_amdgcn_exp2f(-dl);
#pragma unroll
        for (int r = 0; r < 16; ++r) { p0[r] -= dl; p1[r] -= dl; }
    }
#pragma unroll
    for (int r = 0; r < 16; ++r) p0[r] = __builtin_amdgcn_exp2f(p0[r]);
}
__device__ __forceinline__ void finishSM(f32x16& p0, f32x16& p1, float alpha, float& l_reg, bf16x8& pa0, bf16x8& pa1, bf16x8& pa2, bf16x8& pa3) {
#pragma unroll
    for (int r = 0; r < 16; ++r) p1[r] = __builtin_amdgcn_exp2f(p1[r]);
    float ps = 0.f;
#pragma unroll
    for (int r = 0; r < 16; ++r) ps += p0[r];
#pragma unroll
    for (int r = 0; r < 16; ++r) ps += p1[r];
    { auto rr = __builtin_amdgcn_permlane32_swap(__float_as_uint(ps), __float_as_uint(ps), false, false);
      ps = __uint_as_float(rr[0]) + __uint_as_float(rr[1]); }
    l_reg = l_reg * alpha + ps;
#define PK4(P, B_, OUT) do { unsigned a0 = cvt_pk_bf16(P[B_+0], P[B_+1]), a1 = cvt_pk_bf16(P[B_+2], P[B_+3]);                          \
        unsigned b0 = cvt_pk_bf16(P[B_+4], P[B_+5]), b1 = cvt_pk_bf16(P[B_+6], P[B_+7]);                                             \
        auto r0 = __builtin_amdgcn_permlane32_swap(a0, b0, false, false); auto r1 = __builtin_amdgcn_permlane32_swap(a1, b1, false, false); \
        u32x4 w = {r0[0], r1[0], r0[1], r1[1]}; OUT = *reinterpret_cast<bf16x8*>(&w); } while (0)
    PK4(p0, 0, pa0); PK4(p0, 8, pa1); PK4(p1, 0, pa2); PK4(p1, 8, pa3);
#undef PK4
}
template <int DQK, bool NOLDS = false>
__device__ __forceinline__ void qkt(f32x16& p0, f32x16& p1, const LAS unsigned char* Kb, int r32, int hi, const bf16x8* qr, const float negm) {
    constexpr int NKS = DQK / 16, ROWB = DQK * 2;
#pragma unroll
    for (int r = 0; r < 16; ++r) { p0[r] = negm; p1[r] = negm; }
    if (NOLDS) {
#pragma unroll
        for (int d0 = 0; d0 < NKS; ++d0) { p0 = __builtin_amdgcn_mfma_f32_32x32x16_bf16(qr[(d0 + 1) % NKS], qr[d0], p0, 0, 0, 0); p1 = __builtin_amdgcn_mfma_f32_32x32x16_bf16(qr[(d0 + 2) % NKS], qr[d0], p1, 0, 0, 0); }
        return; }
    const int f = (r32 >> 1) & 7;
    const LAS unsigned char* kb[4];
#pragma unroll
    for (int dd = 0; dd < 4; ++dd) kb[dd] = Kb + r32 * ROWB + ((((2 * dd + hi) ^ f)) << 4);
#pragma unroll
    for (int d0 = 0; d0 < NKS; ++d0) { const LAS unsigned char* a_ = kb[d0 & 3] + (d0 >> 2) * 128;
        const bf16x8 b0 = *reinterpret_cast<const LAS bf16x8*>(a_);
        const bf16x8 b1 = *reinterpret_cast<const LAS bf16x8*>(a_ + 32 * ROWB);
        p0 = __builtin_amdgcn_mfma_f32_32x32x16_bf16(b0, qr[d0], p0, 0, 0, 0);
        p1 = __builtin_amdgcn_mfma_f32_32x32x16_bf16(b1, qr[d0], p1, 0, 0, 0); }
}
template <int DQK> __device__ __forceinline__ void qkt_sched() {
    constexpr int NKS = DQK / 16;
    __builtin_amdgcn_sched_group_barrier(0x100, 4, 0);
#pragma unroll
    for (int d0 = 0; d0 < NKS; ++d0) {
        __builtin_amdgcn_sched_group_barrier(0x008, 2, 0);
        __builtin_amdgcn_sched_group_barrier(0x002, 120 / NKS, 0);
        if (d0 + 2 < NKS) __builtin_amdgcn_sched_group_barrier(0x100, 2, 0);
    }
}
template <int DV>
__device__ __forceinline__ void pv_tile(f32x16* o, int vb0, bf16x8 pa0, bf16x8 pa1, bf16x8 pa2, bf16x8 pa3) {
    constexpr int NCB = DV / 32, KS = 2 * NCB * 512, HF = NCB * 512;
#define TRRD(dst, off) asm volatile("ds_read_b64_tr_b16 %0, %1 offset:%2" : "=&v"(dst) : "v"(vb0), "i"(off) : "memory")
#pragma unroll
    for (int d0 = 0; d0 < NCB; ++d0) {
        s16x4 l0, l1, l2, l3, h0, h1, h2, h3;
        if (d0 == 0) { TRRD(l0, 0 * 512); TRRD(h0, 0 * 512 + HF); TRRD(l1, 0 * 512 + KS); TRRD(h1, 0 * 512 + KS + HF); TRRD(l2, 0 * 512 + 2 * KS); TRRD(h2, 0 * 512 + 2 * KS + HF); TRRD(l3, 0 * 512 + 3 * KS); TRRD(h3, 0 * 512 + 3 * KS + HF); }
        else if (d0 == 1) { TRRD(l0, 1 * 512); TRRD(h0, 1 * 512 + HF); TRRD(l1, 1 * 512 + KS); TRRD(h1, 1 * 512 + KS + HF); TRRD(l2, 1 * 512 + 2 * KS); TRRD(h2, 1 * 512 + 2 * KS + HF); TRRD(l3, 1 * 512 + 3 * KS); TRRD(h3, 1 * 512 + 3 * KS + HF); }
        else if (d0 == 2) { TRRD(l0, 2 * 512); TRRD(h0, 2 * 512 + HF); TRRD(l1, 2 * 512 + KS); TRRD(h1, 2 * 512 + KS + HF); TRRD(l2, 2 * 512 + 2 * KS); TRRD(h2, 2 * 512 + 2 * KS + HF); TRRD(l3, 2 * 512 + 3 * KS); TRRD(h3, 2 * 512 + 3 * KS + HF); }
        else { TRRD(l0, 3 * 512); TRRD(h0, 3 * 512 + HF); TRRD(l1, 3 * 512 + KS); TRRD(h1, 3 * 512 + KS + HF); TRRD(l2, 3 * 512 + 2 * KS); TRRD(h2, 3 * 512 + 2 * KS + HF); TRRD(l3, 3 * 512 + 3 * KS); TRRD(h3, 3 * 512 + 3 * KS + HF); }
        asm volatile("s_waitcnt lgkmcnt(0)" ::: "memory"); SBAR();
        o[d0] = __builtin_amdgcn_mfma_f32_32x32x16_bf16(pa0, (bf16x8){l0[0], l0[1], l0[2], l0[3], h0[0], h0[1], h0[2], h0[3]}, o[d0], 0, 0, 0);
        o[d0] = __builtin_amdgcn_mfma_f32_32x32x16_bf16(pa1, (bf16x8){l1[0], l1[1], l1[2], l1[3], h1[0], h1[1], h1[2], h1[3]}, o[d0], 0, 0, 0);
        o[d0] = __builtin_amdgcn_mfma_f32_32x32x16_bf16(pa2, (bf16x8){l2[0], l2[1], l2[2], l2[3], h2[0], h2[1], h2[2], h2[3]}, o[d0], 0, 0, 0);
        o[d0] = __builtin_amdgcn_mfma_f32_32x32x16_bf16(pa3, (bf16x8){l3[0], l3[1], l3[2], l3[3], h3[0], h3[1], h3[2], h3[3]}, o[d0], 0, 0, 0);
    }
#undef TRRD
}

template <int DQK, int DV, bool CAUSAL, int ABL = 0>
__device__ __forceinline__ void attn_unit(const bf16_t* Qb, int qp, const bf16_t* Km, int kp, int c1, const bf16_t* Ke, int kep, const bf16_t* Vb, int vp,
                                          int NT, int q0, const bf16_t* gate, int gp, bf16_t* Y, int yp, LAS unsigned char* lds, const int tid) {
    constexpr int SHM_V = 64 * DV * 2, SHM_K = 64 * DQK * 2, NCK = DQK / 8, NKS = DQK / 16, NCB = DV / 32;
    constexpr int KPT = SHM_K / 8192, VPT = SHM_V / 8192;
    const int wid = __builtin_amdgcn_readfirstlane(tid >> 6), lane = tid & 63, r32 = lane & 31, hi = lane >> 5;
    LAS unsigned char* V_lds = lds; LAS unsigned char* K_lds = lds + 3 * SHM_V; LAS float* ws = (LAS float*)(lds + 3 * SHM_V + 3 * SHM_K) + wid * 64;
    bf16x8 qr[NKS];
#pragma unroll
    for (int d0 = 0; d0 < NKS; ++d0) qr[d0] = *reinterpret_cast<const bf16x8*>(Qb + (size_t)(wid * 32 + r32) * qp + d0 * 16 + hi * 8);
    const char* kbase = (const char*)(Km < Ke ? Km : Ke);
    unsigned koff[KPT]; unsigned kstr[KPT];
#pragma unroll
    for (int i = 0; i < KPT; ++i) { const int p = (wid + 8 * i) * 64 + lane, row = p / NCK, cpos = p % NCK, c = cpos ^ ((row >> 1) & 7);
        if (c < c1) { koff[i] = (unsigned)((const char*)(Km + (size_t)row * kp + c * 8) - kbase); kstr[i] = (unsigned)kp * 128u; }
        else { koff[i] = (unsigned)((const char*)(Ke + (size_t)row * kep + (c - c1) * 8) - kbase); kstr[i] = (unsigned)kep * 128u; } }
    unsigned voff[VPT];
#pragma unroll
    for (int i = 0; i < VPT; ++i) { const int st = 2 * (wid + 8 * i) + (lane >> 5), kk = (st / NCB) * 8 + ((lane & 31) >> 2), k = (kk & ~0xC) | ((kk & 4) << 1) | ((kk & 8) >> 1), col = (st % NCB) * 32 + (lane & 3) * 8;
        voff[i] = (unsigned)(k * vp + col) * 2u; }
    const char* vbase = (const char*)Vb;
    float m_reg = 0.f, l_reg = 0.f; f32x16 o[NCB];
#pragma unroll
    for (int d = 0; d < NCB; ++d) o[d] = f32x16{};
    const int vb0 = (int)(size_t)V_lds + v_rd_base(lane);
    const int qlo = q0 + wid * 32;
#define DMA_K(sl) do { _Pragma("unroll") for (int i = 0; i < KPT; ++i) { __builtin_amdgcn_global_load_lds((const unsigned*)(kbase + koff[i]), (LAS unsigned*)(K_lds + (sl) * SHM_K + (wid + 8 * i) * 1024), 16, 0, 0); koff[i] += kstr[i]; } } while (0)
#define DMA_V(sl) do { _Pragma("unroll") for (int i = 0; i < VPT; ++i) { __builtin_amdgcn_global_load_lds((const unsigned*)(vbase + voff[i]), (LAS unsigned*)(V_lds + (sl) * SHM_V + (wid + 8 * i) * 1024), 16, 0, 0); } vbase += (size_t)vp * 128; } while (0)
#define WAIT_BAR(N) do { asm volatile("s_waitcnt vmcnt(%0) lgkmcnt(0)\n\ts_barrier" :: "i"(N) : "memory"); } while (0)
#define MASKT(P0_, P1_, t) do { if (CAUSAL) { const int kb_ = (t) * 64; if (kb_ + 63 > qlo) mask_tile(P0_, P1_, qlo + r32 - 4 * hi - kb_); } } while (0)
#define RESC(a) do { if (__any((a) < 1.f)) { if (hi == 0) ws[r32] = (a); asm volatile("s_waitcnt lgkmcnt(0)" ::: "memory"); \
        _Pragma("unroll") for (int d_ = 0; d_ < NCB; ++d_) _Pragma("unroll") for (int r = 0; r < 16; ++r) o[d_][r] *= ws[crow(r, hi)]; } } while (0)
    f32x16 pA0, pA1, pB0, pB1; float alA = 1.f, alB = 1.f; bf16x8 pa0, pa1, pa2, pa3;
    DMA_K(0); DMA_K(1); DMA_V(0);
    WAIT_BAR(KPT + VPT);
    DMA_K(2); DMA_V(1);
    qkt<DQK>(pA0, pA1, K_lds, r32, hi, qr, 0.f);
    MASKT(pA0, pA1, 0); partialSM<true>(pA0, pA1, m_reg, alA); alA = 1.f;
    WAIT_BAR(KPT + VPT);
    int ks = 1, vs = 0, ns = 2;
#define ROT() do { vs = ks; ks = ns; ns = (ns == 2) ? 0 : ns + 1; } while (0)
#define STEP(PX0, PX1, alX, PY0, PY1, alY, t, NW) do { \
        if (!(ABL & 1)) { if ((t) + 2 < NT) DMA_K(vs); if ((t) + 1 < NT) DMA_V(ns); } \
        SBAR(); if (!(ABL & 8)) qkt<DQK, (ABL & 32) != 0>(PX0, PX1, K_lds + ks * SHM_K, r32, hi, qr, -m_reg); else { asm volatile("" : "+v"(PX0), "+v"(PX1)); } \
        if (!(ABL & 2)) finishSM(PY0, PY1, alY, l_reg, pa0, pa1, pa2, pa3); else { asm volatile("" : "+v"(PY0), "+v"(PY1), "+v"(pa0), "+v"(pa1), "+v"(pa2), "+v"(pa3)); } SBAR(); \
        if (!(ABL & 4)) pv_tile<DV>(o, vb0 + vs * SHM_V, pa0, pa1, pa2, pa3); \
        if (!(ABL & 2)) { MASKT(PX0, PX1, t); partialSM<false>(PX0, PX1, m_reg, alX); } \
        if (ABL & 1) WAIT_BAR(0); else WAIT_BAR(NW); \
        RESC(alX); ROT(); } while (0)
    int t = 1;
    for (; t + 3 < NT; t += 2) {
        STEP(pB0, pB1, alB, pA0, pA1, alA, t, KPT + VPT);
        STEP(pA0, pA1, alA, pB0, pB1, alB, t + 1, KPT + VPT);
    }
    STEP(pB0, pB1, alB, pA0, pA1, alA, t, KPT + VPT);
    STEP(pA0, pA1, alA, pB0, pB1, alB, t + 1, VPT);
    STEP(pB0, pB1, alB, pA0, pA1, alA, t + 2, 0);
    finishSM(pB0, pB1, alB, l_reg, pa0, pa1, pa2, pa3); SBAR(); pv_tile<DV>(o, vb0 + vs * SHM_V, pa0, pa1, pa2, pa3);
#undef STEP
#undef ROT
#undef RESC
#undef MASKT
#undef WAIT_BAR
#undef DMA_K
#undef DMA_V
    if (hi == 0) ws[32 + r32] = l_reg;
    asm volatile("s_waitcnt lgkmcnt(0)" ::: "memory");
    constexpr int SPITCH = DV * 2 + 16;
    LAS unsigned char* stg = ((DQK == 192) ? K_lds : (lds + 3 * SHM_V + 3 * SHM_K + 2048)) + wid * (32 * SPITCH);
#pragma unroll
    for (int r = 0; r < 16; ++r) {
        const float rl = __builtin_amdgcn_rcpf(ws[32 + crow(r, hi)]);
#pragma unroll
        for (int d0 = 0; d0 < NCB; ++d0) *(LAS unsigned short*)(stg + crow(r, hi) * SPITCH + (d0 * 32 + r32) * 2) = f2bf(o[d0][r] * rl);
    }
    asm volatile("s_waitcnt lgkmcnt(0)" ::: "memory");
    constexpr int CPR = DV / 8, RPP = 64 / CPR;
#pragma unroll
    for (int i = 0; i < 32 / RPP; ++i) {
        const int row = i * RPP + lane / CPR, ch = lane % CPR, orow = wid * 32 + row;
        const u32x4 ov = *(const LAS u32x4*)(stg + row * SPITCH + ch * 16);
        const u32x4 gv = *(const u32x4*)(gate + (size_t)orow * gp + ch * 8);
        u32x4 w;
        w.x = cvt_pk_bf16(bflo(ov.x) * silu_f(bflo(gv.x)), bfhi(ov.x) * silu_f(bfhi(gv.x))); w.y = cvt_pk_bf16(bflo(ov.y) * silu_f(bflo(gv.y)), bfhi(ov.y) * silu_f(bfhi(gv.y)));
        w.z = cvt_pk_bf16(bflo(ov.z) * silu_f(bflo(gv.z)), bfhi(ov.z) * silu_f(bfhi(gv.z))); w.w = cvt_pk_bf16(bflo(ov.w) * silu_f(bflo(gv.w)), bfhi(ov.w) * silu_f(bfhi(gv.w)));
        *(u32x4*)(Y + (size_t)orow * yp + ch * 8) = w;
    }
    __syncthreads();
}
#undef SBAR
}
struct Params {
    const float* x; const float* mem; const int* pos;
    const float *a_pre_g, *a_w_in, *a_q_a_g, *a_w_uq, *a_kv_a_g, *a_w_ukv, *a_mem_g, *a_w_mem_kv, *a_w_out, *a_post_g;
    const float *b_pre_g, *b_w_in, *b_gate_bias, *b_conv_w, *b_conv_b, *b_w_q, *b_w_k, *b_w_v, *b_head_g, *b_skip, *b_mem_g, *b_w_mem_kv, *b_w_out, *b_post_g;
    float* out; unsigned char* ws; int ph_lo, ph_hi;
};
struct Wk { int tid, lane, wave, vcu, G; };
#define LDS_WAIT() asm volatile("s_waitcnt lgkmcnt(0)" ::: "memory")

__device__ __forceinline__ float wsrc(const Params& P, int mat, int k, int n) {
    switch (mat) {
    case 0: { int col; float s = 1.f;
        if (n < 256) col = 384 + n; else if (n < 512) col = n - 256; else if (n < 640) col = 256 + (n - 512);
        else if (n < 704) { const int p_ = n - 640, i = p_ >> 1; col = 640 + ((p_ & 1) ? 32 + i : i); }
        else if (n < 768) return 0.f; else if (n < 1024) { col = 704 + (n - 768); s = MSCALE; } else col = 960 + (n - 1024);
        return P.a_w_in[(size_t)k * A_IN + col] * P.a_pre_g[k] * s; }
    case 1: { if (n >= 1152) return 0.f; const int h = n / 192, d = n % 192; int col;
        if (d < 128) col = h * 192 + d; else { const int p_ = d - 128, i = p_ >> 1; col = h * 192 + 128 + ((p_ & 1) ? 32 + i : i); }
        return P.a_w_uq[(size_t)k * 1152 + col] * P.a_q_a_g[k] * QSCALE; }
    case 2: { int col; if (n < 768) col = (n / 128) * 256 + (n % 128); else { const int n2 = n - 768; col = (n2 / 128) * 256 + 128 + (n2 % 128); }
        return P.a_w_ukv[(size_t)k * 1536 + col] * P.a_kv_a_g[k]; }
    case 3: { if (n < 512) return P.a_w_mem_kv[(size_t)k * 512 + n] * P.a_mem_g[k]; return P.b_w_mem_kv[(size_t)k * 512 + (n - 512)] * P.b_mem_g[k]; }
    case 4: return P.a_w_out[(size_t)k * 1024 + n];
    case 5: { int col; float s = 1.f; if (n < 768) col = n; else if (n < 1536) col = 776 + (n - 768); else if (n < 1792) { col = 1544 + (n - 1536); s = MSCALE; } else col = 1800 + (n - 1792);
        return P.b_w_in[(size_t)k * B_IN + col] * P.b_pre_g[k] * s; }
    case 6: { const int h = n / 192, j = n % 192, pn = n / 256, kabs = k + 192 * pn - 192 * h; if (kabs < 0 || kabs >= 192) return 0.f;
        if (j < 96) return P.b_w_q[((size_t)h * 192 + kabs) * 96 + j]; return P.b_w_k[((size_t)h * 192 + kabs) * 96 + (j - 96)] * KSCALE_B; }
    case 7: { const int h = n / 192, j = n % 192, pn = n / 256, kabs = k + 192 * pn - 192 * h; if (kabs < 0 || kabs >= 192) return 0.f;
        return P.b_w_v[((size_t)h * 192 + kabs) * 192 + j]; }
    default: return P.b_w_out[(size_t)k * 1024 + n];
    }
}
__device__ __forceinline__ void tr_item(const Params& P, int mat, int K, int nblk, bf16_t* WT, LAS float* scr, int item, int lane) {
    const int kb = item / nblk, nb = item % nblk, k0 = 64 * kb, n0 = 32 * nb;
    float tv[32];
#pragma unroll
    for (int i = 0; i < 32; ++i) tv[i] = wsrc(P, mat, k0 + 2 * i + (lane >> 5), n0 + (lane & 31));
#pragma unroll
    for (int i = 0; i < 32; ++i) scr[(2 * i + (lane >> 5)) * 33 + (lane & 31)] = tv[i];
    LDS_WAIT(); asm volatile("" ::: "memory");
    const int c = lane & 7;
#pragma unroll
    for (int j = 0; j < 4; ++j) { const int n = (lane >> 3) + 8 * j; const LAS float* s = scr + (8 * c) * 33 + n;
        u32x4 o; o.x = cvt_pk_bf16(s[0 * 33], s[1 * 33]); o.y = cvt_pk_bf16(s[2 * 33], s[3 * 33]); o.z = cvt_pk_bf16(s[4 * 33], s[5 * 33]); o.w = cvt_pk_bf16(s[6 * 33], s[7 * 33]);
        *(u32x4*)(WT + (size_t)(n0 + n) * K + k0 + 8 * c) = o; }
    LDS_WAIT(); asm volatile("" ::: "memory");
}
__device__ __forceinline__ void row_to_bf16(const float* xrow, bf16_t* orow, float* rstd_out, bool normalise, int lane) {
    const f32x4* xr = (const f32x4*)xrow + lane;
    f32x4 v[4]; float s = 0.f;
#pragma unroll
    for (int j = 0; j < 4; ++j) { v[j] = xr[64 * j]; s += (v[j].x * v[j].x + v[j].y * v[j].y) + (v[j].z * v[j].z + v[j].w * v[j].w); }
    const float rstd = rsqrtf(wave_sum(s) * (1.f / DM) + EPS);
    if (rstd_out && lane == 0) *rstd_out = rstd;
    const float sc = normalise ? rstd : 1.f;
    u32x2* o8 = (u32x2*)orow + lane;
#pragma unroll
    for (int j = 0; j < 4; ++j) { u32x2 w; w.x = cvt_pk_bf16(v[j].x * sc, v[j].y * sc); w.y = cvt_pk_bf16(v[j].z * sc, v[j].w * sc); o8[64 * j] = w; }
}
__device__ __forceinline__ void phase_prologue(const Params& P, const Wk& W, LAS unsigned char* lds) {
    unsigned char* ws = P.ws;
    LAS float* scr = (LAS float*)(lds + W.wave * 8704);
    const int gw = W.vcu * 8 + W.wave, NGW = W.G * 8;
#ifndef PROBE_P0
#define PROBE_P0 0
#endif
    for (int rep_ = 0; rep_ < (PROBE_P0 == 1 ? 2 : 1); ++rep_) {
    int base = 0;
#define DO_MAT(mt, K_, N_, OFF_) do { const int nblk = (N_) / 32, nit = ((K_) / 64) * nblk; \
        int first = gw - (base % NGW); if (first < 0) first += NGW; \
        for (int r = first; r < nit; r += NGW) tr_item(P, mt, K_, nblk, (bf16_t*)(ws + (OFF_)), scr, r, W.lane); \
        base += nit; } while (0)
    DO_MAT(0, 1024, 2048, WS_WINA); DO_MAT(1, 384, 1280, WS_WUQ); DO_MAT(2, 256, 1536, WS_WUKV); DO_MAT(3, 1024, 1024, WS_WMKV); DO_MAT(4, 1024, 1024, WS_WOA);
    DO_MAT(5, 1024, 2816, WS_WINB); DO_MAT(6, 384, 768, WS_WQK); DO_MAT(7, 384, 768, WS_WV); DO_MAT(8, 1024, 1024, WS_WOB);
#undef DO_MAT
    }
    const int gt = (W.vcu * 512 + W.tid), NGT = W.G * 512;
    for (int idx = gt; idx < 8 * 1024; idx += NGT) { const int g = idx >> 10, k = idx & 1023; ((float*)(ws + WS_WG))[idx] = P.b_w_in[(size_t)k * B_IN + 768 + g] * P.b_pre_g[k]; }
    for (int idx = gt; idx < 2 * T; idx += NGT) ((float*)(ws + WS_SSQA))[idx] = 0.f;
    for (int rep_ = 0; rep_ < (PROBE_P0 == 2 ? 2 : 1); ++rep_)
    for (int idx = gt; idx < T * 32; idx += NGT) { const int row = idx >> 5, i = idx & 31;
        const float inv = exp2f(-(float)i * (13.287712379549449f / 32.f));
        const float ang = (float)P.pos[row] * inv;
        double tr = (double)ang * 0.15915494309189535; tr -= floor(tr); const float tf = (float)tr;
        ((float2*)(ws + WS_ROPE))[idx] = make_float2(__builtin_amdgcn_cosf(tf), __builtin_amdgcn_sinf(tf)); }
    for (int rep_ = 0; rep_ < (PROBE_P0 == 3 ? 2 : 1); ++rep_)
    for (int m = gw; m < T; m += 4 * NGW) {
        f32x4 v[4][4]; float s[4];
#pragma unroll
        for (int r = 0; r < 4; ++r) { const f32x4* xr = (const f32x4*)(P.x + (size_t)(m + r * NGW) * DM) + W.lane;
#pragma unroll
            for (int j = 0; j < 4; ++j) v[r][j] = xr[64 * j]; }
#pragma unroll
        for (int r = 0; r < 4; ++r) { float a = 0.f;
#pragma unroll
            for (int j = 0; j < 4; ++j) a += (v[r][j].x * v[r][j].x + v[r][j].y * v[r][j].y) + (v[r][j].z * v[r][j].z + v[r][j].w * v[r][j].w);
            s[r] = wave_sum(a); }
#pragma unroll
        for (int r = 0; r < 4; ++r) { const int mr = m + r * NGW; if (W.lane == 0) ((float*)(ws + WS_RSTD))[mr] = rsqrtf(s[r] * (1.f / DM) + EPS);
            u32x2* o8 = (u32x2*)((bf16_t*)(ws + WS_XB) + (size_t)mr * DM) + W.lane;
#pragma unroll
            for (int j = 0; j < 4; ++j) { u32x2 w; w.x = cvt_pk_bf16(v[r][j].x, v[r][j].y); w.y = cvt_pk_bf16(v[r][j].z, v[r][j].w); o8[64 * j] = w; } }
    }
    for (int m = gw; m < NB * NMEM; m += NGW) row_to_bf16(P.mem + (size_t)m * DM, (bf16_t*)(ws + WS_MEMN) + (size_t)m * DM, nullptr, true, W.lane);
}

__device__ __forceinline__ void phase_rowmid(const Params& P, const Wk& W, LAS unsigned char* lds) {
    unsigned char* ws = P.ws;
    const int gw = W.vcu * 8 + W.wave, NGW = W.G * 8, lane = W.lane;
    const bf16_t* Z = (const bf16_t*)(ws + WS_Z);
    { const int gt_ = W.vcu * 512 + W.tid; if (gt_ < 32 * 192) ((float*)(ws + WS_U0))[gt_] = 0.f; }
    LAS float* Wg = (LAS float*)lds;
    for (int i = W.tid; i < 2048; i += 512) ((LAS f32x4*)Wg)[i] = ((const f32x4*)(ws + WS_WG))[i];
    __syncthreads();
    for (int m = gw; m < T; m += NGW) {
        const f32x4* xr = (const f32x4*)(P.x + (size_t)m * DM) + lane; const u32x2* zr = (const u32x2*)(Z + (size_t)m * DM) + lane;
        f32x4 v[4], z[4]; float s = 0.f;
#pragma unroll
        for (int j = 0; j < 4; ++j) { v[j] = xr[64 * j]; const u32x2 w = zr[64 * j]; z[j] = (f32x4){bflo(w.x), bfhi(w.x), bflo(w.y), bfhi(w.y)};
            s += (z[j].x * z[j].x + z[j].y * z[j].y) + (z[j].z * z[j].z + z[j].w * z[j].w); }
        const float rz = rsqrtf(wave_sum(s) * (1.f / DM) + EPS);
        float s1 = 0.f;
#pragma unroll
        for (int j = 0; j < 4; ++j) { const f32x4 g = ((const f32x4*)P.a_post_g)[lane + 64 * j]; v[j] = v[j] + z[j] * rz * g;
            s1 += (v[j].x * v[j].x + v[j].y * v[j].y) + (v[j].z * v[j].z + v[j].w * v[j].w); }
        const float r1 = rsqrtf(wave_sum(s1) * (1.f / DM) + EPS);
        f32x4* orow = (f32x4*)(P.out + (size_t)m * DM) + lane; u32x2* o8 = (u32x2*)((bf16_t*)(ws + WS_XB) + (size_t)m * DM) + lane;
#pragma unroll
        for (int j = 0; j < 4; ++j) { orow[64 * j] = v[j]; u32x2 w; w.x = cvt_pk_bf16(v[j].x, v[j].y); w.y = cvt_pk_bf16(v[j].z, v[j].w); o8[64 * j] = w; }
        if (lane == 0) ((float*)(ws + WS_RSTD))[m] = r1;
        float ga[8];
#pragma unroll
        for (int g = 0; g < 8; ++g) { float a = 0.f;
#pragma unroll
            for (int j = 0; j < 4; ++j) { const f32x4 w4 = ((const LAS f32x4*)(Wg + g * 1024))[lane + 64 * j]; a += (v[j].x * w4.x + v[j].y * w4.y) + (v[j].z * w4.z + v[j].w * w4.w); }
            ga[g] = a; }
        float gb[4], gc[2], gd;
        { const bool up = (lane & 32) != 0;
#pragma unroll
          for (int i = 0; i < 4; ++i) { const float snd = up ? ga[i] : ga[4 + i]; const float kp = up ? ga[4 + i] : ga[i]; gb[i] = kp + __shfl_xor(snd, 32); } }
        { const bool up = (lane & 16) != 0;
#pragma unroll
          for (int i = 0; i < 2; ++i) { const float snd = up ? gb[i] : gb[2 + i]; const float kp = up ? gb[2 + i] : gb[i]; gc[i] = kp + __shfl_xor(snd, 16); } }
        { const bool up = (lane & 8) != 0; const float snd = up ? gc[0] : gc[1]; const float kp = up ? gc[1] : gc[0]; gd = kp + __shfl_xor(snd, 8); }
        gd += __shfl_xor(gd, 4); gd += __shfl_xor(gd, 2); gd += __shfl_xor(gd, 1);
        if ((lane & 7) == 0) { const int g = lane >> 3;
            ((float*)(ws + WS_IFP))[(size_t)m * 8 + g] = gd * r1 + P.b_gate_bias[g]; }
    }
}
__device__ __forceinline__ void phase_rowfinal(const Params& P, const Wk& W) {
    unsigned char* ws = P.ws;
    const int gw = W.vcu * 8 + W.wave, NGW = W.G * 8, lane = W.lane;
    const bf16_t* Z = (const bf16_t*)(ws + WS_Z);
    for (int m = gw; m < T; m += NGW) {
        f32x4* xr = (f32x4*)(P.out + (size_t)m * DM) + lane; const u32x2* zr = (const u32x2*)(Z + (size_t)m * DM) + lane;
        f32x4 v[4], z[4]; float s = 0.f;
#pragma unroll
        for (int j = 0; j < 4; ++j) { v[j] = xr[64 * j]; const u32x2 w = zr[64 * j]; z[j] = (f32x4){bflo(w.x), bfhi(w.x), bflo(w.y), bfhi(w.y)};
            s += (z[j].x * z[j].x + z[j].y * z[j].y) + (z[j].z * z[j].z + z[j].w * z[j].w); }
        const float rz = rsqrtf(wave_sum(s) * (1.f / DM) + EPS);
#pragma unroll
        for (int j = 0; j < 4; ++j) { const f32x4 g = ((const f32x4*)P.b_post_g)[lane + 64 * j]; xr[64 * j] = v[j] + z[j] * rz * g; }
    }
}
__device__ __forceinline__ void first_token_u0(const Params& P, const Wk& W, LAS unsigned char* lds, int widx) {
    unsigned char* ws = P.ws;
    const int bh = widx >> 2, sl = widx & 3, b = bh >> 2, h = bh & 3, j = W.tid % 192, sub = W.tid / 192; const size_t row = (size_t)b * SEQ;
    LAS float* hs = (LAS float*)lds;
    if (W.tid < 256) hs[W.tid] = P.out[row * DM + sl * 256 + W.tid] * P.b_pre_g[sl * 256 + W.tid] * ((const float*)(ws + WS_RSTD))[row];
    __syncthreads();
    if (W.tid < 384) {
        const float* wp = P.b_w_in + (size_t)(sl * 256 + sub * 128) * B_IN + h * 192 + j; float a = 0.f;
#pragma unroll 64
        for (int k = 0; k < 128; ++k) a += hs[sub * 128 + k] * wp[(size_t)k * B_IN];
        atomicAdd((float*)(ws + WS_U0) + bh * 192 + j, a); }
    __syncthreads();
}
__device__ __forceinline__ void first_token_qk(const Params& P, const Wk& W, LAS unsigned char* lds) {
    unsigned char* ws = P.ws;
    const int first = W.G > 32 ? W.G - 32 : 0, nwk = W.G > 32 ? 32 : W.G;
    if (W.vcu < first) return;
    for (int bh = W.vcu - first; bh < 32; bh += nwk) {
    const int h = bh & 3, tid = W.tid;
    LAS float* uc0 = (LAS float*)lds; LAS float* qk0 = uc0 + 192;
    float wv[96];
    const int o = tid % 192, part = tid / 192, j = o % 96;
    if (tid < 384) { const float* Wm = (o < 96 ? P.b_w_q : P.b_w_k) + (size_t)h * 192 * 96 + (size_t)(part * 96) * 96 + j;
#pragma unroll
        for (int i = 0; i < 96; ++i) wv[i] = Wm[i * 96]; }
    if (tid < 192) { const int col = h * 192 + tid; uc0[tid] = silu_f(P.b_conv_b[col] + P.b_conv_w[3 * 768 + col] * ((const float*)(ws + WS_U0))[bh * 192 + tid]); }
    __syncthreads();
    if (tid < 384) { float a = 0.f;
#pragma unroll
        for (int i = 0; i < 96; ++i) a += uc0[part * 96 + i] * wv[i];
        qk0[part * 192 + o] = a; }
    __syncthreads();
    if (tid < 64) { float a = (qk0[tid] + qk0[192 + tid]) * (qk0[96 + tid] + qk0[288 + tid]); if (tid < 32) a += (qk0[64 + tid] + qk0[256 + tid]) * (qk0[160 + tid] + qk0[352 + tid]);
        a = wave_sum(a); if (tid == 0) ((float*)(ws + WS_C0))[bh] = a * KSCALE_B; }
    __syncthreads();
    }
}
__device__ __forceinline__ void phase_conv(const Params& P, const Wk& W) {
    unsigned char* ws = P.ws;
    const bf16_t* G2 = (const bf16_t*)(ws + WS_G); bf16_t* UC = (bf16_t*)(ws + WS_UC);
    const int gt = W.vcu * 512 + W.tid, NGT = W.G * 512;
    for (int it = gt; it < (T / 8) * 96; it += NGT) {
        const int rg = it / 96, cc = it % 96, row0 = rg * 8, c0 = cc * 8, s0 = row0 & (SEQ - 1);
        float w[4][8], bsv[8];
#pragma unroll
        for (int j = 0; j < 4; ++j) { const f32x4 a = *(const f32x4*)(P.b_conv_w + j * 768 + c0), b = *(const f32x4*)(P.b_conv_w + j * 768 + c0 + 4);
            w[j][0] = a.x; w[j][1] = a.y; w[j][2] = a.z; w[j][3] = a.w; w[j][4] = b.x; w[j][5] = b.y; w[j][6] = b.z; w[j][7] = b.w; }
        { const f32x4 a = *(const f32x4*)(P.b_conv_b + c0), b = *(const f32x4*)(P.b_conv_b + c0 + 4); bsv[0] = a.x; bsv[1] = a.y; bsv[2] = a.z; bsv[3] = a.w; bsv[4] = b.x; bsv[5] = b.y; bsv[6] = b.z; bsv[7] = b.w; }
        float h[3][8];
#pragma unroll
        for (int j = 0; j < 3; ++j) {
            if (s0 - 3 + j >= 0) { const u32x4 q = *(const u32x4*)(G2 + (size_t)(row0 - 3 + j) * G2W + G2_U + c0);
                h[j][0] = bflo(q.x); h[j][1] = bfhi(q.x); h[j][2] = bflo(q.y); h[j][3] = bfhi(q.y); h[j][4] = bflo(q.z); h[j][5] = bfhi(q.z); h[j][6] = bflo(q.w); h[j][7] = bfhi(q.w); }
            else {
#pragma unroll
                for (int e = 0; e < 8; ++e) h[j][e] = 0.f; }
        }
#pragma unroll
        for (int r = 0; r < 8; ++r) {
            const u32x4 q = *(const u32x4*)(G2 + (size_t)(row0 + r) * G2W + G2_U + c0);
            float u[8] = {bflo(q.x), bfhi(q.x), bflo(q.y), bfhi(q.y), bflo(q.z), bfhi(q.z), bflo(q.w), bfhi(q.w)};
            float o[8];
#pragma unroll
            for (int e = 0; e < 8; ++e) { const float cv = bsv[e] + h[0][e] * w[0][e] + h[1][e] * w[1][e] + h[2][e] * w[2][e] + u[e] * w[3][e]; o[e] = silu_f(cv);
                h[0][e] = h[1][e]; h[1][e] = h[2][e]; h[2][e] = u[e]; }
            u32x4 ov; ov.x = cvt_pk_bf16(o[0], o[1]); ov.y = cvt_pk_bf16(o[2], o[3]); ov.z = cvt_pk_bf16(o[4], o[5]); ov.w = cvt_pk_bf16(o[6], o[7]);
            *(u32x4*)(UC + (size_t)(row0 + r) * 768 + c0) = ov;
        }
    }
}
namespace ml {
__device__ __forceinline__ int crow(int r, int hi) { return (r & 3) + 8 * (r >> 2) + 4 * hi; }
template <int NKS>
__device__ __forceinline__ f32x16 tile32(const LAS bf16_t* A, int lda, const LAS bf16_t* B, int ldb, int r32, int hi, f32x16 acc) {
    const LAS bf16_t* ap = A + r32 * lda + hi * 8; const LAS bf16_t* bp = B + r32 * ldb + hi * 8;
#pragma unroll
    for (int ks = 0; ks < NKS; ++ks) { const bf16x8 a = *(const LAS bf16x8*)(ap + ks * 16); const bf16x8 b = *(const LAS bf16x8*)(bp + ks * 16);
        acc = __builtin_amdgcn_mfma_f32_32x32x16_bf16(a, b, acc, 0, 0, 0); }
    return acc;
}
__device__ __forceinline__ float logsigmoid_f(float f) { return fminf(f, 0.f) - log1pf(__expf(-fabsf(f))); }
__device__ __forceinline__ float scan_add(float v, int lane) {
#pragma unroll
    for (int o = 1; o < 64; o <<= 1) { const float t = __shfl_up(v, o); if (lane >= o) v += t; }
    return v;
}
__device__ __forceinline__ float scan_max(float v, int lane) {
#pragma unroll
    for (int o = 1; o < 64; o <<= 1) { const float t = __shfl_up(v, o); if (lane >= o) v = fmaxf(v, t); }
    return v;
}
constexpr int P72 = 72, P104 = 104;
__device__ __forceinline__ int unit_of(const Wk& W, int k) { const int run = W.vcu + (k >> 3) * W.G; return run < 256 ? run * 8 + (k & 7) : -1; }
__device__ __forceinline__ float sum8(const u32x4 q) { return ((bflo(q.x) + bfhi(q.x)) + (bflo(q.y) + bfhi(q.y))) + ((bflo(q.z) + bfhi(q.z)) + (bflo(q.w) + bfhi(q.w))); }

__device__ __forceinline__ void pass1_phase(const Params& P, const Wk& W, LAS unsigned char* lds) {
    unsigned char* ws = P.ws;
    LAS bf16_t* vT = (LAS bf16_t*)lds;
    LAS bf16_t* kwT = (LAS bf16_t*)(lds + 27648);
    LAS float* wsl = (LAS float*)(lds + 41472);
    LAS bf16_t* Cs = (LAS bf16_t*)(lds + 41792);
    const float* ifp = (const float*)(ws + WS_IFP);
    const bf16_t* QK = (const bf16_t*)(ws + WS_QK); const bf16_t* VV = (const bf16_t*)(ws + WS_VV);
    const int tid = W.tid, lane = W.lane, wid = W.wave, r32 = lane & 31, hi = lane >> 5;
    int kq = 0; int u = unit_of(W, 0); if (u < 0) return;
    u32x4 q[5]; float pli = 0.f, pf = 0.f;
    f32x16 T0 = f32x16{}, T1 = f32x16{}, T2 = f32x16{}; float mt_run = -1e30f, bl_run = 0.f, tn_run = 0.f;
#define P1_LOAD(uu) do { const int bh_ = (uu) >> 6, c_ = (uu) & 63, b_ = bh_ >> 2, h_ = bh_ & 3, row0_ = b_ * SEQ + c_ * 64; \
        _Pragma("unroll") for (int i = 0; i < 5; ++i) { const int id = tid + 512 * i; \
            if (id < 768) q[i] = *(const u32x4*)((const char*)QK + (unsigned)((((bh_ * SEQ) + c_ * 64 + (id & 63)) * 192 + 96 + (id >> 6) * 8) * 2)); \
            else if (id < 2304) q[i] = *(const u32x4*)((const char*)VV + (unsigned)((((bh_ * SEQ) + c_ * 64 + (id & 63)) * 192 + ((id - 768) >> 6) * 8) * 2)); } \
        if (wid == 0) { pli = *(const float*)((const char*)ifp + (unsigned)(((row0_ + lane) * 8 + h_) * 4)); pf = *(const float*)((const char*)ifp + (unsigned)(((row0_ + lane) * 8 + 4 + h_) * 4)); } } while (0)
    P1_LOAD(u);
    for (;;) {
        const int un = unit_of(W, kq + 1);
        if (wid == 0) {
            const float bcs = scan_add(logsigmoid_f(pf), lane);
            const float bL = __shfl(bcs, 63);
            const float dec = bL - bcs + pli;
            const float mloc = wave_max(dec);
            wsl[lane] = __expf(dec - mloc);
            if (lane == 0) { ((float*)(ws + WS_BL))[u] = bL; ((float*)(ws + WS_MLOC))[u] = mloc; wsl[64] = bL; wsl[65] = mloc; }
        }
        __syncthreads();
        float a_run, w_run; { const float bL = wsl[64], ml = wsl[65]; const float mn = fmaxf(bL + mt_run, ml); a_run = __expf(bL + mt_run - mn); w_run = __expf(ml - mn); mt_run = mn; bl_run += bL; }
#pragma unroll
        for (int i = 0; i < 5; ++i) { const int id = tid + 512 * i, row = id & 63;
            if (id < 768) { const int cc = id >> 6; const float wv = wsl[row];
                const float e[8] = {bflo(q[i].x), bfhi(q[i].x), bflo(q[i].y), bfhi(q[i].y), bflo(q[i].z), bfhi(q[i].z), bflo(q[i].w), bfhi(q[i].w)};
#pragma unroll
                for (int j = 0; j < 8; ++j) kwT[(cc * 8 + j) * P72 + row] = f2bf(e[j] * wv);
            } else if (id < 2304) { const int cc = (id - 768) >> 6;
                const unsigned short e[8] = {(unsigned short)(q[i].x & 0xffff), (unsigned short)(q[i].x >> 16), (unsigned short)(q[i].y & 0xffff), (unsigned short)(q[i].y >> 16), (unsigned short)(q[i].z & 0xffff), (unsigned short)(q[i].z >> 16), (unsigned short)(q[i].w & 0xffff), (unsigned short)(q[i].w >> 16)};
#pragma unroll
                for (int j = 0; j < 8; ++j) vT[(cc * 8 + j) * P72 + row] = e[j]; }
        }
        __syncthreads();
        if (un >= 0) P1_LOAD(un);
        for (int tt = wid; tt < 18; tt += 8) {
            const int mt = tt / 3, nt = tt % 3;
            f32x16 acc = f32x16{};
            acc = tile32<4>(vT + mt * 32 * P72, P72, kwT + nt * 32 * P72, P72, r32, hi, acc);
            if (tt < 8) T0 = T0 * a_run + acc * w_run; else if (tt < 16) T1 = T1 * a_run + acc * w_run; else T2 = T2 * a_run + acc * w_run;
#pragma unroll
            for (int r = 0; r < 16; ++r) Cs[(mt * 32 + crow(r, hi)) * P104 + nt * 32 + r32] = f2bf(acc[r]);
        }
        if (tid < 384) { const int dk = tid >> 2, sub = tid & 3;
            float sd = sum8(*(const LAS u32x4*)(kwT + dk * P72 + sub * 8)) + sum8(*(const LAS u32x4*)(kwT + dk * P72 + (sub + 4) * 8));
            sd += __shfl_xor(sd, 1); sd += __shfl_xor(sd, 2);
            if (sub == 0) { ((float*)(ws + WS_DN))[(size_t)u * 96 + dk] = sd; tn_run = tn_run * a_run + sd * w_run; } }
        __syncthreads();
        { char* DCb = (char*)(ws + WS_DC) + (size_t)u * (192 * 96 * 2);
#pragma unroll
          for (int i = 0; i < 5; ++i) { const int id = tid + 512 * i; if (id < 2304) { const int dv = id / 12, cc = id % 12; *(u32x4*)(DCb + (unsigned)(id * 16)) = *(const LAS u32x4*)(Cs + dv * P104 + cc * 8); } } }
        if ((kq & 7) == 7) {
            const int run = u >> 3;
            __syncthreads();
#pragma unroll
            for (int k3 = 0; k3 < 3; ++k3) { const int tt = wid + 8 * k3; if (tt < 18) { const int mt = tt / 3, nt = tt % 3; const f32x16 Tv = (k3 == 0) ? T0 : (k3 == 1) ? T1 : T2;
#pragma unroll
                for (int r = 0; r < 16; ++r) Cs[(mt * 32 + crow(r, hi)) * P104 + nt * 32 + r32] = f2bf(Tv[r]); } }
            if (tid < 384 && (tid & 3) == 0) ((float*)(ws + WS_RN))[run * 96 + (tid >> 2)] = tn_run;
            if (tid == 0) { ((float*)(ws + WS_RBL))[run] = bl_run; ((float*)(ws + WS_RBL))[256 + run] = mt_run; }
            __syncthreads();
            { char* RSb = (char*)(ws + WS_RS) + (size_t)run * (192 * 96 * 2);
#pragma unroll
              for (int i = 0; i < 5; ++i) { const int id = tid + 512 * i; if (id < 2304) { const int dv = id / 12, cc = id % 12; *(u32x4*)(RSb + (unsigned)(id * 16)) = *(const LAS u32x4*)(Cs + dv * P104 + cc * 8); } } }
            T0 = f32x16{}; T1 = f32x16{}; T2 = f32x16{}; mt_run = -1e30f; bl_run = 0.f; tn_run = 0.f;
        }
        if (un < 0) break;
        u = un; ++kq;
    }
#undef P1_LOAD
    __syncthreads();
}

__device__ __forceinline__ void pass2(const Params& P, const Wk& W) {
    unsigned char* ws = P.ws;
    const float* BL = (const float*)(ws + WS_RBL); const float* ML = BL + 256; float* MS = (float*)(ws + WS_RBL) + 512;
    const int gt = (W.wave * W.G + W.vcu) * 64 + W.lane, NGT = W.G * 512;
    constexpr int NCE = 32 * 2304, NNE = 32 * 96;
    for (int g = gt; g < NCE + NNE; g += NGT) {
        if (g < NCE) {
            const int bh = g / 2304, e = g % 2304;
            float C[8]; float m = 0.f; float z0 = 0.f; asm volatile("" : "+v"(z0));
#pragma unroll
            for (int j = 0; j < 8; ++j) C[j] = z0;
            u32x4* base = (u32x4*)((bf16_t*)(ws + WS_RS) + (size_t)bh * 8 * 18432 + e * 8);
            u32x4 d[8]; float bL[8], ml[8];
#pragma unroll
            for (int j = 0; j < 8; ++j) { d[j] = base[(size_t)j * (18432 / 8)]; bL[j] = BL[bh * 8 + j]; ml[j] = ML[bh * 8 + j]; }
#pragma unroll
            for (int j = 0; j < 8; ++j) {
                u32x4 o; o.x = cvt_pk_bf16(C[0], C[1]); o.y = cvt_pk_bf16(C[2], C[3]); o.z = cvt_pk_bf16(C[4], C[5]); o.w = cvt_pk_bf16(C[6], C[7]);
                base[(size_t)j * (18432 / 8)] = o;
                if (e == 0) MS[bh * 8 + j] = m;
                const float mn = fmaxf(bL[j] + m, ml[j]), a = __expf(bL[j] + m - mn), w = __expf(ml[j] - mn);
                C[0] = a * C[0] + w * bflo(d[j].x); C[1] = a * C[1] + w * bfhi(d[j].x); C[2] = a * C[2] + w * bflo(d[j].y); C[3] = a * C[3] + w * bfhi(d[j].y);
                C[4] = a * C[4] + w * bflo(d[j].z); C[5] = a * C[5] + w * bfhi(d[j].z); C[6] = a * C[6] + w * bflo(d[j].w); C[7] = a * C[7] + w * bfhi(d[j].w);
                m = mn;
            }
        } else {
            const int g2 = g - NCE, bh = g2 / 96, e = g2 % 96;
            float n = 0.f, m = 0.f; float* base = (float*)(ws + WS_RN) + (size_t)bh * 8 * 96 + e;
            float d[8], bL[8], ml[8];
#pragma unroll
            for (int j = 0; j < 8; ++j) { d[j] = base[j * 96]; bL[j] = BL[bh * 8 + j]; ml[j] = ML[bh * 8 + j]; }
#pragma unroll
            for (int j = 0; j < 8; ++j) { base[j * 96] = n; const float mn = fmaxf(bL[j] + m, ml[j]), a = __expf(bL[j] + m - mn), w = __expf(ml[j] - mn); n = a * n + w * d[j]; m = mn; }
        }
    }
}

__device__ __forceinline__ void pass3_phase(const Params& P, const Wk& W, LAS unsigned char* lds) {
    unsigned char* ws = P.ws;
    LAS bf16_t* Qs = (LAS bf16_t*)lds;
    LAS bf16_t* Ks = (LAS bf16_t*)(lds + 13312);
    LAS bf16_t* vT = (LAS bf16_t*)(lds + 26624);
    LAS bf16_t* CT = (LAS bf16_t*)(lds + 54272);
    LAS bf16_t* Ps = (LAS bf16_t*)(lds + 94208);
    LAS float* Hs = (LAS float*)lds;
    LAS float* sm = (LAS float*)(lds + 103424);
    LAS float* g_s = sm, *Mt = sm + 64, *wint = sm + 128, *eneg = sm + 192, *qn = sm + 256, *rden = sm + 320, *nvec = sm + 384;
    const float* ifp = (const float*)(ws + WS_IFP);
    const bf16_t* QK = (const bf16_t*)(ws + WS_QK); const bf16_t* VV = (const bf16_t*)(ws + WS_VV);
    const int tid = W.tid, lane = W.lane, wid = W.wave, r32 = lane & 31, hi = lane >> 5;
    int kq = 0; int u = unit_of(W, 0); if (u < 0) return;
    u32x4 qa[3], qb[3], qc[5]; float pli = 0.f, pf = 0.f, pn = 0.f, pc0 = 0.f, pbl = 0.f, pml = 0.f;
    u32x4 Cr[5]; float n_reg = 0.f, m_cur = 0.f;
#define P3_LOAD(uu) do { const int bh_ = (uu) >> 6, c_ = (uu) & 63, b_ = bh_ >> 2, h_ = bh_ & 3, row0_ = b_ * SEQ + c_ * 64; \
        const char* CS_ = (const char*)(ws + WS_DC) + (size_t)(uu) * (192 * 96 * 2); \
        _Pragma("unroll") for (int i = 0; i < 3; ++i) { const int id = tid + 512 * i; \
            { const int which = id / 768, i2 = id % 768, row = i2 / 12, cc = i2 % 12; qa[i] = *(const u32x4*)((const char*)QK + (unsigned)((((bh_ * SEQ) + c_ * 64 + row) * 192 + which * 96 + cc * 8) * 2)); } \
            { const int cc = id >> 6, row = id & 63; qb[i] = *(const u32x4*)((const char*)VV + (unsigned)((((bh_ * SEQ) + c_ * 64 + row) * 192 + cc * 8) * 2)); } } \
        _Pragma("unroll") for (int i = 0; i < 5; ++i) { const int id = tid + 512 * i; if (id < 2304) qc[i] = *(const u32x4*)(CS_ + (unsigned)(id * 16)); } \
        pbl = ((const float*)(ws + WS_BL))[uu]; pml = ((const float*)(ws + WS_MLOC))[uu]; \
        if (wid == 0) { pc0 = ((const float*)(ws + WS_C0))[bh_]; pli = *(const float*)((const char*)ifp + (unsigned)(((row0_ + lane) * 8 + h_) * 4)); pf = *(const float*)((const char*)ifp + (unsigned)(((row0_ + lane) * 8 + 4 + h_) * 4)); } \
        if (tid < 96) pn = *(const float*)((const char*)(ws + WS_DN) + (unsigned)(((uu) * 96 + tid) * 4)); } while (0)
    P3_LOAD(u);
    for (;;) {
        const int bh = u >> 6, c = u & 63, b = bh >> 2, h = bh & 3, row0 = b * SEQ + c * 64;
        const int un = unit_of(W, kq + 1);
        const float c0cur = pc0;
        int tid_l = W.tid; asm volatile("" : "+v"(tid_l));
        const int tid = tid_l, lane = tid & 63, r32 = lane & 31, hi = lane >> 5;
        if ((kq & 7) == 0) {
            const int run = u >> 3; const char* RSb = (const char*)(ws + WS_RS) + (size_t)run * (192 * 96 * 2);
#pragma unroll
            for (int i = 0; i < 5; ++i) { const int id = tid + 512 * i; if (id < 2304) Cr[i] = *(const u32x4*)(RSb + (unsigned)(id * 16)); }
            if (tid < 96) n_reg = ((const float*)(ws + WS_RN))[run * 96 + tid];
            m_cur = ((const float*)(ws + WS_RBL))[512 + run];
        }
        if (wid == 0) {
            const float bcs = scan_add(logsigmoid_f(pf), lane);
            const float g = pli - bcs;
            const float pmx = scan_max(g, lane);
            const float M = fmaxf(m_cur, pmx);
            g_s[lane] = g; Mt[lane] = M; wint[lane] = __expf(m_cur - M); eneg[lane] = __expf(-bcs - M);
        }
#pragma unroll
        for (int i = 0; i < 3; ++i) { const int id = tid + 512 * i;
            { const int which = id / 768, i2 = id % 768, row = i2 / 12, cc = i2 % 12; *(LAS u32x4*)((which ? Ks : Qs) + row * P104 + cc * 8) = qa[i]; }
            { const int cc = id >> 6, row = id & 63;
              const unsigned short e[8] = {(unsigned short)(qb[i].x & 0xffff), (unsigned short)(qb[i].x >> 16), (unsigned short)(qb[i].y & 0xffff), (unsigned short)(qb[i].y >> 16), (unsigned short)(qb[i].z & 0xffff), (unsigned short)(qb[i].z >> 16), (unsigned short)(qb[i].w & 0xffff), (unsigned short)(qb[i].w >> 16)};
#pragma unroll
              for (int j = 0; j < 8; ++j) vT[(cc * 8 + j) * P72 + row] = e[j]; } }
        {
            const float mn = fmaxf(pbl + m_cur, pml), a_ = __expf(pbl + m_cur - mn), w_ = __expf(pml - mn);
#pragma unroll
            for (int i = 0; i < 5; ++i) { const int id = tid + 512 * i; if (id < 2304) { const int dv = id / 12, cc = id % 12;
                const u32x4 cq = Cr[i], d = qc[i];
                *(LAS u32x4*)(CT + dv * P104 + cc * 8) = cq;
                u32x4 o;
                o.x = cvt_pk_bf16(a_ * bflo(cq.x) + w_ * bflo(d.x), a_ * bfhi(cq.x) + w_ * bfhi(d.x)); o.y = cvt_pk_bf16(a_ * bflo(cq.y) + w_ * bflo(d.y), a_ * bfhi(cq.y) + w_ * bfhi(d.y));
                o.z = cvt_pk_bf16(a_ * bflo(cq.z) + w_ * bflo(d.z), a_ * bfhi(cq.z) + w_ * bfhi(d.z)); o.w = cvt_pk_bf16(a_ * bflo(cq.w) + w_ * bflo(d.w), a_ * bfhi(cq.w) + w_ * bfhi(d.w));
                Cr[i] = o; } }
            if (tid < 96) { nvec[tid] = n_reg; n_reg = a_ * n_reg + w_ * pn; }
            m_cur = mn;
        }
        __syncthreads();
        if (un >= 0) P3_LOAD(un);
        __builtin_amdgcn_sched_barrier(0);
        if (wid < 4) {
            const int mt = wid >> 1, nt = wid & 1;
            f32x16 acc = f32x16{};
            acc = tile32<6>(Qs + mt * 32 * P104, P104, Ks + nt * 32 * P104, P104, r32, hi, acc);
#ifndef NO_FIRST_TOKEN
            if (c == 0 && wid == 0 && lane == 0) acc[0] = c0cur;
#endif
            const int s = nt * 32 + r32; const float gs = g_s[s];
#pragma unroll
            for (int r = 0; r < 16; ++r) { const int t = mt * 32 + crow(r, hi);
                const float w = (s <= t) ? __expf(gs - Mt[t]) : 0.f;
                Ps[t * P72 + s] = f2bf(acc[r] * w); }
        } else {
            const int t = (tid - 256) >> 2, sub = tid & 3; float a = 0.f;
#pragma unroll
            for (int j = 0; j < 3; ++j) { const int cc = sub + 4 * j; const u32x4 q = *(const LAS u32x4*)(Qs + t * P104 + cc * 8); const LAS float* nv = nvec + cc * 8;
                a += (bflo(q.x) * nv[0] + bfhi(q.x) * nv[1]) + (bflo(q.y) * nv[2] + bfhi(q.y) * nv[3]) + (bflo(q.z) * nv[4] + bfhi(q.z) * nv[5]) + (bflo(q.w) * nv[6] + bfhi(q.w) * nv[7]); }
            a += __shfl_xor(a, 1); a += __shfl_xor(a, 2);
            if (sub == 0) qn[t] = a;
        }
        __syncthreads();
        { const int t = tid >> 3, sub = tid & 7;
          float rs = sum8(*(const LAS u32x4*)(Ps + t * P72 + sub * 8));
          rs += __shfl_xor(rs, 1); rs += __shfl_xor(rs, 2); rs += __shfl_xor(rs, 4);
          if (sub == 0) { float den = wint[t] * qn[t] + rs; den = fmaxf(fabsf(den), eneg[t]); rden[t] = __builtin_amdgcn_rcpf(den); } }
        const int te = tid >> 3, sube = tid & 7;
        const bf16_t* G2 = (const bf16_t*)(ws + WS_G) + (size_t)(row0 + te) * G2W; const bf16_t* UC = (const bf16_t*)(ws + WS_UC) + (size_t)(row0 + te) * 768;
        u32x4 eop[3], egq[3], euq[3];
#pragma unroll
        for (int j = 0; j < 3; ++j) { const int col = h * 192 + (sube + 8 * j) * 8; eop[j] = *(const u32x4*)(G2 + G2_O + col); egq[j] = *(const u32x4*)(G2 + G2_GATE + col); euq[j] = *(const u32x4*)(UC + col); }
        f32x16 accA = f32x16{}, accB = f32x16{};
        {
            const int tt = (wid < 4) ? (8 + wid) : (wid - 4), mt = tt / 6, nt = tt % 6;
            accA = tile32<6>(Qs + mt * 32 * P104, P104, CT + nt * 32 * P104, P104, r32, hi, accA);
#pragma unroll
            for (int r = 0; r < 16; ++r) accA[r] *= wint[mt * 32 + crow(r, hi)];
            accA = tile32<4>(Ps + mt * 32 * P72, P72, vT + nt * 32 * P72, P72, r32, hi, accA);
        }
        if (wid >= 4) {
            const int tt = wid, mt = tt / 6, nt = tt % 6;
            accB = tile32<6>(Qs + mt * 32 * P104, P104, CT + nt * 32 * P104, P104, r32, hi, accB);
#pragma unroll
            for (int r = 0; r < 16; ++r) accB[r] *= wint[mt * 32 + crow(r, hi)];
            accB = tile32<4>(Ps + mt * 32 * P72, P72, vT + nt * 32 * P72, P72, r32, hi, accB);
        }
        __syncthreads();
        {
            const int tt = (wid < 4) ? (8 + wid) : (wid - 4), mt = tt / 6, nt = tt % 6;
#pragma unroll
            for (int r = 0; r < 16; ++r) { const int t = mt * 32 + crow(r, hi); Hs[t * 196 + nt * 32 + r32] = accA[r] * rden[t]; }
        }
        if (wid >= 4) {
            const int tt = wid, mt = tt / 6, nt = tt % 6;
#pragma unroll
            for (int r = 0; r < 16; ++r) { const int t = mt * 32 + crow(r, hi); Hs[t * 196 + nt * 32 + r32] = accB[r] * rden[t]; }
        }
        __syncthreads();
        __builtin_amdgcn_sched_barrier(0);
        {
            float hv[3][8]; float ss = 0.f;
#pragma unroll
            for (int j = 0; j < 3; ++j) { const int col = (sube + 8 * j) * 8;
                const f32x4 a = *(const LAS f32x4*)(Hs + te * 196 + col), bq = *(const LAS f32x4*)(Hs + te * 196 + col + 4);
                hv[j][0] = a.x; hv[j][1] = a.y; hv[j][2] = a.z; hv[j][3] = a.w; hv[j][4] = bq.x; hv[j][5] = bq.y; hv[j][6] = bq.z; hv[j][7] = bq.w;
#pragma unroll
                for (int e = 0; e < 8; ++e) ss += hv[j][e] * hv[j][e]; }
            ss += __shfl_xor(ss, 1); ss += __shfl_xor(ss, 2); ss += __shfl_xor(ss, 4);
            const float rstd = rsqrtf(ss * (1.f / 192.f) + EPS);
            bf16_t* Y = (bf16_t*)(ws + WS_Y2) + (size_t)(row0 + te) * DM;
#pragma unroll
            for (int j = 0; j < 3; ++j) { const int col = h * 192 + (sube + 8 * j) * 8;
                const u32x4 op = eop[j], gq = egq[j], uq = euq[j];
                const float ov[8] = {bflo(op.x), bfhi(op.x), bflo(op.y), bfhi(op.y), bflo(op.z), bfhi(op.z), bflo(op.w), bfhi(op.w)};
                const float gv[8] = {bflo(gq.x), bfhi(gq.x), bflo(gq.y), bfhi(gq.y), bflo(gq.z), bfhi(gq.z), bflo(gq.w), bfhi(gq.w)};
                const float uv[8] = {bflo(uq.x), bfhi(uq.x), bflo(uq.y), bfhi(uq.y), bflo(uq.z), bfhi(uq.z), bflo(uq.w), bfhi(uq.w)};
                float o[8];
#pragma unroll
                for (int e = 0; e < 8; ++e) { const float hn = hv[j][e] * rstd * P.b_head_g[col + e]; const float mix = sigmoid_f(ov[e]) * hn + P.b_skip[col + e] * uv[e]; o[e] = mix * silu_f(gv[e]); }
                u32x4 w; w.x = cvt_pk_bf16(o[0], o[1]); w.y = cvt_pk_bf16(o[2], o[3]); w.z = cvt_pk_bf16(o[4], o[5]); w.w = cvt_pk_bf16(o[6], o[7]);
                *(u32x4*)(Y + col) = w; }
        }
        __syncthreads();
        if (un < 0) break;
        u = un; ++kq;
    }
#undef P3_LOAD
}
}
typedef GAS unsigned gu32;
#define XB_TMO      128
#define XB_XCNT(j)  (256  + 64 * (j))
#define XB_XSUB(j)  (1280 + 64 * (j))
#define XB_XGEN(j)  (2304 + 64 * (j))
#define XB_TOP      3328
#define XB_TOPGEN   3392
#define XCD_BAR_WORDS 3456
#define XB_SPIN_CAP (1u << 18)
__device__ __forceinline__ unsigned xb_ld(unsigned* p)              { return __hip_atomic_load(p, __ATOMIC_RELAXED, __HIP_MEMORY_SCOPE_AGENT); }
__device__ __forceinline__ unsigned xb_add(unsigned* p, unsigned v) { return __hip_atomic_fetch_add(p, v, __ATOMIC_RELAXED, __HIP_MEMORY_SCOPE_AGENT); }
__device__ __forceinline__ unsigned xb_xcc_id() { return (unsigned)__builtin_amdgcn_s_getreg((3 << 11) | 20) & 0xFu; }
#define XB_SPIN(cond, bar) do { unsigned _sp = 0; while (cond) { __builtin_amdgcn_s_sleep(1); \
    if ((++_sp & 255u) == 0u) { if (xb_ld(&(bar)[XB_TMO])) break; if (_sp > XB_SPIN_CAP) { atomicAdd(&(bar)[XB_TMO], 1u); break; } } } } while (0)
struct XcdBarrier { unsigned* bar; unsigned x; volatile LAS unsigned* st; };
__device__ __forceinline__ XcdBarrier xcd_barrier_post(unsigned* bar, volatile LAS unsigned* st) {
    XcdBarrier b; b.bar = bar; b.x = xb_xcc_id(); b.st = st;
    if (threadIdx.x == 0) (void)xb_add(&bar[XB_XCNT(b.x)], 1u);
    return b;
}
__device__ __forceinline__ void xcd_barrier_complete(unsigned* bar, unsigned x, unsigned& nloc, unsigned& nx) {
    const unsigned G = gridDim.x * gridDim.y * gridDim.z;
    unsigned sum, cnt, mine, sp = 0u;
    for (;;) {
        sum = 0u; cnt = 0u; mine = 0u;
#pragma unroll
        for (unsigned j = 0; j < 16; ++j) { const unsigned c = xb_ld(&bar[XB_XCNT(j)]); sum += c; cnt += (c > 0u) ? 1u : 0u; mine = (j == x) ? c : mine; }
        if (sum == G) break;
        __builtin_amdgcn_s_sleep(1);
        if ((++sp & 255u) == 0u) { if (xb_ld(&bar[XB_TMO])) break; if (sp > XB_SPIN_CAP) { atomicAdd(&bar[XB_TMO], 1u); break; } }
    }
    nloc = mine > 0u ? mine : 1u; nx = cnt > 0u ? cnt : 1u;
}
__device__ __forceinline__ void xcd_barrier(const XcdBarrier& b) {
    asm volatile("s_waitcnt vmcnt(0)" ::: "memory");
    __syncthreads();
    if (threadIdx.x == 0) {
        unsigned* bar = b.bar;
        __builtin_amdgcn_s_waitcnt(0);
        unsigned nloc = b.st[0], nx = b.st[1];
        if (nloc == 0u) { xcd_barrier_complete(bar, b.x, nloc, nx); b.st[0] = nloc; b.st[1] = nx; }
        const unsigned old = xb_add(&bar[XB_XSUB(b.x)], 1u);
        const unsigned gen = old / nloc;
        if (old + 1u == (gen + 1u) * nloc) {
            __builtin_amdgcn_fence(__ATOMIC_RELEASE, "agent");
            asm volatile("s_waitcnt vmcnt(0)" ::: "memory");
            const unsigned og = xb_add(&bar[XB_TOP], 1u);
            const unsigned tg = og / nx;
            if (og + 1u == (tg + 1u) * nx) xb_add(&bar[XB_TOPGEN], 1u);
            else XB_SPIN(xb_ld(&bar[XB_TOPGEN]) == tg, bar);
            __builtin_amdgcn_fence(__ATOMIC_ACQUIRE, "agent");
            xb_add(&bar[XB_XGEN(b.x)], 1u);
            asm volatile("s_waitcnt vmcnt(0)" ::: "memory");
        } else {
            XB_SPIN(xb_ld(&bar[XB_XGEN(b.x)]) == gen, bar);
            __builtin_amdgcn_fence(__ATOMIC_ACQUIRE, "agent");
            asm volatile("s_waitcnt vmcnt(0)" ::: "memory");
        }
    }
    __syncthreads();
}

constexpr int RING_BYTES = 131072, LDSCTL_OFF = RING_BYTES, LDS_BYTES = 147456;
constexpr int CW_BAR = 4096;
constexpr int CW_XCNT = 16384;
constexpr int CW_XTMO = 8192;
#ifdef FUSED_FINAL
constexpr int N_PHASES = 13;
#else
constexpr int N_PHASES = 14;
#endif

__device__ __forceinline__ void setup_job(const Params& P, int j, pg8::Gemm& g, pg8::Epi& E) {
    unsigned char* ws = P.ws;
    E.out = nullptr; E.ldc = 0; E.ncols = 1 << 30; E.out2 = nullptr; E.ldc2 = 0; E.split = 1 << 30; E.rs = nullptr; E.rs_mode = 0; E.rs_invdim = 0.f;
    E.ssqA = nullptr; E.ssqB = nullptr; E.ssq_mode = 0; E.rope = (const float2*)(ws + WS_ROPE); E.rope_mode = 0; E.hm_mode = 0;
    E.after = 0; E.fbase = nullptr; E.fout = nullptr; E.fgain = nullptr; E.xslots = (unsigned*)(ws + WS_XSL); E.xcnt = (unsigned*)(ws + WS_CTL) + CW_XCNT; E.xtmo = (unsigned*)(ws + WS_CTL) + CW_XTMO;
    g.M = T; g.lda = 1024; g.apn = 0;
    switch (j) {
    case 0: g.A = (const bf16_t*)(ws + WS_XB); g.Bt = (const bf16_t*)(ws + WS_WINA); g.N = 2048; g.K = 1024;
        E.out = (bf16_t*)(ws + WS_G); E.ldc = G1W; E.rs = (const float*)(ws + WS_RSTD); E.rs_mode = 1; E.ssqA = (float*)(ws + WS_SSQA); E.ssqB = (float*)(ws + WS_SSQB); E.ssq_mode = 1; E.rope_mode = 1; break;
    case 1: g.A = (const bf16_t*)(ws + WS_MEMN); g.Bt = (const bf16_t*)(ws + WS_WMKV); g.M = NB * NMEM; g.N = 1024; g.K = 1024;
        E.out = (bf16_t*)(ws + WS_KVM); E.ldc = 1024; break;
    case 2: g.A = (const bf16_t*)(ws + WS_G) + G1_CQ; g.lda = G1W; g.Bt = (const bf16_t*)(ws + WS_WUQ); g.N = 1280; g.K = 384;
        E.out = (bf16_t*)(ws + WS_Q); E.ldc = QW; E.ncols = QW; E.rs = (const float*)(ws + WS_SSQA); E.rs_mode = 2; E.rs_invdim = 1.f / 384.f; E.rope_mode = 2; break;
    case 3: g.A = (const bf16_t*)(ws + WS_G) + G1_CKV; g.lda = G1W; g.Bt = (const bf16_t*)(ws + WS_WUKV); g.N = 1536; g.K = 256;
        E.out = (bf16_t*)(ws + WS_KN); E.ldc = 768; E.out2 = (bf16_t*)(ws + WS_V); E.ldc2 = 768; E.split = 768; E.rs = (const float*)(ws + WS_SSQB); E.rs_mode = 2; E.rs_invdim = 1.f / 256.f; break;
    case 4: g.A = (const bf16_t*)(ws + WS_Y); g.Bt = (const bf16_t*)(ws + WS_WOA); g.N = 1024; g.K = 1024; E.out = (bf16_t*)(ws + WS_Z); E.ldc = 1024; break;
    case 5: g.A = (const bf16_t*)(ws + WS_XB); g.Bt = (const bf16_t*)(ws + WS_WINB); g.N = G2W; g.K = 1024;
        E.out = (bf16_t*)(ws + WS_G); E.ldc = G2W; E.rs = (const float*)(ws + WS_RSTD); E.rs_mode = 1; break;
    case 6: g.A = (const bf16_t*)(ws + WS_UC); g.lda = 768; g.apn = 192; g.Bt = (const bf16_t*)(ws + WS_WQK); g.N = 768; g.K = 384; E.out = (bf16_t*)(ws + WS_QK); E.ldc = 768; E.hm_mode = 1; break;
    case 7: g.A = (const bf16_t*)(ws + WS_G) + G2_U; g.lda = G2W; g.apn = 192; g.Bt = (const bf16_t*)(ws + WS_WV); g.N = 768; g.K = 384; E.out = (bf16_t*)(ws + WS_VV); E.ldc = 768; E.hm_mode = 1; break;
    default: g.A = (const bf16_t*)(ws + WS_Y2); g.Bt = (const bf16_t*)(ws + WS_WOB); g.N = 1024; g.K = 1024;
#ifdef FUSED_FINAL
        E.after = 1; E.fbase = P.out; E.fout = P.out; E.fgain = P.b_post_g; E.xcnt = (unsigned*)(ws + WS_CTL) + CW_XCNT + (j - 8) * 128 * 64;
#else
        E.out = (bf16_t*)(ws + WS_Z); E.ldc = 1024;
#endif
        break;
    }
}

__device__ __forceinline__ void phase_memattn(const Params& P, const Wk& W, LAS unsigned char* lds, int L) {
    unsigned char* ws = P.ws;
    const bf16_t* G = (const bf16_t*)(ws + WS_G); const bf16_t* KVM = (const bf16_t*)(ws + WS_KVM);
    const int gpitch = L ? G2W : G1W, qm_off = L ? G2_QM : G1_QM, gate_off = L ? G2_GATE : G1_GATE;
    bf16_t* Yb = (bf16_t*)(ws + (L ? WS_Y2 : WS_Y));
    for (int u = W.vcu; u < 512; u += W.G) {
        const int rb = u >> 2, hm = u & 3, row0 = rb * 256, b = row0 / SEQ;
        const bf16_t* Km = KVM + (size_t)(b * NMEM) * 1024 + L * 512 + hm * 64;
        att::attn_unit<64, 64, false>(G + (size_t)row0 * gpitch + qm_off + hm * 64, gpitch, Km, 1024, 8, Km, 1024, Km + 256, 1024, 4, 0,
                                      G + (size_t)row0 * gpitch + gate_off + 768 + hm * 64, gpitch, Yb + (size_t)row0 * DM + 768 + hm * 64, DM, lds, W.tid);
    }
}
template <int ABL>
__device__ __forceinline__ void phase_attn(const Params& P, const Wk& W, LAS unsigned char* lds) {
    unsigned char* ws = P.ws;
    const bf16_t* G = (const bf16_t*)(ws + WS_G); const bf16_t* Qp = (const bf16_t*)(ws + WS_Q); const bf16_t* KN = (const bf16_t*)(ws + WS_KN); const bf16_t* Vp = (const bf16_t*)(ws + WS_V);
    bf16_t* Yb = (bf16_t*)(ws + (ABL ? WS_Z : WS_Y));
    for (int u = W.vcu; u < 768; u += W.G) {
        const int k = u >> 8, cu = u & 255, grp = cu >> 4, i = cu & 15, bh = grp * 3 + k;
        const int qb = (k == 0) ? i : (k == 1) ? ((i + 8) & 15) : (i < 8 ? 15 - 2 * i : 30 - 2 * i);
        const int b = bh / 6, h = bh % 6; const size_t rowb = (size_t)b * SEQ, row0 = rowb + (size_t)qb * 256;
        int tid_u = W.tid; asm volatile("" : "+v"(tid_u));
        att::attn_unit<192, 128, true, ABL>(Qp + row0 * QW + h * 192, QW, KN + rowb * 768 + h * 128, 768, 16, G + rowb * G1W + G1_KR, G1W, Vp + rowb * 768 + h * 128, 768,
                                       4 * (qb + 1), qb * 256, G + row0 * G1W + G1_GATE + h * 128, G1W, Yb + row0 * DM + h * 128, DM, lds, tid_u);
    }
}

__global__ void __launch_bounds__(512, 2) mega_fwd(Params P) {
    extern __shared__ __attribute__((aligned(16))) unsigned char lds_raw[];
    LAS unsigned char* lds = (LAS unsigned char*)lds_raw;
    Wk W; W.tid = threadIdx.x; W.lane = W.tid & 63; W.wave = __builtin_amdgcn_readfirstlane(W.tid >> 6);
    W.G = gridDim.x; { const int bx = blockIdx.x; W.vcu = (W.G % 8 == 0) ? (bx % 8) * (W.G / 8) + bx / 8 : bx; }
    volatile LAS unsigned* MISC = (volatile LAS unsigned*)(lds + LDSCTL_OFF);
    if (W.tid < 64) MISC[W.tid] = 0u;
    __syncthreads();
    const int lo = P.ph_lo, hi = P.ph_hi;
    const int vcu_s = W.vcu;
    const int wave_s = __builtin_amdgcn_readfirstlane(threadIdx.x >> 6);
    XcdBarrier bar; bar.bar = (unsigned*)(P.ws + WS_CTL) + CW_BAR; bar.x = 0; bar.st = nullptr;
    if (hi - lo > 1) bar = xcd_barrier_post((unsigned*)(P.ws + WS_CTL) + CW_BAR, MISC + 8);
#ifndef PROBE_REP
#define PROBE_REP 0
#endif
#ifdef PROBE_PAIR
    bool pair_done = false;
#endif
    for (int ph2 = 2 * lo; ph2 < 2 * hi; ++ph2) {
        const int ph = ph2 >> 1;
        if ((ph2 & 1) && !((PROBE_REP >> ph) & 1)) continue;
        const bool more_ = (ph + 1 < hi) || (!(ph2 & 1) && ((PROBE_REP >> ph) & 1));
        { int t_; asm volatile("v_mbcnt_lo_u32_b32 %0, -1, 0\n\tv_mbcnt_hi_u32_b32 %0, -1, %0" : "=v"(t_)); t_ += wave_s * 64; { int g_ = gridDim.x, v_ = vcu_s; asm volatile("" : "+s"(g_), "+s"(v_)); W.G = g_; W.vcu = v_; } W.tid = t_; W.lane = t_ & 63; W.wave = __builtin_amdgcn_readfirstlane(t_ >> 6); }
        int j0 = 0, j1 = 0;
#ifdef DBG_CUT
        if (ph == 100) { const bf16_t* src = (const bf16_t*)(P.ws + (size_t)DBG_OFF); const int gt_ = W.vcu * 512 + W.tid, NGT_ = W.G * 512; for (int i = gt_; i < T * DM; i += NGT_) {
#ifdef DBG_F32N
            P.out[i] = (i < DBG_F32N) ? ((const float*)src)[i] : 0.f;
#else
            P.out[i] = bf2f(src[i]);
#endif
            } continue; }
#endif
#ifndef PHM
#define PHM 0xffff
#endif
#define PHON(k) ((PHM >> (k)) & 1)
        switch (ph) {
        case 0: if (PHON(0)) phase_prologue(P, W, lds); break;
        case 1: j0 = 0; j1 = 1; break;
        case 2: j0 = 1; j1 = 4; break;
        case 3: if (PHON(3)) {
#ifdef PROBE_ABL
            if (ph2 & 1) phase_attn<PROBE_ABL>(P, W, lds); else
#endif
            phase_attn<0>(P, W, lds); } break;
        case 4: j0 = 4; j1 = 5; break;
        case 5: if (PHON(5)) phase_rowmid(P, W, lds); break;
        case 6: j0 = 5; j1 = 6; break;
        case 7: if (PHON(7)) phase_conv(P, W); break;
        case 8: j0 = 6; j1 = 8; break;
        case 9: if (PHON(9)) ml::pass1_phase(P, W, lds); break;
        case 10: if (PHON(10)) { ml::pass2(P, W);
#ifndef NO_FIRST_TOKEN
            first_token_qk(P, W, lds);
#endif
            } break;
        case 11: if (PHON(11)) ml::pass3_phase(P, W, lds); break;
#ifdef FUSED_FINAL
        case 12: j0 = 8; j1 = 10; break;
        default: break;
#else
        case 12: j0 = 8; j1 = 9; break;
        default: if (PHON(13)) phase_rowfinal(P, W); break;
#endif
        }
        if (PHON(14) && (ph == 3 || ph == 9) && !(ph2 & 1)) phase_memattn(P, W, lds, ph == 9 ? 1 : 0);
        if (PHON(1)) for (int j = j0; j < j1; ++j) {
            pg8::Gemm g; pg8::Epi E; setup_job(P, j, g, E);
            const int shift = (j == 1) ? 128 : (j == 7) ? 128 : 0;
            pg8::StaticOrder S; S.init(g.M, g.N, W.G, (int)((blockIdx.x + shift) % W.G));
#ifdef FUSED_FINAL
            if (j >= 8) { S.i0 = j - 8; S.nmax = 1; }
#endif
            if (j == 2 && W.G == 256) S.give_lo = 128;
            pg8::gemm_phase<true>(lds, g, S, E, W.tid);
        }
#ifndef NO_FIRST_TOKEN
        if (ph == 6) { const int half = W.G / 2, nwk = W.G - half;
            if ((int)blockIdx.x >= half) for (int widx = (int)blockIdx.x - half; widx < 128; widx += nwk) first_token_u0(P, W, lds, widx); }
#endif
        if (more_) xcd_barrier(bar);
#ifdef PROBE_PAIR
        if (ph == PROBE_PAIR + 1 && !pair_done) { pair_done = true; ph2 = 2 * PROBE_PAIR - 1; }
#endif
    }
}

extern "C" void kernel_launch(void* const* d_in, const int* in_sizes, int n_in, void* d_out, int out_size, void* d_ws, size_t ws_size, hipStream_t stream) {
    static int grid = 0;
    if (grid == 0) {
        if (n_in != 27 || in_sizes[0] != T * DM || out_size != T * DM || ws_size < WS_END) {
            fprintf(stderr, "kernel_launch: unexpected shapes (n_in %d in0 %d out %d ws %zu)\n", n_in, n_in > 0 ? in_sizes[0] : -1, out_size, ws_size); grid = -1; return; }
        int dev = 0, cus = 0, per_cu = 0;
        if (hipGetDevice(&dev) != hipSuccess || hipDeviceGetAttribute(&cus, hipDeviceAttributeMultiprocessorCount, dev) != hipSuccess) { grid = -1; return; }
        if (hipFuncSetAttribute((const void*)mega_fwd, hipFuncAttributeMaxDynamicSharedMemorySize, LDS_BYTES) != hipSuccess) { fprintf(stderr, "kernel_launch: hipFuncSetAttribute failed\n"); grid = -1; return; }
        if (hipOccupancyMaxActiveBlocksPerMultiprocessor(&per_cu, (const void*)mega_fwd, 512, LDS_BYTES) != hipSuccess || per_cu < 1) { fprintf(stderr, "kernel_launch: occupancy query says %d\n", per_cu); }
        (void)hipGetLastError();
        grid = cus;
    }
    if (grid < 0) return;
    (void)hipMemsetAsync((char*)d_ws + WS_CTL, 0, CTL_ZERO_BYTES, stream);
    Params p{};
    const float** fp = (const float**)&p.a_pre_g;
    p.x = (const float*)d_in[0]; p.mem = (const float*)d_in[1]; p.pos = (const int*)d_in[2];
    for (int i = 0; i < 24; ++i) fp[i] = (const float*)d_in[3 + i];
    p.out = (float*)d_out; p.ws = (unsigned char*)d_ws;
#ifndef N_LAUNCH_SPLIT
#define N_LAUNCH_SPLIT 0
#endif
#ifdef DBG_CUT
    for (int ph = 0; ph < DBG_CUT; ++ph) { p.ph_lo = ph; p.ph_hi = ph + 1; hipLaunchKernelGGL(mega_fwd, dim3(grid), dim3(512), LDS_BYTES, stream, p); }
    p.ph_lo = 100; p.ph_hi = 101; hipLaunchKernelGGL(mega_fwd, dim3(grid), dim3(512), LDS_BYTES, stream, p);
#elif N_LAUNCH_SPLIT
    for (int ph = 0; ph < N_PHASES; ++ph) { p.ph_lo = ph; p.ph_hi = ph + 1; hipLaunchKernelGGL(mega_fwd, dim3(grid), dim3(512), LDS_BYTES, stream, p); }
#else
    p.ph_lo = 0; p.ph_hi = N_PHASES; hipLaunchKernelGGL(mega_fwd, dim3(grid), dim3(512), LDS_BYTES, stream, p);
#endif
}
```

```cpp
#include <hip/hip_runtime.h>
#include <cstdio>
#include <cstdint>

#define LAS __attribute__((address_space(3)))
#define GAS __attribute__((address_space(1)))
typedef unsigned short bf16_t;
typedef short bf16x8 __attribute__((ext_vector_type(8)));
typedef short s16x4 __attribute__((ext_vector_type(4)));
typedef float f32x4 __attribute__((ext_vector_type(4)));
typedef float f32x16 __attribute__((ext_vector_type(16)));
typedef unsigned u32x4 __attribute__((ext_vector_type(4)));
typedef unsigned u32x2 __attribute__((ext_vector_type(2)));

constexpr int NB = 8, SEQ = 4096, DM = 1024, T = NB * SEQ;
constexpr int NMEM = 256;
constexpr float EPS = 1e-6f;
constexpr int A_IN = 1984, B_IN = 2824;
constexpr int G1W = 2048;
constexpr int G1_CKV = 0, G1_CQ = 256, G1_KR = 640, G1_QM = 768, G1_GATE = 1024;
constexpr int G2W = 2816;
constexpr int G2_U = 0, G2_O = 768, G2_QM = 1536, G2_GATE = 1792;
constexpr int QW = 1152;
constexpr float LOG2E = 1.4426950408889634f;
constexpr float QSCALE = 0.07216878364870323f * LOG2E;
constexpr float MSCALE = 0.125f * LOG2E;
constexpr float KSCALE_B = 0.10206207261596577f;

constexpr size_t MiB = 1u << 20;
constexpr size_t WS_CTL = 0, CTL_ZERO_BYTES = 512 * 1024;
constexpr size_t WS_WINA = 2 * MiB;
constexpr size_t WS_WUQ = 6 * MiB;
constexpr size_t WS_WUKV = 7 * MiB;
constexpr size_t WS_WMKV = 8 * MiB;
constexpr size_t WS_WOA = 10 * MiB;
constexpr size_t WS_WINB = 12 * MiB;
constexpr size_t WS_WQK = 18 * MiB;
constexpr size_t WS_WV = 19 * MiB;
constexpr size_t WS_WOB = 20 * MiB;
constexpr size_t WS_WG = 22 * MiB;
constexpr size_t WS_RSTD = 23 * MiB;
constexpr size_t WS_SSQA = WS_RSTD + 128 * 1024;
constexpr size_t WS_SSQB = WS_SSQA + 128 * 1024;
constexpr size_t WS_ROPE = 24 * MiB;
constexpr size_t WS_MEMN = 32 * MiB;
constexpr size_t WS_KVM = 36 * MiB;
constexpr size_t WS_IFP = 40 * MiB;
constexpr size_t WS_BL = 41 * MiB;
constexpr size_t WS_MLOC = WS_BL + 8192;
constexpr size_t WS_MST = WS_MLOC + 8192;
constexpr size_t WS_C0 = WS_MST + 8192;
constexpr size_t WS_U0 = WS_C0 + 1024;
constexpr size_t WS_RS = 46 * MiB;
constexpr size_t WS_RN = 45 * MiB + 256 * 1024;
constexpr size_t WS_RBL = 45 * MiB + 512 * 1024;
constexpr size_t WS_X1F = 45 * MiB;
constexpr size_t WS_XSL = 44 * MiB;
constexpr size_t WS_DN = 42 * MiB;
constexpr size_t WS_DC = 56 * MiB;
constexpr size_t WS_XB = 64 * MiB;
constexpr size_t WS_Y = 64 * MiB;
constexpr size_t WS_G = 128 * MiB;
constexpr size_t WS_Q = 304 * MiB;
constexpr size_t WS_KN = 376 * MiB;
constexpr size_t WS_V = 424 * MiB;
constexpr size_t WS_Z = 304 * MiB;
constexpr size_t WS_UC = 304 * MiB;
constexpr size_t WS_QK = 352 * MiB;
constexpr size_t WS_VV = 400 * MiB;
constexpr size_t WS_Y2 = 448 * MiB;
constexpr size_t WS_END = 512 * MiB;

typedef float f32x2_t __attribute__((ext_vector_type(2))); typedef __bf16 bf16x2_t __attribute__((ext_vector_type(2)));
__device__ __forceinline__ unsigned cvt_pk_bf16(float lo, float hi) { f32x2_t v = {lo, hi}; bf16x2_t b = __builtin_convertvector(v, bf16x2_t); return __builtin_bit_cast(unsigned, b); }
__device__ __forceinline__ float bf2f(unsigned short b) { return __uint_as_float((unsigned)b << 16); }
__device__ __forceinline__ float bflo(unsigned w) { return __uint_as_float(w << 16); }
__device__ __forceinline__ float bfhi(unsigned w) { return __uint_as_float(w & 0xffff0000u); }
__device__ __forceinline__ unsigned short f2bf(float f) { return (unsigned short)(cvt_pk_bf16(f, f) & 0xffffu); }
__device__ __forceinline__ float wave_sum(float v) {
#pragma unroll
    for (int o = 1; o < 64; o <<= 1) v += __shfl_xor(v, o);
    return v;
}
__device__ __forceinline__ float wave_max(float v) {
#pragma unroll
    for (int o = 1; o < 64; o <<= 1) v = fmaxf(v, __shfl_xor(v, o));
    return v;
}
__device__ __forceinline__ float silu_f(float g) { return g * __builtin_amdgcn_rcpf(1.f + __expf(-g)); }
__device__ __forceinline__ float sigmoid_f(float g) { return __builtin_amdgcn_rcpf(1.f + __expf(-g)); }
namespace pg8 {
constexpr int BM = 256, BK = 64, HALF = 128, HTB = HALF * BK * 2  , STAGE_BYTES = 8 * HTB, NXCD = 8, WGM = 8;
__host__ __device__ __forceinline__ int lds_byte(int r, int c) { const int st = (r >> 4) * 2 + (c >> 5), rr = r & 15, cc = c & 31, ob = rr * 64 + cc * 2; return st * 1024 + (ob ^ (((ob >> 9) & 1) << 5)); }
__host__ __device__ __forceinline__ void stage_rc(int b, int& R, int& C) { const int st = b / 1024, sb = b % 1024, swz = sb ^ (((sb >> 9) & 1) << 5); R = (st >> 1) * 16 + swz / 64; C = (st & 1) * 32 + (swz % 64) / 2; }
__host__ __device__ __forceinline__ int perm32(int rho) { const int n = rho >> 4, i = rho & 15; return 8 * (i >> 2) + 4 * n + (i & 3); }

struct Unit { int pm, pn; };
struct Gemm { const bf16_t* A; const bf16_t* Bt; int M, N, K, lda, apn; };

struct StaticOrder {
    int nM, nN, nwg, G, c, i0, nmax;
    int give_lo;
    __host__ __device__ void init(int M, int N, int G_, int c_) { nM = M / BM; nN = N / BM; nwg = nM * nN; G = G_; c = c_; i0 = 0; nmax = 1 << 30; give_lo = -1; }
    __host__ __device__ bool next(int i, Unit& u) const {
        if (i >= nmax) return false;
        long L = (long)(i + i0) * G + c;
        if (give_lo >= 0) { if (c >= give_lo && c < give_lo + 32 && i == 1) return false; if (c >= give_lo + 32 && c < give_lo + 64 && i == 2) L = (long)G + (c - 32); }
        if (L >= nwg) return false;
        int wgid = (int)L; { const int q = nwg / NXCD, r = nwg % NXCD, xcd = wgid % NXCD, off = wgid / NXCD; wgid = (xcd < r ? xcd * (q + 1) : r * (q + 1) + (xcd - r) * q) + off; }
        const int nig = WGM * nN, gid = wgid / nig, fm = gid * WGM, gsz = (nM - fm) < WGM ? (nM - fm) : WGM;
        u.pm = fm + ((wgid % nig) % gsz); u.pn = (wgid % nig) / gsz; return true;
    }
};

__device__ __forceinline__ void rope8(float (&v)[8], const float2* rp) {
#pragma unroll
    for (int j = 0; j < 4; ++j) { const float2 cs = rp[j]; const float x1 = v[2 * j], x2 = v[2 * j + 1]; v[2 * j] = x1 * cs.x - x2 * cs.y; v[2 * j + 1] = x1 * cs.y + x2 * cs.x; }
}
struct Epi {
    bf16_t* out; int ldc; int ncols;
    bf16_t* out2; int ldc2; int split;
    const float* rs; int rs_mode; float rs_invdim;
    float* ssqA; float* ssqB; int ssq_mode;
    const float2* rope; int rope_mode;
    int hm_mode;
    int after; const float* fbase; float* fout; const float* fgain; unsigned* xslots; unsigned* xcnt; unsigned* xtmo;
    __device__ __forceinline__ void fused(const f32x4 (&acc)[2][2][4][2], const Unit& u, int wr, int wc, int fr, int fq, LAS unsigned char* lds, int wid, int lane) const {
        LAS float* Pp = (LAS float*)lds;
        LAS float* Sr = (LAS float*)(lds + 4096);
        LAS unsigned* flag = (LAS unsigned*)(lds + 4096 + 1024);
#pragma unroll
        for (int ai = 0; ai < 2; ++ai)
#pragma unroll
            for (int m = 0; m < 4; ++m) { float s = 0.f;
#pragma unroll
                for (int bj = 0; bj < 2; ++bj)
#pragma unroll
                    for (int n = 0; n < 2; ++n) { const f32x4 x = acc[ai][bj][m][n]; s += (x[0] * x[0] + x[1] * x[1]) + (x[2] * x[2] + x[3] * x[3]); }
                s += __shfl_xor(s, 16); s += __shfl_xor(s, 32);
                if (fq == 0) Pp[(ai * HALF + wr * 64 + m * 16 + fr) * 4 + wc] = s; }
        asm volatile("s_waitcnt lgkmcnt(0)" ::: "memory"); __builtin_amdgcn_s_barrier(); asm volatile("" ::: "memory");
        const int row = wid * 32 + (lane & 31);
        if (lane < 32) { const float t = (Pp[row * 4 + 0] + Pp[row * 4 + 1]) + (Pp[row * 4 + 2] + Pp[row * 4 + 3]);
            __hip_atomic_store(xslots + ((size_t)(u.pm * BM + row) * 4 + u.pn), __float_as_uint(t), __ATOMIC_RELAXED, __HIP_MEMORY_SCOPE_AGENT); }
        asm volatile("s_waitcnt vmcnt(0)" ::: "memory");
        if (lane == 0) __hip_atomic_fetch_add(xcnt + 64 * u.pm, 1u, __ATOMIC_RELAXED, __HIP_MEMORY_SCOPE_AGENT);
        if (wid == 0) { bool dead = false; const unsigned long long t0 = __builtin_amdgcn_s_memrealtime();
            for (;;) {
                if ((unsigned)__builtin_amdgcn_readfirstlane(__hip_atomic_load(xcnt + 64 * u.pm, __ATOMIC_RELAXED, __HIP_MEMORY_SCOPE_AGENT)) >= 32u) break;
                if (__builtin_amdgcn_s_memrealtime() - t0 > 2000000ull) { if (lane == 0) __hip_atomic_store(xtmo, 1u, __ATOMIC_RELAXED, __HIP_MEMORY_SCOPE_AGENT); dead = true; break; }
                __builtin_amdgcn_s_sleep(2); }
            __builtin_amdgcn_fence(__ATOMIC_ACQUIRE, "agent");
            if (lane == 0) flag[0] = dead ? 1u : 0u; }
        asm volatile("s_waitcnt vmcnt(0) lgkmcnt(0)" ::: "memory"); __builtin_amdgcn_s_barrier(); asm volatile("" ::: "memory");
        const bool bad = flag[0] != 0u;
        if (lane < 32) { const unsigned* sl = xslots + (size_t)(u.pm * BM + row) * 4; float q = 0.f;
#pragma unroll
            for (int t = 0; t < 4; ++t) q += __uint_as_float(__hip_atomic_load(sl + t, __ATOMIC_RELAXED, __HIP_MEMORY_SCOPE_AGENT));
            Sr[row] = rsqrtf(q * (1.f / 1024.f) + EPS); }
        asm volatile("s_waitcnt vmcnt(0) lgkmcnt(0)" ::: "memory"); __builtin_amdgcn_s_barrier(); asm volatile("" ::: "memory");
        const float qnan = __builtin_nanf("");
#pragma unroll
        for (int ai = 0; ai < 2; ++ai)
#pragma unroll
            for (int m = 0; m < 4; ++m) { const int r = ai * HALF + wr * 64 + m * 16 + fr; const float rs_ = bad ? qnan : Sr[r];
#pragma unroll
                for (int bj = 0; bj < 2; ++bj) { const int col0 = u.pn * BM + bj * HALF + wc * 32 + 8 * fq; const size_t off = (size_t)(u.pm * BM + r) * 1024 + col0;
                    *(f32x4*)(fout + off) = *(const f32x4*)(fbase + off) + acc[ai][bj][m][0] * rs_ * *(const f32x4*)(fgain + col0);
                    *(f32x4*)(fout + off + 4) = *(const f32x4*)(fbase + off + 4) + acc[ai][bj][m][1] * rs_ * *(const f32x4*)(fgain + col0 + 4); } }
        asm volatile("s_waitcnt lgkmcnt(0)" ::: "memory"); __builtin_amdgcn_s_barrier(); asm volatile("" ::: "memory");
    }
    __device__ __forceinline__ void operator()(const f32x4 (&acc)[2][2][4][2], const Unit& u, int wr, int wc, int fr, int fq) const {
#pragma unroll
        for (int ai = 0; ai < 2; ++ai)
#pragma unroll
            for (int m = 0; m < 4; ++m) {
                const int row = u.pm * BM + ai * HALF + wr * 64 + m * 16 + fr;
                float sc = 1.f;
                if (rs_mode == 1) sc = rs[row]; else if (rs_mode == 2) sc = rsqrtf(rs[row] * rs_invdim + EPS);
                float ss = 0.f;
#pragma unroll
                for (int bj = 0; bj < 2; ++bj) {
                    const int col0 = u.pn * BM + bj * HALF + wc * 32 + 8 * fq;
                    float v[8];
#pragma unroll
                    for (int j = 0; j < 4; ++j) { v[j] = acc[ai][bj][m][0][j] * sc; v[4 + j] = acc[ai][bj][m][1][j] * sc; }
                    if (ssq_mode == 1 && (u.pn < 2 || (u.pn == 2 && bj == 0))) {
#pragma unroll
                        for (int j = 0; j < 8; ++j) ss += v[j] * v[j];
                    }
                    if (rope_mode == 1) { if (col0 >= 640 && col0 < 704) rope8(v, rope + (size_t)row * 32 + ((col0 - 640) >> 1)); }
                    else if (rope_mode == 2) { const int d = col0 % 192; if (d >= 128) rope8(v, rope + (size_t)row * 32 + ((d - 128) >> 1)); }
                    if (col0 < ncols) {
                        u32x4 w; w.x = cvt_pk_bf16(v[0], v[1]); w.y = cvt_pk_bf16(v[2], v[3]); w.z = cvt_pk_bf16(v[4], v[5]); w.w = cvt_pk_bf16(v[6], v[7]);
                        if (hm_mode) { const int hh = col0 / 192, jj = col0 - hh * 192; *(u32x4*)(out + ((size_t)((row >> 12) * 4 + hh) * SEQ + (row & (SEQ - 1))) * 192 + jj) = w; }
                        else if (col0 < split) *(u32x4*)(out + (size_t)row * ldc + col0) = w;
                        else *(u32x4*)(out2 + (size_t)row * ldc2 + (col0 - split)) = w;
                    }
                }
                if (ssq_mode == 1 && u.pn <= 2) {
                    ss += __shfl_xor(ss, 16); ss += __shfl_xor(ss, 32);
                    if (fq == 0) atomicAdd((u.pn == 0 ? ssqB : ssqA) + row, ss);
                }
            }
    }
};

template <bool ALIGN_EPI>
__device__ __forceinline__ void gemm_phase(LAS unsigned char* lds, const Gemm g, const StaticOrder& S, const Epi& E, const int tid) {
    const int wid = __builtin_amdgcn_readfirstlane(tid >> 6), lane = tid & 63, wr = wid >> 2, wc = wid & 3, fr = lane & 15, fq = lane >> 4;
    const int K = g.K, nt = K / BK, lda = g.lda;
    unsigned voffA[2], voffB[2];
#pragma unroll
    for (int i = 0; i < 2; ++i) { int R, C; stage_rc(tid * 16 + i * 8192, R, C); const int Rb = (R & ~31) + perm32(R & 31);
        voffA[i] = (unsigned)(R * lda + C) * 2u; voffB[i] = (unsigned)(Rb * K + C) * 2u; }
    const size_t kstep = (size_t)(BK * 2);
    const size_t hstepA = (size_t)HALF * lda * 2, hstepB = (size_t)HALF * K * 2;
    const size_t tstepA = 2 * hstepA, tstepB = 2 * hstepB;
    const unsigned ldsw = (unsigned)wid * 1024u;
    const int aoff = lds_byte(wr * 64 + fr, fq * 8), boff = lds_byte(wc * 32 + fr, fq * 8);
#define PG8_SA(b, h) (((b) * 2 + (h)) * HTB)
#define PG8_SB(b, h) ((4 + (b) * 2 + (h)) * HTB)
#define PG8_STAGE(bufoff, gbase, voff) do { _Pragma("unroll") for (int _i = 0; _i < 2; ++_i) \
        __builtin_amdgcn_global_load_lds((const unsigned*)((const char*)(gbase) + (voff)[_i]), (LAS unsigned*)(lds + (bufoff) + ldsw + _i * 8192), 16, 0, 0); } while (0)
#define PG8_LDA(dst, b, h) do { _Pragma("unroll") for (int m = 0; m < 4; ++m) _Pragma("unroll") for (int k = 0; k < 2; ++k) dst[m][k] = *(const LAS bf16x8*)(lds + PG8_SA(b, h) + aoff + m * 2048 + k * 1024); } while (0)
#define PG8_LDB(dst, b, h) do { _Pragma("unroll") for (int n = 0; n < 2; ++n) _Pragma("unroll") for (int k = 0; k < 2; ++k) dst[n][k] = *(const LAS bf16x8*)(lds + PG8_SB(b, h) + boff + n * 2048 + k * 1024); } while (0)
#define PG8_MMA(ai, bj, At, Bt) do { __builtin_amdgcn_s_setprio(1); _Pragma("unroll") for (int m = 0; m < 4; ++m) _Pragma("unroll") for (int n = 0; n < 2; ++n) _Pragma("unroll") for (int k = 0; k < 2; ++k) \
        acc[ai][bj][m][n] = __builtin_amdgcn_mfma_f32_16x16x32_bf16(Bt[n][k], At[m][k], acc[ai][bj][m][n], 0, 0, 0); __builtin_amdgcn_s_setprio(0); } while (0)
#define PG8_WAIT_V(n) asm volatile("s_waitcnt vmcnt(" #n ")" ::: "memory")
#define PG8_WAIT_L(n) asm volatile("s_waitcnt lgkmcnt(" #n ")" ::: "memory")
#define PG8_BAR __builtin_amdgcn_s_barrier()
#define PG8_SCHED __builtin_amdgcn_sched_barrier(0)
    Unit cur, nxt; int ui = 0;
    if (!S.next(0, cur)) return;
    f32x4 acc[2][2][4][2];
#pragma unroll
    for (int a = 0; a < 2; ++a)
#pragma unroll
        for (int b = 0; b < 2; ++b)
#pragma unroll
            for (int m = 0; m < 4; ++m)
#pragma unroll
                for (int n = 0; n < 2; ++n) acc[a][b][m][n] = (f32x4){0.f, 0.f, 0.f, 0.f};
    bf16x8 At[4][2], B0[2][2], B1[2][2];
    const char* cA = (const char*)g.A + (size_t)cur.pm * tstepA + (size_t)cur.pn * g.apn * 2; const char* cB = (const char*)g.Bt + (size_t)cur.pn * tstepB;
    PG8_STAGE(PG8_SB(0, 0), cB, voffB); PG8_STAGE(PG8_SB(0, 1), cB + hstepB, voffB); PG8_STAGE(PG8_SA(0, 0), cA, voffA); PG8_STAGE(PG8_SA(0, 1), cA + hstepA, voffA);
    if (wr == 1) PG8_BAR;
    PG8_WAIT_V(2); PG8_BAR;
    PG8_STAGE(PG8_SB(1, 0), cB + kstep, voffB); PG8_STAGE(PG8_SA(1, 0), cA + kstep, voffA); PG8_STAGE(PG8_SB(1, 1), cB + hstepB + kstep, voffB);
    PG8_WAIT_V(6); PG8_BAR;
    for (;;) {
        const bool has_next = S.next(ui + 1, nxt);
        const char* nA = has_next ? (const char*)g.A + (size_t)nxt.pm * tstepA + (size_t)nxt.pn * g.apn * 2 : cA; const char* nB = has_next ? (const char*)g.Bt + (size_t)nxt.pn * tstepB : cB;
        for (int t = 0; t < nt; t += 2) {
            const bool last = (t == nt - 2);
            const char* a1 = cA + (size_t)(t + 1) * kstep;
            const char* a2 = last ? nA : cA + (size_t)(t + 2) * kstep; const char* b2 = last ? nB : cB + (size_t)(t + 2) * kstep;
            const char* a3 = a2 + kstep; const char* b3 = b2 + kstep;
            PG8_LDB(B0, 0, 0); PG8_LDB(B1, 0, 1); PG8_SCHED; PG8_LDA(At, 0, 0); PG8_STAGE(PG8_SA(1, 1), a1 + hstepA, voffA);
            PG8_WAIT_V(8); PG8_WAIT_L(0); PG8_BAR; PG8_MMA(0, 0, At, B0); PG8_MMA(0, 1, At, B1); PG8_BAR; PG8_SCHED;
            PG8_LDA(At, 0, 1); PG8_STAGE(PG8_SB(0, 0), b2, voffB); PG8_STAGE(PG8_SB(0, 1), b2 + hstepB, voffB); PG8_STAGE(PG8_SA(0, 0), a2, voffA);
            PG8_WAIT_V(8); PG8_WAIT_L(0); PG8_BAR; PG8_MMA(1, 0, At, B0); PG8_MMA(1, 1, At, B1); PG8_BAR; PG8_SCHED;
            PG8_LDB(B0, 1, 0); PG8_LDB(B1, 1, 1); PG8_SCHED; PG8_LDA(At, 1, 0); PG8_STAGE(PG8_SA(0, 1), a2 + hstepA, voffA);
            PG8_WAIT_V(8); PG8_WAIT_L(0); PG8_BAR; PG8_MMA(0, 0, At, B0); PG8_MMA(0, 1, At, B1); PG8_BAR; PG8_SCHED;
            PG8_LDA(At, 1, 1); PG8_STAGE(PG8_SB(1, 0), b3, voffB); PG8_STAGE(PG8_SB(1, 1), b3 + hstepB, voffB); PG8_STAGE(PG8_SA(1, 0), a3, voffA);
            PG8_WAIT_V(8); PG8_WAIT_L(0); PG8_BAR; PG8_MMA(1, 0, At, B0); PG8_MMA(1, 1, At, B1); PG8_BAR; PG8_SCHED;
        }
        if constexpr (ALIGN_EPI) { if (wr == 0) PG8_BAR; }
#ifdef FUSED_FINAL
        if (!E.after) E(acc, cur, wr, wc, fr, fq);
#else
        E(acc, cur, wr, wc, fr, fq);
#endif
        if (!has_next) break;
#pragma unroll
        for (int a = 0; a < 2; ++a)
#pragma unroll
            for (int b = 0; b < 2; ++b)
#pragma unroll
                for (int m = 0; m < 4; ++m)
#pragma unroll
                    for (int n = 0; n < 2; ++n) acc[a][b][m][n] = (f32x4){0.f, 0.f, 0.f, 0.f};
        cur = nxt; cA = nA; cB = nB; ++ui;
        if constexpr (ALIGN_EPI) { if (wr == 1) PG8_BAR; }
    }
    PG8_WAIT_V(0);
    if constexpr (!ALIGN_EPI) { if (wr == 0) PG8_BAR; }
    PG8_BAR;
#ifdef FUSED_FINAL
    if (E.after) E.fused(acc, cur, wr, wc, fr, fq, lds, wid, lane);
#endif
#undef PG8_SA
#undef PG8_SB
#undef PG8_STAGE
#undef PG8_LDA
#undef PG8_LDB
#undef PG8_MMA
#undef PG8_WAIT_V
#undef PG8_WAIT_L
#undef PG8_BAR
#undef PG8_SCHED
}
}
namespace att {
#define SBAR() __builtin_amdgcn_sched_barrier(0)
__device__ __forceinline__ int crow(int r, int hi) { return (r & 3) + 8 * (r >> 2) + 4 * hi; }
template <int DQK> __device__ __forceinline__ int kaddr(int row, int c) { return row * (DQK * 2) + ((c ^ ((row >> 1) & 7)) << 4); }
template <int NCB> __device__ __forceinline__ int v_st(int k, int c) { const int kk = (k & ~0xC) | ((k & 4) << 1) | ((k & 8) >> 1); return ((kk >> 3) * NCB + (c >> 5)) * 512 + ((kk & 7) * 32 + (c & 31)) * 2; }
__device__ __forceinline__ int v_rd_base(int lane) { return ((lane & 3) << 3) | (((lane >> 2) & 3) << 6) | (((lane >> 4) & 1) << 5) | (((lane >> 5) & 1) << 8); }

__device__ __forceinline__ void mask_tile(f32x16& p0, f32x16& p1, int dq) {
    const float NEG = -__builtin_inff();
#pragma unroll
    for (int r = 0; r < 16; ++r) {
        const int c = (r & 3) + 8 * (r >> 2);
        if (dq - c < 0) p0[r] = NEG;
        if (dq - c - 32 < 0) p1[r] = NEG;
    }
}
constexpr float DEFER_THR = 8.f;
template <bool FIRST>
__device__ __forceinline__ void partialSM(f32x16& p0, f32x16& p1, float& m_reg, float& alpha) {
    float pmax = p0[0];
#pragma unroll
    for (int r = 1; r < 16; ++r) pmax = fmaxf(pmax, p0[r]);
#pragma unroll
    for (int r = 0; r < 16; ++r) pmax = fmaxf(pmax, p1[r]);
    { auto rr = __builtin_amdgcn_permlane32_swap(__float_as_uint(pmax), __float_as_uint(pmax), false, false);
      pmax = fmaxf(__uint_as_float(rr[0]), __uint_as_float(rr[1])); }
    alpha = 1.f;
    if (FIRST || !__all(pmax <= DEFER_THR)) {
        const float dl = FIRST ? pmax : fmaxf(pmax, 0.f);
        m_reg += dl; alpha = __builtin_amdgcn_exp2f(-dl);
#pragma unroll
        for (int r = 0; r < 16; ++r) { p0[r] -= dl; p1[r] -= dl; }
    }
#pragma unroll
    for (int r = 0; r < 16; ++r) p0[r] = __builtin_amdgcn_exp2f(p0[r]);
}
__device__ __forceinline__ void finishSM(f32x16& p0, f32x16& p1, float alpha, float& l_reg, bf16x8& pa0, bf16x8& pa1, bf16x8& pa2, bf16x8& pa3) {
#pragma unroll
    for (int r = 0; r < 16; ++r) p1[r] = __builtin_amdgcn_exp2f(p1[r]);
    float ps = 0.f;
#pragma unroll
    for (int r = 0; r < 16; ++r) ps += p0[r];
#pragma unroll
    for (int r = 0; r < 16; ++r) ps += p1[r];
    { auto rr = __builtin_amdgcn_permlane32_swap(__float_as_uint(ps), __float_as_uint(ps), false, false);
      ps = __uint_as_float(rr[0]) + __uint_as_float(rr[1]); }
    l_reg = l_reg * alpha + ps;
#define PK4(P, B_, OUT) do { unsigned a0 = cvt_pk_bf16(P[B_+0], P[B_+1]), a1 = cvt_pk_bf16(P[B_+2], P[B_+3]);                          \
        unsigned b0 = cvt_pk_bf16(P[B_+4], P[B_+5]), b1 = cvt_pk_bf16(P[B_+6], P[B_+7]);                                             \
        auto r0 = __builtin_amdgcn_permlane32_swap(a0, b0, false, false); auto r1 = __builtin_amdgcn_permlane32_swap(a1, b1, false, false); \
        u32x4 w = {r0[0], r1[0], r0[1], r1[1]}; OUT = *reinterpret_cast<bf16x8*>(&w); } while (0)
    PK4(p0, 0, pa0); PK4(p0, 8, pa1); PK4(p1, 0, pa2); PK4(p1, 8, pa3);
#undef PK4
}
template <int DQK, bool NOLDS = false>
__device__ __forceinline__ void qkt(f32x16& p0, f32x16& p1, const LAS unsigned char* Kb, int r32, int hi, const bf16x8* qr, const float negm) {
    constexpr int NKS = DQK / 16, ROWB = DQK * 2;
#pragma unroll
    for (int r = 0; r < 16; ++r) { p0[r] = negm; p1[r] = negm; }
    if (NOLDS) {
#pragma unroll
        for (int d0 = 0; d0 < NKS; ++d0) { p0 = __builtin_amdgcn_mfma_f32_32x32x16_bf16(qr[(d0 + 1) % NKS], qr[d0], p0, 0, 0, 0); p1 = __builtin_amdgcn_mfma_f32_32x32x16_bf16(qr[(d0 + 2) % NKS], qr[d0], p1, 0, 0, 0); }
        return; }
    const int f = (r32 >> 1) & 7;
    const LAS unsigned char* kb[4];
#pragma unroll
    for (int dd = 0; dd < 4; ++dd) kb[dd] = Kb + r32 * ROWB + ((((2 * dd + hi) ^ f)) << 4);
#pragma unroll
    for (int d0 = 0; d0 < NKS; ++d0) { const LAS unsigned char* a_ = kb[d0 & 3] + (d0 >> 2) * 128;
        const bf16x8 b0 = *reinterpret_cast<const LAS bf16x8*>(a_);
        const bf16x8 b1 = *reinterpret_cast<const LAS bf16x8*>(a_ + 32 * ROWB);
        p0 = __builtin_amdgcn_mfma_f32_32x32x16_bf16(b0, qr[d0], p0, 0, 0, 0);
        p1 = __builtin_amdgcn_mfma_f32_32x32x16_bf16(b1, qr[d0], p1, 0, 0, 0); }
}
template <int DQK> __device__ __forceinline__ void qkt_sched() {
    constexpr int NKS = DQK / 16;
    __builtin_amdgcn_sched_group_barrier(0x100, 4, 0);
#pragma unroll
    for (int d0 = 0; d0 < NKS; ++d0) {
        __builtin_amdgcn_sched_group_barrier(0x008, 2, 0);
        __builtin_amdgcn_sched_group_barrier(0x002, 120 / NKS, 0);
        if (d0 + 2 < NKS) __builtin_amdgcn_sched_group_barrier(0x100, 2, 0);
    }
}
template <int DV>
__device__ __forceinline__ void pv_tile(f32x16* o, int vb0, bf16x8 pa0, bf16x8 pa1, bf16x8 pa2, bf16x8 pa3) {
    constexpr int NCB = DV / 32, KS = 2 * NCB * 512, HF = NCB * 512;
#define TRRD(dst, off) asm volatile("ds_read_b64_tr_b16 %0, %1 offset:%2" : "=&v"(dst) : "v"(vb0), "i"(off) : "memory")
#pragma unroll
    for (int d0 = 0; d0 < NCB; ++d0) {
        s16x4 l0, l1, l2, l3, h0, h1, h2, h3;
        if (d0 == 0) { TRRD(l0, 0 * 512); TRRD(h0, 0 * 512 + HF); TRRD(l1, 0 * 512 + KS); TRRD(h1, 0 * 512 + KS + HF); TRRD(l2, 0 * 512 + 2 * KS); TRRD(h2, 0 * 512 + 2 * KS + HF); TRRD(l3, 0 * 512 + 3 * KS); TRRD(h3, 0 * 512 + 3 * KS + HF); }
        else if (d0 == 1) { TRRD(l0, 1 * 512); TRRD(h0, 1 * 512 + HF); TRRD(l1, 1 * 512 + KS); TRRD(h1, 1 * 512 + KS + HF); TRRD(l2, 1 * 512 + 2 * KS); TRRD(h2, 1 * 512 + 2 * KS + HF); TRRD(l3, 1 * 512 + 3 * KS); TRRD(h3, 1 * 512 + 3 * KS + HF); }
        else if (d0 == 2) { TRRD(l0, 2 * 512); TRRD(h0, 2 * 512 + HF); TRRD(l1, 2 * 512 + KS); TRRD(h1, 2 * 512 + KS + HF); TRRD(l2, 2 * 512 + 2 * KS); TRRD(h2, 2 * 512 + 2 * KS + HF); TRRD(l3, 2 * 512 + 3 * KS); TRRD(h3, 2 * 512 + 3 * KS + HF); }
        else { TRRD(l0, 3 * 512); TRRD(h0, 3 * 512 + HF); TRRD(l1, 3 * 512 + KS); TRRD(h1, 3 * 512 + KS + HF); TRRD(l2, 3 * 512 + 2 * KS); TRRD(h2, 3 * 512 + 2 * KS + HF); TRRD(l3, 3 * 512 + 3 * KS); TRRD(h3, 3 * 512 + 3 * KS + HF); }
        asm volatile("s_waitcnt lgkmcnt(0)" ::: "memory"); SBAR();
        o[d0] = __builtin_amdgcn_mfma_f32_32x32x16_bf16(pa0, (bf16x8){l0[0], l0[1], l0[2], l0[3], h0[0], h0[1], h0[2], h0[3]}, o[d0], 0, 0, 0);
        o[d0] = __builtin_amdgcn_mfma_f32_32x32x16_bf16(pa1, (bf16x8){l1[0], l1[1], l1[2], l1[3], h1[0], h1[1], h1[2], h1[3]}, o[d0], 0, 0, 0);
        o[d0] = __builtin_amdgcn_mfma_f32_32x32x16_bf16(pa2, (bf16x8){l2[0], l2[1], l2[2], l2[3], h2[0], h2[1], h2[2], h2[3]}, o[d0], 0, 0, 0);
        o[d0] = __builtin_amdgcn_mfma_f32_32x32x16_bf16(pa3, (bf16x8){l3[0], l3[1], l3[2], l3[3], h3[0], h3[1], h3[2], h3[3]}, o[d0], 0, 0, 0);
    }
#undef TRRD
}

template <int DQK, int DV, bool CAUSAL, int ABL = 0>
__device__ __forceinline__ void attn_unit(const bf16_t* Qb, int qp, const bf16_t* Km, int kp, int c1, const bf16_t* Ke, int kep, const bf16_t* Vb, int vp,
                                          int NT, int q0, const bf16_t* gate, int gp, bf16_t* Y, int yp, LAS unsigned char* lds, const int tid) {
    constexpr int SHM_V = 64 * DV * 2, SHM_K = 64 * DQK * 2, NCK = DQK / 8, NKS = DQK / 16, NCB = DV / 32;
    constexpr int KPT = SHM_K / 8192, VPT = SHM_V / 8192;
    const int wid = __builtin_amdgcn_readfirstlane(tid >> 6), lane = tid & 63, r32 = lane & 31, hi = lane >> 5;
    LAS unsigned char* V_lds = lds; LAS unsigned char* K_lds = lds + 3 * SHM_V; LAS float* ws = (LAS float*)(lds + 3 * SHM_V + 3 * SHM_K) + wid * 64;
    bf16x8 qr[NKS];
#pragma unroll
    for (int d0 = 0; d0 < NKS; ++d0) qr[d0] = *reinterpret_cast<const bf16x8*>(Qb + (size_t)(wid * 32 + r32) * qp + d0 * 16 + hi * 8);
    const char* kbase = (const char*)(Km < Ke ? Km : Ke);
    unsigned koff[KPT]; unsigned kstr[KPT];
#pragma unroll
    for (int i = 0; i < KPT; ++i) { const int p = (wid + 8 * i) * 64 + lane, row = p / NCK, cpos = p % NCK, c = cpos ^ ((row >> 1) & 7);
        if (c < c1) { koff[i] = (unsigned)((const char*)(Km + (size_t)row * kp + c * 8) - kbase); kstr[i] = (unsigned)kp * 128u; }
        else { koff[i] = (unsigned)((const char*)(Ke + (size_t)row * kep + (c - c1) * 8) - kbase); kstr[i] = (unsigned)kep * 128u; } }
    unsigned voff[VPT];
#pragma unroll
    for (int i = 0; i < VPT; ++i) { const int st = 2 * (wid + 8 * i) + (lane >> 5), kk = (st / NCB) * 8 + ((lane & 31) >> 2), k = (kk & ~0xC) | ((kk & 4) << 1) | ((kk & 8) >> 1), col = (st % NCB) * 32 + (lane & 3) * 8;
        voff[i] = (unsigned)(k * vp + col) * 2u; }
    const char* vbase = (const char*)Vb;
    float m_reg = 0.f, l_reg = 0.f; f32x16 o[NCB];
#pragma unroll
    for (int d = 0; d < NCB; ++d) o[d] = f32x16{};
    const int vb0 = (int)(size_t)V_lds + v_rd_base(lane);
    const int qlo = q0 + wid * 32;
#define DMA_K(sl) do { _Pragma("unroll") for (int i = 0; i < KPT; ++i) { __builtin_amdgcn_global_load_lds((const unsigned*)(kbase + koff[i]), (LAS unsigned*)(K_lds + (sl) * SHM_K + (wid + 8 * i) * 1024), 16, 0, 0); koff[i] += kstr[i]; } } while (0)
#define DMA_V(sl) do { _Pragma("unroll") for (int i = 0; i < VPT; ++i) { __builtin_amdgcn_global_load_lds((const unsigned*)(vbase + voff[i]), (LAS unsigned*)(V_lds + (sl) * SHM_V + (wid + 8 * i) * 1024), 16, 0, 0); } vbase += (size_t)vp * 128; } while (0)
#define WAIT_BAR(N) do { asm volatile("s_waitcnt vmcnt(%0) lgkmcnt(0)\n\ts_barrier" :: "i"(N) : "memory"); } while (0)
#define MASKT(P0_, P1_, t) do { if (CAUSAL) { const int kb_ = (t) * 64; if (kb_ + 63 > qlo) mask_tile(P0_, P1_, qlo + r32 - 4 * hi - kb_); } } while (0)
#define RESC(a) do { if (__any((a) < 1.f)) { if (hi == 0) ws[r32] = (a); asm volatile("s_waitcnt lgkmcnt(0)" ::: "memory"); \
        _Pragma("unroll") for (int d_ = 0; d_ < NCB; ++d_) _Pragma("unroll") for (int r = 0; r < 16; ++r) o[d_][r] *= ws[crow(r, hi)]; } } while (0)
    f32x16 pA0, pA1, pB0, pB1; float alA = 1.f, alB = 1.f; bf16x8 pa0, pa1, pa2, pa3;
    DMA_K(0); DMA_K(1); DMA_V(0);
    WAIT_BAR(KPT + VPT);
    DMA_K(2); DMA_V(1);
    qkt<DQK>(pA0, pA1, K_lds, r32, hi, qr, 0.f);
    MASKT(pA0, pA1, 0); partialSM<true>(pA0, pA1, m_reg, alA); alA = 1.f;
    WAIT_BAR(KPT + VPT);
    int ks = 1, vs = 0, ns = 2;
#define ROT() do { vs = ks; ks = ns; ns = (ns == 2) ? 0 : ns + 1; } while (0)
#define STEP(PX0, PX1, alX, PY0, PY1, alY, t, NW) do { \
        if (!(ABL & 1)) { if ((t) + 2 < NT) DMA_K(vs); if ((t) + 1 < NT) DMA_V(ns); } \
        SBAR(); if (!(ABL & 8)) qkt<DQK, (ABL & 32) != 0>(PX0, PX1, K_lds + ks * SHM_K, r32, hi, qr, -m_reg); else { asm volatile("" : "+v"(PX0), "+v"(PX1)); } \
        if (!(ABL & 2)) finishSM(PY0, PY1, alY, l_reg, pa0, pa1, pa2, pa3); else { asm volatile("" : "+v"(PY0), "+v"(PY1), "+v"(pa0), "+v"(pa1), "+v"(pa2), "+v"(pa3)); } SBAR(); \
        if (!(ABL & 4)) pv_tile<DV>(o, vb0 + vs * SHM_V, pa0, pa1, pa2, pa3); \
        if (!(ABL & 2)) { MASKT(PX0, PX1, t); partialSM<false>(PX0, PX1, m_reg, alX); } \
        if (ABL & 1) WAIT_BAR(0); else WAIT_BAR(NW); \
        RESC(alX); ROT(); } while (0)
    int t = 1;
    for (; t + 3 < NT; t += 2) {
        STEP(pB0, pB1, alB, pA0, pA1, alA, t, KPT + VPT);
        STEP(pA0, pA1, alA, pB0, pB1, alB, t + 1, KPT + VPT);
    }
    STEP(pB0, pB1, alB, pA0, pA1, alA, t, KPT + VPT);
    STEP(pA0, pA1, alA, pB0, pB1, alB, t + 1, VPT);
    STEP(pB0, pB1, alB, pA0, pA1, alA, t + 2, 0);
    finishSM(pB0, pB1, alB, l_reg, pa0, pa1, pa2, pa3); SBAR(); pv_tile<DV>(o, vb0 + vs * SHM_V, pa0, pa1, pa2, pa3);
#undef STEP
#undef ROT
#undef RESC
#undef MASKT
#undef WAIT_BAR
#undef DMA_K
#undef DMA_V
    if (hi == 0) ws[32 + r32] = l_reg;
    asm volatile("s_waitcnt lgkmcnt(0)" ::: "memory");
    constexpr int SPITCH = DV * 2 + 16;
    LAS unsigned char* stg = ((DQK == 192) ? K_lds : (lds + 3 * SHM_V + 3 * SHM_K + 2048)) + wid * (32 * SPITCH);
#pragma unroll
    for (int r = 0; r < 16; ++r) {
        const float rl = __builtin_amdgcn_rcpf(ws[32 + crow(r, hi)]);
#pragma unroll
        for (int d0 = 0; d0 < NCB; ++d0) *(LAS unsigned short*)(stg + crow(r, hi) * SPITCH + (d0 * 32 + r32) * 2) = f2bf(o[d0][r] * rl);
    }
    asm volatile("s_waitcnt lgkmcnt(0)" ::: "memory");
    constexpr int CPR = DV / 8, RPP = 64 / CPR;
#pragma unroll
    for (int i = 0; i < 32 / RPP; ++i) {
        const int row = i * RPP + lane / CPR, ch = lane % CPR, orow = wid * 32 + row;
        const u32x4 ov = *(const LAS u32x4*)(stg + row * SPITCH + ch * 16);
        const u32x4 gv = *(const u32x4*)(gate + (size_t)orow * gp + ch * 8);
        u32x4 w;
        w.x = cvt_pk_bf16(bflo(ov.x) * silu_f(bflo(gv.x)), bfhi(ov.x) * silu_f(bfhi(gv.x))); w.y = cvt_pk_bf16(bflo(ov.y) * silu_f(bflo(gv.y)), bfhi(ov.y) * silu_f(bfhi(gv.y)));
        w.z = cvt_pk_bf16(bflo(ov.z) * silu_f(bflo(gv.z)), bfhi(ov.z) * silu_f(bfhi(gv.z))); w.w = cvt_pk_bf16(bflo(ov.w) * silu_f(bflo(gv.w)), bfhi(ov.w) * silu_f(bfhi(gv.w)));
        *(u32x4*)(Y + (size_t)orow * yp + ch * 8) = w;
    }
    __syncthreads();
}
#undef SBAR
}
struct Params {
    const float* x; const float* mem; const int* pos;
    const float *a_pre_g, *a_w_in, *a_q_a_g, *a_w_uq, *a_kv_a_g, *a_w_ukv, *a_mem_g, *a_w_mem_kv, *a_w_out, *a_post_g;
    const float *b_pre_g, *b_w_in, *b_gate_bias, *b_conv_w, *b_conv_b, *b_w_q, *b_w_k, *b_w_v, *b_head_g, *b_skip, *b_mem_g, *b_w_mem_kv, *b_w_out, *b_post_g;
    float* out; unsigned char* ws; int ph_lo, ph_hi;
};
struct Wk { int tid, lane, wave, vcu, G; };
#define LDS_WAIT() asm volatile("s_waitcnt lgkmcnt(0)" ::: "memory")

__device__ __forceinline__ float wsrc(const Params& P, int mat, int k, int n) {
    switch (mat) {
    case 0: { int col; float s = 1.f;
        if (n < 256) col = 384 + n; else if (n < 512) col = n - 256; else if (n < 640) col = 256 + (n - 512);
        else if (n < 704) { const int p_ = n - 640, i = p_ >> 1; col = 640 + ((p_ & 1) ? 32 + i : i); }
        else if (n < 768) return 0.f; else if (n < 1024) { col = 704 + (n - 768); s = MSCALE; } else col = 960 + (n - 1024);
        return P.a_w_in[(size_t)k * A_IN + col] * P.a_pre_g[k] * s; }
    case 1: { if (n >= 1152) return 0.f; const int h = n / 192, d = n % 192; int col;
        if (d < 128) col = h * 192 + d; else { const int p_ = d - 128, i = p_ >> 1; col = h * 192 + 128 + ((p_ & 1) ? 32 + i : i); }
        return P.a_w_uq[(size_t)k * 1152 + col] * P.a_q_a_g[k] * QSCALE; }
    case 2: { int col; if (n < 768) col = (n / 128) * 256 + (n % 128); else { const int n2 = n - 768; col = (n2 / 128) * 256 + 128 + (n2 % 128); }
        return P.a_w_ukv[(size_t)k * 1536 + col] * P.a_kv_a_g[k]; }
    case 3: { if (n < 512) return P.a_w_mem_kv[(size_t)k * 512 + n] * P.a_mem_g[k]; return P.b_w_mem_kv[(size_t)k * 512 + (n - 512)] * P.b_mem_g[k]; }
    case 4: return P.a_w_out[(size_t)k * 1024 + n];
    case 5: { int col; float s = 1.f; if (n < 768) col = n; else if (n < 1536) col = 776 + (n - 768); else if (n < 1792) { col = 1544 + (n - 1536); s = MSCALE; } else col = 1800 + (n - 1792);
        return P.b_w_in[(size_t)k * B_IN + col] * P.b_pre_g[k] * s; }
    case 6: { const int h = n / 192, j = n % 192, pn = n / 256, kabs = k + 192 * pn - 192 * h; if (kabs < 0 || kabs >= 192) return 0.f;
        if (j < 96) return P.b_w_q[((size_t)h * 192 + kabs) * 96 + j]; return P.b_w_k[((size_t)h * 192 + kabs) * 96 + (j - 96)] * KSCALE_B; }
    case 7: { const int h = n / 192, j = n % 192, pn = n / 256, kabs = k + 192 * pn - 192 * h; if (kabs < 0 || kabs >= 192) return 0.f;
        return P.b_w_v[((size_t)h * 192 + kabs) * 192 + j]; }
    default: return P.b_w_out[(size_t)k * 1024 + n];
    }
}
__device__ __forceinline__ void tr_item(const Params& P, int mat, int K, int nblk, bf16_t* WT, LAS float* scr, int item, int lane) {
    const int kb = item / nblk, nb = item % nblk, k0 = 64 * kb, n0 = 32 * nb;
    float tv[32];
#pragma unroll
    for (int i = 0; i < 32; ++i) tv[i] = wsrc(P, mat, k0 + 2 * i + (lane >> 5), n0 + (lane & 31));
#pragma unroll
    for (int i = 0; i < 32; ++i) scr[(2 * i + (lane >> 5)) * 33 + (lane & 31)] = tv[i];
    LDS_WAIT(); asm volatile("" ::: "memory");
    const int c = lane & 7;
#pragma unroll
    for (int j = 0; j < 4; ++j) { const int n = (lane >> 3) + 8 * j; const LAS float* s = scr + (8 * c) * 33 + n;
        u32x4 o; o.x = cvt_pk_bf16(s[0 * 33], s[1 * 33]); o.y = cvt_pk_bf16(s[2 * 33], s[3 * 33]); o.z = cvt_pk_bf16(s[4 * 33], s[5 * 33]); o.w = cvt_pk_bf16(s[6 * 33], s[7 * 33]);
        *(u32x4*)(WT + (size_t)(n0 + n) * K + k0 + 8 * c) = o; }
    LDS_WAIT(); asm volatile("" ::: "memory");
}
__device__ __forceinline__ void row_to_bf16(const float* xrow, bf16_t* orow, float* rstd_out, bool normalise, int lane) {
    const f32x4* xr = (const f32x4*)xrow + lane;
    f32x4 v[4]; float s = 0.f;
#pragma unroll
    for (int j = 0; j < 4; ++j) { v[j] = xr[64 * j]; s += (v[j].x * v[j].x + v[j].y * v[j].y) + (v[j].z * v[j].z + v[j].w * v[j].w); }
    const float rstd = rsqrtf(wave_sum(s) * (1.f / DM) + EPS);
    if (rstd_out && lane == 0) *rstd_out = rstd;
    const float sc = normalise ? rstd : 1.f;
    u32x2* o8 = (u32x2*)orow + lane;
#pragma unroll
    for (int j = 0; j < 4; ++j) { u32x2 w; w.x = cvt_pk_bf16(v[j].x * sc, v[j].y * sc); w.y = cvt_pk_bf16(v[j].z * sc, v[j].w * sc); o8[64 * j] = w; }
}
__device__ __forceinline__ void phase_prologue(const Params& P, const Wk& W, LAS unsigned char* lds) {
    unsigned char* ws = P.ws;
    LAS float* scr = (LAS float*)(lds + W.wave * 8704);
    const int gw = W.vcu * 8 + W.wave, NGW = W.G * 8;
#ifndef PROBE_P0
#define PROBE_P0 0
#endif
    for (int rep_ = 0; rep_ < (PROBE_P0 == 1 ? 2 : 1); ++rep_) {
    int base = 0;
#define DO_MAT(mt, K_, N_, OFF_) do { const int nblk = (N_) / 32, nit = ((K_) / 64) * nblk; \
        int first = gw - (base % NGW); if (first < 0) first += NGW; \
        for (int r = first; r < nit; r += NGW) tr_item(P, mt, K_, nblk, (bf16_t*)(ws + (OFF_)), scr, r, W.lane); \
        base += nit; } while (0)
    DO_MAT(0, 1024, 2048, WS_WINA); DO_MAT(1, 384, 1280, WS_WUQ); DO_MAT(2, 256, 1536, WS_WUKV); DO_MAT(3, 1024, 1024, WS_WMKV); DO_MAT(4, 1024, 1024, WS_WOA);
    DO_MAT(5, 1024, 2816, WS_WINB); DO_MAT(6, 384, 768, WS_WQK); DO_MAT(7, 384, 768, WS_WV); DO_MAT(8, 1024, 1024, WS_WOB);
#undef DO_MAT
    }
    const int gt = (W.vcu * 512 + W.tid), NGT = W.G * 512;
    for (int idx = gt; idx < 8 * 1024; idx += NGT) { const int g = idx >> 10, k = idx & 1023; ((float*)(ws + WS_WG))[idx] = P.b_w_in[(size_t)k * B_IN + 768 + g] * P.b_pre_g[k]; }
    for (int idx = gt; idx < 2 * T; idx += NGT) ((float*)(ws + WS_SSQA))[idx] = 0.f;
    for (int rep_ = 0; rep_ < (PROBE_P0 == 2 ? 2 : 1); ++rep_)
    for (int idx = gt; idx < T * 32; idx += NGT) { const int row = idx >> 5, i = idx & 31;
        const float inv = exp2f(-(float)i * (13.287712379549449f / 32.f));
        const float ang = (float)P.pos[row] * inv;
        double tr = (double)ang * 0.15915494309189535; tr -= floor(tr); const float tf = (float)tr;
        ((float2*)(ws + WS_ROPE))[idx] = make_float2(__builtin_amdgcn_cosf(tf), __builtin_amdgcn_sinf(tf)); }
    for (int rep_ = 0; rep_ < (PROBE_P0 == 3 ? 2 : 1); ++rep_)
    for (int m = gw; m < T; m += 4 * NGW) {
        f32x4 v[4][4]; float s[4];
#pragma unroll
        for (int r = 0; r < 4; ++r) { const f32x4* xr = (const f32x4*)(P.x + (size_t)(m + r * NGW) * DM) + W.lane;
#pragma unroll
            for (int j = 0; j < 4; ++j) v[r][j] = xr[64 * j]; }
#pragma unroll
        for (int r = 0; r < 4; ++r) { float a = 0.f;
#pragma unroll
            for (int j = 0; j < 4; ++j) a += (v[r][j].x * v[r][j].x + v[r][j].y * v[r][j].y) + (v[r][j].z * v[r][j].z + v[r][j].w * v[r][j].w);
            s[r] = wave_sum(a); }
#pragma unroll
        for (int r = 0; r < 4; ++r) { const int mr = m + r * NGW; if (W.lane == 0) ((float*)(ws + WS_RSTD))[mr] = rsqrtf(s[r] * (1.f / DM) + EPS);
            u32x2* o8 = (u32x2*)((bf16_t*)(ws + WS_XB) + (size_t)mr * DM) + W.lane;
#pragma unroll
            for (int j = 0; j < 4; ++j) { u32x2 w; w.x = cvt_pk_bf16(v[r][j].x, v[r][j].y); w.y = cvt_pk_bf16(v[r][j].z, v[r][j].w); o8[64 * j] = w; } }
    }
    for (int m = gw; m < NB * NMEM; m += NGW) row_to_bf16(P.mem + (size_t)m * DM, (bf16_t*)(ws + WS_MEMN) + (size_t)m * DM, nullptr, true, W.lane);
}

__device__ __forceinline__ void phase_rowmid(const Params& P, const Wk& W, LAS unsigned char* lds) {
    unsigned char* ws = P.ws;
    const int gw = W.vcu * 8 + W.wave, NGW = W.G * 8, lane = W.lane;
    const bf16_t* Z = (const bf16_t*)(ws + WS_Z);
    { const int gt_ = W.vcu * 512 + W.tid; if (gt_ < 32 * 192) ((float*)(ws + WS_U0))[gt_] = 0.f; }
    LAS float* Wg = (LAS float*)lds;
    for (int i = W.tid; i < 2048; i += 512) ((LAS f32x4*)Wg)[i] = ((const f32x4*)(ws + WS_WG))[i];
    __syncthreads();
    f32x4 pg[4];
#pragma unroll
    for (int j = 0; j < 4; ++j) pg[j] = ((const f32x4*)P.a_post_g)[lane + 64 * j];
    f32x4 vn[4]; u32x2 zn[4];
    if (gw < T) { const f32x4* xr = (const f32x4*)(P.x + (size_t)gw * DM) + lane; const u32x2* zr = (const u32x2*)(Z + (size_t)gw * DM) + lane;
#pragma unroll
        for (int j = 0; j < 4; ++j) { vn[j] = xr[64 * j]; zn[j] = zr[64 * j]; } }
    for (int m = gw; m < T; m += NGW) {
        f32x4 v[4], z[4]; float s = 0.f;
#pragma unroll
        for (int j = 0; j < 4; ++j) { v[j] = vn[j]; const u32x2 w = zn[j]; z[j] = (f32x4){bflo(w.x), bfhi(w.x), bflo(w.y), bfhi(w.y)};
            s += (z[j].x * z[j].x + z[j].y * z[j].y) + (z[j].z * z[j].z + z[j].w * z[j].w); }
        if (m + NGW < T) { const f32x4* xr = (const f32x4*)(P.x + (size_t)(m + NGW) * DM) + lane; const u32x2* zr = (const u32x2*)(Z + (size_t)(m + NGW) * DM) + lane;
#pragma unroll
            for (int j = 0; j < 4; ++j) { vn[j] = xr[64 * j]; zn[j] = zr[64 * j]; } }
        const float rz = rsqrtf(wave_sum(s) * (1.f / DM) + EPS);
        float s1 = 0.f;
#pragma unroll
        for (int j = 0; j < 4; ++j) { const f32x4 g = pg[j]; v[j] = v[j] + z[j] * rz * g;
            s1 += (v[j].x * v[j].x + v[j].y * v[j].y) + (v[j].z * v[j].z + v[j].w * v[j].w); }
        const float r1 = rsqrtf(wave_sum(s1) * (1.f / DM) + EPS);
        f32x4* orow = (f32x4*)(P.out + (size_t)m * DM) + lane; u32x2* o8 = (u32x2*)((bf16_t*)(ws + WS_XB) + (size_t)m * DM) + lane;
#pragma unroll
        for (int j = 0; j < 4; ++j) { orow[64 * j] = v[j]; u32x2 w; w.x = cvt_pk_bf16(v[j].x, v[j].y); w.y = cvt_pk_bf16(v[j].z, v[j].w); o8[64 * j] = w; }
        if (lane == 0) ((float*)(ws + WS_RSTD))[m] = r1;
        float ga[8];
#pragma unroll
        for (int g = 0; g < 8; ++g) { float a = 0.f;
#pragma unroll
            for (int j = 0; j < 4; ++j) { const f32x4 w4 = ((const LAS f32x4*)(Wg + g * 1024))[lane + 64 * j]; a += (v[j].x * w4.x + v[j].y * w4.y) + (v[j].z * w4.z + v[j].w * w4.w); }
            ga[g] = a; }
        float gb[4], gc[2], gd;
        { const bool up = (lane & 32) != 0;
#pragma unroll
          for (int i = 0; i < 4; ++i) { const float snd = up ? ga[i] : ga[4 + i]; const float kp = up ? ga[4 + i] : ga[i]; gb[i] = kp + __shfl_xor(snd, 32); } }
        { const bool up = (lane & 16) != 0;
#pragma unroll
          for (int i = 0; i < 2; ++i) { const float snd = up ? gb[i] : gb[2 + i]; const float kp = up ? gb[2 + i] : gb[i]; gc[i] = kp + __shfl_xor(snd, 16); } }
        { const bool up = (lane & 8) != 0; const float snd = up ? gc[0] : gc[1]; const float kp = up ? gc[1] : gc[0]; gd = kp + __shfl_xor(snd, 8); }
        gd += __shfl_xor(gd, 4); gd += __shfl_xor(gd, 2); gd += __shfl_xor(gd, 1);
        if ((lane & 7) == 0) { const int g = lane >> 3;
            ((float*)(ws + WS_IFP))[(size_t)m * 8 + g] = gd * r1 + P.b_gate_bias[g]; }
    }
}
__device__ __forceinline__ void phase_rowfinal(const Params& P, const Wk& W) {
    unsigned char* ws = P.ws;
    const int gw = W.vcu * 8 + W.wave, NGW = W.G * 8, lane = W.lane;
    const bf16_t* Z = (const bf16_t*)(ws + WS_Z);
    f32x4 pg[4];
#pragma unroll
    for (int j = 0; j < 4; ++j) pg[j] = ((const f32x4*)P.b_post_g)[lane + 64 * j];
    f32x4 vn[4]; u32x2 zn[4];
    if (gw < T) { const f32x4* xr = (const f32x4*)(P.out + (size_t)gw * DM) + lane; const u32x2* zr = (const u32x2*)(Z + (size_t)gw * DM) + lane;
#pragma unroll
        for (int j = 0; j < 4; ++j) { vn[j] = xr[64 * j]; zn[j] = zr[64 * j]; } }
    for (int m = gw; m < T; m += NGW) {
        f32x4* xo = (f32x4*)(P.out + (size_t)m * DM) + lane;
        f32x4 v[4], z[4]; float s = 0.f;
#pragma unroll
        for (int j = 0; j < 4; ++j) { v[j] = vn[j]; const u32x2 w = zn[j]; z[j] = (f32x4){bflo(w.x), bfhi(w.x), bflo(w.y), bfhi(w.y)};
            s += (z[j].x * z[j].x + z[j].y * z[j].y) + (z[j].z * z[j].z + z[j].w * z[j].w); }
        if (m + NGW < T) { const f32x4* xr = (const f32x4*)(P.out + (size_t)(m + NGW) * DM) + lane; const u32x2* zr = (const u32x2*)(Z + (size_t)(m + NGW) * DM) + lane;
#pragma unroll
            for (int j = 0; j < 4; ++j) { vn[j] = xr[64 * j]; zn[j] = zr[64 * j]; } }
        const float rz = rsqrtf(wave_sum(s) * (1.f / DM) + EPS);
#pragma unroll
        for (int j = 0; j < 4; ++j) xo[64 * j] = v[j] + z[j] * rz * pg[j];
    }
}
__device__ __forceinline__ void first_token_u0(const Params& P, const Wk& W, LAS unsigned char* lds, int widx) {
    unsigned char* ws = P.ws;
    const int bh = widx >> 2, sl = widx & 3, b = bh >> 2, h = bh & 3, j = W.tid % 192, sub = W.tid / 192; const size_t row = (size_t)b * SEQ;
    LAS float* hs = (LAS float*)lds;
    if (W.tid < 256) hs[W.tid] = P.out[row * DM + sl * 256 + W.tid] * P.b_pre_g[sl * 256 + W.tid] * ((const float*)(ws + WS_RSTD))[row];
    __syncthreads();
    if (W.tid < 384) {
        const float* wp = P.b_w_in + (size_t)(sl * 256 + sub * 128) * B_IN + h * 192 + j; float a = 0.f;
#pragma unroll 64
        for (int k = 0; k < 128; ++k) a += hs[sub * 128 + k] * wp[(size_t)k * B_IN];
        atomicAdd((float*)(ws + WS_U0) + bh * 192 + j, a); }
    __syncthreads();
}
__device__ __forceinline__ void first_token_qk(const Params& P, const Wk& W, LAS unsigned char* lds) {
    unsigned char* ws = P.ws;
    const int first = W.G > 32 ? W.G - 32 : 0, nwk = W.G > 32 ? 32 : W.G;
    if (W.vcu < first) return;
    for (int bh = W.vcu - first; bh < 32; bh += nwk) {
    const int h = bh & 3, tid = W.tid;
    LAS float* uc0 = (LAS float*)lds; LAS float* qk0 = uc0 + 192;
    float wv[96];
    const int o = tid % 192, part = tid / 192, j = o % 96;
    if (tid < 384) { const float* Wm = (o < 96 ? P.b_w_q : P.b_w_k) + (size_t)h * 192 * 96 + (size_t)(part * 96) * 96 + j;
#pragma unroll
        for (int i = 0; i < 96; ++i) wv[i] = Wm[i * 96]; }
    if (tid < 192) { const int col = h * 192 + tid; uc0[tid] = silu_f(P.b_conv_b[col] + P.b_conv_w[3 * 768 + col] * ((const float*)(ws + WS_U0))[bh * 192 + tid]); }
    __syncthreads();
    if (tid < 384) { float a = 0.f;
#pragma unroll
        for (int i = 0; i < 96; ++i) a += uc0[part * 96 + i] * wv[i];
        qk0[part * 192 + o] = a; }
    __syncthreads();
    if (tid < 64) { float a = (qk0[tid] + qk0[192 + tid]) * (qk0[96 + tid] + qk0[288 + tid]); if (tid < 32) a += (qk0[64 + tid] + qk0[256 + tid]) * (qk0[160 + tid] + qk0[352 + tid]);
        a = wave_sum(a); if (tid == 0) ((float*)(ws + WS_C0))[bh] = a * KSCALE_B; }
    __syncthreads();
    }
}
__device__ __forceinline__ void phase_conv(const Params& P, const Wk& W) {
    unsigned char* ws = P.ws;
    const bf16_t* G2 = (const bf16_t*)(ws + WS_G); bf16_t* UC = (bf16_t*)(ws + WS_UC);
    const int gt = W.vcu * 512 + W.tid, NGT = W.G * 512;
    for (int it = gt; it < (T / 8) * 96; it += NGT) {
        const int rg = it / 96, cc = it % 96, row0 = rg * 8, c0 = cc * 8, s0 = row0 & (SEQ - 1);
        float w[4][8], bsv[8];
#pragma unroll
        for (int j = 0; j < 4; ++j) { const f32x4 a = *(const f32x4*)(P.b_conv_w + j * 768 + c0), b = *(const f32x4*)(P.b_conv_w + j * 768 + c0 + 4);
            w[j][0] = a.x; w[j][1] = a.y; w[j][2] = a.z; w[j][3] = a.w; w[j][4] = b.x; w[j][5] = b.y; w[j][6] = b.z; w[j][7] = b.w; }
        { const f32x4 a = *(const f32x4*)(P.b_conv_b + c0), b = *(const f32x4*)(P.b_conv_b + c0 + 4); bsv[0] = a.x; bsv[1] = a.y; bsv[2] = a.z; bsv[3] = a.w; bsv[4] = b.x; bsv[5] = b.y; bsv[6] = b.z; bsv[7] = b.w; }
        float h[3][8];
#pragma unroll
        for (int j = 0; j < 3; ++j) {
            if (s0 - 3 + j >= 0) { const u32x4 q = *(const u32x4*)(G2 + (size_t)(row0 - 3 + j) * G2W + G2_U + c0);
                h[j][0] = bflo(q.x); h[j][1] = bfhi(q.x); h[j][2] = bflo(q.y); h[j][3] = bfhi(q.y); h[j][4] = bflo(q.z); h[j][5] = bfhi(q.z); h[j][6] = bflo(q.w); h[j][7] = bfhi(q.w); }
            else {
#pragma unroll
                for (int e = 0; e < 8; ++e) h[j][e] = 0.f; }
        }
#pragma unroll
        for (int r = 0; r < 8; ++r) {
            const u32x4 q = *(const u32x4*)(G2 + (size_t)(row0 + r) * G2W + G2_U + c0);
            float u[8] = {bflo(q.x), bfhi(q.x), bflo(q.y), bfhi(q.y), bflo(q.z), bfhi(q.z), bflo(q.w), bfhi(q.w)};
            float o[8];
#pragma unroll
            for (int e = 0; e < 8; ++e) { const float cv = bsv[e] + h[0][e] * w[0][e] + h[1][e] * w[1][e] + h[2][e] * w[2][e] + u[e] * w[3][e]; o[e] = silu_f(cv);
                h[0][e] = h[1][e]; h[1][e] = h[2][e]; h[2][e] = u[e]; }
            u32x4 ov; ov.x = cvt_pk_bf16(o[0], o[1]); ov.y = cvt_pk_bf16(o[2], o[3]); ov.z = cvt_pk_bf16(o[4], o[5]); ov.w = cvt_pk_bf16(o[6], o[7]);
            *(u32x4*)(UC + (size_t)(row0 + r) * 768 + c0) = ov;
        }
    }
}
namespace ml {
__device__ __forceinline__ int crow(int r, int hi) { return (r & 3) + 8 * (r >> 2) + 4 * hi; }
template <int NKS>
__device__ __forceinline__ f32x16 tile32(const LAS bf16_t* A, int lda, const LAS bf16_t* B, int ldb, int r32, int hi, f32x16 acc) {
    const LAS bf16_t* ap = A + r32 * lda + hi * 8; const LAS bf16_t* bp = B + r32 * ldb + hi * 8;
#pragma unroll
    for (int ks = 0; ks < NKS; ++ks) { const bf16x8 a = *(const LAS bf16x8*)(ap + ks * 16); const bf16x8 b = *(const LAS bf16x8*)(bp + ks * 16);
        acc = __builtin_amdgcn_mfma_f32_32x32x16_bf16(a, b, acc, 0, 0, 0); }
    return acc;
}
__device__ __forceinline__ float logsigmoid_f(float f) { return fminf(f, 0.f) - log1pf(__expf(-fabsf(f))); }
__device__ __forceinline__ float scan_add(float v, int lane) {
#pragma unroll
    for (int o = 1; o < 64; o <<= 1) { const float t = __shfl_up(v, o); if (lane >= o) v += t; }
    return v;
}
__device__ __forceinline__ float scan_max(float v, int lane) {
#pragma unroll
    for (int o = 1; o < 64; o <<= 1) { const float t = __shfl_up(v, o); if (lane >= o) v = fmaxf(v, t); }
    return v;
}
constexpr int P72 = 72, P104 = 104;
__device__ __forceinline__ int unit_of(const Wk& W, int k) { const int run = W.vcu + (k >> 3) * W.G; return run < 256 ? run * 8 + (k & 7) : -1; }
__device__ __forceinline__ float sum8(const u32x4 q) { return ((bflo(q.x) + bfhi(q.x)) + (bflo(q.y) + bfhi(q.y))) + ((bflo(q.z) + bfhi(q.z)) + (bflo(q.w) + bfhi(q.w))); }

__device__ __forceinline__ void pass1_phase(const Params& P, const Wk& W, LAS unsigned char* lds) {
    unsigned char* ws = P.ws;
    LAS bf16_t* vT = (LAS bf16_t*)lds;
    LAS bf16_t* kwT = (LAS bf16_t*)(lds + 27648);
    LAS float* wsl = (LAS float*)(lds + 41472);
    LAS bf16_t* Cs = (LAS bf16_t*)(lds + 41792);
    const float* ifp = (const float*)(ws + WS_IFP);
    const bf16_t* QK = (const bf16_t*)(ws + WS_QK); const bf16_t* VV = (const bf16_t*)(ws + WS_VV);
    const int tid = W.tid, lane = W.lane, wid = W.wave, r32 = lane & 31, hi = lane >> 5;
    int kq = 0; int u = unit_of(W, 0); if (u < 0) return;
    u32x4 q[5]; float pli = 0.f, pf = 0.f;
    f32x16 T0 = f32x16{}, T1 = f32x16{}, T2 = f32x16{}; float mt_run = -1e30f, bl_run = 0.f, tn_run = 0.f;
#define P1_LOAD(uu) do { const int bh_ = (uu) >> 6, c_ = (uu) & 63, b_ = bh_ >> 2, h_ = bh_ & 3, row0_ = b_ * SEQ + c_ * 64; \
        _Pragma("unroll") for (int i = 0; i < 5; ++i) { const int id = tid + 512 * i; \
            if (id < 768) q[i] = *(const u32x4*)((const char*)QK + (unsigned)((((bh_ * SEQ) + c_ * 64 + (id & 63)) * 192 + 96 + (id >> 6) * 8) * 2)); \
            else if (id < 2304) q[i] = *(const u32x4*)((const char*)VV + (unsigned)((((bh_ * SEQ) + c_ * 64 + (id & 63)) * 192 + ((id - 768) >> 6) * 8) * 2)); } \
        if (wid == 0) { pli = *(const float*)((const char*)ifp + (unsigned)(((row0_ + lane) * 8 + h_) * 4)); pf = *(const float*)((const char*)ifp + (unsigned)(((row0_ + lane) * 8 + 4 + h_) * 4)); } } while (0)
    P1_LOAD(u);
    for (;;) {
        const int un = unit_of(W, kq + 1);
        if (wid == 0) {
            const float bcs = scan_add(logsigmoid_f(pf), lane);
            const float bL = __shfl(bcs, 63);
            const float dec = bL - bcs + pli;
            const float mloc = wave_max(dec);
            wsl[lane] = __expf(dec - mloc);
            if (lane == 0) { ((float*)(ws + WS_BL))[u] = bL; ((float*)(ws + WS_MLOC))[u] = mloc; wsl[64] = bL; wsl[65] = mloc; }
        }
        __syncthreads();
        float a_run, w_run; { const float bL = wsl[64], ml = wsl[65]; const float mn = fmaxf(bL + mt_run, ml); a_run = __expf(bL + mt_run - mn); w_run = __expf(ml - mn); mt_run = mn; bl_run += bL; }
#pragma unroll
        for (int i = 0; i < 5; ++i) { const int id = tid + 512 * i, row = id & 63;
            if (id < 768) { const int cc = id >> 6; const float wv = wsl[row];
                const float e[8] = {bflo(q[i].x), bfhi(q[i].x), bflo(q[i].y), bfhi(q[i].y), bflo(q[i].z), bfhi(q[i].z), bflo(q[i].w), bfhi(q[i].w)};
#pragma unroll
                for (int j = 0; j < 8; ++j) kwT[(cc * 8 + j) * P72 + row] = f2bf(e[j] * wv);
            } else if (id < 2304) { const int cc = (id - 768) >> 6;
                const unsigned short e[8] = {(unsigned short)(q[i].x & 0xffff), (unsigned short)(q[i].x >> 16), (unsigned short)(q[i].y & 0xffff), (unsigned short)(q[i].y >> 16), (unsigned short)(q[i].z & 0xffff), (unsigned short)(q[i].z >> 16), (unsigned short)(q[i].w & 0xffff), (unsigned short)(q[i].w >> 16)};
#pragma unroll
                for (int j = 0; j < 8; ++j) vT[(cc * 8 + j) * P72 + row] = e[j]; }
        }
        __syncthreads();
        if (un >= 0) P1_LOAD(un);
        for (int tt = wid; tt < 18; tt += 8) {
            const int mt = tt / 3, nt = tt % 3;
            f32x16 acc = f32x16{};
            acc = tile32<4>(vT + mt * 32 * P72, P72, kwT + nt * 32 * P72, P72, r32, hi, acc);
            if (tt < 8) T0 = T0 * a_run + acc * w_run; else if (tt < 16) T1 = T1 * a_run + acc * w_run; else T2 = T2 * a_run + acc * w_run;
#pragma unroll
            for (int r = 0; r < 16; ++r) Cs[(mt * 32 + crow(r, hi)) * P104 + nt * 32 + r32] = f2bf(acc[r]);
        }
        if (tid < 384) { const int dk = tid >> 2, sub = tid & 3;
            float sd = sum8(*(const LAS u32x4*)(kwT + dk * P72 + sub * 8)) + sum8(*(const LAS u32x4*)(kwT + dk * P72 + (sub + 4) * 8));
            sd += __shfl_xor(sd, 1); sd += __shfl_xor(sd, 2);
            if (sub == 0) { ((float*)(ws + WS_DN))[(size_t)u * 96 + dk] = sd; tn_run = tn_run * a_run + sd * w_run; } }
        __syncthreads();
        { char* DCb = (char*)(ws + WS_DC) + (size_t)u * (192 * 96 * 2);
#pragma unroll
          for (int i = 0; i < 5; ++i) { const int id = tid + 512 * i; if (id < 2304) { const int dv = id / 12, cc = id % 12; *(u32x4*)(DCb + (unsigned)(id * 16)) = *(const LAS u32x4*)(Cs + dv * P104 + cc * 8); } } }
        if ((kq & 7) == 7) {
            const int run = u >> 3;
            __syncthreads();
#pragma unroll
            for (int k3 = 0; k3 < 3; ++k3) { const int tt = wid + 8 * k3; if (tt < 18) { const int mt = tt / 3, nt = tt % 3; const f32x16 Tv = (k3 == 0) ? T0 : (k3 == 1) ? T1 : T2;
#pragma unroll
                for (int r = 0; r < 16; ++r) Cs[(mt * 32 + crow(r, hi)) * P104 + nt * 32 + r32] = f2bf(Tv[r]); } }
            if (tid < 384 && (tid & 3) == 0) ((float*)(ws + WS_RN))[run * 96 + (tid >> 2)] = tn_run;
            if (tid == 0) { ((float*)(ws + WS_RBL))[run] = bl_run; ((float*)(ws + WS_RBL))[256 + run] = mt_run; }
            __syncthreads();
            { char* RSb = (char*)(ws + WS_RS) + (size_t)run * (192 * 96 * 2);
#pragma unroll
              for (int i = 0; i < 5; ++i) { const int id = tid + 512 * i; if (id < 2304) { const int dv = id / 12, cc = id % 12; *(u32x4*)(RSb + (unsigned)(id * 16)) = *(const LAS u32x4*)(Cs + dv * P104 + cc * 8); } } }
            T0 = f32x16{}; T1 = f32x16{}; T2 = f32x16{}; mt_run = -1e30f; bl_run = 0.f; tn_run = 0.f;
        }
        if (un < 0) break;
        u = un; ++kq;
    }
#undef P1_LOAD
    __syncthreads();
}

__device__ __forceinline__ void pass2(const Params& P, const Wk& W) {
    unsigned char* ws = P.ws;
    const float* BL = (const float*)(ws + WS_RBL); const float* ML = BL + 256; float* MS = (float*)(ws + WS_RBL) + 512;
    const int gt = (W.wave * W.G + W.vcu) * 64 + W.lane, NGT = W.G * 512;
    constexpr int NCE = 32 * 2304, NNE = 32 * 96;
    for (int g = gt; g < NCE + NNE; g += NGT) {
        if (g < NCE) {
            const int bh = g / 2304, e = g % 2304;
            float C[8]; float m = 0.f; float z0 = 0.f; asm volatile("" : "+v"(z0));
#pragma unroll
            for (int j = 0; j < 8; ++j) C[j] = z0;
            u32x4* base = (u32x4*)((bf16_t*)(ws + WS_RS) + (size_t)bh * 8 * 18432 + e * 8);
            u32x4 d[8]; float bL[8], ml[8];
#pragma unroll
            for (int j = 0; j < 8; ++j) { d[j] = base[(size_t)j * (18432 / 8)]; bL[j] = BL[bh * 8 + j]; ml[j] = ML[bh * 8 + j]; }
#pragma unroll
            for (int j = 0; j < 8; ++j) {
                u32x4 o; o.x = cvt_pk_bf16(C[0], C[1]); o.y = cvt_pk_bf16(C[2], C[3]); o.z = cvt_pk_bf16(C[4], C[5]); o.w = cvt_pk_bf16(C[6], C[7]);
                base[(size_t)j * (18432 / 8)] = o;
                if (e == 0) MS[bh * 8 + j] = m;
                const float mn = fmaxf(bL[j] + m, ml[j]), a = __expf(bL[j] + m - mn), w = __expf(ml[j] - mn);
                C[0] = a * C[0] + w * bflo(d[j].x); C[1] = a * C[1] + w * bfhi(d[j].x); C[2] = a * C[2] + w * bflo(d[j].y); C[3] = a * C[3] + w * bfhi(d[j].y);
                C[4] = a * C[4] + w * bflo(d[j].z); C[5] = a * C[5] + w * bfhi(d[j].z); C[6] = a * C[6] + w * bflo(d[j].w); C[7] = a * C[7] + w * bfhi(d[j].w);
                m = mn;
            }
        } else {
            const int g2 = g - NCE, bh = g2 / 96, e = g2 % 96;
            float n = 0.f, m = 0.f; float* base = (float*)(ws + WS_RN) + (size_t)bh * 8 * 96 + e;
            float d[8], bL[8], ml[8];
#pragma unroll
            for (int j = 0; j < 8; ++j) { d[j] = base[j * 96]; bL[j] = BL[bh * 8 + j]; ml[j] = ML[bh * 8 + j]; }
#pragma unroll
            for (int j = 0; j < 8; ++j) { base[j * 96] = n; const float mn = fmaxf(bL[j] + m, ml[j]), a = __expf(bL[j] + m - mn), w = __expf(ml[j] - mn); n = a * n + w * d[j]; m = mn; }
        }
    }
}

__device__ __forceinline__ void pass3_phase(const Params& P, const Wk& W, LAS unsigned char* lds) {
    unsigned char* ws = P.ws;
    LAS bf16_t* Qs = (LAS bf16_t*)lds;
    LAS bf16_t* Ks = (LAS bf16_t*)(lds + 13312);
    LAS bf16_t* vT = (LAS bf16_t*)(lds + 26624);
    LAS bf16_t* CT = (LAS bf16_t*)(lds + 54272);
    LAS bf16_t* Ps = (LAS bf16_t*)(lds + 94208);
    LAS float* Hs = (LAS float*)lds;
    LAS float* sm = (LAS float*)(lds + 103424);
    LAS float* g_s = sm, *Mt = sm + 64, *wint = sm + 128, *eneg = sm + 192, *qn = sm + 256, *rden = sm + 320, *nvec = sm + 384;
    const float* ifp = (const float*)(ws + WS_IFP);
    const bf16_t* QK = (const bf16_t*)(ws + WS_QK); const bf16_t* VV = (const bf16_t*)(ws + WS_VV);
    const int tid = W.tid, lane = W.lane, wid = W.wave, r32 = lane & 31, hi = lane >> 5;
    int kq = 0; int u = unit_of(W, 0); if (u < 0) return;
    u32x4 qa[3], qb[3], qc[5]; float pli = 0.f, pf = 0.f, pn = 0.f, pc0 = 0.f, pbl = 0.f, pml = 0.f;
    u32x4 Cr[5]; float n_reg = 0.f, m_cur = 0.f;
#define P3_LOAD(uu) do { const int bh_ = (uu) >> 6, c_ = (uu) & 63, b_ = bh_ >> 2, h_ = bh_ & 3, row0_ = b_ * SEQ + c_ * 64; \
        const char* CS_ = (const char*)(ws + WS_DC) + (size_t)(uu) * (192 * 96 * 2); \
        _Pragma("unroll") for (int i = 0; i < 3; ++i) { const int id = tid + 512 * i; \
            { const int which = id / 768, i2 = id % 768, row = i2 / 12, cc = i2 % 12; qa[i] = *(const u32x4*)((const char*)QK + (unsigned)((((bh_ * SEQ) + c_ * 64 + row) * 192 + which * 96 + cc * 8) * 2)); } \
            { const int cc = id >> 6, row = id & 63; qb[i] = *(const u32x4*)((const char*)VV + (unsigned)((((bh_ * SEQ) + c_ * 64 + row) * 192 + cc * 8) * 2)); } } \
        _Pragma("unroll") for (int i = 0; i < 5; ++i) { const int id = tid + 512 * i; if (id < 2304) qc[i] = *(const u32x4*)(CS_ + (unsigned)(id * 16)); } \
        pbl = ((const float*)(ws + WS_BL))[uu]; pml = ((const float*)(ws + WS_MLOC))[uu]; \
        if (wid == 0) { pc0 = ((const float*)(ws + WS_C0))[bh_]; pli = *(const float*)((const char*)ifp + (unsigned)(((row0_ + lane) * 8 + h_) * 4)); pf = *(const float*)((const char*)ifp + (unsigned)(((row0_ + lane) * 8 + 4 + h_) * 4)); } \
        if (tid < 96) pn = *(const float*)((const char*)(ws + WS_DN) + (unsigned)(((uu) * 96 + tid) * 4)); } while (0)
    P3_LOAD(u);
    for (;;) {
        const int bh = u >> 6, c = u & 63, b = bh >> 2, h = bh & 3, row0 = b * SEQ + c * 64;
        const int un = unit_of(W, kq + 1);
        const float c0cur = pc0;
        int tid_l = W.tid; asm volatile("" : "+v"(tid_l));
        const int tid = tid_l, lane = tid & 63, r32 = lane & 31, hi = lane >> 5;
        if ((kq & 7) == 0) {
            const int run = u >> 3; const char* RSb = (const char*)(ws + WS_RS) + (size_t)run * (192 * 96 * 2);
#pragma unroll
            for (int i = 0; i < 5; ++i) { const int id = tid + 512 * i; if (id < 2304) Cr[i] = *(const u32x4*)(RSb + (unsigned)(id * 16)); }
            if (tid < 96) n_reg = ((const float*)(ws + WS_RN))[run * 96 + tid];
            m_cur = ((const float*)(ws + WS_RBL))[512 + run];
        }
        if (wid == 0) {
            const float bcs = scan_add(logsigmoid_f(pf), lane);
            const float g = pli - bcs;
            const float pmx = scan_max(g, lane);
            const float M = fmaxf(m_cur, pmx);
            g_s[lane] = g; Mt[lane] = M; wint[lane] = __expf(m_cur - M); eneg[lane] = __expf(-bcs - M);
        }
#pragma unroll
        for (int i = 0; i < 3; ++i) { const int id = tid + 512 * i;
            { const int which = id / 768, i2 = id % 768, row = i2 / 12, cc = i2 % 12; *(LAS u32x4*)((which ? Ks : Qs) + row * P104 + cc * 8) = qa[i]; }
            { const int cc = id >> 6, row = id & 63;
              const unsigned short e[8] = {(unsigned short)(qb[i].x & 0xffff), (unsigned short)(qb[i].x >> 16), (unsigned short)(qb[i].y & 0xffff), (unsigned short)(qb[i].y >> 16), (unsigned short)(qb[i].z & 0xffff), (unsigned short)(qb[i].z >> 16), (unsigned short)(qb[i].w & 0xffff), (unsigned short)(qb[i].w >> 16)};
#pragma unroll
              for (int j = 0; j < 8; ++j) vT[(cc * 8 + j) * P72 + row] = e[j]; } }
        {
            const float mn = fmaxf(pbl + m_cur, pml), a_ = __expf(pbl + m_cur - mn), w_ = __expf(pml - mn);
#pragma unroll
            for (int i = 0; i < 5; ++i) { const int id = tid + 512 * i; if (id < 2304) { const int dv = id / 12, cc = id % 12;
                const u32x4 cq = Cr[i], d = qc[i];
                *(LAS u32x4*)(CT + dv * P104 + cc * 8) = cq;
                u32x4 o;
                o.x = cvt_pk_bf16(a_ * bflo(cq.x) + w_ * bflo(d.x), a_ * bfhi(cq.x) + w_ * bfhi(d.x)); o.y = cvt_pk_bf16(a_ * bflo(cq.y) + w_ * bflo(d.y), a_ * bfhi(cq.y) + w_ * bfhi(d.y));
                o.z = cvt_pk_bf16(a_ * bflo(cq.z) + w_ * bflo(d.z), a_ * bfhi(cq.z) + w_ * bfhi(d.z)); o.w = cvt_pk_bf16(a_ * bflo(cq.w) + w_ * bflo(d.w), a_ * bfhi(cq.w) + w_ * bfhi(d.w));
                Cr[i] = o; } }
            if (tid < 96) { nvec[tid] = n_reg; n_reg = a_ * n_reg + w_ * pn; }
            m_cur = mn;
        }
        __syncthreads();
        if (un >= 0) P3_LOAD(un);
        __builtin_amdgcn_sched_barrier(0);
        if (wid < 4) {
            const int mt = wid >> 1, nt = wid & 1;
            f32x16 acc = f32x16{};
            acc = tile32<6>(Qs + mt * 32 * P104, P104, Ks + nt * 32 * P104, P104, r32, hi, acc);
#ifndef NO_FIRST_TOKEN
            if (c == 0 && wid == 0 && lane == 0) acc[0] = c0cur;
#endif
            const int s = nt * 32 + r32; const float gs = g_s[s];
#pragma unroll
            for (int r = 0; r < 16; ++r) { const int t = mt * 32 + crow(r, hi);
                const float w = (s <= t) ? __expf(gs - Mt[t]) : 0.f;
                Ps[t * P72 + s] = f2bf(acc[r] * w); }
        } else {
            const int t = (tid - 256) >> 2, sub = tid & 3; float a = 0.f;
#pragma unroll
            for (int j = 0; j < 3; ++j) { const int cc = sub + 4 * j; const u32x4 q = *(const LAS u32x4*)(Qs + t * P104 + cc * 8); const LAS float* nv = nvec + cc * 8;
                a += (bflo(q.x) * nv[0] + bfhi(q.x) * nv[1]) + (bflo(q.y) * nv[2] + bfhi(q.y) * nv[3]) + (bflo(q.z) * nv[4] + bfhi(q.z) * nv[5]) + (bflo(q.w) * nv[6] + bfhi(q.w) * nv[7]); }
            a += __shfl_xor(a, 1); a += __shfl_xor(a, 2);
            if (sub == 0) qn[t] = a;
        }
        __syncthreads();
        { const int t = tid >> 3, sub = tid & 7;
          float rs = sum8(*(const LAS u32x4*)(Ps + t * P72 + sub * 8));
          rs += __shfl_xor(rs, 1); rs += __shfl_xor(rs, 2); rs += __shfl_xor(rs, 4);
          if (sub == 0) { float den = wint[t] * qn[t] + rs; den = fmaxf(fabsf(den), eneg[t]); rden[t] = __builtin_amdgcn_rcpf(den); } }
        const int te = tid >> 3, sube = tid & 7;
        const bf16_t* G2 = (const bf16_t*)(ws + WS_G) + (size_t)(row0 + te) * G2W; const bf16_t* UC = (const bf16_t*)(ws + WS_UC) + (size_t)(row0 + te) * 768;
        u32x4 eop[3], egq[3], euq[3];
#pragma unroll
        for (int j = 0; j < 3; ++j) { const int col = h * 192 + (sube + 8 * j) * 8; eop[j] = *(const u32x4*)(G2 + G2_O + col); egq[j] = *(const u32x4*)(G2 + G2_GATE + col); euq[j] = *(const u32x4*)(UC + col); }
        f32x16 accA = f32x16{}, accB = f32x16{};
        {
            const int tt = (wid < 4) ? (8 + wid) : (wid - 4), mt = tt / 6, nt = tt % 6;
            accA = tile32<6>(Qs + mt * 32 * P104, P104, CT + nt * 32 * P104, P104, r32, hi, accA);
#pragma unroll
            for (int r = 0; r < 16; ++r) accA[r] *= wint[mt * 32 + crow(r, hi)];
            accA = tile32<4>(Ps + mt * 32 * P72, P72, vT + nt * 32 * P72, P72, r32, hi, accA);
        }
        if (wid >= 4) {
            const int tt = wid, mt = tt / 6, nt = tt % 6;
            accB = tile32<6>(Qs + mt * 32 * P104, P104, CT + nt * 32 * P104, P104, r32, hi, accB);
#pragma unroll
            for (int r = 0; r < 16; ++r) accB[r] *= wint[mt * 32 + crow(r, hi)];
            accB = tile32<4>(Ps + mt * 32 * P72, P72, vT + nt * 32 * P72, P72, r32, hi, accB);
        }
        __syncthreads();
        {
            const int tt = (wid < 4) ? (8 + wid) : (wid - 4), mt = tt / 6, nt = tt % 6;
#pragma unroll
            for (int r = 0; r < 16; ++r) { const int t = mt * 32 + crow(r, hi); Hs[t * 196 + nt * 32 + r32] = accA[r] * rden[t]; }
        }
        if (wid >= 4) {
            const int tt = wid, mt = tt / 6, nt = tt % 6;
#pragma unroll
            for (int r = 0; r < 16; ++r) { const int t = mt * 32 + crow(r, hi); Hs[t * 196 + nt * 32 + r32] = accB[r] * rden[t]; }
        }
        __syncthreads();
        __builtin_amdgcn_sched_barrier(0);
        {
            float hv[3][8]; float ss = 0.f;
#pragma unroll
            for (int j = 0; j < 3; ++j) { const int col = (sube + 8 * j) * 8;
                const f32x4 a = *(const LAS f32x4*)(Hs + te * 196 + col), bq = *(const LAS f32x4*)(Hs + te * 196 + col + 4);
                hv[j][0] = a.x; hv[j][1] = a.y; hv[j][2] = a.z; hv[j][3] = a.w; hv[j][4] = bq.x; hv[j][5] = bq.y; hv[j][6] = bq.z; hv[j][7] = bq.w;
#pragma unroll
                for (int e = 0; e < 8; ++e) ss += hv[j][e] * hv[j][e]; }
            ss += __shfl_xor(ss, 1); ss += __shfl_xor(ss, 2); ss += __shfl_xor(ss, 4);
            const float rstd = rsqrtf(ss * (1.f / 192.f) + EPS);
            bf16_t* Y = (bf16_t*)(ws + WS_Y2) + (size_t)(row0 + te) * DM;
#pragma unroll
            for (int j = 0; j < 3; ++j) { const int col = h * 192 + (sube + 8 * j) * 8;
                const u32x4 op = eop[j], gq = egq[j], uq = euq[j];
                const float ov[8] = {bflo(op.x), bfhi(op.x), bflo(op.y), bfhi(op.y), bflo(op.z), bfhi(op.z), bflo(op.w), bfhi(op.w)};
                const float gv[8] = {bflo(gq.x), bfhi(gq.x), bflo(gq.y), bfhi(gq.y), bflo(gq.z), bfhi(gq.z), bflo(gq.w), bfhi(gq.w)};
                const float uv[8] = {bflo(uq.x), bfhi(uq.x), bflo(uq.y), bfhi(uq.y), bflo(uq.z), bfhi(uq.z), bflo(uq.w), bfhi(uq.w)};
                float o[8];
#pragma unroll
                for (int e = 0; e < 8; ++e) { const float hn = hv[j][e] * rstd * P.b_head_g[col + e]; const float mix = sigmoid_f(ov[e]) * hn + P.b_skip[col + e] * uv[e]; o[e] = mix * silu_f(gv[e]); }
                u32x4 w; w.x = cvt_pk_bf16(o[0], o[1]); w.y = cvt_pk_bf16(o[2], o[3]); w.z = cvt_pk_bf16(o[4], o[5]); w.w = cvt_pk_bf16(o[6], o[7]);
                *(u32x4*)(Y + col) = w; }
        }
        __syncthreads();
        if (un < 0) break;
        u = un; ++kq;
    }
#undef P3_LOAD
}
}
typedef GAS unsigned gu32;
#define XB_TMO      128
#define XB_XCNT(j)  (256  + 64 * (j))
#define XB_XSUB(j)  (1280 + 64 * (j))
#define XB_XGEN(j)  (2304 + 64 * (j))
#define XB_TOP      3328
#define XB_TOPGEN   3392
#define XCD_BAR_WORDS 3456
#define XB_SPIN_CAP (1u << 18)
__device__ __forceinline__ unsigned xb_ld(unsigned* p)              { return __hip_atomic_load(p, __ATOMIC_RELAXED, __HIP_MEMORY_SCOPE_AGENT); }
__device__ __forceinline__ unsigned xb_add(unsigned* p, unsigned v) { return __hip_atomic_fetch_add(p, v, __ATOMIC_RELAXED, __HIP_MEMORY_SCOPE_AGENT); }
__device__ __forceinline__ unsigned xb_xcc_id() { return (unsigned)__builtin_amdgcn_s_getreg((3 << 11) | 20) & 0xFu; }
#define XB_SPIN(cond, bar) do { unsigned _sp = 0; while (cond) { __builtin_amdgcn_s_sleep(1); \
    if ((++_sp & 255u) == 0u) { if (xb_ld(&(bar)[XB_TMO])) break; if (_sp > XB_SPIN_CAP) { atomicAdd(&(bar)[XB_TMO], 1u); break; } } } } while (0)
struct XcdBarrier { unsigned* bar; unsigned x; volatile LAS unsigned* st; };
__device__ __forceinline__ XcdBarrier xcd_barrier_post(unsigned* bar, volatile LAS unsigned* st) {
    XcdBarrier b; b.bar = bar; b.x = xb_xcc_id(); b.st = st;
    if (threadIdx.x == 0) (void)xb_add(&bar[XB_XCNT(b.x)], 1u);
    return b;
}
__device__ __forceinline__ void xcd_barrier_complete(unsigned* bar, unsigned x, unsigned& nloc, unsigned& nx) {
    const unsigned G = gridDim.x * gridDim.y * gridDim.z;
    unsigned sum, cnt, mine, sp = 0u;
    for (;;) {
        sum = 0u; cnt = 0u; mine = 0u;
#pragma unroll
        for (unsigned j = 0; j < 16; ++j) { const unsigned c = xb_ld(&bar[XB_XCNT(j)]); sum += c; cnt += (c > 0u) ? 1u : 0u; mine = (j == x) ? c : mine; }
        if (sum == G) break;
        __builtin_amdgcn_s_sleep(1);
        if ((++sp & 255u) == 0u) { if (xb_ld(&bar[XB_TMO])) break; if (sp > XB_SPIN_CAP) { atomicAdd(&bar[XB_TMO], 1u); break; } }
    }
    nloc = mine > 0u ? mine : 1u; nx = cnt > 0u ? cnt : 1u;
}
__device__ __forceinline__ void xcd_barrier(const XcdBarrier& b) {
    asm volatile("s_waitcnt vmcnt(0)" ::: "memory");
    __syncthreads();
    if (threadIdx.x == 0) {
        unsigned* bar = b.bar;
        __builtin_amdgcn_s_waitcnt(0);
        unsigned nloc = b.st[0], nx = b.st[1];
        if (nloc == 0u) { xcd_barrier_complete(bar, b.x, nloc, nx); b.st[0] = nloc; b.st[1] = nx; }
        const unsigned old = xb_add(&bar[XB_XSUB(b.x)], 1u);
        const unsigned gen = old / nloc;
        if (old + 1u == (gen + 1u) * nloc) {
            __builtin_amdgcn_fence(__ATOMIC_RELEASE, "agent");
            asm volatile("s_waitcnt vmcnt(0)" ::: "memory");
            const unsigned og = xb_add(&bar[XB_TOP], 1u);
            const unsigned tg = og / nx;
            if (og + 1u == (tg + 1u) * nx) xb_add(&bar[XB_TOPGEN], 1u);
            else XB_SPIN(xb_ld(&bar[XB_TOPGEN]) == tg, bar);
            __builtin_amdgcn_fence(__ATOMIC_ACQUIRE, "agent");
            xb_add(&bar[XB_XGEN(b.x)], 1u);
            asm volatile("s_waitcnt vmcnt(0)" ::: "memory");
        } else {
            XB_SPIN(xb_ld(&bar[XB_XGEN(b.x)]) == gen, bar);
            __builtin_amdgcn_fence(__ATOMIC_ACQUIRE, "agent");
            asm volatile("s_waitcnt vmcnt(0)" ::: "memory");
        }
    }
    __syncthreads();
}

constexpr int RING_BYTES = 131072, LDSCTL_OFF = RING_BYTES, LDS_BYTES = 147456;
constexpr int CW_BAR = 4096;
constexpr int CW_XCNT = 16384;
constexpr int CW_XTMO = 8192;
#ifdef FUSED_FINAL
constexpr int N_PHASES = 13;
#else
constexpr int N_PHASES = 14;
#endif

__device__ __forceinline__ void setup_job(const Params& P, int j, pg8::Gemm& g, pg8::Epi& E) {
    unsigned char* ws = P.ws;
    E.out = nullptr; E.ldc = 0; E.ncols = 1 << 30; E.out2 = nullptr; E.ldc2 = 0; E.split = 1 << 30; E.rs = nullptr; E.rs_mode = 0; E.rs_invdim = 0.f;
    E.ssqA = nullptr; E.ssqB = nullptr; E.ssq_mode = 0; E.rope = (const float2*)(ws + WS_ROPE); E.rope_mode = 0; E.hm_mode = 0;
    E.after = 0; E.fbase = nullptr; E.fout = nullptr; E.fgain = nullptr; E.xslots = (unsigned*)(ws + WS_XSL); E.xcnt = (unsigned*)(ws + WS_CTL) + CW_XCNT; E.xtmo = (unsigned*)(ws + WS_CTL) + CW_XTMO;
    g.M = T; g.lda = 1024; g.apn = 0;
    switch (j) {
    case 0: g.A = (const bf16_t*)(ws + WS_XB); g.Bt = (const bf16_t*)(ws + WS_WINA); g.N = 2048; g.K = 1024;
        E.out = (bf16_t*)(ws + WS_G); E.ldc = G1W; E.rs = (const float*)(ws + WS_RSTD); E.rs_mode = 1; E.ssqA = (float*)(ws + WS_SSQA); E.ssqB = (float*)(ws + WS_SSQB); E.ssq_mode = 1; E.rope_mode = 1; break;
    case 1: g.A = (const bf16_t*)(ws + WS_MEMN); g.Bt = (const bf16_t*)(ws + WS_WMKV); g.M = NB * NMEM; g.N = 1024; g.K = 1024;
        E.out = (bf16_t*)(ws + WS_KVM); E.ldc = 1024; break;
    case 2: g.A = (const bf16_t*)(ws + WS_G) + G1_CQ; g.lda = G1W; g.Bt = (const bf16_t*)(ws + WS_WUQ); g.N = 1280; g.K = 384;
        E.out = (bf16_t*)(ws + WS_Q); E.ldc = QW; E.ncols = QW; E.rs = (const float*)(ws + WS_SSQA); E.rs_mode = 2; E.rs_invdim = 1.f / 384.f; E.rope_mode = 2; break;
    case 3: g.A = (const bf16_t*)(ws + WS_G) + G1_CKV; g.lda = G1W; g.Bt = (const bf16_t*)(ws + WS_WUKV); g.N = 1536; g.K = 256;
        E.out = (bf16_t*)(ws + WS_KN); E.ldc = 768; E.out2 = (bf16_t*)(ws + WS_V); E.ldc2 = 768; E.split = 768; E.rs = (const float*)(ws + WS_SSQB); E.rs_mode = 2; E.rs_invdim = 1.f / 256.f; break;
    case 4: g.A = (const bf16_t*)(ws + WS_Y); g.Bt = (const bf16_t*)(ws + WS_WOA); g.N = 1024; g.K = 1024; E.out = (bf16_t*)(ws + WS_Z); E.ldc = 1024; break;
    case 5: g.A = (const bf16_t*)(ws + WS_XB); g.Bt = (const bf16_t*)(ws + WS_WINB); g.N = G2W; g.K = 1024;
        E.out = (bf16_t*)(ws + WS_G); E.ldc = G2W; E.rs = (const float*)(ws + WS_RSTD); E.rs_mode = 1; break;
    case 6: g.A = (const bf16_t*)(ws + WS_UC); g.lda = 768; g.apn = 192; g.Bt = (const bf16_t*)(ws + WS_WQK); g.N = 768; g.K = 384; E.out = (bf16_t*)(ws + WS_QK); E.ldc = 768; E.hm_mode = 1; break;
    case 7: g.A = (const bf16_t*)(ws + WS_G) + G2_U; g.lda = G2W; g.apn = 192; g.Bt = (const bf16_t*)(ws + WS_WV); g.N = 768; g.K = 384; E.out = (bf16_t*)(ws + WS_VV); E.ldc = 768; E.hm_mode = 1; break;
    default: g.A = (const bf16_t*)(ws + WS_Y2); g.Bt = (const bf16_t*)(ws + WS_WOB); g.N = 1024; g.K = 1024;
#ifdef FUSED_FINAL
        E.after = 1; E.fbase = P.out; E.fout = P.out; E.fgain = P.b_post_g; E.xcnt = (unsigned*)(ws + WS_CTL) + CW_XCNT + (j - 8) * 128 * 64;
#else
        E.out = (bf16_t*)(ws + WS_Z); E.ldc = 1024;
#endif
        break;
    }
}

__device__ __forceinline__ void phase_memattn(const Params& P, const Wk& W, LAS unsigned char* lds, int L) {
    unsigned char* ws = P.ws;
    const bf16_t* G = (const bf16_t*)(ws + WS_G); const bf16_t* KVM = (const bf16_t*)(ws + WS_KVM);
    const int gpitch = L ? G2W : G1W, qm_off = L ? G2_QM : G1_QM, gate_off = L ? G2_GATE : G1_GATE;
    bf16_t* Yb = (bf16_t*)(ws + (L ? WS_Y2 : WS_Y));
    for (int u = W.vcu; u < 512; u += W.G) {
        const int rb = u >> 2, hm = u & 3, row0 = rb * 256, b = row0 / SEQ;
        const bf16_t* Km = KVM + (size_t)(b * NMEM) * 1024 + L * 512 + hm * 64;
        att::attn_unit<64, 64, false>(G + (size_t)row0 * gpitch + qm_off + hm * 64, gpitch, Km, 1024, 8, Km, 1024, Km + 256, 1024, 4, 0,
                                      G + (size_t)row0 * gpitch + gate_off + 768 + hm * 64, gpitch, Yb + (size_t)row0 * DM + 768 + hm * 64, DM, lds, W.tid);
    }
}
template <int ABL>
__device__ __forceinline__ void phase_attn(const Params& P, const Wk& W, LAS unsigned char* lds) {
    unsigned char* ws = P.ws;
    const bf16_t* G = (const bf16_t*)(ws + WS_G); const bf16_t* Qp = (const bf16_t*)(ws + WS_Q); const bf16_t* KN = (const bf16_t*)(ws + WS_KN); const bf16_t* Vp = (const bf16_t*)(ws + WS_V);
    bf16_t* Yb = (bf16_t*)(ws + (ABL ? WS_Z : WS_Y));
    for (int u = W.vcu; u < 768; u += W.G) {
        const int k = u >> 8, cu = u & 255, grp = cu >> 4, i = cu & 15, bh = grp * 3 + k;
        const int qb = (k == 0) ? i : (k == 1) ? ((i + 8) & 15) : (i < 8 ? 15 - 2 * i : 30 - 2 * i);
        const int b = bh / 6, h = bh % 6; const size_t rowb = (size_t)b * SEQ, row0 = rowb + (size_t)qb * 256;
        int tid_u = W.tid; asm volatile("" : "+v"(tid_u));
        att::attn_unit<192, 128, true, ABL>(Qp + row0 * QW + h * 192, QW, KN + rowb * 768 + h * 128, 768, 16, G + rowb * G1W + G1_KR, G1W, Vp + rowb * 768 + h * 128, 768,
                                       4 * (qb + 1), qb * 256, G + row0 * G1W + G1_GATE + h * 128, G1W, Yb + row0 * DM + h * 128, DM, lds, tid_u);
    }
}

__global__ void __launch_bounds__(512, 2) mega_fwd(Params P) {
    extern __shared__ __attribute__((aligned(16))) unsigned char lds_raw[];
    LAS unsigned char* lds = (LAS unsigned char*)lds_raw;
    Wk W; W.tid = threadIdx.x; W.lane = W.tid & 63; W.wave = __builtin_amdgcn_readfirstlane(W.tid >> 6);
    W.G = gridDim.x; { const int bx = blockIdx.x; W.vcu = (W.G % 8 == 0) ? (bx % 8) * (W.G / 8) + bx / 8 : bx; }
    volatile LAS unsigned* MISC = (volatile LAS unsigned*)(lds + LDSCTL_OFF);
    if (W.tid < 64) MISC[W.tid] = 0u;
    __syncthreads();
    const int lo = P.ph_lo, hi = P.ph_hi;
    const int vcu_s = W.vcu;
    const int wave_s = __builtin_amdgcn_readfirstlane(threadIdx.x >> 6);
    XcdBarrier bar; bar.bar = (unsigned*)(P.ws + WS_CTL) + CW_BAR; bar.x = 0; bar.st = nullptr;
    if (hi - lo > 1) bar = xcd_barrier_post((unsigned*)(P.ws + WS_CTL) + CW_BAR, MISC + 8);
#ifndef PROBE_REP
#define PROBE_REP 0
#endif
#ifdef PROBE_PAIR
    bool pair_done = false;
#endif
    for (int ph2 = 2 * lo; ph2 < 2 * hi; ++ph2) {
        const int ph = ph2 >> 1;
        if ((ph2 & 1) && !((PROBE_REP >> ph) & 1)) continue;
        const bool more_ = (ph + 1 < hi) || (!(ph2 & 1) && ((PROBE_REP >> ph) & 1));
        { int t_; asm volatile("v_mbcnt_lo_u32_b32 %0, -1, 0\n\tv_mbcnt_hi_u32_b32 %0, -1, %0" : "=v"(t_)); t_ += wave_s * 64; { int g_ = gridDim.x, v_ = vcu_s; asm volatile("" : "+s"(g_), "+s"(v_)); W.G = g_; W.vcu = v_; } W.tid = t_; W.lane = t_ & 63; W.wave = __builtin_amdgcn_readfirstlane(t_ >> 6); }
        int j0 = 0, j1 = 0;
#ifdef DBG_CUT
        if (ph == 100) { const bf16_t* src = (const bf16_t*)(P.ws + (size_t)DBG_OFF); const int gt_ = W.vcu * 512 + W.tid, NGT_ = W.G * 512; for (int i = gt_; i < T * DM; i += NGT_) {
#ifdef DBG_F32N
            P.out[i] = (i < DBG_F32N) ? ((const float*)src)[i] : 0.f;
#else
            P.out[i] = bf2f(src[i]);
#endif
            } continue; }
#endif
#ifndef PHM
#define PHM 0xffff
#endif
#define PHON(k) ((PHM >> (k)) & 1)
        switch (ph) {
        case 0: if (PHON(0)) phase_prologue(P, W, lds); break;
        case 1: j0 = 0; j1 = 1; break;
        case 2: j0 = 1; j1 = 4; break;
        case 3: if (PHON(3)) {
#ifdef PROBE_ABL
            if (ph2 & 1) phase_attn<PROBE_ABL>(P, W, lds); else
#endif
            phase_attn<0>(P, W, lds); } break;
        case 4: j0 = 4; j1 = 5; break;
        case 5: if (PHON(5)) phase_rowmid(P, W, lds); break;
        case 6: j0 = 5; j1 = 6; break;
        case 7: if (PHON(7)) phase_conv(P, W); break;
        case 8: j0 = 6; j1 = 8; break;
        case 9: if (PHON(9)) ml::pass1_phase(P, W, lds); break;
        case 10: if (PHON(10)) { ml::pass2(P, W);
#ifndef NO_FIRST_TOKEN
            first_token_qk(P, W, lds);
#endif
            } break;
        case 11: if (PHON(11)) ml::pass3_phase(P, W, lds); break;
#ifdef FUSED_FINAL
        case 12: j0 = 8; j1 = 10; break;
        default: break;
#else
        case 12: j0 = 8; j1 = 9; break;
        default: if (PHON(13)) phase_rowfinal(P, W); break;
#endif
        }
        if (PHON(14) && (ph == 3 || ph == 9) && !(ph2 & 1)) phase_memattn(P, W, lds, ph == 9 ? 1 : 0);
        if (PHON(1)) for (int j = j0; j < j1; ++j) {
            pg8::Gemm g; pg8::Epi E; setup_job(P, j, g, E);
            const int shift = (j == 1) ? 128 : (j == 7) ? 128 : 0;
            pg8::StaticOrder S; S.init(g.M, g.N, W.G, (int)((blockIdx.x + shift) % W.G));
#ifdef FUSED_FINAL
            if (j >= 8) { S.i0 = j - 8; S.nmax = 1; }
#endif
            if (j == 2 && W.G == 256) S.give_lo = 128;
            pg8::gemm_phase<true>(lds, g, S, E, W.tid);
        }
#ifndef NO_FIRST_TOKEN
        if (ph == 6) { const int half = W.G / 2, nwk = W.G - half;
            if ((int)blockIdx.x >= half) for (int widx = (int)blockIdx.x - half; widx < 128; widx += nwk) first_token_u0(P, W, lds, widx); }
#endif
        if (more_) xcd_barrier(bar);
#ifdef PROBE_PAIR
        if (ph == PROBE_PAIR + 1 && !pair_done) { pair_done = true; ph2 = 2 * PROBE_PAIR - 1; }
#endif
    }
}

extern "C" void kernel_launch(void* const* d_in, const int* in_sizes, int n_in, void* d_out, int out_size, void* d_ws, size_t ws_size, hipStream_t stream) {
    static int grid = 0;
    if (grid == 0) {
        if (n_in != 27 || in_sizes[0] != T * DM || out_size != T * DM || ws_size < WS_END) {
            fprintf(stderr, "kernel_launch: unexpected shapes (n_in %d in0 %d out %d ws %zu)\n", n_in, n_in > 0 ? in_sizes[0] : -1, out_size, ws_size); grid = -1; return; }
        int dev = 0, cus = 0, per_cu = 0;
        if (hipGetDevice(&dev) != hipSuccess || hipDeviceGetAttribute(&cus, hipDeviceAttributeMultiprocessorCount, dev) != hipSuccess) { grid = -1; return; }
        if (hipFuncSetAttribute((const void*)mega_fwd, hipFuncAttributeMaxDynamicSharedMemorySize, LDS_BYTES) != hipSuccess) { fprintf(stderr, "kernel_launch: hipFuncSetAttribute failed\n"); grid = -1; return; }
        if (hipOccupancyMaxActiveBlocksPerMultiprocessor(&per_cu, (const void*)mega_fwd, 512, LDS_BYTES) != hipSuccess || per_cu < 1) { fprintf(stderr, "kernel_launch: occupancy query says %d\n", per_cu); }
        (void)hipGetLastError();
        grid = cus;
    }
    if (grid < 0) return;
    (void)hipMemsetAsync((char*)d_ws + WS_CTL, 0, CTL_ZERO_BYTES, stream);
    Params p{};
    const float** fp = (const float**)&p.a_pre_g;
    p.x = (const float*)d_in[0]; p.mem = (const float*)d_in[1]; p.pos = (const int*)d_in[2];
    for (int i = 0; i < 24; ++i) fp[i] = (const float*)d_in[3 + i];
    p.out = (float*)d_out; p.ws = (unsigned char*)d_ws;
#ifndef N_LAUNCH_SPLIT
#define N_LAUNCH_SPLIT 0
#endif
#ifdef DBG_CUT
    for (int ph = 0; ph < DBG_CUT; ++ph) { p.ph_lo = ph; p.ph_hi = ph + 1; hipLaunchKernelGGL(mega_fwd, dim3(grid), dim3(512), LDS_BYTES, stream, p); }
    p.ph_lo = 100; p.ph_hi = 101; hipLaunchKernelGGL(mega_fwd, dim3(grid), dim3(512), LDS_BYTES, stream, p);
#elif N_LAUNCH_SPLIT
    for (int ph = 0; ph < N_PHASES; ++ph) { p.ph_lo = ph; p.ph_hi = ph + 1; hipLaunchKernelGGL(mega_fwd, dim3(grid), dim3(512), LDS_BYTES, stream, p); }
#else
    p.ph_lo = 0; p.ph_hi = N_PHASES; hipLaunchKernelGGL(mega_fwd, dim3(grid), dim3(512), LDS_BYTES, stream, p);
#endif
}
```

```cpp
#include <hip/hip_runtime.h>
#include <cstdio>
#include <cstdint>

#define LAS __attribute__((address_space(3)))
#define GAS __attribute__((address_space(1)))
typedef unsigned short bf16_t;
typedef short bf16x8 __attribute__((ext_vector_type(8)));
typedef short s16x4 __attribute__((ext_vector_type(4)));
typedef float f32x4 __attribute__((ext_vector_type(4)));
typedef float f32x16 __attribute__((ext_vector_type(16)));
typedef unsigned u32x4 __attribute__((ext_vector_type(4)));
typedef unsigned u32x2 __attribute__((ext_vector_type(2)));

constexpr int NB = 8, SEQ = 4096, DM = 1024, T = NB * SEQ;
constexpr int NMEM = 256;
constexpr float EPS = 1e-6f;
constexpr int A_IN = 1984, B_IN = 2824;
constexpr int G1W = 2048;
constexpr int G1_CKV = 0, G1_CQ = 256, G1_KR = 640, G1_QM = 768, G1_GATE = 1024;
constexpr int G2W = 2816;
constexpr int G2_U = 0, G2_O = 768, G2_QM = 1536, G2_GATE = 1792;
constexpr int QW = 1152;
constexpr float LOG2E = 1.4426950408889634f;
constexpr float QSCALE = 0.07216878364870323f * LOG2E;
constexpr float MSCALE = 0.125f * LOG2E;
constexpr float KSCALE_B = 0.10206207261596577f;

constexpr size_t MiB = 1u << 20;
constexpr size_t WS_CTL = 0, CTL_ZERO_BYTES = 512 * 1024;
constexpr size_t WS_WINA = 2 * MiB;
constexpr size_t WS_WUQ = 6 * MiB;
constexpr size_t WS_WUKV = 7 * MiB;
constexpr size_t WS_WMKV = 8 * MiB;
constexpr size_t WS_WOA = 10 * MiB;
constexpr size_t WS_WINB = 12 * MiB;
constexpr size_t WS_WQK = 18 * MiB;
constexpr size_t WS_WV = 19 * MiB;
constexpr size_t WS_WOB = 20 * MiB;
constexpr size_t WS_WG = 22 * MiB;
constexpr size_t WS_RSTD = 23 * MiB;
constexpr size_t WS_SSQA = WS_RSTD + 128 * 1024;
constexpr size_t WS_SSQB = WS_SSQA + 128 * 1024;
constexpr size_t WS_ROPE = 24 * MiB;
constexpr size_t WS_MEMN = 32 * MiB;
constexpr size_t WS_KVM = 36 * MiB;
constexpr size_t WS_IFP = 40 * MiB;
constexpr size_t WS_BL = 41 * MiB;
constexpr size_t WS_MLOC = WS_BL + 8192;
constexpr size_t WS_MST = WS_MLOC + 8192;
constexpr size_t WS_C0 = WS_MST + 8192;
constexpr size_t WS_U0 = WS_C0 + 1024;
constexpr size_t WS_RS = 46 * MiB;
constexpr size_t WS_RN = 45 * MiB + 256 * 1024;
constexpr size_t WS_RBL = 45 * MiB + 512 * 1024;
constexpr size_t WS_X1F = 45 * MiB;
constexpr size_t WS_XSL = 44 * MiB;
constexpr size_t WS_DN = 42 * MiB;
constexpr size_t WS_XB = 64 * MiB;
constexpr size_t WS_Y = 64 * MiB;
constexpr size_t WS_G = 128 * MiB;
constexpr size_t WS_Q = 304 * MiB;
constexpr size_t WS_KN = 376 * MiB;
constexpr size_t WS_V = 424 * MiB;
constexpr size_t WS_Z = 304 * MiB;
constexpr size_t WS_UC = 304 * MiB;
constexpr size_t WS_QK = 352 * MiB;
constexpr size_t WS_VV = 400 * MiB;
constexpr size_t WS_Y2 = 448 * MiB;
constexpr size_t WS_END = 512 * MiB;

typedef float f32x2_t __attribute__((ext_vector_type(2))); typedef __bf16 bf16x2_t __attribute__((ext_vector_type(2)));
__device__ __forceinline__ unsigned cvt_pk_bf16(float lo, float hi) { f32x2_t v = {lo, hi}; bf16x2_t b = __builtin_convertvector(v, bf16x2_t); return __builtin_bit_cast(unsigned, b); }
__device__ __forceinline__ float bf2f(unsigned short b) { return __uint_as_float((unsigned)b << 16); }
__device__ __forceinline__ float bflo(unsigned w) { return __uint_as_float(w << 16); }
__device__ __forceinline__ float bfhi(unsigned w) { return __uint_as_float(w & 0xffff0000u); }
__device__ __forceinline__ unsigned short f2bf(float f) { return (unsigned short)(cvt_pk_bf16(f, f) & 0xffffu); }
__device__ __forceinline__ float wave_sum(float v) {
#pragma unroll
    for (int o = 1; o < 64; o <<= 1) v += __shfl_xor(v, o);
    return v;
}
__device__ __forceinline__ float wave_max(float v) {
#pragma unroll
    for (int o = 1; o < 64; o <<= 1) v = fmaxf(v, __shfl_xor(v, o));
    return v;
}
__device__ __forceinline__ float silu_f(float g) { return g * __builtin_amdgcn_rcpf(1.f + __expf(-g)); }
__device__ __forceinline__ float sigmoid_f(float g) { return __builtin_amdgcn_rcpf(1.f + __expf(-g)); }
namespace pg8 {
constexpr int BM = 256, BK = 64, HALF = 128, HTB = HALF * BK * 2  , STAGE_BYTES = 8 * HTB, NXCD = 8, WGM = 8;
__host__ __device__ __forceinline__ int lds_byte(int r, int c) { const int st = (r >> 4) * 2 + (c >> 5), rr = r & 15, cc = c & 31, ob = rr * 64 + cc * 2; return st * 1024 + (ob ^ (((ob >> 9) & 1) << 5)); }
__host__ __device__ __forceinline__ void stage_rc(int b, int& R, int& C) { const int st = b / 1024, sb = b % 1024, swz = sb ^ (((sb >> 9) & 1) << 5); R = (st >> 1) * 16 + swz / 64; C = (st & 1) * 32 + (swz % 64) / 2; }
__host__ __device__ __forceinline__ int perm32(int rho) { const int n = rho >> 4, i = rho & 15; return 8 * (i >> 2) + 4 * n + (i & 3); }

struct Unit { int pm, pn; };
struct Gemm { const bf16_t* A; const bf16_t* Bt; int M, N, K, lda, apn; };

struct StaticOrder {
    int nM, nN, nwg, G, c, i0, nmax;
    int give_lo;
    __host__ __device__ void init(int M, int N, int G_, int c_) { nM = M / BM; nN = N / BM; nwg = nM * nN; G = G_; c = c_; i0 = 0; nmax = 1 << 30; give_lo = -1; }
    __host__ __device__ bool next(int i, Unit& u) const {
        if (i >= nmax) return false;
        long L = (long)(i + i0) * G + c;
        if (give_lo >= 0) { if (c >= give_lo && c < give_lo + 32 && i == 1) return false; if (c >= give_lo + 32 && c < give_lo + 64 && i == 2) L = (long)G + (c - 32); }
        if (L >= nwg) return false;
        int wgid = (int)L; { const int q = nwg / NXCD, r = nwg % NXCD, xcd = wgid % NXCD, off = wgid / NXCD; wgid = (xcd < r ? xcd * (q + 1) : r * (q + 1) + (xcd - r) * q) + off; }
        const int nig = WGM * nN, gid = wgid / nig, fm = gid * WGM, gsz = (nM - fm) < WGM ? (nM - fm) : WGM;
        u.pm = fm + ((wgid % nig) % gsz); u.pn = (wgid % nig) / gsz; return true;
    }
};

__device__ __forceinline__ void rope8(float (&v)[8], const float2* rp) {
#pragma unroll
    for (int j = 0; j < 4; ++j) { const float2 cs = rp[j]; const float x1 = v[2 * j], x2 = v[2 * j + 1]; v[2 * j] = x1 * cs.x - x2 * cs.y; v[2 * j + 1] = x1 * cs.y + x2 * cs.x; }
}
struct Epi {
    bf16_t* out; int ldc; int ncols;
    bf16_t* out2; int ldc2; int split;
    const float* rs; int rs_mode; float rs_invdim;
    float* ssqA; float* ssqB; int ssq_mode;
    const float2* rope; int rope_mode;
    int hm_mode;
    int after; const float* fbase; float* fout; const float* fgain; unsigned* xslots; unsigned* xcnt; unsigned* xtmo;
    __device__ __forceinline__ void fused(const f32x4 (&acc)[2][2][4][2], const Unit& u, int wr, int wc, int fr, int fq, LAS unsigned char* lds, int wid, int lane) const {
        LAS float* Pp = (LAS float*)lds;
        LAS float* Sr = (LAS float*)(lds + 4096);
        LAS unsigned* flag = (LAS unsigned*)(lds + 4096 + 1024);
#pragma unroll
        for (int ai = 0; ai < 2; ++ai)
#pragma unroll
            for (int m = 0; m < 4; ++m) { float s = 0.f;
#pragma unroll
                for (int bj = 0; bj < 2; ++bj)
#pragma unroll
                    for (int n = 0; n < 2; ++n) { const f32x4 x = acc[ai][bj][m][n]; s += (x[0] * x[0] + x[1] * x[1]) + (x[2] * x[2] + x[3] * x[3]); }
                s += __shfl_xor(s, 16); s += __shfl_xor(s, 32);
                if (fq == 0) Pp[(ai * HALF + wr * 64 + m * 16 + fr) * 4 + wc] = s; }
        asm volatile("s_waitcnt lgkmcnt(0)" ::: "memory"); __builtin_amdgcn_s_barrier(); asm volatile("" ::: "memory");
        const int row = wid * 32 + (lane & 31);
        if (lane < 32) { const float t = (Pp[row * 4 + 0] + Pp[row * 4 + 1]) + (Pp[row * 4 + 2] + Pp[row * 4 + 3]);
            __hip_atomic_store(xslots + ((size_t)(u.pm * BM + row) * 4 + u.pn), __float_as_uint(t), __ATOMIC_RELAXED, __HIP_MEMORY_SCOPE_AGENT); }
        asm volatile("s_waitcnt vmcnt(0)" ::: "memory");
        if (lane == 0) __hip_atomic_fetch_add(xcnt + 64 * u.pm, 1u, __ATOMIC_RELAXED, __HIP_MEMORY_SCOPE_AGENT);
        if (wid == 0) { bool dead = false; const unsigned long long t0 = __builtin_amdgcn_s_memrealtime();
            for (;;) {
                if ((unsigned)__builtin_amdgcn_readfirstlane(__hip_atomic_load(xcnt + 64 * u.pm, __ATOMIC_RELAXED, __HIP_MEMORY_SCOPE_AGENT)) >= 32u) break;
                if (__builtin_amdgcn_s_memrealtime() - t0 > 2000000ull) { if (lane == 0) __hip_atomic_store(xtmo, 1u, __ATOMIC_RELAXED, __HIP_MEMORY_SCOPE_AGENT); dead = true; break; }
                __builtin_amdgcn_s_sleep(2); }
            __builtin_amdgcn_fence(__ATOMIC_ACQUIRE, "agent");
            if (lane == 0) flag[0] = dead ? 1u : 0u; }
        asm volatile("s_waitcnt vmcnt(0) lgkmcnt(0)" ::: "memory"); __builtin_amdgcn_s_barrier(); asm volatile("" ::: "memory");
        const bool bad = flag[0] != 0u;
        if (lane < 32) { const unsigned* sl = xslots + (size_t)(u.pm * BM + row) * 4; float q = 0.f;
#pragma unroll
            for (int t = 0; t < 4; ++t) q += __uint_as_float(__hip_atomic_load(sl + t, __ATOMIC_RELAXED, __HIP_MEMORY_SCOPE_AGENT));
            Sr[row] = rsqrtf(q * (1.f / 1024.f) + EPS); }
        asm volatile("s_waitcnt vmcnt(0) lgkmcnt(0)" ::: "memory"); __builtin_amdgcn_s_barrier(); asm volatile("" ::: "memory");
        const float qnan = __builtin_nanf("");
#pragma unroll
        for (int ai = 0; ai < 2; ++ai)
#pragma unroll
            for (int m = 0; m < 4; ++m) { const int r = ai * HALF + wr * 64 + m * 16 + fr; const float rs_ = bad ? qnan : Sr[r];
#pragma unroll
                for (int bj = 0; bj < 2; ++bj) { const int col0 = u.pn * BM + bj * HALF + wc * 32 + 8 * fq; const size_t off = (size_t)(u.pm * BM + r) * 1024 + col0;
                    *(f32x4*)(fout + off) = *(const f32x4*)(fbase + off) + acc[ai][bj][m][0] * rs_ * *(const f32x4*)(fgain + col0);
                    *(f32x4*)(fout + off + 4) = *(const f32x4*)(fbase + off + 4) + acc[ai][bj][m][1] * rs_ * *(const f32x4*)(fgain + col0 + 4); } }
        asm volatile("s_waitcnt lgkmcnt(0)" ::: "memory"); __builtin_amdgcn_s_barrier(); asm volatile("" ::: "memory");
    }
    __device__ __forceinline__ void operator()(const f32x4 (&acc)[2][2][4][2], const Unit& u, int wr, int wc, int fr, int fq) const {
#pragma unroll
        for (int ai = 0; ai < 2; ++ai)
#pragma unroll
            for (int m = 0; m < 4; ++m) {
                const int row = u.pm * BM + ai * HALF + wr * 64 + m * 16 + fr;
                float sc = 1.f;
                if (rs_mode == 1) sc = rs[row]; else if (rs_mode == 2) sc = rsqrtf(rs[row] * rs_invdim + EPS);
                float ss = 0.f;
#pragma unroll
                for (int bj = 0; bj < 2; ++bj) {
                    const int col0 = u.pn * BM + bj * HALF + wc * 32 + 8 * fq;
                    float v[8];
#pragma unroll
                    for (int j = 0; j < 4; ++j) { v[j] = acc[ai][bj][m][0][j] * sc; v[4 + j] = acc[ai][bj][m][1][j] * sc; }
                    if (ssq_mode == 1 && (u.pn < 2 || (u.pn == 2 && bj == 0))) {
#pragma unroll
                        for (int j = 0; j < 8; ++j) ss += v[j] * v[j];
                    }
                    if (rope_mode == 1) { if (col0 >= 640 && col0 < 704) rope8(v, rope + (size_t)row * 32 + ((col0 - 640) >> 1)); }
                    else if (rope_mode == 2) { const int d = col0 % 192; if (d >= 128) rope8(v, rope + (size_t)row * 32 + ((d - 128) >> 1)); }
                    if (col0 < ncols) {
                        u32x4 w; w.x = cvt_pk_bf16(v[0], v[1]); w.y = cvt_pk_bf16(v[2], v[3]); w.z = cvt_pk_bf16(v[4], v[5]); w.w = cvt_pk_bf16(v[6], v[7]);
                        if (hm_mode) { const int hh = col0 / 192, jj = col0 - hh * 192; *(u32x4*)(out + ((size_t)((row >> 12) * 4 + hh) * SEQ + (row & (SEQ - 1))) * 192 + jj) = w; }
                        else if (col0 < split) *(u32x4*)(out + (size_t)row * ldc + col0) = w;
                        else *(u32x4*)(out2 + (size_t)row * ldc2 + (col0 - split)) = w;
                    }
                }
                if (ssq_mode == 1 && u.pn <= 2) {
                    ss += __shfl_xor(ss, 16); ss += __shfl_xor(ss, 32);
                    if (fq == 0) atomicAdd((u.pn == 0 ? ssqB : ssqA) + row, ss);
                }
            }
    }
};

template <bool ALIGN_EPI>
__device__ __forceinline__ void gemm_phase(LAS unsigned char* lds, const Gemm g, const StaticOrder& S, const Epi& E, const int tid) {
    const int wid = __builtin_amdgcn_readfirstlane(tid >> 6), lane = tid & 63, wr = wid >> 2, wc = wid & 3, fr = lane & 15, fq = lane >> 4;
    const int K = g.K, nt = K / BK, lda = g.lda;
    unsigned voffA[2], voffB[2];
#pragma unroll
    for (int i = 0; i < 2; ++i) { int R, C; stage_rc(tid * 16 + i * 8192, R, C); const int Rb = (R & ~31) + perm32(R & 31);
        voffA[i] = (unsigned)(R * lda + C) * 2u; voffB[i] = (unsigned)(Rb * K + C) * 2u; }
    const size_t kstep = (size_t)(BK * 2);
    const size_t hstepA = (size_t)HALF * lda * 2, hstepB = (size_t)HALF * K * 2;
    const size_t tstepA = 2 * hstepA, tstepB = 2 * hstepB;
    const unsigned ldsw = (unsigned)wid * 1024u;
    const int aoff = lds_byte(wr * 64 + fr, fq * 8), boff = lds_byte(wc * 32 + fr, fq * 8);
#define PG8_SA(b, h) (((b) * 2 + (h)) * HTB)
#define PG8_SB(b, h) ((4 + (b) * 2 + (h)) * HTB)
#define PG8_STAGE(bufoff, gbase, voff) do { _Pragma("unroll") for (int _i = 0; _i < 2; ++_i) \
        __builtin_amdgcn_global_load_lds((const unsigned*)((const char*)(gbase) + (voff)[_i]), (LAS unsigned*)(lds + (bufoff) + ldsw + _i * 8192), 16, 0, 0); } while (0)
#define PG8_LDA(dst, b, h) do { _Pragma("unroll") for (int m = 0; m < 4; ++m) _Pragma("unroll") for (int k = 0; k < 2; ++k) dst[m][k] = *(const LAS bf16x8*)(lds + PG8_SA(b, h) + aoff + m * 2048 + k * 1024); } while (0)
#define PG8_LDB(dst, b, h) do { _Pragma("unroll") for (int n = 0; n < 2; ++n) _Pragma("unroll") for (int k = 0; k < 2; ++k) dst[n][k] = *(const LAS bf16x8*)(lds + PG8_SB(b, h) + boff + n * 2048 + k * 1024); } while (0)
#define PG8_MMA(ai, bj, At, Bt) do { __builtin_amdgcn_s_setprio(1); _Pragma("unroll") for (int m = 0; m < 4; ++m) _Pragma("unroll") for (int n = 0; n < 2; ++n) _Pragma("unroll") for (int k = 0; k < 2; ++k) \
        acc[ai][bj][m][n] = __builtin_amdgcn_mfma_f32_16x16x32_bf16(Bt[n][k], At[m][k], acc[ai][bj][m][n], 0, 0, 0); __builtin_amdgcn_s_setprio(0); } while (0)
#define PG8_WAIT_V(n) asm volatile("s_waitcnt vmcnt(" #n ")" ::: "memory")
#define PG8_WAIT_L(n) asm volatile("s_waitcnt lgkmcnt(" #n ")" ::: "memory")
#define PG8_BAR __builtin_amdgcn_s_barrier()
#define PG8_SCHED __builtin_amdgcn_sched_barrier(0)
    Unit cur, nxt; int ui = 0;
    if (!S.next(0, cur)) return;
    f32x4 acc[2][2][4][2];
#pragma unroll
    for (int a = 0; a < 2; ++a)
#pragma unroll
        for (int b = 0; b < 2; ++b)
#pragma unroll
            for (int m = 0; m < 4; ++m)
#pragma unroll
                for (int n = 0; n < 2; ++n) acc[a][b][m][n] = (f32x4){0.f, 0.f, 0.f, 0.f};
    bf16x8 At[4][2], B0[2][2], B1[2][2];
    const char* cA = (const char*)g.A + (size_t)cur.pm * tstepA + (size_t)cur.pn * g.apn * 2; const char* cB = (const char*)g.Bt + (size_t)cur.pn * tstepB;
    PG8_STAGE(PG8_SB(0, 0), cB, voffB); PG8_STAGE(PG8_SB(0, 1), cB + hstepB, voffB); PG8_STAGE(PG8_SA(0, 0), cA, voffA); PG8_STAGE(PG8_SA(0, 1), cA + hstepA, voffA);
    if (wr == 1) PG8_BAR;
    PG8_WAIT_V(2); PG8_BAR;
    PG8_STAGE(PG8_SB(1, 0), cB + kstep, voffB); PG8_STAGE(PG8_SA(1, 0), cA + kstep, voffA); PG8_STAGE(PG8_SB(1, 1), cB + hstepB + kstep, voffB);
    PG8_WAIT_V(6); PG8_BAR;
    for (;;) {
        const bool has_next = S.next(ui + 1, nxt);
        const char* nA = has_next ? (const char*)g.A + (size_t)nxt.pm * tstepA + (size_t)nxt.pn * g.apn * 2 : cA; const char* nB = has_next ? (const char*)g.Bt + (size_t)nxt.pn * tstepB : cB;
        for (int t = 0; t < nt; t += 2) {
            const bool last = (t == nt - 2);
            const char* a1 = cA + (size_t)(t + 1) * kstep;
            const char* a2 = last ? nA : cA + (size_t)(t + 2) * kstep; const char* b2 = last ? nB : cB + (size_t)(t + 2) * kstep;
            const char* a3 = a2 + kstep; const char* b3 = b2 + kstep;
            PG8_LDB(B0, 0, 0); PG8_LDB(B1, 0, 1); PG8_SCHED; PG8_LDA(At, 0, 0); PG8_STAGE(PG8_SA(1, 1), a1 + hstepA, voffA);
            PG8_WAIT_V(8); PG8_WAIT_L(0); PG8_BAR; PG8_MMA(0, 0, At, B0); PG8_MMA(0, 1, At, B1); PG8_BAR; PG8_SCHED;
            PG8_LDA(At, 0, 1); PG8_STAGE(PG8_SB(0, 0), b2, voffB); PG8_STAGE(PG8_SB(0, 1), b2 + hstepB, voffB); PG8_STAGE(PG8_SA(0, 0), a2, voffA);
            PG8_WAIT_V(8); PG8_WAIT_L(0); PG8_BAR; PG8_MMA(1, 0, At, B0); PG8_MMA(1, 1, At, B1); PG8_BAR; PG8_SCHED;
            PG8_LDB(B0, 1, 0); PG8_LDB(B1, 1, 1); PG8_SCHED; PG8_LDA(At, 1, 0); PG8_STAGE(PG8_SA(0, 1), a2 + hstepA, voffA);
            PG8_WAIT_V(8); PG8_WAIT_L(0); PG8_BAR; PG8_MMA(0, 0, At, B0); PG8_MMA(0, 1, At, B1); PG8_BAR; PG8_SCHED;
            PG8_LDA(At, 1, 1); PG8_STAGE(PG8_SB(1, 0), b3, voffB); PG8_STAGE(PG8_SB(1, 1), b3 + hstepB, voffB); PG8_STAGE(PG8_SA(1, 0), a3, voffA);
            PG8_WAIT_V(8); PG8_WAIT_L(0); PG8_BAR; PG8_MMA(1, 0, At, B0); PG8_MMA(1, 1, At, B1); PG8_BAR; PG8_SCHED;
        }
        if constexpr (ALIGN_EPI) { if (wr == 0) PG8_BAR; }
#ifdef FUSED_FINAL
        if (!E.after) E(acc, cur, wr, wc, fr, fq);
#else
        E(acc, cur, wr, wc, fr, fq);
#endif
        if (!has_next) break;
#pragma unroll
        for (int a = 0; a < 2; ++a)
#pragma unroll
            for (int b = 0; b < 2; ++b)
#pragma unroll
                for (int m = 0; m < 4; ++m)
#pragma unroll
                    for (int n = 0; n < 2; ++n) acc[a][b][m][n] = (f32x4){0.f, 0.f, 0.f, 0.f};
        cur = nxt; cA = nA; cB = nB; ++ui;
        if constexpr (ALIGN_EPI) { if (wr == 1) PG8_BAR; }
    }
    PG8_WAIT_V(0);
    if constexpr (!ALIGN_EPI) { if (wr == 0) PG8_BAR; }
    PG8_BAR;
#ifdef FUSED_FINAL
    if (E.after) E.fused(acc, cur, wr, wc, fr, fq, lds, wid, lane);
#endif
#undef PG8_SA
#undef PG8_SB
#undef PG8_STAGE
#undef PG8_LDA
#undef PG8_LDB
#undef PG8_MMA
#undef PG8_WAIT_V
#undef PG8_WAIT_L
#undef PG8_BAR
#undef PG8_SCHED
}
}
namespace att {
#define SBAR() __builtin_amdgcn_sched_barrier(0)
__device__ __forceinline__ int crow(int r, int hi) { return (r & 3) + 8 * (r >> 2) + 4 * hi; }
template <int DQK> __device__ __forceinline__ int kaddr(int row, int c) { return row * (DQK * 2) + ((c ^ ((row >> 1) & 7)) << 4); }
template <int NCB> __device__ __forceinline__ int v_st(int k, int c) { const int kk = (k & ~0xC) | ((k & 4) << 1) | ((k & 8) >> 1); return ((kk >> 3) * NCB + (c >> 5)) * 512 + ((kk & 7) * 32 + (c & 31)) * 2; }
__device__ __forceinline__ int v_rd_base(int lane) { return ((lane & 3) << 3) | (((lane >> 2) & 3) << 6) | (((lane >> 4) & 1) << 5) | (((lane >> 5) & 1) << 8); }

__device__ __forceinline__ void mask_tile(f32x16& p0, f32x16& p1, int dq) {
    const float NEG = -__builtin_inff();
#pragma unroll
    for (int r = 0; r < 16; ++r) {
        const int c = (r & 3) + 8 * (r >> 2);
        if (dq - c < 0) p0[r] = NEG;
        if (dq - c - 32 < 0) p1[r] = NEG;
    }
}
constexpr float DEFER_THR = 8.f;
template <bool FIRST>
__device__ __forceinline__ void partialSM(f32x16& p0, f32x16& p1, float& m_reg, float& alpha) {
    float pmax = p0[0];
#pragma unroll
    for (int r = 1; r < 16; ++r) pmax = fmaxf(pmax, p0[r]);
#pragma unroll
    for (int r = 0; r < 16; ++r) pmax = fmaxf(pmax, p1[r]);
    { auto rr = __builtin_amdgcn_permlane32_swap(__float_as_uint(pmax), __float_as_uint(pmax), false, false);
      pmax = fmaxf(__uint_as_float(rr[0]), __uint_as_float(rr[1])); }
    alpha = 1.f;
    if (FIRST || !__all(pmax <= DEFER_THR)) {
        const float dl = FIRST ? pmax : fmaxf(pmax, 0.f);
        m_reg += dl; alpha = __builtin_amdgcn_exp2f(-dl);
#pragma unroll
        for (int r = 0; r < 16; ++r) { p0[r] -= dl; p1[r] -= dl; }
    }
#pragma unroll
    for (int r = 0; r < 16; ++r) p0[r] = __builtin_amdgcn_exp2f(p0[r]);
}
__device__ __forceinline__ void finishSM(f32x16& p0, f32x16& p1, float alpha, float& l_reg, bf16x8& pa0, bf16x8& pa1, bf16x8& pa2, bf16x8& pa3) {
#pragma unroll
    for (int r = 0; r < 16; ++r) p1[r] = __builtin_amdgcn_exp2f(p1[r]);
    float ps = 0.f;
#pragma unroll
    for (int r = 0; r < 16; ++r) ps += p0[r];
#pragma unroll
    for (int r = 0; r < 16; ++r) ps += p1[r];
    { auto rr = __builtin_amdgcn_permlane32_swap(__float_as_uint(ps), __float_as_uint(ps), false, false);
      ps = __uint_as_float(rr[0]) + __uint_as_float(rr[1]); }
    l_reg = l_reg * alpha + ps;
#define PK4(P, B_, OUT) do { unsigned a0 = cvt_pk_bf16(P[B_+0], P[B_+1]), a1 = cvt_pk_bf16(P[B_+2], P[B_+3]);                          \
        unsigned b0 = cvt_pk_bf16(P[B_+4], P[B_+5]), b1 = cvt_pk_bf16(P[B_+6], P[B_+7]);                                             \
        auto r0 = __builtin_amdgcn_permlane32_swap(a0, b0, false, false); auto r1 = __builtin_amdgcn_permlane32_swap(a1, b1, false, false); \
        u32x4 w = {r0[0], r1[0], r0[1], r1[1]}; OUT = *reinterpret_cast<bf16x8*>(&w); } while (0)
    PK4(p0, 0, pa0); PK4(p0, 8, pa1); PK4(p1, 0, pa2); PK4(p1, 8, pa3);
#undef PK4
}
template <int DQK, bool NOLDS = false>
__device__ __forceinline__ void qkt(f32x16& p0, f32x16& p1, const LAS unsigned char* Kb, int r32, int hi, const bf16x8* qr, const float negm) {
    constexpr int NKS = DQK / 16, ROWB = DQK * 2;
#pragma unroll
    for (int r = 0; r < 16; ++r) { p0[r] = negm; p1[r] = negm; }
    if (NOLDS) {
#pragma unroll
        for (int d0 = 0; d0 < NKS; ++d0) { p0 = __builtin_amdgcn_mfma_f32_32x32x16_bf16(qr[(d0 + 1) % NKS], qr[d0], p0, 0, 0, 0); p1 = __builtin_amdgcn_mfma_f32_32x32x16_bf16(qr[(d0 + 2) % NKS], qr[d0], p1, 0, 0, 0); }
        return; }
    const int f = (r32 >> 1) & 7;
    const LAS unsigned char* kb[4];
#pragma unroll
    for (int dd = 0; dd < 4; ++dd) kb[dd] = Kb + r32 * ROWB + ((((2 * dd + hi) ^ f)) << 4);
#pragma unroll
    for (int d0 = 0; d0 < NKS; ++d0) { const LAS unsigned char* a_ = kb[d0 & 3] + (d0 >> 2) * 128;
        const bf16x8 b0 = *reinterpret_cast<const LAS bf16x8*>(a_);
        const bf16x8 b1 = *reinterpret_cast<const LAS bf16x8*>(a_ + 32 * ROWB);
        p0 = __builtin_amdgcn_mfma_f32_32x32x16_bf16(b0, qr[d0], p0, 0, 0, 0);
        p1 = __builtin_amdgcn_mfma_f32_32x32x16_bf16(b1, qr[d0], p1, 0, 0, 0); }
}
template <int DQK> __device__ __forceinline__ void qkt_sched() {
    constexpr int NKS = DQK / 16;
    __builtin_amdgcn_sched_group_barrier(0x100, 4, 0);
#pragma unroll
    for (int d0 = 0; d0 < NKS; ++d0) {
        __builtin_amdgcn_sched_group_barrier(0x008, 2, 0);
        __builtin_amdgcn_sched_group_barrier(0x002, 120 / NKS, 0);
        if (d0 + 2 < NKS) __builtin_amdgcn_sched_group_barrier(0x100, 2, 0);
    }
}
template <int DV>
__device__ __forceinline__ void pv_tile(f32x16* o, int vb0, bf16x8 pa0, bf16x8 pa1, bf16x8 pa2, bf16x8 pa3) {
    constexpr int NCB = DV / 32, KS = 2 * NCB * 512, HF = NCB * 512;
#define TRRD(dst, off) asm volatile("ds_read_b64_tr_b16 %0, %1 offset:%2" : "=&v"(dst) : "v"(vb0), "i"(off) : "memory")
#pragma unroll
    for (int d0 = 0; d0 < NCB; ++d0) {
        s16x4 l0, l1, l2, l3, h0, h1, h2, h3;
        if (d0 == 0) { TRRD(l0, 0 * 512); TRRD(h0, 0 * 512 + HF); TRRD(l1, 0 * 512 + KS); TRRD(h1, 0 * 512 + KS + HF); TRRD(l2, 0 * 512 + 2 * KS); TRRD(h2, 0 * 512 + 2 * KS + HF); TRRD(l3, 0 * 512 + 3 * KS); TRRD(h3, 0 * 512 + 3 * KS + HF); }
        else if (d0 == 1) { TRRD(l0, 1 * 512); TRRD(h0, 1 * 512 + HF); TRRD(l1, 1 * 512 + KS); TRRD(h1, 1 * 512 + KS + HF); TRRD(l2, 1 * 512 + 2 * KS); TRRD(h2, 1 * 512 + 2 * KS + HF); TRRD(l3, 1 * 512 + 3 * KS); TRRD(h3, 1 * 512 + 3 * KS + HF); }
        else if (d0 == 2) { TRRD(l0, 2 * 512); TRRD(h0, 2 * 512 + HF); TRRD(l1, 2 * 512 + KS); TRRD(h1, 2 * 512 + KS + HF); TRRD(l2, 2 * 512 + 2 * KS); TRRD(h2, 2 * 512 + 2 * KS + HF); TRRD(l3, 2 * 512 + 3 * KS); TRRD(h3, 2 * 512 + 3 * KS + HF); }
        else { TRRD(l0, 3 * 512); TRRD(h0, 3 * 512 + HF); TRRD(l1, 3 * 512 + KS); TRRD(h1, 3 * 512 + KS + HF); TRRD(l2, 3 * 512 + 2 * KS); TRRD(h2, 3 * 512 + 2 * KS + HF); TRRD(l3, 3 * 512 + 3 * KS); TRRD(h3, 3 * 512 + 3 * KS + HF); }
        asm volatile("s_waitcnt lgkmcnt(0)" ::: "memory"); SBAR();
        o[d0] = __builtin_amdgcn_mfma_f32_32x32x16_bf16(pa0, (bf16x8){l0[0], l0[1], l0[2], l0[3], h0[0], h0[1], h0[2], h0[3]}, o[d0], 0, 0, 0);
        o[d0] = __builtin_amdgcn_mfma_f32_32x32x16_bf16(pa1, (bf16x8){l1[0], l1[1], l1[2], l1[3], h1[0], h1[1], h1[2], h1[3]}, o[d0], 0, 0, 0);
        o[d0] = __builtin_amdgcn_mfma_f32_32x32x16_bf16(pa2, (bf16x8){l2[0], l2[1], l2[2], l2[3], h2[0], h2[1], h2[2], h2[3]}, o[d0], 0, 0, 0);
        o[d0] = __builtin_amdgcn_mfma_f32_32x32x16_bf16(pa3, (bf16x8){l3[0], l3[1], l3[2], l3[3], h3[0], h3[1], h3[2], h3[3]}, o[d0], 0, 0, 0);
    }
#undef TRRD
}

template <int DQK, int DV, bool CAUSAL, int ABL = 0>
__device__ __forceinline__ void attn_unit(const bf16_t* Qb, int qp, const bf16_t* Km, int kp, int c1, const bf16_t* Ke, int kep, const bf16_t* Vb, int vp,
                                          int NT, int q0, const bf16_t* gate, int gp, bf16_t* Y, int yp, LAS unsigned char* lds, const int tid) {
    constexpr int SHM_V = 64 * DV * 2, SHM_K = 64 * DQK * 2, NCK = DQK / 8, NKS = DQK / 16, NCB = DV / 32;
    constexpr int KPT = SHM_K / 8192, VPT = SHM_V / 8192;
    const int wid = __builtin_amdgcn_readfirstlane(tid >> 6), lane = tid & 63, r32 = lane & 31, hi = lane >> 5;
    LAS unsigned char* V_lds = lds; LAS unsigned char* K_lds = lds + 3 * SHM_V; LAS float* ws = (LAS float*)(lds + 3 * SHM_V + 3 * SHM_K) + wid * 64;
    bf16x8 qr[NKS];
#pragma unroll
    for (int d0 = 0; d0 < NKS; ++d0) qr[d0] = *reinterpret_cast<const bf16x8*>(Qb + (size_t)(wid * 32 + r32) * qp + d0 * 16 + hi * 8);
    const char* kbase = (const char*)(Km < Ke ? Km : Ke);
    unsigned koff[KPT]; unsigned kstr[KPT];
#pragma unroll
    for (int i = 0; i < KPT; ++i) { const int p = (wid + 8 * i) * 64 + lane, row = p / NCK, cpos = p % NCK, c = cpos ^ ((row >> 1) & 7);
        if (c < c1) { koff[i] = (unsigned)((const char*)(Km + (size_t)row * kp + c * 8) - kbase); kstr[i] = (unsigned)kp * 128u; }
        else { koff[i] = (unsigned)((const char*)(Ke + (size_t)row * kep + (c - c1) * 8) - kbase); kstr[i] = (unsigned)kep * 128u; } }
    unsigned voff[VPT];
#pragma unroll
    for (int i = 0; i < VPT; ++i) { const int st = 2 * (wid + 8 * i) + (lane >> 5), kk = (st / NCB) * 8 + ((lane & 31) >> 2), k = (kk & ~0xC) | ((kk & 4) << 1) | ((kk & 8) >> 1), col = (st % NCB) * 32 + (lane & 3) * 8;
        voff[i] = (unsigned)(k * vp + col) * 2u; }
    const char* vbase = (const char*)Vb;
    float m_reg = 0.f, l_reg = 0.f; f32x16 o[NCB];
#pragma unroll
    for (int d = 0; d < NCB; ++d) o[d] = f32x16{};
    const int vb0 = (int)(size_t)V_lds + v_rd_base(lane);
    const int qlo = q0 + wid * 32;
#define DMA_K(sl) do { _Pragma("unroll") for (int i = 0; i < KPT; ++i) { __builtin_amdgcn_global_load_lds((const unsigned*)(kbase + koff[i]), (LAS unsigned*)(K_lds + (sl) * SHM_K + (wid + 8 * i) * 1024), 16, 0, 0); koff[i] += kstr[i]; } } while (0)
#define DMA_V(sl) do { _Pragma("unroll") for (int i = 0; i < VPT; ++i) { __builtin_amdgcn_global_load_lds((const unsigned*)(vbase + voff[i]), (LAS unsigned*)(V_lds + (sl) * SHM_V + (wid + 8 * i) * 1024), 16, 0, 0); } vbase += (size_t)vp * 128; } while (0)
#define WAIT_BAR(N) do { asm volatile("s_waitcnt vmcnt(%0) lgkmcnt(0)\n\ts_barrier" :: "i"(N) : "memory"); } while (0)
#define MASKT(P0_, P1_, t) do { if (CAUSAL) { const int kb_ = (t) * 64; if (kb_ + 63 > qlo) mask_tile(P0_, P1_, qlo + r32 - 4 * hi - kb_); } } while (0)
#define RESC(a) do { if (__any((a) < 1.f)) { if (hi == 0) ws[r32] = (a); asm volatile("s_waitcnt lgkmcnt(0)" ::: "memory"); \
        _Pragma("unroll") for (int d_ = 0; d_ < NCB; ++d_) _Pragma("unroll") for (int r = 0; r < 16; ++r) o[d_][r] *= ws[crow(r, hi)]; } } while (0)
    f32x16 pA0, pA1, pB0, pB1; float alA = 1.f, alB = 1.f; bf16x8 pa0, pa1, pa2, pa3;
    DMA_K(0); DMA_K(1); DMA_V(0);
    WAIT_BAR(KPT + VPT);
    DMA_K(2); DMA_V(1);
    qkt<DQK>(pA0, pA1, K_lds, r32, hi, qr, 0.f);
    MASKT(pA0, pA1, 0); partialSM<true>(pA0, pA1, m_reg, alA); alA = 1.f;
    WAIT_BAR(KPT + VPT);
    int ks = 1, vs = 0, ns = 2;
#define ROT() do { vs = ks; ks = ns; ns = (ns == 2) ? 0 : ns + 1; } while (0)
#define STEP(PX0, PX1, alX, PY0, PY1, alY, t, NW) do { \
        if (!(ABL & 1)) { if ((t) + 2 < NT) DMA_K(vs); if ((t) + 1 < NT) DMA_V(ns); } \
        SBAR(); if (!(ABL & 8)) qkt<DQK, (ABL & 32) != 0>(PX0, PX1, K_lds + ks * SHM_K, r32, hi, qr, -m_reg); else { asm volatile("" : "+v"(PX0), "+v"(PX1)); } \
        if (!(ABL & 2)) finishSM(PY0, PY1, alY, l_reg, pa0, pa1, pa2, pa3); else { asm volatile("" : "+v"(PY0), "+v"(PY1), "+v"(pa0), "+v"(pa1), "+v"(pa2), "+v"(pa3)); } SBAR(); \
        if (!(ABL & 4)) pv_tile<DV>(o, vb0 + vs * SHM_V, pa0, pa1, pa2, pa3); \
        if (!(ABL & 2)) { MASKT(PX0, PX1, t); partialSM<false>(PX0, PX1, m_reg, alX); } \
        if (ABL & 1) WAIT_BAR(0); else WAIT_BAR(NW); \
        RESC(alX); ROT(); } while (0)
    int t = 1;
    for (; t + 3 < NT; t += 2) {
        STEP(pB0, pB1, alB, pA0, pA1, alA, t, KPT + VPT);
        STEP(pA0, pA1, alA, pB0, pB1, alB, t + 1, KPT + VPT);
    }
    STEP(pB0, pB1, alB, pA0, pA1, alA, t, KPT + VPT);
    STEP(pA0, pA1, alA, pB0, pB1, alB, t + 1, VPT);
    STEP(pB0, pB1, alB, pA0, pA1, alA, t + 2, 0);
    finishSM(pB0, pB1, alB, l_reg, pa0, pa1, pa2, pa3); SBAR(); pv_tile<DV>(o, vb0 + vs * SHM_V, pa0, pa1, pa2, pa3);
#undef STEP
#undef ROT
#undef RESC
#undef MASKT
#undef WAIT_BAR
#undef DMA_K
#undef DMA_V
    if (hi == 0) ws[32 + r32] = l_reg;
    asm volatile("s_waitcnt lgkmcnt(0)" ::: "memory");
    constexpr int SPITCH = DV * 2 + 16;
    LAS unsigned char* stg = ((DQK == 192) ? K_lds : (lds + 3 * SHM_V + 3 * SHM_K + 2048)) + wid * (32 * SPITCH);
#pragma unroll
    for (int r = 0; r < 16; ++r) {
        const float rl = __builtin_amdgcn_rcpf(ws[32 + crow(r, hi)]);
#pragma unroll
        for (int d0 = 0; d0 < NCB; ++d0) *(LAS unsigned short*)(stg + crow(r, hi) * SPITCH + (d0 * 32 + r32) * 2) = f2bf(o[d0][r] * rl);
    }
    asm volatile("s_waitcnt lgkmcnt(0)" ::: "memory");
    constexpr int CPR = DV / 8, RPP = 64 / CPR;
#pragma unroll
    for (int i = 0; i < 32 / RPP; ++i) {
        const int row = i * RPP + lane / CPR, ch = lane % CPR, orow = wid * 32 + row;
        const u32x4 ov = *(const LAS u32x4*)(stg + row * SPITCH + ch * 16);
        const u32x4 gv = *(const u32x4*)(gate + (size_t)orow * gp + ch * 8);
        u32x4 w;
        w.x = cvt_pk_bf16(bflo(ov.x) * silu_f(bflo(gv.x)), bfhi(ov.x) * silu_f(bfhi(gv.x))); w.y = cvt_pk_bf16(bflo(ov.y) * silu_f(bflo(gv.y)), bfhi(ov.y) * silu_f(bfhi(gv.y)));
        w.z = cvt_pk_bf16(bflo(ov.z) * silu_f(bflo(gv.z)), bfhi(ov.z) * silu_f(bfhi(gv.z))); w.w = cvt_pk_bf16(bflo(ov.w) * silu_f(bflo(gv.w)), bfhi(ov.w) * silu_f(bfhi(gv.w)));
        *(u32x4*)(Y + (size_t)orow * yp + ch * 8) = w;
    }
    __syncthreads();
}
#undef SBAR
}
struct Params {
    const float* x; const float* mem; const int* pos;
    const float *a_pre_g, *a_w_in, *a_q_a_g, *a_w_uq, *a_kv_a_g, *a_w_ukv, *a_mem_g, *a_w_mem_kv, *a_w_out, *a_post_g;
    const float *b_pre_g, *b_w_in, *b_gate_bias, *b_conv_w, *b_conv_b, *b_w_q, *b_w_k, *b_w_v, *b_head_g, *b_skip, *b_mem_g, *b_w_mem_kv, *b_w_out, *b_post_g;
    float* out; unsigned char* ws; int ph_lo, ph_hi;
};
struct Wk { int tid, lane, wave, vcu, G; };
#define LDS_WAIT() asm volatile("s_waitcnt lgkmcnt(0)" ::: "memory")

__device__ __forceinline__ float wsrc(const Params& P, int mat, int k, int n) {
    switch (mat) {
    case 0: { int col; float s = 1.f;
        if (n < 256) col = 384 + n; else if (n < 512) col = n - 256; else if (n < 640) col = 256 + (n - 512);
        else if (n < 704) { const int p_ = n - 640, i = p_ >> 1; col = 640 + ((p_ & 1) ? 32 + i : i); }
        else if (n < 768) return 0.f; else if (n < 1024) { col = 704 + (n - 768); s = MSCALE; } else col = 960 + (n - 1024);
        return P.a_w_in[(size_t)k * A_IN + col] * P.a_pre_g[k] * s; }
    case 1: { if (n >= 1152) return 0.f; const int h = n / 192, d = n % 192; int col;
        if (d < 128) col = h * 192 + d; else { const int p_ = d - 128, i = p_ >> 1; col = h * 192 + 128 + ((p_ & 1) ? 32 + i : i); }
        return P.a_w_uq[(size_t)k * 1152 + col] * P.a_q_a_g[k] * QSCALE; }
    case 2: { int col; if (n < 768) col = (n / 128) * 256 + (n % 128); else { const int n2 = n - 768; col = (n2 / 128) * 256 + 128 + (n2 % 128); }
        return P.a_w_ukv[(size_t)k * 1536 + col] * P.a_kv_a_g[k]; }
    case 3: { if (n < 512) return P.a_w_mem_kv[(size_t)k * 512 + n] * P.a_mem_g[k]; return P.b_w_mem_kv[(size_t)k * 512 + (n - 512)] * P.b_mem_g[k]; }
    case 4: return P.a_w_out[(size_t)k * 1024 + n];
    case 5: { int col; float s = 1.f; if (n < 768) col = n; else if (n < 1536) col = 776 + (n - 768); else if (n < 1792) { col = 1544 + (n - 1536); s = MSCALE; } else col = 1800 + (n - 1792);
        return P.b_w_in[(size_t)k * B_IN + col] * P.b_pre_g[k] * s; }
    case 6: { const int h = n / 192, j = n % 192, pn = n / 256, kabs = k + 192 * pn - 192 * h; if (kabs < 0 || kabs >= 192) return 0.f;
        if (j < 96) return P.b_w_q[((size_t)h * 192 + kabs) * 96 + j]; return P.b_w_k[((size_t)h * 192 + kabs) * 96 + (j - 96)] * KSCALE_B; }
    case 7: { const int h = n / 192, j = n % 192, pn = n / 256, kabs = k + 192 * pn - 192 * h; if (kabs < 0 || kabs >= 192) return 0.f;
        return P.b_w_v[((size_t)h * 192 + kabs) * 192 + j]; }
    default: return P.b_w_out[(size_t)k * 1024 + n];
    }
}
__device__ __forceinline__ void tr_item(const Params& P, int mat, int K, int nblk, bf16_t* WT, LAS float* scr, int item, int lane) {
    const int kb = item / nblk, nb = item % nblk, k0 = 64 * kb, n0 = 32 * nb;
    float tv[32];
#pragma unroll
    for (int i = 0; i < 32; ++i) tv[i] = wsrc(P, mat, k0 + 2 * i + (lane >> 5), n0 + (lane & 31));
#pragma unroll
    for (int i = 0; i < 32; ++i) scr[(2 * i + (lane >> 5)) * 33 + (lane & 31)] = tv[i];
    LDS_WAIT(); asm volatile("" ::: "memory");
    const int c = lane & 7;
#pragma unroll
    for (int j = 0; j < 4; ++j) { const int n = (lane >> 3) + 8 * j; const LAS float* s = scr + (8 * c) * 33 + n;
        u32x4 o; o.x = cvt_pk_bf16(s[0 * 33], s[1 * 33]); o.y = cvt_pk_bf16(s[2 * 33], s[3 * 33]); o.z = cvt_pk_bf16(s[4 * 33], s[5 * 33]); o.w = cvt_pk_bf16(s[6 * 33], s[7 * 33]);
        *(u32x4*)(WT + (size_t)(n0 + n) * K + k0 + 8 * c) = o; }
    LDS_WAIT(); asm volatile("" ::: "memory");
}
__device__ __forceinline__ void row_to_bf16(const float* xrow, bf16_t* orow, float* rstd_out, bool normalise, int lane) {
    const f32x4* xr = (const f32x4*)xrow + lane;
    f32x4 v[4]; float s = 0.f;
#pragma unroll
    for (int j = 0; j < 4; ++j) { v[j] = xr[64 * j]; s += (v[j].x * v[j].x + v[j].y * v[j].y) + (v[j].z * v[j].z + v[j].w * v[j].w); }
    const float rstd = rsqrtf(wave_sum(s) * (1.f / DM) + EPS);
    if (rstd_out && lane == 0) *rstd_out = rstd;
    const float sc = normalise ? rstd : 1.f;
    u32x2* o8 = (u32x2*)orow + lane;
#pragma unroll
    for (int j = 0; j < 4; ++j) { u32x2 w; w.x = cvt_pk_bf16(v[j].x * sc, v[j].y * sc); w.y = cvt_pk_bf16(v[j].z * sc, v[j].w * sc); o8[64 * j] = w; }
}
__device__ __forceinline__ void phase_prologue(const Params& P, const Wk& W, LAS unsigned char* lds) {
    unsigned char* ws = P.ws;
    LAS float* scr = (LAS float*)(lds + W.wave * 8704);
    const int gw = W.vcu * 8 + W.wave, NGW = W.G * 8;
#ifndef PROBE_P0
#define PROBE_P0 0
#endif
    for (int rep_ = 0; rep_ < (PROBE_P0 == 1 ? 2 : 1); ++rep_) {
    int base = 0;
#define DO_MAT(mt, K_, N_, OFF_) do { const int nblk = (N_) / 32, nit = ((K_) / 64) * nblk; \
        int first = gw - (base % NGW); if (first < 0) first += NGW; \
        for (int r = first; r < nit; r += NGW) tr_item(P, mt, K_, nblk, (bf16_t*)(ws + (OFF_)), scr, r, W.lane); \
        base += nit; } while (0)
    DO_MAT(0, 1024, 2048, WS_WINA); DO_MAT(1, 384, 1280, WS_WUQ); DO_MAT(2, 256, 1536, WS_WUKV); DO_MAT(3, 1024, 1024, WS_WMKV); DO_MAT(4, 1024, 1024, WS_WOA);
    DO_MAT(5, 1024, 2816, WS_WINB); DO_MAT(6, 384, 768, WS_WQK); DO_MAT(7, 384, 768, WS_WV); DO_MAT(8, 1024, 1024, WS_WOB);
#undef DO_MAT
    }
    const int gt = (W.vcu * 512 + W.tid), NGT = W.G * 512;
    for (int idx = gt; idx < 8 * 1024; idx += NGT) { const int g = idx >> 10, k = idx & 1023; ((float*)(ws + WS_WG))[idx] = P.b_w_in[(size_t)k * B_IN + 768 + g] * P.b_pre_g[k]; }
    for (int idx = gt; idx < 2 * T; idx += NGT) ((float*)(ws + WS_SSQA))[idx] = 0.f;
    for (int rep_ = 0; rep_ < (PROBE_P0 == 2 ? 2 : 1); ++rep_)
    for (int idx = gt; idx < T * 32; idx += NGT) { const int row = idx >> 5, i = idx & 31;
        const float inv = exp2f(-(float)i * (13.287712379549449f / 32.f));
        const float ang = (float)P.pos[row] * inv;
        double tr = (double)ang * 0.15915494309189535; tr -= floor(tr); const float tf = (float)tr;
        ((float2*)(ws + WS_ROPE))[idx] = make_float2(__builtin_amdgcn_cosf(tf), __builtin_amdgcn_sinf(tf)); }
    for (int rep_ = 0; rep_ < (PROBE_P0 == 3 ? 2 : 1); ++rep_)
    for (int m = gw; m < T; m += 4 * NGW) {
        f32x4 v[4][4]; float s[4];
#pragma unroll
        for (int r = 0; r < 4; ++r) { const f32x4* xr = (const f32x4*)(P.x + (size_t)(m + r * NGW) * DM) + W.lane;
#pragma unroll
            for (int j = 0; j < 4; ++j) v[r][j] = xr[64 * j]; }
#pragma unroll
        for (int r = 0; r < 4; ++r) { float a = 0.f;
#pragma unroll
            for (int j = 0; j < 4; ++j) a += (v[r][j].x * v[r][j].x + v[r][j].y * v[r][j].y) + (v[r][j].z * v[r][j].z + v[r][j].w * v[r][j].w);
            s[r] = wave_sum(a); }
#pragma unroll
        for (int r = 0; r < 4; ++r) { const int mr = m + r * NGW; if (W.lane == 0) ((float*)(ws + WS_RSTD))[mr] = rsqrtf(s[r] * (1.f / DM) + EPS);
            u32x2* o8 = (u32x2*)((bf16_t*)(ws + WS_XB) + (size_t)mr * DM) + W.lane;
#pragma unroll
            for (int j = 0; j < 4; ++j) { u32x2 w; w.x = cvt_pk_bf16(v[r][j].x, v[r][j].y); w.y = cvt_pk_bf16(v[r][j].z, v[r][j].w); o8[64 * j] = w; } }
    }
    for (int m = gw; m < NB * NMEM; m += NGW) row_to_bf16(P.mem + (size_t)m * DM, (bf16_t*)(ws + WS_MEMN) + (size_t)m * DM, nullptr, true, W.lane);
}

__device__ __forceinline__ void phase_rowmid(const Params& P, const Wk& W, LAS unsigned char* lds) {
    unsigned char* ws = P.ws;
    const int gw = W.vcu * 8 + W.wave, NGW = W.G * 8, lane = W.lane;
    const bf16_t* Z = (const bf16_t*)(ws + WS_Z);
    { const int gt_ = W.vcu * 512 + W.tid; if (gt_ < 32 * 192) ((float*)(ws + WS_U0))[gt_] = 0.f; }
    LAS float* Wg = (LAS float*)lds;
    for (int i = W.tid; i < 2048; i += 512) ((LAS f32x4*)Wg)[i] = ((const f32x4*)(ws + WS_WG))[i];
    __syncthreads();
    f32x4 pg[4];
#pragma unroll
    for (int j = 0; j < 4; ++j) pg[j] = ((const f32x4*)P.a_post_g)[lane + 64 * j];
    f32x4 vn[4]; u32x2 zn[4];
    if (gw < T) { const f32x4* xr = (const f32x4*)(P.x + (size_t)gw * DM) + lane; const u32x2* zr = (const u32x2*)(Z + (size_t)gw * DM) + lane;
#pragma unroll
        for (int j = 0; j < 4; ++j) { vn[j] = xr[64 * j]; zn[j] = zr[64 * j]; } }
    for (int m = gw; m < T; m += NGW) {
        f32x4 v[4], z[4]; float s = 0.f;
#pragma unroll
        for (int j = 0; j < 4; ++j) { v[j] = vn[j]; const u32x2 w = zn[j]; z[j] = (f32x4){bflo(w.x), bfhi(w.x), bflo(w.y), bfhi(w.y)};
            s += (z[j].x * z[j].x + z[j].y * z[j].y) + (z[j].z * z[j].z + z[j].w * z[j].w); }
        if (m + NGW < T) { const f32x4* xr = (const f32x4*)(P.x + (size_t)(m + NGW) * DM) + lane; const u32x2* zr = (const u32x2*)(Z + (size_t)(m + NGW) * DM) + lane;
#pragma unroll
            for (int j = 0; j < 4; ++j) { vn[j] = xr[64 * j]; zn[j] = zr[64 * j]; } }
        const float rz = rsqrtf(wave_sum(s) * (1.f / DM) + EPS);
        float s1 = 0.f;
#pragma unroll
        for (int j = 0; j < 4; ++j) { const f32x4 g = pg[j]; v[j] = v[j] + z[j] * rz * g;
            s1 += (v[j].x * v[j].x + v[j].y * v[j].y) + (v[j].z * v[j].z + v[j].w * v[j].w); }
        const float r1 = rsqrtf(wave_sum(s1) * (1.f / DM) + EPS);
        u32x2* o8 = (u32x2*)((bf16_t*)(ws + WS_XB) + (size_t)m * DM) + lane;
#pragma unroll
        for (int j = 0; j < 4; ++j) { u32x2 w; w.x = cvt_pk_bf16(v[j].x, v[j].y); w.y = cvt_pk_bf16(v[j].z, v[j].w); o8[64 * j] = w; }
        if ((m & (SEQ - 1)) == 0) { f32x4* xf = (f32x4*)((float*)(ws + WS_X1F) + (size_t)(m / SEQ) * DM) + lane;
#pragma unroll
            for (int j = 0; j < 4; ++j) xf[64 * j] = v[j]; }
        if (lane == 0) ((float*)(ws + WS_RSTD))[m] = r1;
        float ga[8];
#pragma unroll
        for (int g = 0; g < 8; ++g) { float a = 0.f;
#pragma unroll
            for (int j = 0; j < 4; ++j) { const f32x4 w4 = ((const LAS f32x4*)(Wg + g * 1024))[lane + 64 * j]; a += (v[j].x * w4.x + v[j].y * w4.y) + (v[j].z * w4.z + v[j].w * w4.w); }
            ga[g] = a; }
        float gb[4], gc[2], gd;
        { const bool up = (lane & 32) != 0;
#pragma unroll
          for (int i = 0; i < 4; ++i) { const float snd = up ? ga[i] : ga[4 + i]; const float kp = up ? ga[4 + i] : ga[i]; gb[i] = kp + __shfl_xor(snd, 32); } }
        { const bool up = (lane & 16) != 0;
#pragma unroll
          for (int i = 0; i < 2; ++i) { const float snd = up ? gb[i] : gb[2 + i]; const float kp = up ? gb[2 + i] : gb[i]; gc[i] = kp + __shfl_xor(snd, 16); } }
        { const bool up = (lane & 8) != 0; const float snd = up ? gc[0] : gc[1]; const float kp = up ? gc[1] : gc[0]; gd = kp + __shfl_xor(snd, 8); }
        gd += __shfl_xor(gd, 4); gd += __shfl_xor(gd, 2); gd += __shfl_xor(gd, 1);
        if ((lane & 7) == 0) { const int g = lane >> 3;
            ((float*)(ws + WS_IFP))[(size_t)m * 8 + g] = gd * r1 + P.b_gate_bias[g]; }
    }
}
__device__ __forceinline__ void phase_rowfinal(const Params& P, const Wk& W) {
    unsigned char* ws = P.ws;
    const int gw = W.vcu * 8 + W.wave, NGW = W.G * 8, lane = W.lane;
    const bf16_t* Z = (const bf16_t*)(ws + WS_Z);
    f32x4 pg[4];
#pragma unroll
    for (int j = 0; j < 4; ++j) pg[j] = ((const f32x4*)P.b_post_g)[lane + 64 * j];
    u32x2 vn[4], zn[4];
    const bf16_t* X1 = (const bf16_t*)(ws + WS_XB);
    if (gw < T) { const u32x2* xr = (const u32x2*)(X1 + (size_t)gw * DM) + lane; const u32x2* zr = (const u32x2*)(Z + (size_t)gw * DM) + lane;
#pragma unroll
        for (int j = 0; j < 4; ++j) { vn[j] = xr[64 * j]; zn[j] = zr[64 * j]; } }
    for (int m = gw; m < T; m += NGW) {
        f32x4* xo = (f32x4*)(P.out + (size_t)m * DM) + lane;
        f32x4 v[4], z[4]; float s = 0.f;
#pragma unroll
        for (int j = 0; j < 4; ++j) { const u32x2 a = vn[j]; v[j] = (f32x4){bflo(a.x), bfhi(a.x), bflo(a.y), bfhi(a.y)}; const u32x2 w = zn[j]; z[j] = (f32x4){bflo(w.x), bfhi(w.x), bflo(w.y), bfhi(w.y)};
            s += (z[j].x * z[j].x + z[j].y * z[j].y) + (z[j].z * z[j].z + z[j].w * z[j].w); }
        if (m + NGW < T) { const u32x2* xr = (const u32x2*)(X1 + (size_t)(m + NGW) * DM) + lane; const u32x2* zr = (const u32x2*)(Z + (size_t)(m + NGW) * DM) + lane;
#pragma unroll
            for (int j = 0; j < 4; ++j) { vn[j] = xr[64 * j]; zn[j] = zr[64 * j]; } }
        const float rz = rsqrtf(wave_sum(s) * (1.f / DM) + EPS);
#pragma unroll
        for (int j = 0; j < 4; ++j) xo[64 * j] = v[j] + z[j] * rz * pg[j];
    }
}
__device__ __forceinline__ void first_token_u0(const Params& P, const Wk& W, LAS unsigned char* lds, int widx) {
    unsigned char* ws = P.ws;
    const int bh = widx >> 2, sl = widx & 3, b = bh >> 2, h = bh & 3, j = W.tid % 192, sub = W.tid / 192; const size_t row = (size_t)b * SEQ;
    LAS float* hs = (LAS float*)lds;
    if (W.tid < 256) hs[W.tid] = ((const float*)(ws + WS_X1F))[(size_t)b * DM + sl * 256 + W.tid] * P.b_pre_g[sl * 256 + W.tid] * ((const float*)(ws + WS_RSTD))[row];
    __syncthreads();
    if (W.tid < 384) {
        const float* wp = P.b_w_in + (size_t)(sl * 256 + sub * 128) * B_IN + h * 192 + j; float a = 0.f;
#pragma unroll 64
        for (int k = 0; k < 128; ++k) a += hs[sub * 128 + k] * wp[(size_t)k * B_IN];
        atomicAdd((float*)(ws + WS_U0) + bh * 192 + j, a); }
    __syncthreads();
}
__device__ __forceinline__ void first_token_qk(const Params& P, const Wk& W, LAS unsigned char* lds) {
    unsigned char* ws = P.ws;
    const int first = W.G > 32 ? W.G - 32 : 0, nwk = W.G > 32 ? 32 : W.G;
    if (W.vcu < first) return;
    for (int bh = W.vcu - first; bh < 32; bh += nwk) {
    const int h = bh & 3, tid = W.tid;
    LAS float* uc0 = (LAS float*)lds; LAS float* qk0 = uc0 + 192;
    float wv[96];
    const int o = tid % 192, part = tid / 192, j = o % 96;
    if (tid < 384) { const float* Wm = (o < 96 ? P.b_w_q : P.b_w_k) + (size_t)h * 192 * 96 + (size_t)(part * 96) * 96 + j;
#pragma unroll
        for (int i = 0; i < 96; ++i) wv[i] = Wm[i * 96]; }
    if (tid < 192) { const int col = h * 192 + tid; uc0[tid] = silu_f(P.b_conv_b[col] + P.b_conv_w[3 * 768 + col] * ((const float*)(ws + WS_U0))[bh * 192 + tid]); }
    __syncthreads();
    if (tid < 384) { float a = 0.f;
#pragma unroll
        for (int i = 0; i < 96; ++i) a += uc0[part * 96 + i] * wv[i];
        qk0[part * 192 + o] = a; }
    __syncthreads();
    if (tid < 64) { float a = (qk0[tid] + qk0[192 + tid]) * (qk0[96 + tid] + qk0[288 + tid]); if (tid < 32) a += (qk0[64 + tid] + qk0[256 + tid]) * (qk0[160 + tid] + qk0[352 + tid]);
        a = wave_sum(a); if (tid == 0) ((float*)(ws + WS_C0))[bh] = a * KSCALE_B; }
    __syncthreads();
    }
}
__device__ __forceinline__ void phase_conv(const Params& P, const Wk& W) {
    unsigned char* ws = P.ws;
    const bf16_t* G2 = (const bf16_t*)(ws + WS_G); bf16_t* UC = (bf16_t*)(ws + WS_UC);
    const int gt = W.vcu * 512 + W.tid, NGT = W.G * 512;
    for (int it = gt; it < (T / 8) * 96; it += NGT) {
        const int rg = it / 96, cc = it % 96, row0 = rg * 8, c0 = cc * 8, s0 = row0 & (SEQ - 1);
        float w[4][8], bsv[8];
#pragma unroll
        for (int j = 0; j < 4; ++j) { const f32x4 a = *(const f32x4*)(P.b_conv_w + j * 768 + c0), b = *(const f32x4*)(P.b_conv_w + j * 768 + c0 + 4);
            w[j][0] = a.x; w[j][1] = a.y; w[j][2] = a.z; w[j][3] = a.w; w[j][4] = b.x; w[j][5] = b.y; w[j][6] = b.z; w[j][7] = b.w; }
        { const f32x4 a = *(const f32x4*)(P.b_conv_b + c0), b = *(const f32x4*)(P.b_conv_b + c0 + 4); bsv[0] = a.x; bsv[1] = a.y; bsv[2] = a.z; bsv[3] = a.w; bsv[4] = b.x; bsv[5] = b.y; bsv[6] = b.z; bsv[7] = b.w; }
        float h[3][8];
#pragma unroll
        for (int j = 0; j < 3; ++j) {
            if (s0 - 3 + j >= 0) { const u32x4 q = *(const u32x4*)(G2 + (size_t)(row0 - 3 + j) * G2W + G2_U + c0);
                h[j][0] = bflo(q.x); h[j][1] = bfhi(q.x); h[j][2] = bflo(q.y); h[j][3] = bfhi(q.y); h[j][4] = bflo(q.z); h[j][5] = bfhi(q.z); h[j][6] = bflo(q.w); h[j][7] = bfhi(q.w); }
            else {
#pragma unroll
                for (int e = 0; e < 8; ++e) h[j][e] = 0.f; }
        }
#pragma unroll
        for (int r = 0; r < 8; ++r) {
            const u32x4 q = *(const u32x4*)(G2 + (size_t)(row0 + r) * G2W + G2_U + c0);
            float u[8] = {bflo(q.x), bfhi(q.x), bflo(q.y), bfhi(q.y), bflo(q.z), bfhi(q.z), bflo(q.w), bfhi(q.w)};
            float o[8];
#pragma unroll
            for (int e = 0; e < 8; ++e) { const float cv = bsv[e] + h[0][e] * w[0][e] + h[1][e] * w[1][e] + h[2][e] * w[2][e] + u[e] * w[3][e]; o[e] = silu_f(cv);
                h[0][e] = h[1][e]; h[1][e] = h[2][e]; h[2][e] = u[e]; }
            u32x4 ov; ov.x = cvt_pk_bf16(o[0], o[1]); ov.y = cvt_pk_bf16(o[2], o[3]); ov.z = cvt_pk_bf16(o[4], o[5]); ov.w = cvt_pk_bf16(o[6], o[7]);
            *(u32x4*)(UC + (size_t)(row0 + r) * 768 + c0) = ov;
        }
    }
}
namespace ml {
__device__ __forceinline__ int crow(int r, int hi) { return (r & 3) + 8 * (r >> 2) + 4 * hi; }
template <int NKS>
__device__ __forceinline__ f32x16 tile32(const LAS bf16_t* A, int lda, const LAS bf16_t* B, int ldb, int r32, int hi, f32x16 acc) {
    const LAS bf16_t* ap = A + r32 * lda + hi * 8; const LAS bf16_t* bp = B + r32 * ldb + hi * 8;
#pragma unroll
    for (int ks = 0; ks < NKS; ++ks) { const bf16x8 a = *(const LAS bf16x8*)(ap + ks * 16); const bf16x8 b = *(const LAS bf16x8*)(bp + ks * 16);
        acc = __builtin_amdgcn_mfma_f32_32x32x16_bf16(a, b, acc, 0, 0, 0); }
    return acc;
}
__device__ __forceinline__ float logsigmoid_f(float f) { return fminf(f, 0.f) - log1pf(__expf(-fabsf(f))); }
__device__ __forceinline__ float scan_add(float v, int lane) {
#pragma unroll
    for (int o = 1; o < 64; o <<= 1) { const float t = __shfl_up(v, o); if (lane >= o) v += t; }
    return v;
}
__device__ __forceinline__ float scan_max(float v, int lane) {
#pragma unroll
    for (int o = 1; o < 64; o <<= 1) { const float t = __shfl_up(v, o); if (lane >= o) v = fmaxf(v, t); }
    return v;
}
constexpr int P72 = 72, P104 = 104;
__device__ __forceinline__ int unit_of(const Wk& W, int k) { const int run = W.vcu + (k >> 3) * W.G; return run < 256 ? run * 8 + (k & 7) : -1; }
__device__ __forceinline__ float sum8(const u32x4 q) { return ((bflo(q.x) + bfhi(q.x)) + (bflo(q.y) + bfhi(q.y))) + ((bflo(q.z) + bfhi(q.z)) + (bflo(q.w) + bfhi(q.w))); }

__device__ __forceinline__ void pass1_phase(const Params& P, const Wk& W, LAS unsigned char* lds) {
    unsigned char* ws = P.ws;
    LAS bf16_t* vT = (LAS bf16_t*)lds;
    LAS bf16_t* kwT = (LAS bf16_t*)(lds + 27648);
    LAS float* wsl = (LAS float*)(lds + 41472);
    LAS bf16_t* Cs = (LAS bf16_t*)(lds + 41792);
    const float* ifp = (const float*)(ws + WS_IFP);
    const bf16_t* QK = (const bf16_t*)(ws + WS_QK); const bf16_t* VV = (const bf16_t*)(ws + WS_VV);
    const int tid = W.tid, lane = W.lane, wid = W.wave, r32 = lane & 31, hi = lane >> 5;
    int kq = 0; int u = unit_of(W, 0); if (u < 0) return;
    u32x4 q[5]; float pli = 0.f, pf = 0.f;
    f32x16 T0 = f32x16{}, T1 = f32x16{}, T2 = f32x16{}; float mt_run = -1e30f, bl_run = 0.f, tn_run = 0.f;
#define P1_LOAD(uu) do { const int bh_ = (uu) >> 6, c_ = (uu) & 63, b_ = bh_ >> 2, h_ = bh_ & 3, row0_ = b_ * SEQ + c_ * 64; \
        _Pragma("unroll") for (int i = 0; i < 5; ++i) { const int id = tid + 512 * i; \
            if (id < 768) q[i] = *(const u32x4*)((const char*)QK + (unsigned)((((bh_ * SEQ) + c_ * 64 + (id & 63)) * 192 + 96 + (id >> 6) * 8) * 2)); \
            else if (id < 2304) q[i] = *(const u32x4*)((const char*)VV + (unsigned)((((bh_ * SEQ) + c_ * 64 + (id & 63)) * 192 + ((id - 768) >> 6) * 8) * 2)); } \
        if (wid == 0) { pli = *(const float*)((const char*)ifp + (unsigned)(((row0_ + lane) * 8 + h_) * 4)); pf = *(const float*)((const char*)ifp + (unsigned)(((row0_ + lane) * 8 + 4 + h_) * 4)); } } while (0)
    P1_LOAD(u);
    for (;;) {
        const int un = unit_of(W, kq + 1);
        if (wid == 0) {
            const float bcs = scan_add(logsigmoid_f(pf), lane);
            const float bL = __shfl(bcs, 63);
            const float dec = bL - bcs + pli;
            const float mloc = wave_max(dec);
            wsl[lane] = __expf(dec - mloc);
            if (lane == 0) { ((float*)(ws + WS_BL))[u] = bL; ((float*)(ws + WS_MLOC))[u] = mloc; wsl[64] = bL; wsl[65] = mloc; }
        }
        __syncthreads();
        float a_run, w_run; { const float bL = wsl[64], ml = wsl[65]; const float mn = fmaxf(bL + mt_run, ml); a_run = __expf(bL + mt_run - mn); w_run = __expf(ml - mn); mt_run = mn; bl_run += bL; }
#pragma unroll
        for (int i = 0; i < 5; ++i) { const int id = tid + 512 * i, row = id & 63;
            if (id < 768) { const int cc = id >> 6; const float wv = wsl[row];
                const float e[8] = {bflo(q[i].x), bfhi(q[i].x), bflo(q[i].y), bfhi(q[i].y), bflo(q[i].z), bfhi(q[i].z), bflo(q[i].w), bfhi(q[i].w)};
#pragma unroll
                for (int j = 0; j < 8; ++j) kwT[(cc * 8 + j) * P72 + row] = f2bf(e[j] * wv);
            } else if (id < 2304) { const int cc = (id - 768) >> 6;
                const unsigned short e[8] = {(unsigned short)(q[i].x & 0xffff), (unsigned short)(q[i].x >> 16), (unsigned short)(q[i].y & 0xffff), (unsigned short)(q[i].y >> 16), (unsigned short)(q[i].z & 0xffff), (unsigned short)(q[i].z >> 16), (unsigned short)(q[i].w & 0xffff), (unsigned short)(q[i].w >> 16)};
#pragma unroll
                for (int j = 0; j < 8; ++j) vT[(cc * 8 + j) * P72 + row] = e[j]; }
        }
        __syncthreads();
        if (un >= 0) P1_LOAD(un);
        for (int tt = wid; tt < 18; tt += 8) {
            const int mt = tt / 3, nt = tt % 3;
            f32x16 acc = f32x16{};
            acc = tile32<4>(vT + mt * 32 * P72, P72, kwT + nt * 32 * P72, P72, r32, hi, acc);
            if (tt < 8) T0 = T0 * a_run + acc * w_run; else if (tt < 16) T1 = T1 * a_run + acc * w_run; else T2 = T2 * a_run + acc * w_run;
#pragma unroll
            for (int r = 0; r < 16; ++r) Cs[(mt * 32 + crow(r, hi)) * P104 + nt * 32 + r32] = f2bf(acc[r]);
        }
        if (tid < 384) { const int dk = tid >> 2, sub = tid & 3;
            float sd = sum8(*(const LAS u32x4*)(kwT + dk * P72 + sub * 8)) + sum8(*(const LAS u32x4*)(kwT + dk * P72 + (sub + 4) * 8));
            sd += __shfl_xor(sd, 1); sd += __shfl_xor(sd, 2);
            if (sub == 0) { ((float*)(ws + WS_DN))[(size_t)u * 96 + dk] = sd; tn_run = tn_run * a_run + sd * w_run; } }
        __syncthreads();
        { char* DCb = (char*)P.out + (size_t)u * (192 * 96 * 2);
#pragma unroll
          for (int i = 0; i < 5; ++i) { const int id = tid + 512 * i; if (id < 2304) { const int dv = id / 12, cc = id % 12; *(u32x4*)(DCb + (unsigned)(id * 16)) = *(const LAS u32x4*)(Cs + dv * P104 + cc * 8); } } }
        if ((kq & 7) == 7) {
            const int run = u >> 3;
            __syncthreads();
#pragma unroll
            for (int k3 = 0; k3 < 3; ++k3) { const int tt = wid + 8 * k3; if (tt < 18) { const int mt = tt / 3, nt = tt % 3; const f32x16 Tv = (k3 == 0) ? T0 : (k3 == 1) ? T1 : T2;
#pragma unroll
                for (int r = 0; r < 16; ++r) Cs[(mt * 32 + crow(r, hi)) * P104 + nt * 32 + r32] = f2bf(Tv[r]); } }
            if (tid < 384 && (tid & 3) == 0) ((float*)(ws + WS_RN))[run * 96 + (tid >> 2)] = tn_run;
            if (tid == 0) { ((float*)(ws + WS_RBL))[run] = bl_run; ((float*)(ws + WS_RBL))[256 + run] = mt_run; }
            __syncthreads();
            { char* RSb = (char*)(ws + WS_RS) + (size_t)run * (192 * 96 * 2);
#pragma unroll
              for (int i = 0; i < 5; ++i) { const int id = tid + 512 * i; if (id < 2304) { const int dv = id / 12, cc = id % 12; *(u32x4*)(RSb + (unsigned)(id * 16)) = *(const LAS u32x4*)(Cs + dv * P104 + cc * 8); } } }
            T0 = f32x16{}; T1 = f32x16{}; T2 = f32x16{}; mt_run = -1e30f; bl_run = 0.f; tn_run = 0.f;
        }
        if (un < 0) break;
        u = un; ++kq;
    }
#undef P1_LOAD
    __syncthreads();
}

__device__ __forceinline__ void pass2(const Params& P, const Wk& W) {
    unsigned char* ws = P.ws;
    const float* BL = (const float*)(ws + WS_RBL); const float* ML = BL + 256; float* MS = (float*)(ws + WS_RBL) + 512;
    const int gt = (W.wave * W.G + W.vcu) * 64 + W.lane, NGT = W.G * 512;
    constexpr int NCE = 32 * 2304, NNE = 32 * 96;
    for (int g = gt; g < NCE + NNE; g += NGT) {
        if (g < NCE) {
            const int bh = g / 2304, e = g % 2304;
            float C[8]; float m = 0.f; float z0 = 0.f; asm volatile("" : "+v"(z0));
#pragma unroll
            for (int j = 0; j < 8; ++j) C[j] = z0;
            u32x4* base = (u32x4*)((bf16_t*)(ws + WS_RS) + (size_t)bh * 8 * 18432 + e * 8);
            u32x4 d[8]; float bL[8], ml[8];
#pragma unroll
            for (int j = 0; j < 8; ++j) { d[j] = base[(size_t)j * (18432 / 8)]; bL[j] = BL[bh * 8 + j]; ml[j] = ML[bh * 8 + j]; }
#pragma unroll
            for (int j = 0; j < 8; ++j) {
                u32x4 o; o.x = cvt_pk_bf16(C[0], C[1]); o.y = cvt_pk_bf16(C[2], C[3]); o.z = cvt_pk_bf16(C[4], C[5]); o.w = cvt_pk_bf16(C[6], C[7]);
                base[(size_t)j * (18432 / 8)] = o;
                if (e == 0) MS[bh * 8 + j] = m;
                const float mn = fmaxf(bL[j] + m, ml[j]), a = __expf(bL[j] + m - mn), w = __expf(ml[j] - mn);
                C[0] = a * C[0] + w * bflo(d[j].x); C[1] = a * C[1] + w * bfhi(d[j].x); C[2] = a * C[2] + w * bflo(d[j].y); C[3] = a * C[3] + w * bfhi(d[j].y);
                C[4] = a * C[4] + w * bflo(d[j].z); C[5] = a * C[5] + w * bfhi(d[j].z); C[6] = a * C[6] + w * bflo(d[j].w); C[7] = a * C[7] + w * bfhi(d[j].w);
                m = mn;
            }
        } else {
            const int g2 = g - NCE, bh = g2 / 96, e = g2 % 96;
            float n = 0.f, m = 0.f; float* base = (float*)(ws + WS_RN) + (size_t)bh * 8 * 96 + e;
            float d[8], bL[8], ml[8];
#pragma unroll
            for (int j = 0; j < 8; ++j) { d[j] = base[j * 96]; bL[j] = BL[bh * 8 + j]; ml[j] = ML[bh * 8 + j]; }
#pragma unroll
            for (int j = 0; j < 8; ++j) { base[j * 96] = n; const float mn = fmaxf(bL[j] + m, ml[j]), a = __expf(bL[j] + m - mn), w = __expf(ml[j] - mn); n = a * n + w * d[j]; m = mn; }
        }
    }
}

__device__ __forceinline__ void pass3_phase(const Params& P, const Wk& W, LAS unsigned char* lds) {
    unsigned char* ws = P.ws;
    LAS bf16_t* Qs = (LAS bf16_t*)lds;
    LAS bf16_t* Ks = (LAS bf16_t*)(lds + 13312);
    LAS bf16_t* vT = (LAS bf16_t*)(lds + 26624);
    LAS bf16_t* CT = (LAS bf16_t*)(lds + 54272);
    LAS bf16_t* Ps = (LAS bf16_t*)(lds + 94208);
    LAS float* Hs = (LAS float*)lds;
    LAS float* sm = (LAS float*)(lds + 103424);
    LAS float* g_s = sm, *Mt = sm + 64, *wint = sm + 128, *eneg = sm + 192, *qn = sm + 256, *rden = sm + 320, *nvec = sm + 384;
    const float* ifp = (const float*)(ws + WS_IFP);
    const bf16_t* QK = (const bf16_t*)(ws + WS_QK); const bf16_t* VV = (const bf16_t*)(ws + WS_VV);
    const int tid = W.tid, lane = W.lane, wid = W.wave, r32 = lane & 31, hi = lane >> 5;
    int kq = 0; int u = unit_of(W, 0); if (u < 0) return;
    u32x4 qa[3], qb[3], qc[5]; float pli = 0.f, pf = 0.f, pn = 0.f, pc0 = 0.f, pbl = 0.f, pml = 0.f;
    u32x4 Cr[5]; float n_reg = 0.f, m_cur = 0.f;
#define P3_LOAD(uu) do { const int bh_ = (uu) >> 6, c_ = (uu) & 63, b_ = bh_ >> 2, h_ = bh_ & 3, row0_ = b_ * SEQ + c_ * 64; \
        const char* CS_ = (const char*)P.out + (size_t)(uu) * (192 * 96 * 2); \
        _Pragma("unroll") for (int i = 0; i < 3; ++i) { const int id = tid + 512 * i; \
            { const int which = id / 768, i2 = id % 768, row = i2 / 12, cc = i2 % 12; qa[i] = *(const u32x4*)((const char*)QK + (unsigned)((((bh_ * SEQ) + c_ * 64 + row) * 192 + which * 96 + cc * 8) * 2)); } \
            { const int cc = id >> 6, row = id & 63; qb[i] = *(const u32x4*)((const char*)VV + (unsigned)((((bh_ * SEQ) + c_ * 64 + row) * 192 + cc * 8) * 2)); } } \
        _Pragma("unroll") for (int i = 0; i < 5; ++i) { const int id = tid + 512 * i; if (id < 2304) qc[i] = *(const u32x4*)(CS_ + (unsigned)(id * 16)); } \
        pbl = ((const float*)(ws + WS_BL))[uu]; pml = ((const float*)(ws + WS_MLOC))[uu]; \
        if (wid == 0) { pc0 = ((const float*)(ws + WS_C0))[bh_]; pli = *(const float*)((const char*)ifp + (unsigned)(((row0_ + lane) * 8 + h_) * 4)); pf = *(const float*)((const char*)ifp + (unsigned)(((row0_ + lane) * 8 + 4 + h_) * 4)); } \
        if (tid < 96) pn = *(const float*)((const char*)(ws + WS_DN) + (unsigned)(((uu) * 96 + tid) * 4)); } while (0)
    P3_LOAD(u);
    for (;;) {
        const int bh = u >> 6, c = u & 63, b = bh >> 2, h = bh & 3, row0 = b * SEQ + c * 64;
        const int un = unit_of(W, kq + 1);
        const float c0cur = pc0;
        int tid_l = W.tid; asm volatile("" : "+v"(tid_l));
        const int tid = tid_l, lane = tid & 63, r32 = lane & 31, hi = lane >> 5;
        if ((kq & 7) == 0) {
            const int run = u >> 3; const char* RSb = (const char*)(ws + WS_RS) + (size_t)run * (192 * 96 * 2);
#pragma unroll
            for (int i = 0; i < 5; ++i) { const int id = tid + 512 * i; if (id < 2304) Cr[i] = *(const u32x4*)(RSb + (unsigned)(id * 16)); }
            if (tid < 96) n_reg = ((const float*)(ws + WS_RN))[run * 96 + tid];
            m_cur = ((const float*)(ws + WS_RBL))[512 + run];
        }
        if (wid == 0) {
            const float bcs = scan_add(logsigmoid_f(pf), lane);
            const float g = pli - bcs;
            const float pmx = scan_max(g, lane);
            const float M = fmaxf(m_cur, pmx);
            g_s[lane] = g; Mt[lane] = M; wint[lane] = __expf(m_cur - M); eneg[lane] = __expf(-bcs - M);
        }
#pragma unroll
        for (int i = 0; i < 3; ++i) { const int id = tid + 512 * i;
            { const int which = id / 768, i2 = id % 768, row = i2 / 12, cc = i2 % 12; *(LAS u32x4*)((which ? Ks : Qs) + row * P104 + cc * 8) = qa[i]; }
            { const int cc = id >> 6, row = id & 63;
              const unsigned short e[8] = {(unsigned short)(qb[i].x & 0xffff), (unsigned short)(qb[i].x >> 16), (unsigned short)(qb[i].y & 0xffff), (unsigned short)(qb[i].y >> 16), (unsigned short)(qb[i].z & 0xffff), (unsigned short)(qb[i].z >> 16), (unsigned short)(qb[i].w & 0xffff), (unsigned short)(qb[i].w >> 16)};
#pragma unroll
              for (int j = 0; j < 8; ++j) vT[(cc * 8 + j) * P72 + row] = e[j]; } }
        {
            const float mn = fmaxf(pbl + m_cur, pml), a_ = __expf(pbl + m_cur - mn), w_ = __expf(pml - mn);
#pragma unroll
            for (int i = 0; i < 5; ++i) { const int id = tid + 512 * i; if (id < 2304) { const int dv = id / 12, cc = id % 12;
                const u32x4 cq = Cr[i], d = qc[i];
                *(LAS u32x4*)(CT + dv * P104 + cc * 8) = cq;
                u32x4 o;
                o.x = cvt_pk_bf16(a_ * bflo(cq.x) + w_ * bflo(d.x), a_ * bfhi(cq.x) + w_ * bfhi(d.x)); o.y = cvt_pk_bf16(a_ * bflo(cq.y) + w_ * bflo(d.y), a_ * bfhi(cq.y) + w_ * bfhi(d.y));
                o.z = cvt_pk_bf16(a_ * bflo(cq.z) + w_ * bflo(d.z), a_ * bfhi(cq.z) + w_ * bfhi(d.z)); o.w = cvt_pk_bf16(a_ * bflo(cq.w) + w_ * bflo(d.w), a_ * bfhi(cq.w) + w_ * bfhi(d.w));
                Cr[i] = o; } }
            if (tid < 96) { nvec[tid] = n_reg; n_reg = a_ * n_reg + w_ * pn; }
            m_cur = mn;
        }
        __syncthreads();
        if (un >= 0) P3_LOAD(un);
        __builtin_amdgcn_sched_barrier(0);
        if (wid < 4) {
            const int mt = wid >> 1, nt = wid & 1;
            f32x16 acc = f32x16{};
            acc = tile32<6>(Qs + mt * 32 * P104, P104, Ks + nt * 32 * P104, P104, r32, hi, acc);
#ifndef NO_FIRST_TOKEN
            if (c == 0 && wid == 0 && lane == 0) acc[0] = c0cur;
#endif
            const int s = nt * 32 + r32; const float gs = g_s[s];
#pragma unroll
            for (int r = 0; r < 16; ++r) { const int t = mt * 32 + crow(r, hi);
                const float w = (s <= t) ? __expf(gs - Mt[t]) : 0.f;
                Ps[t * P72 + s] = f2bf(acc[r] * w); }
        } else {
            const int t = (tid - 256) >> 2, sub = tid & 3; float a = 0.f;
#pragma unroll
            for (int j = 0; j < 3; ++j) { const int cc = sub + 4 * j; const u32x4 q = *(const LAS u32x4*)(Qs + t * P104 + cc * 8); const LAS float* nv = nvec + cc * 8;
                a += (bflo(q.x) * nv[0] + bfhi(q.x) * nv[1]) + (bflo(q.y) * nv[2] + bfhi(q.y) * nv[3]) + (bflo(q.z) * nv[4] + bfhi(q.z) * nv[5]) + (bflo(q.w) * nv[6] + bfhi(q.w) * nv[7]); }
            a += __shfl_xor(a, 1); a += __shfl_xor(a, 2);
            if (sub == 0) qn[t] = a;
        }
        __syncthreads();
        { const int t = tid >> 3, sub = tid & 7;
          float rs = sum8(*(const LAS u32x4*)(Ps + t * P72 + sub * 8));
          rs += __shfl_xor(rs, 1); rs += __shfl_xor(rs, 2); rs += __shfl_xor(rs, 4);
          if (sub == 0) { float den = wint[t] * qn[t] + rs; den = fmaxf(fabsf(den), eneg[t]); rden[t] = __builtin_amdgcn_rcpf(den); } }
        const int te = tid >> 3, sube = tid & 7;
        const bf16_t* G2 = (const bf16_t*)(ws + WS_G) + (size_t)(row0 + te) * G2W; const bf16_t* UC = (const bf16_t*)(ws + WS_UC) + (size_t)(row0 + te) * 768;
        u32x4 eop[3], egq[3], euq[3];
#pragma unroll
        for (int j = 0; j < 3; ++j) { const int col = h * 192 + (sube + 8 * j) * 8; eop[j] = *(const u32x4*)(G2 + G2_O + col); egq[j] = *(const u32x4*)(G2 + G2_GATE + col); euq[j] = *(const u32x4*)(UC + col); }
        f32x16 accA = f32x16{}, accB = f32x16{};
        {
            const int tt = (wid < 4) ? (8 + wid) : (wid - 4), mt = tt / 6, nt = tt % 6;
            accA = tile32<6>(Qs + mt * 32 * P104, P104, CT + nt * 32 * P104, P104, r32, hi, accA);
#pragma unroll
            for (int r = 0; r < 16; ++r) accA[r] *= wint[mt * 32 + crow(r, hi)];
            accA = tile32<4>(Ps + mt * 32 * P72, P72, vT + nt * 32 * P72, P72, r32, hi, accA);
        }
        if (wid >= 4) {
            const int tt = wid, mt = tt / 6, nt = tt % 6;
            accB = tile32<6>(Qs + mt * 32 * P104, P104, CT + nt * 32 * P104, P104, r32, hi, accB);
#pragma unroll
            for (int r = 0; r < 16; ++r) accB[r] *= wint[mt * 32 + crow(r, hi)];
            accB = tile32<4>(Ps + mt * 32 * P72, P72, vT + nt * 32 * P72, P72, r32, hi, accB);
        }
        __syncthreads();
        {
            const int tt = (wid < 4) ? (8 + wid) : (wid - 4), mt = tt / 6, nt = tt % 6;
#pragma unroll
            for (int r = 0; r < 16; ++r) { const int t = mt * 32 + crow(r, hi); Hs[t * 196 + nt * 32 + r32] = accA[r] * rden[t]; }
        }
        if (wid >= 4) {
            const int tt = wid, mt = tt / 6, nt = tt % 6;
#pragma unroll
            for (int r = 0; r < 16; ++r) { const int t = mt * 32 + crow(r, hi); Hs[t * 196 + nt * 32 + r32] = accB[r] * rden[t]; }
        }
        __syncthreads();
        __builtin_amdgcn_sched_barrier(0);
        {
            float hv[3][8]; float ss = 0.f;
#pragma unroll
            for (int j = 0; j < 3; ++j) { const int col = (sube + 8 * j) * 8;
                const f32x4 a = *(const LAS f32x4*)(Hs + te * 196 + col), bq = *(const LAS f32x4*)(Hs + te * 196 + col + 4);
                hv[j][0] = a.x; hv[j][1] = a.y; hv[j][2] = a.z; hv[j][3] = a.w; hv[j][4] = bq.x; hv[j][5] = bq.y; hv[j][6] = bq.z; hv[j][7] = bq.w;
#pragma unroll
                for (int e = 0; e < 8; ++e) ss += hv[j][e] * hv[j][e]; }
            ss += __shfl_xor(ss, 1); ss += __shfl_xor(ss, 2); ss += __shfl_xor(ss, 4);
            const float rstd = rsqrtf(ss * (1.f / 192.f) + EPS);
            bf16_t* Y = (bf16_t*)(ws + WS_Y2) + (size_t)(row0 + te) * DM;
#pragma unroll
            for (int j = 0; j < 3; ++j) { const int col = h * 192 + (sube + 8 * j) * 8;
                const u32x4 op = eop[j], gq = egq[j], uq = euq[j];
                const float ov[8] = {bflo(op.x), bfhi(op.x), bflo(op.y), bfhi(op.y), bflo(op.z), bfhi(op.z), bflo(op.w), bfhi(op.w)};
                const float gv[8] = {bflo(gq.x), bfhi(gq.x), bflo(gq.y), bfhi(gq.y), bflo(gq.z), bfhi(gq.z), bflo(gq.w), bfhi(gq.w)};
                const float uv[8] = {bflo(uq.x), bfhi(uq.x), bflo(uq.y), bfhi(uq.y), bflo(uq.z), bfhi(uq.z), bflo(uq.w), bfhi(uq.w)};
                float o[8];
#pragma unroll
                for (int e = 0; e < 8; ++e) { const float hn = hv[j][e] * rstd * P.b_head_g[col + e]; const float mix = sigmoid_f(ov[e]) * hn + P.b_skip[col + e] * uv[e]; o[e] = mix * silu_f(gv[e]); }
                u32x4 w; w.x = cvt_pk_bf16(o[0], o[1]); w.y = cvt_pk_bf16(o[2], o[3]); w.z = cvt_pk_bf16(o[4], o[5]); w.w = cvt_pk_bf16(o[6], o[7]);
                *(u32x4*)(Y + col) = w; }
        }
        __syncthreads();
        if (un < 0) break;
        u = un; ++kq;
    }
#undef P3_LOAD
}
}
typedef GAS unsigned gu32;
#define XB_TMO      128
#define XB_XCNT(j)  (256  + 64 * (j))
#define XB_XSUB(j)  (1280 + 64 * (j))
#define XB_XGEN(j)  (2304 + 64 * (j))
#define XB_TOP      3328
#define XB_TOPGEN   3392
#define XCD_BAR_WORDS 3456
#define XB_SPIN_CAP (1u << 18)
__device__ __forceinline__ unsigned xb_ld(unsigned* p)              { return __hip_atomic_load(p, __ATOMIC_RELAXED, __HIP_MEMORY_SCOPE_AGENT); }
__device__ __forceinline__ unsigned xb_add(unsigned* p, unsigned v) { return __hip_atomic_fetch_add(p, v, __ATOMIC_RELAXED, __HIP_MEMORY_SCOPE_AGENT); }
__device__ __forceinline__ unsigned xb_xcc_id() { return (unsigned)__builtin_amdgcn_s_getreg((3 << 11) | 20) & 0xFu; }
#define XB_SPIN(cond, bar) do { unsigned _sp = 0; while (cond) { __builtin_amdgcn_s_sleep(1); \
    if ((++_sp & 255u) == 0u) { if (xb_ld(&(bar)[XB_TMO])) break; if (_sp > XB_SPIN_CAP) { atomicAdd(&(bar)[XB_TMO], 1u); break; } } } } while (0)
struct XcdBarrier { unsigned* bar; unsigned x; volatile LAS unsigned* st; };
__device__ __forceinline__ XcdBarrier xcd_barrier_post(unsigned* bar, volatile LAS unsigned* st) {
    XcdBarrier b; b.bar = bar; b.x = xb_xcc_id(); b.st = st;
    if (threadIdx.x == 0) (void)xb_add(&bar[XB_XCNT(b.x)], 1u);
    return b;
}
__device__ __forceinline__ void xcd_barrier_complete(unsigned* bar, unsigned x, unsigned& nloc, unsigned& nx) {
    const unsigned G = gridDim.x * gridDim.y * gridDim.z;
    unsigned sum, cnt, mine, sp = 0u;
    for (;;) {
        sum = 0u; cnt = 0u; mine = 0u;
#pragma unroll
        for (unsigned j = 0; j < 16; ++j) { const unsigned c = xb_ld(&bar[XB_XCNT(j)]); sum += c; cnt += (c > 0u) ? 1u : 0u; mine = (j == x) ? c : mine; }
        if (sum == G) break;
        __builtin_amdgcn_s_sleep(1);
        if ((++sp & 255u) == 0u) { if (xb_ld(&bar[XB_TMO])) break; if (sp > XB_SPIN_CAP) { atomicAdd(&bar[XB_TMO], 1u); break; } }
    }
    nloc = mine > 0u ? mine : 1u; nx = cnt > 0u ? cnt : 1u;
}
__device__ __forceinline__ void xcd_barrier(const XcdBarrier& b) {
    asm volatile("s_waitcnt vmcnt(0)" ::: "memory");
    __syncthreads();
    if (threadIdx.x == 0) {
        unsigned* bar = b.bar;
        __builtin_amdgcn_s_waitcnt(0);
        unsigned nloc = b.st[0], nx = b.st[1];
        if (nloc == 0u) { xcd_barrier_complete(bar, b.x, nloc, nx); b.st[0] = nloc; b.st[1] = nx; }
        const unsigned old = xb_add(&bar[XB_XSUB(b.x)], 1u);
        const unsigned gen = old / nloc;
        if (old + 1u == (gen + 1u) * nloc) {
            __builtin_amdgcn_fence(__ATOMIC_RELEASE, "agent");
            asm volatile("s_waitcnt vmcnt(0)" ::: "memory");
            const unsigned og = xb_add(&bar[XB_TOP], 1u);
            const unsigned tg = og / nx;
            if (og + 1u == (tg + 1u) * nx) xb_add(&bar[XB_TOPGEN], 1u);
            else XB_SPIN(xb_ld(&bar[XB_TOPGEN]) == tg, bar);
            __builtin_amdgcn_fence(__ATOMIC_ACQUIRE, "agent");
            xb_add(&bar[XB_XGEN(b.x)], 1u);
            asm volatile("s_waitcnt vmcnt(0)" ::: "memory");
        } else {
            XB_SPIN(xb_ld(&bar[XB_XGEN(b.x)]) == gen, bar);
            __builtin_amdgcn_fence(__ATOMIC_ACQUIRE, "agent");
            asm volatile("s_waitcnt vmcnt(0)" ::: "memory");
        }
    }
    __syncthreads();
}

constexpr int RING_BYTES = 131072, LDSCTL_OFF = RING_BYTES, LDS_BYTES = 147456;
constexpr int CW_BAR = 4096;
constexpr int CW_XCNT = 16384;
constexpr int CW_XTMO = 8192;
#ifdef FUSED_FINAL
constexpr int N_PHASES = 13;
#else
constexpr int N_PHASES = 14;
#endif

__device__ __forceinline__ void setup_job(const Params& P, int j, pg8::Gemm& g, pg8::Epi& E) {
    unsigned char* ws = P.ws;
    E.out = nullptr; E.ldc = 0; E.ncols = 1 << 30; E.out2 = nullptr; E.ldc2 = 0; E.split = 1 << 30; E.rs = nullptr; E.rs_mode = 0; E.rs_invdim = 0.f;
    E.ssqA = nullptr; E.ssqB = nullptr; E.ssq_mode = 0; E.rope = (const float2*)(ws + WS_ROPE); E.rope_mode = 0; E.hm_mode = 0;
    E.after = 0; E.fbase = nullptr; E.fout = nullptr; E.fgain = nullptr; E.xslots = (unsigned*)(ws + WS_XSL); E.xcnt = (unsigned*)(ws + WS_CTL) + CW_XCNT; E.xtmo = (unsigned*)(ws + WS_CTL) + CW_XTMO;
    g.M = T; g.lda = 1024; g.apn = 0;
    switch (j) {
    case 0: g.A = (const bf16_t*)(ws + WS_XB); g.Bt = (const bf16_t*)(ws + WS_WINA); g.N = 2048; g.K = 1024;
        E.out = (bf16_t*)(ws + WS_G); E.ldc = G1W; E.rs = (const float*)(ws + WS_RSTD); E.rs_mode = 1; E.ssqA = (float*)(ws + WS_SSQA); E.ssqB = (float*)(ws + WS_SSQB); E.ssq_mode = 1; E.rope_mode = 1; break;
    case 1: g.A = (const bf16_t*)(ws + WS_MEMN); g.Bt = (const bf16_t*)(ws + WS_WMKV); g.M = NB * NMEM; g.N = 1024; g.K = 1024;
        E.out = (bf16_t*)(ws + WS_KVM); E.ldc = 1024; break;
    case 2: g.A = (const bf16_t*)(ws + WS_G) + G1_CQ; g.lda = G1W; g.Bt = (const bf16_t*)(ws + WS_WUQ); g.N = 1280; g.K = 384;
        E.out = (bf16_t*)(ws + WS_Q); E.ldc = QW; E.ncols = QW; E.rs = (const float*)(ws + WS_SSQA); E.rs_mode = 2; E.rs_invdim = 1.f / 384.f; E.rope_mode = 2; break;
    case 3: g.A = (const bf16_t*)(ws + WS_G) + G1_CKV; g.lda = G1W; g.Bt = (const bf16_t*)(ws + WS_WUKV); g.N = 1536; g.K = 256;
        E.out = (bf16_t*)(ws + WS_KN); E.ldc = 768; E.out2 = (bf16_t*)(ws + WS_V); E.ldc2 = 768; E.split = 768; E.rs = (const float*)(ws + WS_SSQB); E.rs_mode = 2; E.rs_invdim = 1.f / 256.f; break;
    case 4: g.A = (const bf16_t*)(ws + WS_Y); g.Bt = (const bf16_t*)(ws + WS_WOA); g.N = 1024; g.K = 1024; E.out = (bf16_t*)(ws + WS_Z); E.ldc = 1024; break;
    case 5: g.A = (const bf16_t*)(ws + WS_XB); g.Bt = (const bf16_t*)(ws + WS_WINB); g.N = G2W; g.K = 1024;
        E.out = (bf16_t*)(ws + WS_G); E.ldc = G2W; E.rs = (const float*)(ws + WS_RSTD); E.rs_mode = 1; break;
    case 6: g.A = (const bf16_t*)(ws + WS_UC); g.lda = 768; g.apn = 192; g.Bt = (const bf16_t*)(ws + WS_WQK); g.N = 768; g.K = 384; E.out = (bf16_t*)(ws + WS_QK); E.ldc = 768; E.hm_mode = 1; break;
    case 7: g.A = (const bf16_t*)(ws + WS_G) + G2_U; g.lda = G2W; g.apn = 192; g.Bt = (const bf16_t*)(ws + WS_WV); g.N = 768; g.K = 384; E.out = (bf16_t*)(ws + WS_VV); E.ldc = 768; E.hm_mode = 1; break;
    default: g.A = (const bf16_t*)(ws + WS_Y2); g.Bt = (const bf16_t*)(ws + WS_WOB); g.N = 1024; g.K = 1024;
#ifdef FUSED_FINAL
        E.after = 1; E.fbase = P.out; E.fout = P.out; E.fgain = P.b_post_g; E.xcnt = (unsigned*)(ws + WS_CTL) + CW_XCNT + (j - 8) * 128 * 64;
#else
        E.out = (bf16_t*)(ws + WS_Z); E.ldc = 1024;
#endif
        break;
    }
}

__device__ __forceinline__ void phase_memattn(const Params& P, const Wk& W, LAS unsigned char* lds, int L) {
    unsigned char* ws = P.ws;
    const bf16_t* G = (const bf16_t*)(ws + WS_G); const bf16_t* KVM = (const bf16_t*)(ws + WS_KVM);
    const int gpitch = L ? G2W : G1W, qm_off = L ? G2_QM : G1_QM, gate_off = L ? G2_GATE : G1_GATE;
    bf16_t* Yb = (bf16_t*)(ws + (L ? WS_Y2 : WS_Y));
    for (int u = W.vcu; u < 512; u += W.G) {
        const int rb = u >> 2, hm = u & 3, row0 = rb * 256, b = row0 / SEQ;
        const bf16_t* Km = KVM + (size_t)(b * NMEM) * 1024 + L * 512 + hm * 64;
        att::attn_unit<64, 64, false>(G + (size_t)row0 * gpitch + qm_off + hm * 64, gpitch, Km, 1024, 8, Km, 1024, Km + 256, 1024, 4, 0,
                                      G + (size_t)row0 * gpitch + gate_off + 768 + hm * 64, gpitch, Yb + (size_t)row0 * DM + 768 + hm * 64, DM, lds, W.tid);
    }
}
template <int ABL>
__device__ __forceinline__ void phase_attn(const Params& P, const Wk& W, LAS unsigned char* lds) {
    unsigned char* ws = P.ws;
    const bf16_t* G = (const bf16_t*)(ws + WS_G); const bf16_t* Qp = (const bf16_t*)(ws + WS_Q); const bf16_t* KN = (const bf16_t*)(ws + WS_KN); const bf16_t* Vp = (const bf16_t*)(ws + WS_V);
    bf16_t* Yb = (bf16_t*)(ws + (ABL ? WS_Z : WS_Y));
    for (int u = W.vcu; u < 768; u += W.G) {
        const int k = u >> 8, cu = u & 255, grp = cu >> 4, i = cu & 15, bh = grp * 3 + k;
        const int qb = (k == 0) ? i : (k == 1) ? ((i + 8) & 15) : (i < 8 ? 15 - 2 * i : 30 - 2 * i);
        const int b = bh / 6, h = bh % 6; const size_t rowb = (size_t)b * SEQ, row0 = rowb + (size_t)qb * 256;
        int tid_u = W.tid; asm volatile("" : "+v"(tid_u));
        att::attn_unit<192, 128, true, ABL>(Qp + row0 * QW + h * 192, QW, KN + rowb * 768 + h * 128, 768, 16, G + rowb * G1W + G1_KR, G1W, Vp + rowb * 768 + h * 128, 768,
                                       4 * (qb + 1), qb * 256, G + row0 * G1W + G1_GATE + h * 128, G1W, Yb + row0 * DM + h * 128, DM, lds, tid_u);
    }
}

__global__ void __launch_bounds__(512, 2) mega_fwd(Params P) {
    extern __shared__ __attribute__((aligned(16))) unsigned char lds_raw[];
    LAS unsigned char* lds = (LAS unsigned char*)lds_raw;
    Wk W; W.tid = threadIdx.x; W.lane = W.tid & 63; W.wave = __builtin_amdgcn_readfirstlane(W.tid >> 6);
    W.G = gridDim.x; { const int bx = blockIdx.x; W.vcu = (W.G % 8 == 0) ? (bx % 8) * (W.G / 8) + bx / 8 : bx; }
    volatile LAS unsigned* MISC = (volatile LAS unsigned*)(lds + LDSCTL_OFF);
    if (W.tid < 64) MISC[W.tid] = 0u;
    __syncthreads();
    const int lo = P.ph_lo, hi = P.ph_hi;
    const int vcu_s = W.vcu;
    const int wave_s = __builtin_amdgcn_readfirstlane(threadIdx.x >> 6);
    XcdBarrier bar; bar.bar = (unsigned*)(P.ws + WS_CTL) + CW_BAR; bar.x = 0; bar.st = nullptr;
    if (hi - lo > 1) bar = xcd_barrier_post((unsigned*)(P.ws + WS_CTL) + CW_BAR, MISC + 8);
#ifndef PROBE_REP
#define PROBE_REP 0
#endif
#ifdef PROBE_PAIR
    bool pair_done = false;
#endif
    for (int ph2 = 2 * lo; ph2 < 2 * hi; ++ph2) {
        const int ph = ph2 >> 1;
        if ((ph2 & 1) && !((PROBE_REP >> ph) & 1)) continue;
        const bool more_ = (ph + 1 < hi) || (!(ph2 & 1) && ((PROBE_REP >> ph) & 1));
        { int t_; asm volatile("v_mbcnt_lo_u32_b32 %0, -1, 0\n\tv_mbcnt_hi_u32_b32 %0, -1, %0" : "=v"(t_)); t_ += wave_s * 64; { int g_ = gridDim.x, v_ = vcu_s; asm volatile("" : "+s"(g_), "+s"(v_)); W.G = g_; W.vcu = v_; } W.tid = t_; W.lane = t_ & 63; W.wave = __builtin_amdgcn_readfirstlane(t_ >> 6); }
        int j0 = 0, j1 = 0;
#ifdef DBG_CUT
        if (ph == 100) { const bf16_t* src = (const bf16_t*)(P.ws + (size_t)DBG_OFF); const int gt_ = W.vcu * 512 + W.tid, NGT_ = W.G * 512; for (int i = gt_; i < T * DM; i += NGT_) {
#ifdef DBG_F32N
            P.out[i] = (i < DBG_F32N) ? ((const float*)src)[i] : 0.f;
#else
            P.out[i] = bf2f(src[i]);
#endif
            } continue; }
#endif
#ifndef PHM
#define PHM 0xffff
#endif
#define PHON(k) ((PHM >> (k)) & 1)
        switch (ph) {
        case 0: if (PHON(0)) phase_prologue(P, W, lds); break;
        case 1: j0 = 0; j1 = 1; break;
        case 2: j0 = 1; j1 = 4; break;
        case 3: if (PHON(3)) {
#ifdef PROBE_ABL
            if (ph2 & 1) phase_attn<PROBE_ABL>(P, W, lds); else
#endif
            phase_attn<0>(P, W, lds); } break;
        case 4: j0 = 4; j1 = 5; break;
        case 5: if (PHON(5)) phase_rowmid(P, W, lds); break;
        case 6: j0 = 5; j1 = 6; break;
        case 7: if (PHON(7)) phase_conv(P, W); break;
        case 8: j0 = 6; j1 = 8; break;
        case 9: if (PHON(9)) ml::pass1_phase(P, W, lds); break;
        case 10: if (PHON(10)) { ml::pass2(P, W);
#ifndef NO_FIRST_TOKEN
            first_token_qk(P, W, lds);
#endif
            } break;
        case 11: if (PHON(11)) ml::pass3_phase(P, W, lds); break;
#ifdef FUSED_FINAL
        case 12: j0 = 8; j1 = 10; break;
        default: break;
#else
        case 12: j0 = 8; j1 = 9; break;
        default: if (PHON(13)) phase_rowfinal(P, W); break;
#endif
        }
        if (PHON(14) && (ph == 3 || ph == 9) && !(ph2 & 1)) phase_memattn(P, W, lds, ph == 9 ? 1 : 0);
        if (PHON(1)) for (int j = j0; j < j1; ++j) {
            pg8::Gemm g; pg8::Epi E; setup_job(P, j, g, E);
            const int shift = (j == 1) ? 128 : (j == 7) ? 128 : 0;
            pg8::StaticOrder S; S.init(g.M, g.N, W.G, (int)((blockIdx.x + shift) % W.G));
#ifdef FUSED_FINAL
            if (j >= 8) { S.i0 = j - 8; S.nmax = 1; }
#endif
            if (j == 2 && W.G == 256) S.give_lo = 128;
            pg8::gemm_phase<true>(lds, g, S, E, W.tid);
        }
#ifndef NO_FIRST_TOKEN
        if (ph == 6) { const int half = W.G / 2, nwk = W.G - half;
            if ((int)blockIdx.x >= half) for (int widx = (int)blockIdx.x - half; widx < 128; widx += nwk) first_token_u0(P, W, lds, widx); }
#endif
        if (more_) xcd_barrier(bar);
#ifdef PROBE_PAIR
        if (ph == PROBE_PAIR + 1 && !pair_done) { pair_done = true; ph2 = 2 * PROBE_PAIR - 1; }
#endif
    }
}

extern "C" void kernel_launch(void* const* d_in, const int* in_sizes, int n_in, void* d_out, int out_size, void* d_ws, size_t ws_size, hipStream_t stream) {
    static int grid = 0;
    if (grid == 0) {
        if (n_in != 27 || in_sizes[0] != T * DM || out_size != T * DM || ws_size < WS_END) {
            fprintf(stderr, "kernel_launch: unexpected shapes (n_in %d in0 %d out %d ws %zu)\n", n_in, n_in > 0 ? in_sizes[0] : -1, out_size, ws_size); grid = -1; return; }
        int dev = 0, cus = 0, per_cu = 0;
        if (hipGetDevice(&dev) != hipSuccess || hipDeviceGetAttribute(&cus, hipDeviceAttributeMultiprocessorCount, dev) != hipSuccess) { grid = -1; return; }
        if (hipFuncSetAttribute((const void*)mega_fwd, hipFuncAttributeMaxDynamicSharedMemorySize, LDS_BYTES) != hipSuccess) { fprintf(stderr, "kernel_launch: hipFuncSetAttribute failed\n"); grid = -1; return; }
        if (hipOccupancyMaxActiveBlocksPerMultiprocessor(&per_cu, (const void*)mega_fwd, 512, LDS_BYTES) != hipSuccess || per_cu < 1) { fprintf(stderr, "kernel_launch: occupancy query says %d\n", per_cu); }
        (void)hipGetLastError();
        grid = cus;
    }
    if (grid < 0) return;
    (void)hipMemsetAsync((char*)d_ws + WS_CTL, 0, CTL_ZERO_BYTES, stream);
    Params p{};
    const float** fp = (const float**)&p.a_pre_g;
    p.x = (const float*)d_in[0]; p.mem = (const float*)d_in[1]; p.pos = (const int*)d_in[2];
    for (int i = 0; i < 24; ++i) fp[i] = (const float*)d_in[3 + i];
    p.out = (float*)d_out; p.ws = (unsigned char*)d_ws;
#ifndef N_LAUNCH_SPLIT
#define N_LAUNCH_SPLIT 0
#endif
#ifdef DBG_CUT
    for (int ph = 0; ph < DBG_CUT; ++ph) { p.ph_lo = ph; p.ph_hi = ph + 1; hipLaunchKernelGGL(mega_fwd, dim3(grid), dim3(512), LDS_BYTES, stream, p); }
    p.ph_lo = 100; p.ph_hi = 101; hipLaunchKernelGGL(mega_fwd, dim3(grid), dim3(512), LDS_BYTES, stream, p);
#elif N_LAUNCH_SPLIT
    for (int ph = 0; ph < N_PHASES; ++ph) { p.ph_lo = ph; p.ph_hi = ph + 1; hipLaunchKernelGGL(mega_fwd, dim3(grid), dim3(512), LDS_BYTES, stream, p); }
#else
    p.ph_lo = 0; p.ph_hi = N_PHASES; hipLaunchKernelGGL(mega_fwd, dim3(grid), dim3(512), LDS_BYTES, stream, p);
#endif
}
```

```cpp
#include <hip/hip_runtime.h>
#include <cstdio>
#include <cstdint>

#define LAS __attribute__((address_space(3)))
#define GAS __attribute__((address_space(1)))
typedef unsigned short bf16_t;
typedef short bf16x8 __attribute__((ext_vector_type(8)));
typedef short s16x4 __attribute__((ext_vector_type(4)));
typedef float f32x4 __attribute__((ext_vector_type(4)));
typedef float f32x16 __attribute__((ext_vector_type(16)));
typedef unsigned u32x4 __attribute__((ext_vector_type(4)));
typedef unsigned u32x2 __attribute__((ext_vector_type(2)));

constexpr int NB = 8, SEQ = 4096, DM = 1024, T = NB * SEQ;
constexpr int NMEM = 256;
constexpr float EPS = 1e-6f;
constexpr int A_IN = 1984, B_IN = 2824;
constexpr int G1W = 2112;
constexpr int G1_CKV = 0, G1_CQ = 256, G1_KR = 640, G1_QM = 768, G1_GATE = 1024;
constexpr int G2W = 2816;
constexpr int G2_U = 0, G2_O = 768, G2_QM = 1536, G2_GATE = 1792;
constexpr int QW = 1152;
constexpr float LOG2E = 1.4426950408889634f;
constexpr float QSCALE = 0.07216878364870323f * LOG2E;
constexpr float MSCALE = 0.125f * LOG2E;
constexpr float KSCALE_B = 0.10206207261596577f;

constexpr size_t MiB = 1u << 20;
constexpr size_t WS_CTL = 0, CTL_ZERO_BYTES = 512 * 1024;
constexpr size_t WS_WINA = 2 * MiB;
constexpr size_t WS_WUQ = 6 * MiB;
constexpr size_t WS_WUKV = 7 * MiB;
constexpr size_t WS_WMKV = 8 * MiB;
constexpr size_t WS_WOA = 10 * MiB;
constexpr size_t WS_WINB = 12 * MiB;
constexpr size_t WS_WQK = 18 * MiB;
constexpr size_t WS_WV = 19 * MiB;
constexpr size_t WS_WOB = 20 * MiB;
constexpr size_t WS_WG = 22 * MiB;
constexpr size_t WS_RSTD = 23 * MiB;
constexpr size_t WS_SSQA = WS_RSTD + 128 * 1024;
constexpr size_t WS_SSQB = WS_SSQA + 128 * 1024;
constexpr size_t WS_ROPE = 24 * MiB;
constexpr size_t WS_MEMN = 32 * MiB;
constexpr size_t WS_KVM = 36 * MiB;
constexpr size_t WS_IFP = 40 * MiB;
constexpr size_t WS_BL = 41 * MiB;
constexpr size_t WS_MLOC = WS_BL + 8192;
constexpr size_t WS_MST = WS_MLOC + 8192;
constexpr size_t WS_C0 = WS_MST + 8192;
constexpr size_t WS_U0 = WS_C0 + 1024;
constexpr size_t WS_RS = 46 * MiB;
constexpr size_t WS_RN = 45 * MiB + 256 * 1024;
constexpr size_t WS_RBL = 45 * MiB + 512 * 1024;
constexpr size_t WS_X1F = 45 * MiB;
constexpr size_t WS_XSL = 44 * MiB;
constexpr size_t WS_DN = 42 * MiB;
constexpr size_t WS_XB = 64 * MiB;
constexpr size_t WS_Y = 64 * MiB;
constexpr size_t WS_G = 128 * MiB;
constexpr size_t WS_Q = 304 * MiB;
constexpr size_t WS_KN = 376 * MiB;
constexpr size_t WS_V = 424 * MiB;
constexpr size_t WS_Z = 304 * MiB;
constexpr size_t WS_UC = 304 * MiB;
constexpr size_t WS_QK = 352 * MiB;
constexpr size_t WS_VV = 400 * MiB;
constexpr size_t WS_Y2 = 448 * MiB;
constexpr size_t WS_END = 512 * MiB;

typedef float f32x2_t __attribute__((ext_vector_type(2))); typedef __bf16 bf16x2_t __attribute__((ext_vector_type(2)));
__device__ __forceinline__ unsigned cvt_pk_bf16(float lo, float hi) { f32x2_t v = {lo, hi}; bf16x2_t b = __builtin_convertvector(v, bf16x2_t); return __builtin_bit_cast(unsigned, b); }
__device__ __forceinline__ float bf2f(unsigned short b) { return __uint_as_float((unsigned)b << 16); }
__device__ __forceinline__ float bflo(unsigned w) { return __uint_as_float(w << 16); }
__device__ __forceinline__ float bfhi(unsigned w) { return __uint_as_float(w & 0xffff0000u); }
__device__ __forceinline__ unsigned short f2bf(float f) { return (unsigned short)(cvt_pk_bf16(f, f) & 0xffffu); }
__device__ __forceinline__ float wave_sum(float v) {
#pragma unroll
    for (int o = 1; o < 64; o <<= 1) v += __shfl_xor(v, o);
    return v;
}
__device__ __forceinline__ float wave_max(float v) {
#pragma unroll
    for (int o = 1; o < 64; o <<= 1) v = fmaxf(v, __shfl_xor(v, o));
    return v;
}
__device__ __forceinline__ float silu_f(float g) { return g * __builtin_amdgcn_rcpf(1.f + __expf(-g)); }
__device__ __forceinline__ float sigmoid_f(float g) { return __builtin_amdgcn_rcpf(1.f + __expf(-g)); }
namespace pg8 {
constexpr int BM = 256, BK = 64, HALF = 128, HTB = HALF * BK * 2  , STAGE_BYTES = 8 * HTB, NXCD = 8, WGM = 8;
__host__ __device__ __forceinline__ int lds_byte(int r, int c) { const int st = (r >> 4) * 2 + (c >> 5), rr = r & 15, cc = c & 31, ob = rr * 64 + cc * 2; return st * 1024 + (ob ^ (((ob >> 9) & 1) << 5)); }
__host__ __device__ __forceinline__ void stage_rc(int b, int& R, int& C) { const int st = b / 1024, sb = b % 1024, swz = sb ^ (((sb >> 9) & 1) << 5); R = (st >> 1) * 16 + swz / 64; C = (st & 1) * 32 + (swz % 64) / 2; }
__host__ __device__ __forceinline__ int perm32(int rho) { const int n = rho >> 4, i = rho & 15; return 8 * (i >> 2) + 4 * n + (i & 3); }

struct Unit { int pm, pn; };
struct Gemm { const bf16_t* A; const bf16_t* Bt; int M, N, K, lda, apn; };

struct StaticOrder {
    int nM, nN, nwg, G, c, i0, nmax;
    int give_lo;
    __host__ __device__ void init(int M, int N, int G_, int c_) { nM = M / BM; nN = N / BM; nwg = nM * nN; G = G_; c = c_; i0 = 0; nmax = 1 << 30; give_lo = -1; }
    __host__ __device__ bool next(int i, Unit& u) const {
        if (i >= nmax) return false;
        long L = (long)(i + i0) * G + c;
        if (give_lo >= 0) { if (c >= give_lo && c < give_lo + 32 && i == 1) return false; if (c >= give_lo + 32 && c < give_lo + 64 && i == 2) L = (long)G + (c - 32); }
        if (L >= nwg) return false;
        int wgid = (int)L; { const int q = nwg / NXCD, r = nwg % NXCD, xcd = wgid % NXCD, off = wgid / NXCD; wgid = (xcd < r ? xcd * (q + 1) : r * (q + 1) + (xcd - r) * q) + off; }
        const int nig = WGM * nN, gid = wgid / nig, fm = gid * WGM, gsz = (nM - fm) < WGM ? (nM - fm) : WGM;
        u.pm = fm + ((wgid % nig) % gsz); u.pn = (wgid % nig) / gsz; return true;
    }
};

__device__ __forceinline__ void rope8(float (&v)[8], const float2* rp) {
#pragma unroll
    for (int j = 0; j < 4; ++j) { const float2 cs = rp[j]; const float x1 = v[2 * j], x2 = v[2 * j + 1]; v[2 * j] = x1 * cs.x - x2 * cs.y; v[2 * j + 1] = x1 * cs.y + x2 * cs.x; }
}
struct Epi {
    bf16_t* out; int ldc; int ncols;
    bf16_t* out2; int ldc2; int split;
    const float* rs; int rs_mode; float rs_invdim;
    float* ssqA; float* ssqB; int ssq_mode;
    const float2* rope; int rope_mode;
    int hm_mode;
    int after; const float* fbase; float* fout; const float* fgain; unsigned* xslots; unsigned* xcnt; unsigned* xtmo;
    __device__ __forceinline__ void fused(const f32x4 (&acc)[2][2][4][2], const Unit& u, int wr, int wc, int fr, int fq, LAS unsigned char* lds, int wid, int lane) const {
        LAS float* Pp = (LAS float*)lds;
        LAS float* Sr = (LAS float*)(lds + 4096);
        LAS unsigned* flag = (LAS unsigned*)(lds + 4096 + 1024);
#pragma unroll
        for (int ai = 0; ai < 2; ++ai)
#pragma unroll
            for (int m = 0; m < 4; ++m) { float s = 0.f;
#pragma unroll
                for (int bj = 0; bj < 2; ++bj)
#pragma unroll
                    for (int n = 0; n < 2; ++n) { const f32x4 x = acc[ai][bj][m][n]; s += (x[0] * x[0] + x[1] * x[1]) + (x[2] * x[2] + x[3] * x[3]); }
                s += __shfl_xor(s, 16); s += __shfl_xor(s, 32);
                if (fq == 0) Pp[(ai * HALF + wr * 64 + m * 16 + fr) * 4 + wc] = s; }
        asm volatile("s_waitcnt lgkmcnt(0)" ::: "memory"); __builtin_amdgcn_s_barrier(); asm volatile("" ::: "memory");
        const int row = wid * 32 + (lane & 31);
        if (lane < 32) { const float t = (Pp[row * 4 + 0] + Pp[row * 4 + 1]) + (Pp[row * 4 + 2] + Pp[row * 4 + 3]);
            __hip_atomic_store(xslots + ((size_t)(u.pm * BM + row) * 4 + u.pn), __float_as_uint(t), __ATOMIC_RELAXED, __HIP_MEMORY_SCOPE_AGENT); }
        asm volatile("s_waitcnt vmcnt(0)" ::: "memory");
        if (lane == 0) __hip_atomic_fetch_add(xcnt + 64 * u.pm, 1u, __ATOMIC_RELAXED, __HIP_MEMORY_SCOPE_AGENT);
        if (wid == 0) { bool dead = false; const unsigned long long t0 = __builtin_amdgcn_s_memrealtime();
            for (;;) {
                if ((unsigned)__builtin_amdgcn_readfirstlane(__hip_atomic_load(xcnt + 64 * u.pm, __ATOMIC_RELAXED, __HIP_MEMORY_SCOPE_AGENT)) >= 32u) break;
                if (__builtin_amdgcn_s_memrealtime() - t0 > 2000000ull) { if (lane == 0) __hip_atomic_store(xtmo, 1u, __ATOMIC_RELAXED, __HIP_MEMORY_SCOPE_AGENT); dead = true; break; }
                __builtin_amdgcn_s_sleep(2); }
            __builtin_amdgcn_fence(__ATOMIC_ACQUIRE, "agent");
            if (lane == 0) flag[0] = dead ? 1u : 0u; }
        asm volatile("s_waitcnt vmcnt(0) lgkmcnt(0)" ::: "memory"); __builtin_amdgcn_s_barrier(); asm volatile("" ::: "memory");
        const bool bad = flag[0] != 0u;
        if (lane < 32) { const unsigned* sl = xslots + (size_t)(u.pm * BM + row) * 4; float q = 0.f;
#pragma unroll
            for (int t = 0; t < 4; ++t) q += __uint_as_float(__hip_atomic_load(sl + t, __ATOMIC_RELAXED, __HIP_MEMORY_SCOPE_AGENT));
            Sr[row] = rsqrtf(q * (1.f / 1024.f) + EPS); }
        asm volatile("s_waitcnt vmcnt(0) lgkmcnt(0)" ::: "memory"); __builtin_amdgcn_s_barrier(); asm volatile("" ::: "memory");
        const float qnan = __builtin_nanf("");
#pragma unroll
        for (int ai = 0; ai < 2; ++ai)
#pragma unroll
            for (int m = 0; m < 4; ++m) { const int r = ai * HALF + wr * 64 + m * 16 + fr; const float rs_ = bad ? qnan : Sr[r];
#pragma unroll
                for (int bj = 0; bj < 2; ++bj) { const int col0 = u.pn * BM + bj * HALF + wc * 32 + 8 * fq; const size_t off = (size_t)(u.pm * BM + r) * 1024 + col0;
                    *(f32x4*)(fout + off) = *(const f32x4*)(fbase + off) + acc[ai][bj][m][0] * rs_ * *(const f32x4*)(fgain + col0);
                    *(f32x4*)(fout + off + 4) = *(const f32x4*)(fbase + off + 4) + acc[ai][bj][m][1] * rs_ * *(const f32x4*)(fgain + col0 + 4); } }
        asm volatile("s_waitcnt lgkmcnt(0)" ::: "memory"); __builtin_amdgcn_s_barrier(); asm volatile("" ::: "memory");
    }
    __device__ __forceinline__ void operator()(const f32x4 (&acc)[2][2][4][2], const Unit& u, int wr, int wc, int fr, int fq) const {
#pragma unroll
        for (int ai = 0; ai < 2; ++ai)
#pragma unroll
            for (int m = 0; m < 4; ++m) {
                const int row = u.pm * BM + ai * HALF + wr * 64 + m * 16 + fr;
                float sc = 1.f;
                if (rs_mode == 1) sc = rs[row]; else if (rs_mode == 2) sc = rsqrtf(rs[row] * rs_invdim + EPS);
                float ss = 0.f;
#pragma unroll
                for (int bj = 0; bj < 2; ++bj) {
                    const int col0 = u.pn * BM + bj * HALF + wc * 32 + 8 * fq;
                    float v[8];
#pragma unroll
                    for (int j = 0; j < 4; ++j) { v[j] = acc[ai][bj][m][0][j] * sc; v[4 + j] = acc[ai][bj][m][1][j] * sc; }
                    if (ssq_mode == 1 && (u.pn < 2 || (u.pn == 2 && bj == 0))) {
#pragma unroll
                        for (int j = 0; j < 8; ++j) ss += v[j] * v[j];
                    }
                    if (rope_mode == 1) { if (col0 >= 640 && col0 < 704) rope8(v, rope + (size_t)row * 32 + ((col0 - 640) >> 1)); }
                    else if (rope_mode == 2) { const int d = col0 % 192; if (d >= 128) rope8(v, rope + (size_t)row * 32 + ((d - 128) >> 1)); }
                    if (col0 < ncols) {
                        u32x4 w; w.x = cvt_pk_bf16(v[0], v[1]); w.y = cvt_pk_bf16(v[2], v[3]); w.z = cvt_pk_bf16(v[4], v[5]); w.w = cvt_pk_bf16(v[6], v[7]);
                        if (hm_mode) { const int hh = col0 / 192, jj = col0 - hh * 192; *(u32x4*)(out + ((size_t)((row >> 12) * 4 + hh) * SEQ + (row & (SEQ - 1))) * 192 + jj) = w; }
                        else if (col0 < split) *(u32x4*)(out + (size_t)row * ldc + col0) = w;
                        else *(u32x4*)(out2 + (size_t)row * ldc2 + (col0 - split)) = w;
                    }
                }
                if (ssq_mode == 1 && u.pn <= 2) {
                    ss += __shfl_xor(ss, 16); ss += __shfl_xor(ss, 32);
                    if (fq == 0) atomicAdd((u.pn == 0 ? ssqB : ssqA) + row, ss);
                }
            }
    }
};

template <bool ALIGN_EPI>
__device__ __forceinline__ void gemm_phase(LAS unsigned char* lds, const Gemm g, const StaticOrder& S, const Epi& E, const int tid) {
    const int wid = __builtin_amdgcn_readfirstlane(tid >> 6), lane = tid & 63, wr = wid >> 2, wc = wid & 3, fr = lane & 15, fq = lane >> 4;
    const int K = g.K, nt = K / BK, lda = g.lda;
    unsigned voffA[2], voffB[2];
#pragma unroll
    for (int i = 0; i < 2; ++i) { int R, C; stage_rc(tid * 16 + i * 8192, R, C); const int Rb = (R & ~31) + perm32(R & 31);
        voffA[i] = (unsigned)(R * lda + C) * 2u; voffB[i] = (unsigned)(Rb * K + C) * 2u; }
    const size_t kstep = (size_t)(BK * 2);
    const size_t hstepA = (size_t)HALF * lda * 2, hstepB = (size_t)HALF * K * 2;
    const size_t tstepA = 2 * hstepA, tstepB = 2 * hstepB;
    const unsigned ldsw = (unsigned)wid * 1024u;
    const int aoff = lds_byte(wr * 64 + fr, fq * 8), boff = lds_byte(wc * 32 + fr, fq * 8);
#define PG8_SA(b, h) (((b) * 2 + (h)) * HTB)
#define PG8_SB(b, h) ((4 + (b) * 2 + (h)) * HTB)
#define PG8_STAGE(bufoff, gbase, voff) do { _Pragma("unroll") for (int _i = 0; _i < 2; ++_i) \
        __builtin_amdgcn_global_load_lds((const unsigned*)((const char*)(gbase) + (voff)[_i]), (LAS unsigned*)(lds + (bufoff) + ldsw + _i * 8192), 16, 0, 0); } while (0)
#define PG8_LDA(dst, b, h) do { _Pragma("unroll") for (int m = 0; m < 4; ++m) _Pragma("unroll") for (int k = 0; k < 2; ++k) dst[m][k] = *(const LAS bf16x8*)(lds + PG8_SA(b, h) + aoff + m * 2048 + k * 1024); } while (0)
#define PG8_LDB(dst, b, h) do { _Pragma("unroll") for (int n = 0; n < 2; ++n) _Pragma("unroll") for (int k = 0; k < 2; ++k) dst[n][k] = *(const LAS bf16x8*)(lds + PG8_SB(b, h) + boff + n * 2048 + k * 1024); } while (0)
#define PG8_MMA(ai, bj, At, Bt) do { __builtin_amdgcn_s_setprio(1); _Pragma("unroll") for (int m = 0; m < 4; ++m) _Pragma("unroll") for (int n = 0; n < 2; ++n) _Pragma("unroll") for (int k = 0; k < 2; ++k) \
        acc[ai][bj][m][n] = __builtin_amdgcn_mfma_f32_16x16x32_bf16(Bt[n][k], At[m][k], acc[ai][bj][m][n], 0, 0, 0); __builtin_amdgcn_s_setprio(0); } while (0)
#define PG8_WAIT_V(n) asm volatile("s_waitcnt vmcnt(" #n ")" ::: "memory")
#define PG8_WAIT_L(n) asm volatile("s_waitcnt lgkmcnt(" #n ")" ::: "memory")
#define PG8_BAR __builtin_amdgcn_s_barrier()
#define PG8_SCHED __builtin_amdgcn_sched_barrier(0)
    Unit cur, nxt; int ui = 0;
    if (!S.next(0, cur)) return;
    f32x4 acc[2][2][4][2];
#pragma unroll
    for (int a = 0; a < 2; ++a)
#pragma unroll
        for (int b = 0; b < 2; ++b)
#pragma unroll
            for (int m = 0; m < 4; ++m)
#pragma unroll
                for (int n = 0; n < 2; ++n) acc[a][b][m][n] = (f32x4){0.f, 0.f, 0.f, 0.f};
    bf16x8 At[4][2], B0[2][2], B1[2][2];
    const char* cA = (const char*)g.A + (size_t)cur.pm * tstepA + (size_t)cur.pn * g.apn * 2; const char* cB = (const char*)g.Bt + (size_t)cur.pn * tstepB;
    PG8_STAGE(PG8_SB(0, 0), cB, voffB); PG8_STAGE(PG8_SB(0, 1), cB + hstepB, voffB); PG8_STAGE(PG8_SA(0, 0), cA, voffA); PG8_STAGE(PG8_SA(0, 1), cA + hstepA, voffA);
    if (wr == 1) PG8_BAR;
    PG8_WAIT_V(2); PG8_BAR;
    PG8_STAGE(PG8_SB(1, 0), cB + kstep, voffB); PG8_STAGE(PG8_SA(1, 0), cA + kstep, voffA); PG8_STAGE(PG8_SB(1, 1), cB + hstepB + kstep, voffB);
    PG8_WAIT_V(6); PG8_BAR;
    for (;;) {
        const bool has_next = S.next(ui + 1, nxt);
        const char* nA = has_next ? (const char*)g.A + (size_t)nxt.pm * tstepA + (size_t)nxt.pn * g.apn * 2 : cA; const char* nB = has_next ? (const char*)g.Bt + (size_t)nxt.pn * tstepB : cB;
        for (int t = 0; t < nt; t += 2) {
            const bool last = (t == nt - 2);
            const char* a1 = cA + (size_t)(t + 1) * kstep;
            const char* a2 = last ? nA : cA + (size_t)(t + 2) * kstep; const char* b2 = last ? nB : cB + (size_t)(t + 2) * kstep;
            const char* a3 = a2 + kstep; const char* b3 = b2 + kstep;
            PG8_LDB(B0, 0, 0); PG8_LDB(B1, 0, 1); PG8_SCHED; PG8_LDA(At, 0, 0); PG8_STAGE(PG8_SA(1, 1), a1 + hstepA, voffA);
            PG8_WAIT_V(8); PG8_WAIT_L(0); PG8_BAR; PG8_MMA(0, 0, At, B0); PG8_MMA(0, 1, At, B1); PG8_BAR; PG8_SCHED;
            PG8_LDA(At, 0, 1); PG8_STAGE(PG8_SB(0, 0), b2, voffB); PG8_STAGE(PG8_SB(0, 1), b2 + hstepB, voffB); PG8_STAGE(PG8_SA(0, 0), a2, voffA);
            PG8_WAIT_V(8); PG8_WAIT_L(0); PG8_BAR; PG8_MMA(1, 0, At, B0); PG8_MMA(1, 1, At, B1); PG8_BAR; PG8_SCHED;
            PG8_LDB(B0, 1, 0); PG8_LDB(B1, 1, 1); PG8_SCHED; PG8_LDA(At, 1, 0); PG8_STAGE(PG8_SA(0, 1), a2 + hstepA, voffA);
            PG8_WAIT_V(8); PG8_WAIT_L(0); PG8_BAR; PG8_MMA(0, 0, At, B0); PG8_MMA(0, 1, At, B1); PG8_BAR; PG8_SCHED;
            PG8_LDA(At, 1, 1); PG8_STAGE(PG8_SB(1, 0), b3, voffB); PG8_STAGE(PG8_SB(1, 1), b3 + hstepB, voffB); PG8_STAGE(PG8_SA(1, 0), a3, voffA);
            PG8_WAIT_V(8); PG8_WAIT_L(0); PG8_BAR; PG8_MMA(1, 0, At, B0); PG8_MMA(1, 1, At, B1); PG8_BAR; PG8_SCHED;
        }
        if constexpr (ALIGN_EPI) { if (wr == 0) PG8_BAR; }
#ifdef FUSED_FINAL
        if (!E.after) E(acc, cur, wr, wc, fr, fq);
#else
        E(acc, cur, wr, wc, fr, fq);
#endif
        if (!has_next) break;
#pragma unroll
        for (int a = 0; a < 2; ++a)
#pragma unroll
            for (int b = 0; b < 2; ++b)
#pragma unroll
                for (int m = 0; m < 4; ++m)
#pragma unroll
                    for (int n = 0; n < 2; ++n) acc[a][b][m][n] = (f32x4){0.f, 0.f, 0.f, 0.f};
        cur = nxt; cA = nA; cB = nB; ++ui;
        if constexpr (ALIGN_EPI) { if (wr == 1) PG8_BAR; }
    }
    PG8_WAIT_V(0);
    if constexpr (!ALIGN_EPI) { if (wr == 0) PG8_BAR; }
    PG8_BAR;
#ifdef FUSED_FINAL
    if (E.after) E.fused(acc, cur, wr, wc, fr, fq, lds, wid, lane);
#endif
#undef PG8_SA
#undef PG8_SB
#undef PG8_STAGE
#undef PG8_LDA
#undef PG8_LDB
#undef PG8_MMA
#undef PG8_WAIT_V
#undef PG8_WAIT_L
#undef PG8_BAR
#undef PG8_SCHED
}
}
namespace att {
#define SBAR() __builtin_amdgcn_sched_barrier(0)
__device__ __forceinline__ int crow(int r, int hi) { return (r & 3) + 8 * (r >> 2) + 4 * hi; }
template <int DQK> __device__ __forceinline__ int kaddr(int row, int c) { return row * (DQK * 2) + ((c ^ ((row >> 1) & 7)) << 4); }
template <int NCB> __device__ __forceinline__ int v_st(int k, int c) { const int kk = (k & ~0xC) | ((k & 4) << 1) | ((k & 8) >> 1); return ((kk >> 3) * NCB + (c >> 5)) * 512 + ((kk & 7) * 32 + (c & 31)) * 2; }
__device__ __forceinline__ int v_rd_base(int lane) { return ((lane & 3) << 3) | (((lane >> 2) & 3) << 6) | (((lane >> 4) & 1) << 5) | (((lane >> 5) & 1) << 8); }

__device__ __forceinline__ void mask_tile(f32x16& p0, f32x16& p1, int dq) {
    const float NEG = -__builtin_inff();
#pragma unroll
    for (int r = 0; r < 16; ++r) {
        const int c = (r & 3) + 8 * (r >> 2);
        if (dq - c < 0) p0[r] = NEG;
        if (dq - c - 32 < 0) p1[r] = NEG;
    }
}
constexpr float DEFER_THR = 8.f;
template <bool FIRST>
__device__ __forceinline__ void partialSM(f32x16& p0, f32x16& p1, float& m_reg, float& alpha) {
    float pmax = p0[0];
#pragma unroll
    for (int r = 1; r < 16; ++r) pmax = fmaxf(pmax, p0[r]);
#pragma unroll
    for (int r = 0; r < 16; ++r) pmax = fmaxf(pmax, p1[r]);
    { auto rr = __builtin_amdgcn_permlane32_swap(__float_as_uint(pmax), __float_as_uint(pmax), false, false);
      pmax = fmaxf(__uint_as_float(rr[0]), __uint_as_float(rr[1])); }
    alpha = 1.f;
    if (FIRST || !__all(pmax <= DEFER_THR)) {
        const float dl = FIRST ? pmax : fmaxf(pmax, 0.f);
        m_reg += dl; alpha = __builtin_amdgcn_exp2f(-dl);
#pragma unroll
        for (int r = 0; r < 16; ++r) { p0[r] -= dl; p1[r] -= dl; }
    }
#pragma unroll
    for (int r = 0; r < 16; ++r) p0[r] = __builtin_amdgcn_exp2f(p0[r]);
}
__device__ __forceinline__ void finishSM(f32x16& p0, f32x16& p1, float alpha, float& l_reg, bf16x8& pa0, bf16x8& pa1, bf16x8& pa2, bf16x8& pa3) {
#pragma unroll
    for (int r = 0; r < 16; ++r) p1[r] = __builtin_amdgcn_exp2f(p1[r]);
    float ps = 0.f;
#pragma unroll
    for (int r = 0; r < 16; ++r) ps += p0[r];
#pragma unroll
    for (int r = 0; r < 16; ++r) ps += p1[r];
    { auto rr = __builtin_amdgcn_permlane32_swap(__float_as_uint(ps), __float_as_uint(ps), false, false);
      ps = __uint_as_float(rr[0]) + __uint_as_float(rr[1]); }
    l_reg = l_reg * alpha + ps;
#define PK4(P, B_, OUT) do { unsigned a0 = cvt_pk_bf16(P[B_+0], P[B_+1]), a1 = cvt_pk_bf16(P[B_+2], P[B_+3]);                          \
        unsigned b0 = cvt_pk_bf16(P[B_+4], P[B_+5]), b1 = cvt_pk_bf16(P[B_+6], P[B_+7]);                                             \
        auto r0 = __builtin_amdgcn_permlane32_swap(a0, b0, false, false); auto r1 = __builtin_amdgcn_permlane32_swap(a1, b1, false, false); \
        u32x4 w = {r0[0], r1[0], r0[1], r1[1]}; OUT = *reinterpret_cast<bf16x8*>(&w); } while (0)
    PK4(p0, 0, pa0); PK4(p0, 8, pa1); PK4(p1, 0, pa2); PK4(p1, 8, pa3);
#undef PK4
}
template <int DQK, bool NOLDS = false>
__device__ __forceinline__ void qkt(f32x16& p0, f32x16& p1, const LAS unsigned char* Kb, int r32, int hi, const bf16x8* qr, const float negm) {
    constexpr int NKS = DQK / 16, ROWB = DQK * 2;
#pragma unroll
    for (int r = 0; r < 16; ++r) { p0[r] = negm; p1[r] = negm; }
    if (NOLDS) {
#pragma unroll
        for (int d0 = 0; d0 < NKS; ++d0) { p0 = __builtin_amdgcn_mfma_f32_32x32x16_bf16(qr[(d0 + 1) % NKS], qr[d0], p0, 0, 0, 0); p1 = __builtin_amdgcn_mfma_f32_32x32x16_bf16(qr[(d0 + 2) % NKS], qr[d0], p1, 0, 0, 0); }
        return; }
    const int f = (r32 >> 1) & 7;
    const LAS unsigned char* kb[4];
#pragma unroll
    for (int dd = 0; dd < 4; ++dd) kb[dd] = Kb + r32 * ROWB + ((((2 * dd + hi) ^ f)) << 4);
#pragma unroll
    for (int d0 = 0; d0 < NKS; ++d0) { const LAS unsigned char* a_ = kb[d0 & 3] + (d0 >> 2) * 128;
        const bf16x8 b0 = *reinterpret_cast<const LAS bf16x8*>(a_);
        const bf16x8 b1 = *reinterpret_cast<const LAS bf16x8*>(a_ + 32 * ROWB);
        p0 = __builtin_amdgcn_mfma_f32_32x32x16_bf16(b0, qr[d0], p0, 0, 0, 0);
        p1 = __builtin_amdgcn_mfma_f32_32x32x16_bf16(b1, qr[d0], p1, 0, 0, 0); }
}
template <int DQK> __device__ __forceinline__ void qkt_sched() {
    constexpr int NKS = DQK / 16;
    __builtin_amdgcn_sched_group_barrier(0x100, 4, 0);
#pragma unroll
    for (int d0 = 0; d0 < NKS; ++d0) {
        __builtin_amdgcn_sched_group_barrier(0x008, 2, 0);
        __builtin_amdgcn_sched_group_barrier(0x002, 120 / NKS, 0);
        if (d0 + 2 < NKS) __builtin_amdgcn_sched_group_barrier(0x100, 2, 0);
    }
}
template <int DV>
__device__ __forceinline__ void pv_tile(f32x16* o, int vb0, bf16x8 pa0, bf16x8 pa1, bf16x8 pa2, bf16x8 pa3) {
    constexpr int NCB = DV / 32, KS = 2 * NCB * 512, HF = NCB * 512;
#define TRRD(dst, off) asm volatile("ds_read_b64_tr_b16 %0, %1 offset:%2" : "=&v"(dst) : "v"(vb0), "i"(off) : "memory")
#pragma unroll
    for (int d0 = 0; d0 < NCB; ++d0) {
        s16x4 l0, l1, l2, l3, h0, h1, h2, h3;
        if (d0 == 0) { TRRD(l0, 0 * 512); TRRD(h0, 0 * 512 + HF); TRRD(l1, 0 * 512 + KS); TRRD(h1, 0 * 512 + KS + HF); TRRD(l2, 0 * 512 + 2 * KS); TRRD(h2, 0 * 512 + 2 * KS + HF); TRRD(l3, 0 * 512 + 3 * KS); TRRD(h3, 0 * 512 + 3 * KS + HF); }
        else if (d0 == 1) { TRRD(l0, 1 * 512); TRRD(h0, 1 * 512 + HF); TRRD(l1, 1 * 512 + KS); TRRD(h1, 1 * 512 + KS + HF); TRRD(l2, 1 * 512 + 2 * KS); TRRD(h2, 1 * 512 + 2 * KS + HF); TRRD(l3, 1 * 512 + 3 * KS); TRRD(h3, 1 * 512 + 3 * KS + HF); }
        else if (d0 == 2) { TRRD(l0, 2 * 512); TRRD(h0, 2 * 512 + HF); TRRD(l1, 2 * 512 + KS); TRRD(h1, 2 * 512 + KS + HF); TRRD(l2, 2 * 512 + 2 * KS); TRRD(h2, 2 * 512 + 2 * KS + HF); TRRD(l3, 2 * 512 + 3 * KS); TRRD(h3, 2 * 512 + 3 * KS + HF); }
        else { TRRD(l0, 3 * 512); TRRD(h0, 3 * 512 + HF); TRRD(l1, 3 * 512 + KS); TRRD(h1, 3 * 512 + KS + HF); TRRD(l2, 3 * 512 + 2 * KS); TRRD(h2, 3 * 512 + 2 * KS + HF); TRRD(l3, 3 * 512 + 3 * KS); TRRD(h3, 3 * 512 + 3 * KS + HF); }
        asm volatile("s_waitcnt lgkmcnt(0)" ::: "memory"); SBAR();
        o[d0] = __builtin_amdgcn_mfma_f32_32x32x16_bf16(pa0, (bf16x8){l0[0], l0[1], l0[2], l0[3], h0[0], h0[1], h0[2], h0[3]}, o[d0], 0, 0, 0);
        o[d0] = __builtin_amdgcn_mfma_f32_32x32x16_bf16(pa1, (bf16x8){l1[0], l1[1], l1[2], l1[3], h1[0], h1[1], h1[2], h1[3]}, o[d0], 0, 0, 0);
        o[d0] = __builtin_amdgcn_mfma_f32_32x32x16_bf16(pa2, (bf16x8){l2[0], l2[1], l2[2], l2[3], h2[0], h2[1], h2[2], h2[3]}, o[d0], 0, 0, 0);
        o[d0] = __builtin_amdgcn_mfma_f32_32x32x16_bf16(pa3, (bf16x8){l3[0], l3[1], l3[2], l3[3], h3[0], h3[1], h3[2], h3[3]}, o[d0], 0, 0, 0);
    }
#undef TRRD
}

template <int DQK, int DV, bool CAUSAL, int ABL = 0>
__device__ __forceinline__ void attn_unit(const bf16_t* Qb, int qp, const bf16_t* Km, int kp, int c1, const bf16_t* Ke, int kep, const bf16_t* Vb, int vp,
                                          int NT, int q0, const bf16_t* gate, int gp, bf16_t* Y, int yp, LAS unsigned char* lds, const int tid) {
    constexpr int SHM_V = 64 * DV * 2, SHM_K = 64 * DQK * 2, NCK = DQK / 8, NKS = DQK / 16, NCB = DV / 32;
    constexpr int KPT = SHM_K / 8192, VPT = SHM_V / 8192;
    const int wid = __builtin_amdgcn_readfirstlane(tid >> 6), lane = tid & 63, r32 = lane & 31, hi = lane >> 5;
    LAS unsigned char* V_lds = lds; LAS unsigned char* K_lds = lds + 3 * SHM_V; LAS float* ws = (LAS float*)(lds + 3 * SHM_V + 3 * SHM_K) + wid * 64;
    bf16x8 qr[NKS];
#pragma unroll
    for (int d0 = 0; d0 < NKS; ++d0) qr[d0] = *reinterpret_cast<const bf16x8*>(Qb + (size_t)(wid * 32 + r32) * qp + d0 * 16 + hi * 8);
    const char* kbase = (const char*)(Km < Ke ? Km : Ke);
    unsigned koff[KPT]; unsigned kstr[KPT];
#pragma unroll
    for (int i = 0; i < KPT; ++i) { const int p = (wid + 8 * i) * 64 + lane, row = p / NCK, cpos = p % NCK, c = cpos ^ ((row >> 1) & 7);
        if (c < c1) { koff[i] = (unsigned)((const char*)(Km + (size_t)row * kp + c * 8) - kbase); kstr[i] = (unsigned)kp * 128u; }
        else { koff[i] = (unsigned)((const char*)(Ke + (size_t)row * kep + (c - c1) * 8) - kbase); kstr[i] = (unsigned)kep * 128u; } }
    unsigned voff[VPT];
#pragma unroll
    for (int i = 0; i < VPT; ++i) { const int st = 2 * (wid + 8 * i) + (lane >> 5), kk = (st / NCB) * 8 + ((lane & 31) >> 2), k = (kk & ~0xC) | ((kk & 4) << 1) | ((kk & 8) >> 1), col = (st % NCB) * 32 + (lane & 3) * 8;
        voff[i] = (unsigned)(k * vp + col) * 2u; }
    const char* vbase = (const char*)Vb;
    float m_reg = 0.f, l_reg = 0.f; f32x16 o[NCB];
#pragma unroll
    for (int d = 0; d < NCB; ++d) o[d] = f32x16{};
    const int vb0 = (int)(size_t)V_lds + v_rd_base(lane);
    const int qlo = q0 + wid * 32;
#define DMA_K(sl) do { _Pragma("unroll") for (int i = 0; i < KPT; ++i) { __builtin_amdgcn_global_load_lds((const unsigned*)(kbase + koff[i]), (LAS unsigned*)(K_lds + (sl) * SHM_K + (wid + 8 * i) * 1024), 16, 0, 0); koff[i] += kstr[i]; } } while (0)
#define DMA_V(sl) do { _Pragma("unroll") for (int i = 0; i < VPT; ++i) { __builtin_amdgcn_global_load_lds((const unsigned*)(vbase + voff[i]), (LAS unsigned*)(V_lds + (sl) * SHM_V + (wid + 8 * i) * 1024), 16, 0, 0); } vbase += (size_t)vp * 128; } while (0)
#define WAIT_BAR(N) do { asm volatile("s_waitcnt vmcnt(%0) lgkmcnt(0)\n\ts_barrier" :: "i"(N) : "memory"); } while (0)
#define MASKT(P0_, P1_, t) do { if (CAUSAL) { const int kb_ = (t) * 64; if (kb_ + 63 > qlo) mask_tile(P0_, P1_, qlo + r32 - 4 * hi - kb_); } } while (0)
#define RESC(a) do { if (__any((a) < 1.f)) { if (hi == 0) ws[r32] = (a); asm volatile("s_waitcnt lgkmcnt(0)" ::: "memory"); \
        _Pragma("unroll") for (int d_ = 0; d_ < NCB; ++d_) _Pragma("unroll") for (int r = 0; r < 16; ++r) o[d_][r] *= ws[crow(r, hi)]; } } while (0)
    f32x16 pA0, pA1, pB0, pB1; float alA = 1.f, alB = 1.f; bf16x8 pa0, pa1, pa2, pa3;
    DMA_K(0); DMA_K(1); DMA_V(0);
    WAIT_BAR(KPT + VPT);
    DMA_K(2); DMA_V(1);
    qkt<DQK>(pA0, pA1, K_lds, r32, hi, qr, 0.f);
    MASKT(pA0, pA1, 0); partialSM<true>(pA0, pA1, m_reg, alA); alA = 1.f;
    WAIT_BAR(KPT + VPT);
    int ks = 1, vs = 0, ns = 2;
#define ROT() do { vs = ks; ks = ns; ns = (ns == 2) ? 0 : ns + 1; } while (0)
#define STEP(PX0, PX1, alX, PY0, PY1, alY, t, NW) do { \
        if (!(ABL & 1)) { if ((t) + 2 < NT) DMA_K(vs); if ((t) + 1 < NT) DMA_V(ns); } \
        SBAR(); if (!(ABL & 8)) qkt<DQK, (ABL & 32) != 0>(PX0, PX1, K_lds + ks * SHM_K, r32, hi, qr, -m_reg); else { asm volatile("" : "+v"(PX0), "+v"(PX1)); } \
        if (!(ABL & 2)) finishSM(PY0, PY1, alY, l_reg, pa0, pa1, pa2, pa3); else { asm volatile("" : "+v"(PY0), "+v"(PY1), "+v"(pa0), "+v"(pa1), "+v"(pa2), "+v"(pa3)); } SBAR(); \
        if (!(ABL & 4)) pv_tile<DV>(o, vb0 + vs * SHM_V, pa0, pa1, pa2, pa3); \
        if (!(ABL & 2)) { MASKT(PX0, PX1, t); partialSM<false>(PX0, PX1, m_reg, alX); } \
        if (ABL & 1) WAIT_BAR(0); else WAIT_BAR(NW); \
        RESC(alX); ROT(); } while (0)
    int t = 1;
    for (; t + 3 < NT; t += 2) {
        STEP(pB0, pB1, alB, pA0, pA1, alA, t, KPT + VPT);
        STEP(pA0, pA1, alA, pB0, pB1, alB, t + 1, KPT + VPT);
    }
    STEP(pB0, pB1, alB, pA0, pA1, alA, t, KPT + VPT);
    STEP(pA0, pA1, alA, pB0, pB1, alB, t + 1, VPT);
    STEP(pB0, pB1, alB, pA0, pA1, alA, t + 2, 0);
    finishSM(pB0, pB1, alB, l_reg, pa0, pa1, pa2, pa3); SBAR(); pv_tile<DV>(o, vb0 + vs * SHM_V, pa0, pa1, pa2, pa3);
#undef STEP
#undef ROT
#undef RESC
#undef MASKT
#undef WAIT_BAR
#undef DMA_K
#undef DMA_V
    if (hi == 0) ws[32 + r32] = l_reg;
    asm volatile("s_waitcnt lgkmcnt(0)" ::: "memory");
    constexpr int SPITCH = DV * 2 + 16;
    LAS unsigned char* stg = ((DQK == 192) ? K_lds : (lds + 3 * SHM_V + 3 * SHM_K + 2048)) + wid * (32 * SPITCH);
#pragma unroll
    for (int r = 0; r < 16; ++r) {
        const float rl = __builtin_amdgcn_rcpf(ws[32 + crow(r, hi)]);
#pragma unroll
        for (int d0 = 0; d0 < NCB; ++d0) *(LAS unsigned short*)(stg + crow(r, hi) * SPITCH + (d0 * 32 + r32) * 2) = f2bf(o[d0][r] * rl);
    }
    asm volatile("s_waitcnt lgkmcnt(0)" ::: "memory");
    constexpr int CPR = DV / 8, RPP = 64 / CPR;
#pragma unroll
    for (int i = 0; i < 32 / RPP; ++i) {
        const int row = i * RPP + lane / CPR, ch = lane % CPR, orow = wid * 32 + row;
        const u32x4 ov = *(const LAS u32x4*)(stg + row * SPITCH + ch * 16);
        const u32x4 gv = *(const u32x4*)(gate + (size_t)orow * gp + ch * 8);
        u32x4 w;
        w.x = cvt_pk_bf16(bflo(ov.x) * silu_f(bflo(gv.x)), bfhi(ov.x) * silu_f(bfhi(gv.x))); w.y = cvt_pk_bf16(bflo(ov.y) * silu_f(bflo(gv.y)), bfhi(ov.y) * silu_f(bfhi(gv.y)));
        w.z = cvt_pk_bf16(bflo(ov.z) * silu_f(bflo(gv.z)), bfhi(ov.z) * silu_f(bfhi(gv.z))); w.w = cvt_pk_bf16(bflo(ov.w) * silu_f(bflo(gv.w)), bfhi(ov.w) * silu_f(bfhi(gv.w)));
        *(u32x4*)(Y + (size_t)orow * yp + ch * 8) = w;
    }
    __syncthreads();
}
#undef SBAR
}
struct Params {
    const float* x; const float* mem; const int* pos;
    const float *a_pre_g, *a_w_in, *a_q_a_g, *a_w_uq, *a_kv_a_g, *a_w_ukv, *a_mem_g, *a_w_mem_kv, *a_w_out, *a_post_g;
    const float *b_pre_g, *b_w_in, *b_gate_bias, *b_conv_w, *b_conv_b, *b_w_q, *b_w_k, *b_w_v, *b_head_g, *b_skip, *b_mem_g, *b_w_mem_kv, *b_w_out, *b_post_g;
    float* out; unsigned char* ws; int ph_lo, ph_hi;
};
struct Wk { int tid, lane, wave, vcu, G; };
#define LDS_WAIT() asm volatile("s_waitcnt lgkmcnt(0)" ::: "memory")

__device__ __forceinline__ float wsrc(const Params& P, int mat, int k, int n) {
    switch (mat) {
    case 0: { int col; float s = 1.f;
        if (n < 256) col = 384 + n; else if (n < 512) col = n - 256; else if (n < 640) col = 256 + (n - 512);
        else if (n < 704) { const int p_ = n - 640, i = p_ >> 1; col = 640 + ((p_ & 1) ? 32 + i : i); }
        else if (n < 768) return 0.f; else if (n < 1024) { col = 704 + (n - 768); s = MSCALE; } else col = 960 + (n - 1024);
        return P.a_w_in[(size_t)k * A_IN + col] * P.a_pre_g[k] * s; }
    case 1: { if (n >= 1152) return 0.f; const int h = n / 192, d = n % 192; int col;
        if (d < 128) col = h * 192 + d; else { const int p_ = d - 128, i = p_ >> 1; col = h * 192 + 128 + ((p_ & 1) ? 32 + i : i); }
        return P.a_w_uq[(size_t)k * 1152 + col] * P.a_q_a_g[k] * QSCALE; }
    case 2: { int col; if (n < 768) col = (n / 128) * 256 + (n % 128); else { const int n2 = n - 768; col = (n2 / 128) * 256 + 128 + (n2 % 128); }
        return P.a_w_ukv[(size_t)k * 1536 + col] * P.a_kv_a_g[k]; }
    case 3: { if (n < 512) return P.a_w_mem_kv[(size_t)k * 512 + n] * P.a_mem_g[k]; return P.b_w_mem_kv[(size_t)k * 512 + (n - 512)] * P.b_mem_g[k]; }
    case 4: return P.a_w_out[(size_t)k * 1024 + n];
    case 5: { int col; float s = 1.f; if (n < 768) col = n; else if (n < 1536) col = 776 + (n - 768); else if (n < 1792) { col = 1544 + (n - 1536); s = MSCALE; } else col = 1800 + (n - 1792);
        return P.b_w_in[(size_t)k * B_IN + col] * P.b_pre_g[k] * s; }
    case 6: { const int h = n / 192, j = n % 192, pn = n / 256, kabs = k + 192 * pn - 192 * h; if (kabs < 0 || kabs >= 192) return 0.f;
        if (j < 96) return P.b_w_q[((size_t)h * 192 + kabs) * 96 + j]; return P.b_w_k[((size_t)h * 192 + kabs) * 96 + (j - 96)] * KSCALE_B; }
    case 7: { const int h = n / 192, j = n % 192, pn = n / 256, kabs = k + 192 * pn - 192 * h; if (kabs < 0 || kabs >= 192) return 0.f;
        return P.b_w_v[((size_t)h * 192 + kabs) * 192 + j]; }
    default: return P.b_w_out[(size_t)k * 1024 + n];
    }
}
__device__ __forceinline__ void tr_item(const Params& P, int mat, int K, int nblk, bf16_t* WT, LAS float* scr, int item, int lane) {
    const int kb = item / nblk, nb = item % nblk, k0 = 64 * kb, n0 = 32 * nb;
    float tv[32];
#pragma unroll
    for (int i = 0; i < 32; ++i) tv[i] = wsrc(P, mat, k0 + 2 * i + (lane >> 5), n0 + (lane & 31));
#pragma unroll
    for (int i = 0; i < 32; ++i) scr[(2 * i + (lane >> 5)) * 33 + (lane & 31)] = tv[i];
    LDS_WAIT(); asm volatile("" ::: "memory");
    const int c = lane & 7;
#pragma unroll
    for (int j = 0; j < 4; ++j) { const int n = (lane >> 3) + 8 * j; const LAS float* s = scr + (8 * c) * 33 + n;
        u32x4 o; o.x = cvt_pk_bf16(s[0 * 33], s[1 * 33]); o.y = cvt_pk_bf16(s[2 * 33], s[3 * 33]); o.z = cvt_pk_bf16(s[4 * 33], s[5 * 33]); o.w = cvt_pk_bf16(s[6 * 33], s[7 * 33]);
        *(u32x4*)(WT + (size_t)(n0 + n) * K + k0 + 8 * c) = o; }
    LDS_WAIT(); asm volatile("" ::: "memory");
}
__device__ __forceinline__ void row_to_bf16(const float* xrow, bf16_t* orow, float* rstd_out, bool normalise, int lane) {
    const f32x4* xr = (const f32x4*)xrow + lane;
    f32x4 v[4]; float s = 0.f;
#pragma unroll
    for (int j = 0; j < 4; ++j) { v[j] = xr[64 * j]; s += (v[j].x * v[j].x + v[j].y * v[j].y) + (v[j].z * v[j].z + v[j].w * v[j].w); }
    const float rstd = rsqrtf(wave_sum(s) * (1.f / DM) + EPS);
    if (rstd_out && lane == 0) *rstd_out = rstd;
    const float sc = normalise ? rstd : 1.f;
    u32x2* o8 = (u32x2*)orow + lane;
#pragma unroll
    for (int j = 0; j < 4; ++j) { u32x2 w; w.x = cvt_pk_bf16(v[j].x * sc, v[j].y * sc); w.y = cvt_pk_bf16(v[j].z * sc, v[j].w * sc); o8[64 * j] = w; }
}
__device__ __forceinline__ void phase_prologue(const Params& P, const Wk& W, LAS unsigned char* lds) {
    unsigned char* ws = P.ws;
    LAS float* scr = (LAS float*)(lds + W.wave * 8704);
    const int gw = W.vcu * 8 + W.wave, NGW = W.G * 8;
#ifndef PROBE_P0
#define PROBE_P0 0
#endif
    for (int rep_ = 0; rep_ < (PROBE_P0 == 1 ? 2 : 1); ++rep_) {
    int base = 0;
#define DO_MAT(mt, K_, N_, OFF_) do { const int nblk = (N_) / 32, nit = ((K_) / 64) * nblk; \
        int first = gw - (base % NGW); if (first < 0) first += NGW; \
        for (int r = first; r < nit; r += NGW) tr_item(P, mt, K_, nblk, (bf16_t*)(ws + (OFF_)), scr, r, W.lane); \
        base += nit; } while (0)
    DO_MAT(0, 1024, 2048, WS_WINA); DO_MAT(1, 384, 1280, WS_WUQ); DO_MAT(2, 256, 1536, WS_WUKV); DO_MAT(3, 1024, 1024, WS_WMKV); DO_MAT(4, 1024, 1024, WS_WOA);
    DO_MAT(5, 1024, 2816, WS_WINB); DO_MAT(6, 384, 768, WS_WQK); DO_MAT(7, 384, 768, WS_WV); DO_MAT(8, 1024, 1024, WS_WOB);
#undef DO_MAT
    }
    const int gt = (W.vcu * 512 + W.tid), NGT = W.G * 512;
    for (int idx = gt; idx < 8 * 1024; idx += NGT) { const int g = idx >> 10, k = idx & 1023; ((float*)(ws + WS_WG))[idx] = P.b_w_in[(size_t)k * B_IN + 768 + g] * P.b_pre_g[k]; }
    for (int idx = gt; idx < 2 * T; idx += NGT) ((float*)(ws + WS_SSQA))[idx] = 0.f;
    for (int rep_ = 0; rep_ < (PROBE_P0 == 2 ? 2 : 1); ++rep_)
    for (int idx = gt; idx < T * 32; idx += NGT) { const int row = idx >> 5, i = idx & 31;
        const float inv = exp2f(-(float)i * (13.287712379549449f / 32.f));
        const float ang = (float)P.pos[row] * inv;
        double tr = (double)ang * 0.15915494309189535; tr -= floor(tr); const float tf = (float)tr;
        ((float2*)(ws + WS_ROPE))[idx] = make_float2(__builtin_amdgcn_cosf(tf), __builtin_amdgcn_sinf(tf)); }
    for (int rep_ = 0; rep_ < (PROBE_P0 == 3 ? 2 : 1); ++rep_)
    for (int m = gw; m < T; m += 4 * NGW) {
        f32x4 v[4][4]; float s[4];
#pragma unroll
        for (int r = 0; r < 4; ++r) { const f32x4* xr = (const f32x4*)(P.x + (size_t)(m + r * NGW) * DM) + W.lane;
#pragma unroll
            for (int j = 0; j < 4; ++j) v[r][j] = xr[64 * j]; }
#pragma unroll
        for (int r = 0; r < 4; ++r) { float a = 0.f;
#pragma unroll
            for (int j = 0; j < 4; ++j) a += (v[r][j].x * v[r][j].x + v[r][j].y * v[r][j].y) + (v[r][j].z * v[r][j].z + v[r][j].w * v[r][j].w);
            s[r] = wave_sum(a); }
#pragma unroll
        for (int r = 0; r < 4; ++r) { const int mr = m + r * NGW; if (W.lane == 0) ((float*)(ws + WS_RSTD))[mr] = rsqrtf(s[r] * (1.f / DM) + EPS);
            u32x2* o8 = (u32x2*)((bf16_t*)(ws + WS_XB) + (size_t)mr * DM) + W.lane;
#pragma unroll
            for (int j = 0; j < 4; ++j) { u32x2 w; w.x = cvt_pk_bf16(v[r][j].x, v[r][j].y); w.y = cvt_pk_bf16(v[r][j].z, v[r][j].w); o8[64 * j] = w; } }
    }
    for (int m = gw; m < NB * NMEM; m += NGW) row_to_bf16(P.mem + (size_t)m * DM, (bf16_t*)(ws + WS_MEMN) + (size_t)m * DM, nullptr, true, W.lane);
}

__device__ __forceinline__ void phase_rowmid(const Params& P, const Wk& W, LAS unsigned char* lds) {
    unsigned char* ws = P.ws;
    const int gw = W.vcu * 8 + W.wave, NGW = W.G * 8, lane = W.lane;
    const bf16_t* Z = (const bf16_t*)(ws + WS_Z);
    { const int gt_ = W.vcu * 512 + W.tid; if (gt_ < 32 * 192) ((float*)(ws + WS_U0))[gt_] = 0.f; }
    LAS float* Wg = (LAS float*)lds;
    for (int i = W.tid; i < 2048; i += 512) ((LAS f32x4*)Wg)[i] = ((const f32x4*)(ws + WS_WG))[i];
    __syncthreads();
    f32x4 pg[4];
#pragma unroll
    for (int j = 0; j < 4; ++j) pg[j] = ((const f32x4*)P.a_post_g)[lane + 64 * j];
    f32x4 vn[4]; u32x2 zn[4];
    if (gw < T) { const f32x4* xr = (const f32x4*)(P.x + (size_t)gw * DM) + lane; const u32x2* zr = (const u32x2*)(Z + (size_t)gw * DM) + lane;
#pragma unroll
        for (int j = 0; j < 4; ++j) { vn[j] = xr[64 * j]; zn[j] = zr[64 * j]; } }
    for (int m = gw; m < T; m += NGW) {
        f32x4 v[4], z[4]; float s = 0.f;
#pragma unroll
        for (int j = 0; j < 4; ++j) { v[j] = vn[j]; const u32x2 w = zn[j]; z[j] = (f32x4){bflo(w.x), bfhi(w.x), bflo(w.y), bfhi(w.y)};
            s += (z[j].x * z[j].x + z[j].y * z[j].y) + (z[j].z * z[j].z + z[j].w * z[j].w); }
        if (m + NGW < T) { const f32x4* xr = (const f32x4*)(P.x + (size_t)(m + NGW) * DM) + lane; const u32x2* zr = (const u32x2*)(Z + (size_t)(m + NGW) * DM) + lane;
#pragma unroll
            for (int j = 0; j < 4; ++j) { vn[j] = xr[64 * j]; zn[j] = zr[64 * j]; } }
        const float rz = rsqrtf(wave_sum(s) * (1.f / DM) + EPS);
        float s1 = 0.f;
#pragma unroll
        for (int j = 0; j < 4; ++j) { const f32x4 g = pg[j]; v[j] = v[j] + z[j] * rz * g;
            s1 += (v[j].x * v[j].x + v[j].y * v[j].y) + (v[j].z * v[j].z + v[j].w * v[j].w); }
        const float r1 = rsqrtf(wave_sum(s1) * (1.f / DM) + EPS);
        u32x2* o8 = (u32x2*)((bf16_t*)(ws + WS_XB) + (size_t)m * DM) + lane;
#pragma unroll
        for (int j = 0; j < 4; ++j) { u32x2 w; w.x = cvt_pk_bf16(v[j].x, v[j].y); w.y = cvt_pk_bf16(v[j].z, v[j].w); o8[64 * j] = w; }
        if ((m & (SEQ - 1)) == 0) { f32x4* xf = (f32x4*)((float*)(ws + WS_X1F) + (size_t)(m / SEQ) * DM) + lane;
#pragma unroll
            for (int j = 0; j < 4; ++j) xf[64 * j] = v[j]; }
        if (lane == 0) ((float*)(ws + WS_RSTD))[m] = r1;
        float ga[8];
#pragma unroll
        for (int g = 0; g < 8; ++g) { float a = 0.f;
#pragma unroll
            for (int j = 0; j < 4; ++j) { const f32x4 w4 = ((const LAS f32x4*)(Wg + g * 1024))[lane + 64 * j]; a += (v[j].x * w4.x + v[j].y * w4.y) + (v[j].z * w4.z + v[j].w * w4.w); }
            ga[g] = a; }
        float gb[4], gc[2], gd;
        { const bool up = (lane & 32) != 0;
#pragma unroll
          for (int i = 0; i < 4; ++i) { const float snd = up ? ga[i] : ga[4 + i]; const float kp = up ? ga[4 + i] : ga[i]; gb[i] = kp + __shfl_xor(snd, 32); } }
        { const bool up = (lane & 16) != 0;
#pragma unroll
          for (int i = 0; i < 2; ++i) { const float snd = up ? gb[i] : gb[2 + i]; const float kp = up ? gb[2 + i] : gb[i]; gc[i] = kp + __shfl_xor(snd, 16); } }
        { const bool up = (lane & 8) != 0; const float snd = up ? gc[0] : gc[1]; const float kp = up ? gc[1] : gc[0]; gd = kp + __shfl_xor(snd, 8); }
        gd += __shfl_xor(gd, 4); gd += __shfl_xor(gd, 2); gd += __shfl_xor(gd, 1);
        if ((lane & 7) == 0) { const int g = lane >> 3;
            ((float*)(ws + WS_IFP))[(size_t)m * 8 + g] = gd * r1 + P.b_gate_bias[g]; }
    }
}
__device__ __forceinline__ void phase_rowfinal(const Params& P, const Wk& W) {
    unsigned char* ws = P.ws;
    const int gw = W.vcu * 8 + W.wave, NGW = W.G * 8, lane = W.lane;
    const bf16_t* Z = (const bf16_t*)(ws + WS_Z);
    f32x4 pg[4];
#pragma unroll
    for (int j = 0; j < 4; ++j) pg[j] = ((const f32x4*)P.b_post_g)[lane + 64 * j];
    u32x2 vn[4], zn[4];
    const bf16_t* X1 = (const bf16_t*)(ws + WS_XB);
    if (gw < T) { const u32x2* xr = (const u32x2*)(X1 + (size_t)gw * DM) + lane; const u32x2* zr = (const u32x2*)(Z + (size_t)gw * DM) + lane;
#pragma unroll
        for (int j = 0; j < 4; ++j) { vn[j] = xr[64 * j]; zn[j] = zr[64 * j]; } }
    for (int m = gw; m < T; m += NGW) {
        f32x4* xo = (f32x4*)(P.out + (size_t)m * DM) + lane;
        f32x4 v[4], z[4]; float s = 0.f;
#pragma unroll
        for (int j = 0; j < 4; ++j) { const u32x2 a = vn[j]; v[j] = (f32x4){bflo(a.x), bfhi(a.x), bflo(a.y), bfhi(a.y)}; const u32x2 w = zn[j]; z[j] = (f32x4){bflo(w.x), bfhi(w.x), bflo(w.y), bfhi(w.y)};
            s += (z[j].x * z[j].x + z[j].y * z[j].y) + (z[j].z * z[j].z + z[j].w * z[j].w); }
        if (m + NGW < T) { const u32x2* xr = (const u32x2*)(X1 + (size_t)(m + NGW) * DM) + lane; const u32x2* zr = (const u32x2*)(Z + (size_t)(m + NGW) * DM) + lane;
#pragma unroll
            for (int j = 0; j < 4; ++j) { vn[j] = xr[64 * j]; zn[j] = zr[64 * j]; } }
        const float rz = rsqrtf(wave_sum(s) * (1.f / DM) + EPS);
#pragma unroll
        for (int j = 0; j < 4; ++j) xo[64 * j] = v[j] + z[j] * rz * pg[j];
    }
}
__device__ __forceinline__ void first_token_u0(const Params& P, const Wk& W, LAS unsigned char* lds, int widx) {
    unsigned char* ws = P.ws;
    const int bh = widx >> 2, sl = widx & 3, b = bh >> 2, h = bh & 3, j = W.tid % 192, sub = W.tid / 192; const size_t row = (size_t)b * SEQ;
    LAS float* hs = (LAS float*)lds;
    if (W.tid < 256) hs[W.tid] = ((const float*)(ws + WS_X1F))[(size_t)b * DM + sl * 256 + W.tid] * P.b_pre_g[sl * 256 + W.tid] * ((const float*)(ws + WS_RSTD))[row];
    __syncthreads();
    if (W.tid < 384) {
        const float* wp = P.b_w_in + (size_t)(sl * 256 + sub * 128) * B_IN + h * 192 + j; float a = 0.f;
#pragma unroll 64
        for (int k = 0; k < 128; ++k) a += hs[sub * 128 + k] * wp[(size_t)k * B_IN];
        atomicAdd((float*)(ws + WS_U0) + bh * 192 + j, a); }
    __syncthreads();
}
__device__ __forceinline__ void first_token_qk(const Params& P, const Wk& W, LAS unsigned char* lds) {
    unsigned char* ws = P.ws;
    const int first = W.G > 32 ? W.G - 32 : 0, nwk = W.G > 32 ? 32 : W.G;
    if (W.vcu < first) return;
    for (int bh = W.vcu - first; bh < 32; bh += nwk) {
    const int h = bh & 3, tid = W.tid;
    LAS float* uc0 = (LAS float*)lds; LAS float* qk0 = uc0 + 192;
    float wv[96];
    const int o = tid % 192, part = tid / 192, j = o % 96;
    if (tid < 384) { const float* Wm = (o < 96 ? P.b_w_q : P.b_w_k) + (size_t)h * 192 * 96 + (size_t)(part * 96) * 96 + j;
#pragma unroll
        for (int i = 0; i < 96; ++i) wv[i] = Wm[i * 96]; }
    if (tid < 192) { const int col = h * 192 + tid; uc0[tid] = silu_f(P.b_conv_b[col] + P.b_conv_w[3 * 768 + col] * ((const float*)(ws + WS_U0))[bh * 192 + tid]); }
    __syncthreads();
    if (tid < 384) { float a = 0.f;
#pragma unroll
        for (int i = 0; i < 96; ++i) a += uc0[part * 96 + i] * wv[i];
        qk0[part * 192 + o] = a; }
    __syncthreads();
    if (tid < 64) { float a = (qk0[tid] + qk0[192 + tid]) * (qk0[96 + tid] + qk0[288 + tid]); if (tid < 32) a += (qk0[64 + tid] + qk0[256 + tid]) * (qk0[160 + tid] + qk0[352 + tid]);
        a = wave_sum(a); if (tid == 0) ((float*)(ws + WS_C0))[bh] = a * KSCALE_B; }
    __syncthreads();
    }
}
__device__ __forceinline__ void phase_conv(const Params& P, const Wk& W) {
    unsigned char* ws = P.ws;
    const bf16_t* G2 = (const bf16_t*)(ws + WS_G); bf16_t* UC = (bf16_t*)(ws + WS_UC);
    const int gt = W.vcu * 512 + W.tid, NGT = W.G * 512;
    for (int it = gt; it < (T / 8) * 96; it += NGT) {
        const int rg = it / 96, cc = it % 96, row0 = rg * 8, c0 = cc * 8, s0 = row0 & (SEQ - 1);
        float w[4][8], bsv[8];
#pragma unroll
        for (int j = 0; j < 4; ++j) { const f32x4 a = *(const f32x4*)(P.b_conv_w + j * 768 + c0), b = *(const f32x4*)(P.b_conv_w + j * 768 + c0 + 4);
            w[j][0] = a.x; w[j][1] = a.y; w[j][2] = a.z; w[j][3] = a.w; w[j][4] = b.x; w[j][5] = b.y; w[j][6] = b.z; w[j][7] = b.w; }
        { const f32x4 a = *(const f32x4*)(P.b_conv_b + c0), b = *(const f32x4*)(P.b_conv_b + c0 + 4); bsv[0] = a.x; bsv[1] = a.y; bsv[2] = a.z; bsv[3] = a.w; bsv[4] = b.x; bsv[5] = b.y; bsv[6] = b.z; bsv[7] = b.w; }
        float h[3][8];
#pragma unroll
        for (int j = 0; j < 3; ++j) {
            if (s0 - 3 + j >= 0) { const u32x4 q = *(const u32x4*)(G2 + (size_t)(row0 - 3 + j) * G2W + G2_U + c0);
                h[j][0] = bflo(q.x); h[j][1] = bfhi(q.x); h[j][2] = bflo(q.y); h[j][3] = bfhi(q.y); h[j][4] = bflo(q.z); h[j][5] = bfhi(q.z); h[j][6] = bflo(q.w); h[j][7] = bfhi(q.w); }
            else {
#pragma unroll
                for (int e = 0; e < 8; ++e) h[j][e] = 0.f; }
        }
#pragma unroll
        for (int r = 0; r < 8; ++r) {
            const u32x4 q = *(const u32x4*)(G2 + (size_t)(row0 + r) * G2W + G2_U + c0);
            float u[8] = {bflo(q.x), bfhi(q.x), bflo(q.y), bfhi(q.y), bflo(q.z), bfhi(q.z), bflo(q.w), bfhi(q.w)};
            float o[8];
#pragma unroll
            for (int e = 0; e < 8; ++e) { const float cv = bsv[e] + h[0][e] * w[0][e] + h[1][e] * w[1][e] + h[2][e] * w[2][e] + u[e] * w[3][e]; o[e] = silu_f(cv);
                h[0][e] = h[1][e]; h[1][e] = h[2][e]; h[2][e] = u[e]; }
            u32x4 ov; ov.x = cvt_pk_bf16(o[0], o[1]); ov.y = cvt_pk_bf16(o[2], o[3]); ov.z = cvt_pk_bf16(o[4], o[5]); ov.w = cvt_pk_bf16(o[6], o[7]);
            *(u32x4*)(UC + (size_t)(row0 + r) * 768 + c0) = ov;
        }
    }
}
namespace ml {
__device__ __forceinline__ int crow(int r, int hi) { return (r & 3) + 8 * (r >> 2) + 4 * hi; }
template <int NKS>
__device__ __forceinline__ f32x16 tile32(const LAS bf16_t* A, int lda, const LAS bf16_t* B, int ldb, int r32, int hi, f32x16 acc) {
    const LAS bf16_t* ap = A + r32 * lda + hi * 8; const LAS bf16_t* bp = B + r32 * ldb + hi * 8;
#pragma unroll
    for (int ks = 0; ks < NKS; ++ks) { const bf16x8 a = *(const LAS bf16x8*)(ap + ks * 16); const bf16x8 b = *(const LAS bf16x8*)(bp + ks * 16);
        acc = __builtin_amdgcn_mfma_f32_32x32x16_bf16(a, b, acc, 0, 0, 0); }
    return acc;
}
__device__ __forceinline__ float logsigmoid_f(float f) { return fminf(f, 0.f) - log1pf(__expf(-fabsf(f))); }
__device__ __forceinline__ float scan_add(float v, int lane) {
#pragma unroll
    for (int o = 1; o < 64; o <<= 1) { const float t = __shfl_up(v, o); if (lane >= o) v += t; }
    return v;
}
__device__ __forceinline__ float scan_max(float v, int lane) {
#pragma unroll
    for (int o = 1; o < 64; o <<= 1) { const float t = __shfl_up(v, o); if (lane >= o) v = fmaxf(v, t); }
    return v;
}
constexpr int P72 = 72, P104 = 104;
__device__ __forceinline__ int unit_of(const Wk& W, int k) { const int run = W.vcu + (k >> 3) * W.G; return run < 256 ? run * 8 + (k & 7) : -1; }
__device__ __forceinline__ float sum8(const u32x4 q) { return ((bflo(q.x) + bfhi(q.x)) + (bflo(q.y) + bfhi(q.y))) + ((bflo(q.z) + bfhi(q.z)) + (bflo(q.w) + bfhi(q.w))); }

__device__ __forceinline__ void pass1_phase(const Params& P, const Wk& W, LAS unsigned char* lds) {
    unsigned char* ws = P.ws;
    LAS bf16_t* vT = (LAS bf16_t*)lds;
    LAS bf16_t* kwT = (LAS bf16_t*)(lds + 27648);
    LAS float* wsl = (LAS float*)(lds + 41472);
    LAS bf16_t* Cs = (LAS bf16_t*)(lds + 41792);
    const float* ifp = (const float*)(ws + WS_IFP);
    const bf16_t* QK = (const bf16_t*)(ws + WS_QK); const bf16_t* VV = (const bf16_t*)(ws + WS_VV);
    const int tid = W.tid, lane = W.lane, wid = W.wave, r32 = lane & 31, hi = lane >> 5;
    int kq = 0; int u = unit_of(W, 0); if (u < 0) return;
    u32x4 q[5]; float pli = 0.f, pf = 0.f;
    f32x16 T0 = f32x16{}, T1 = f32x16{}, T2 = f32x16{}; float mt_run = -1e30f, bl_run = 0.f, tn_run = 0.f;
#define P1_LOAD(uu) do { const int bh_ = (uu) >> 6, c_ = (uu) & 63, b_ = bh_ >> 2, h_ = bh_ & 3, row0_ = b_ * SEQ + c_ * 64; \
        _Pragma("unroll") for (int i = 0; i < 5; ++i) { const int id = tid + 512 * i; \
            if (id < 768) q[i] = *(const u32x4*)((const char*)QK + (unsigned)((((bh_ * SEQ) + c_ * 64 + (id & 63)) * 192 + 96 + (id >> 6) * 8) * 2)); \
            else if (id < 2304) q[i] = *(const u32x4*)((const char*)VV + (unsigned)((((bh_ * SEQ) + c_ * 64 + (id & 63)) * 192 + ((id - 768) >> 6) * 8) * 2)); } \
        if (wid == 0) { pli = *(const float*)((const char*)ifp + (unsigned)(((row0_ + lane) * 8 + h_) * 4)); pf = *(const float*)((const char*)ifp + (unsigned)(((row0_ + lane) * 8 + 4 + h_) * 4)); } } while (0)
    P1_LOAD(u);
    for (;;) {
        const int un = unit_of(W, kq + 1);
        if (wid == 0) {
            const float bcs = scan_add(logsigmoid_f(pf), lane);
            const float bL = __shfl(bcs, 63);
            const float dec = bL - bcs + pli;
            const float mloc = wave_max(dec);
            wsl[lane] = __expf(dec - mloc);
            if (lane == 0) { ((float*)(ws + WS_BL))[u] = bL; ((float*)(ws + WS_MLOC))[u] = mloc; wsl[64] = bL; wsl[65] = mloc; }
        }
        __syncthreads();
        float a_run, w_run; { const float bL = wsl[64], ml = wsl[65]; const float mn = fmaxf(bL + mt_run, ml); a_run = __expf(bL + mt_run - mn); w_run = __expf(ml - mn); mt_run = mn; bl_run += bL; }
#pragma unroll
        for (int i = 0; i < 5; ++i) { const int id = tid + 512 * i, row = id & 63;
            if (id < 768) { const int cc = id >> 6; const float wv = wsl[row];
                const float e[8] = {bflo(q[i].x), bfhi(q[i].x), bflo(q[i].y), bfhi(q[i].y), bflo(q[i].z), bfhi(q[i].z), bflo(q[i].w), bfhi(q[i].w)};
#pragma unroll
                for (int j = 0; j < 8; ++j) kwT[(cc * 8 + j) * P72 + row] = f2bf(e[j] * wv);
            } else if (id < 2304) { const int cc = (id - 768) >> 6;
                const unsigned short e[8] = {(unsigned short)(q[i].x & 0xffff), (unsigned short)(q[i].x >> 16), (unsigned short)(q[i].y & 0xffff), (unsigned short)(q[i].y >> 16), (unsigned short)(q[i].z & 0xffff), (unsigned short)(q[i].z >> 16), (unsigned short)(q[i].w & 0xffff), (unsigned short)(q[i].w >> 16)};
#pragma unroll
                for (int j = 0; j < 8; ++j) vT[(cc * 8 + j) * P72 + row] = e[j]; }
        }
        __syncthreads();
        if (un >= 0) P1_LOAD(un);
        for (int tt = wid; tt < 18; tt += 8) {
            const int mt = tt / 3, nt = tt % 3;
            f32x16 acc = f32x16{};
            acc = tile32<4>(vT + mt * 32 * P72, P72, kwT + nt * 32 * P72, P72, r32, hi, acc);
            if (tt < 8) T0 = T0 * a_run + acc * w_run; else if (tt < 16) T1 = T1 * a_run + acc * w_run; else T2 = T2 * a_run + acc * w_run;
#pragma unroll
            for (int r = 0; r < 16; ++r) Cs[(mt * 32 + crow(r, hi)) * P104 + nt * 32 + r32] = f2bf(acc[r]);
        }
        if (tid < 384) { const int dk = tid >> 2, sub = tid & 3;
            float sd = sum8(*(const LAS u32x4*)(kwT + dk * P72 + sub * 8)) + sum8(*(const LAS u32x4*)(kwT + dk * P72 + (sub + 4) * 8));
            sd += __shfl_xor(sd, 1); sd += __shfl_xor(sd, 2);
            if (sub == 0) { ((float*)(ws + WS_DN))[(size_t)u * 96 + dk] = sd; tn_run = tn_run * a_run + sd * w_run; } }
        __syncthreads();
        { char* DCb = (char*)P.out + (size_t)u * (192 * 96 * 2);
#pragma unroll
          for (int i = 0; i < 5; ++i) { const int id = tid + 512 * i; if (id < 2304) { const int dv = id / 12, cc = id % 12; *(u32x4*)(DCb + (unsigned)(id * 16)) = *(const LAS u32x4*)(Cs + dv * P104 + cc * 8); } } }
        if ((kq & 7) == 7) {
            const int run = u >> 3;
            __syncthreads();
#pragma unroll
            for (int k3 = 0; k3 < 3; ++k3) { const int tt = wid + 8 * k3; if (tt < 18) { const int mt = tt / 3, nt = tt % 3; const f32x16 Tv = (k3 == 0) ? T0 : (k3 == 1) ? T1 : T2;
#pragma unroll
                for (int r = 0; r < 16; ++r) Cs[(mt * 32 + crow(r, hi)) * P104 + nt * 32 + r32] = f2bf(Tv[r]); } }
            if (tid < 384 && (tid & 3) == 0) ((float*)(ws + WS_RN))[run * 96 + (tid >> 2)] = tn_run;
            if (tid == 0) { ((float*)(ws + WS_RBL))[run] = bl_run; ((float*)(ws + WS_RBL))[256 + run] = mt_run; }
            __syncthreads();
            { char* RSb = (char*)(ws + WS_RS) + (size_t)run * (192 * 96 * 2);
#pragma unroll
              for (int i = 0; i < 5; ++i) { const int id = tid + 512 * i; if (id < 2304) { const int dv = id / 12, cc = id % 12; *(u32x4*)(RSb + (unsigned)(id * 16)) = *(const LAS u32x4*)(Cs + dv * P104 + cc * 8); } } }
            T0 = f32x16{}; T1 = f32x16{}; T2 = f32x16{}; mt_run = -1e30f; bl_run = 0.f; tn_run = 0.f;
        }
        if (un < 0) break;
        u = un; ++kq;
    }
#undef P1_LOAD
    __syncthreads();
}

__device__ __forceinline__ void pass2(const Params& P, const Wk& W) {
    unsigned char* ws = P.ws;
    const float* BL = (const float*)(ws + WS_RBL); const float* ML = BL + 256; float* MS = (float*)(ws + WS_RBL) + 512;
    const int gt = (W.wave * W.G + W.vcu) * 64 + W.lane, NGT = W.G * 512;
    constexpr int NCE = 32 * 2304, NNE = 32 * 96;
    for (int g = gt; g < NCE + NNE; g += NGT) {
        if (g < NCE) {
            const int bh = g / 2304, e = g % 2304;
            float C[8]; float m = 0.f; float z0 = 0.f; asm volatile("" : "+v"(z0));
#pragma unroll
            for (int j = 0; j < 8; ++j) C[j] = z0;
            u32x4* base = (u32x4*)((bf16_t*)(ws + WS_RS) + (size_t)bh * 8 * 18432 + e * 8);
            u32x4 d[8]; float bL[8], ml[8];
#pragma unroll
            for (int j = 0; j < 8; ++j) { d[j] = base[(size_t)j * (18432 / 8)]; bL[j] = BL[bh * 8 + j]; ml[j] = ML[bh * 8 + j]; }
#pragma unroll
            for (int j = 0; j < 8; ++j) {
                u32x4 o; o.x = cvt_pk_bf16(C[0], C[1]); o.y = cvt_pk_bf16(C[2], C[3]); o.z = cvt_pk_bf16(C[4], C[5]); o.w = cvt_pk_bf16(C[6], C[7]);
                base[(size_t)j * (18432 / 8)] = o;
                if (e == 0) MS[bh * 8 + j] = m;
                const float mn = fmaxf(bL[j] + m, ml[j]), a = __expf(bL[j] + m - mn), w = __expf(ml[j] - mn);
                C[0] = a * C[0] + w * bflo(d[j].x); C[1] = a * C[1] + w * bfhi(d[j].x); C[2] = a * C[2] + w * bflo(d[j].y); C[3] = a * C[3] + w * bfhi(d[j].y);
                C[4] = a * C[4] + w * bflo(d[j].z); C[5] = a * C[5] + w * bfhi(d[j].z); C[6] = a * C[6] + w * bflo(d[j].w); C[7] = a * C[7] + w * bfhi(d[j].w);
                m = mn;
            }
        } else {
            const int g2 = g - NCE, bh = g2 / 96, e = g2 % 96;
            float n = 0.f, m = 0.f; float* base = (float*)(ws + WS_RN) + (size_t)bh * 8 * 96 + e;
            float d[8], bL[8], ml[8];
#pragma unroll
            for (int j = 0; j < 8; ++j) { d[j] = base[j * 96]; bL[j] = BL[bh * 8 + j]; ml[j] = ML[bh * 8 + j]; }
#pragma unroll
            for (int j = 0; j < 8; ++j) { base[j * 96] = n; const float mn = fmaxf(bL[j] + m, ml[j]), a = __expf(bL[j] + m - mn), w = __expf(ml[j] - mn); n = a * n + w * d[j]; m = mn; }
        }
    }
}

__device__ __forceinline__ void pass3_phase(const Params& P, const Wk& W, LAS unsigned char* lds) {
    unsigned char* ws = P.ws;
    LAS bf16_t* Qs = (LAS bf16_t*)lds;
    LAS bf16_t* Ks = (LAS bf16_t*)(lds + 13312);
    LAS bf16_t* vT = (LAS bf16_t*)(lds + 26624);
    LAS bf16_t* CT = (LAS bf16_t*)(lds + 54272);
    LAS bf16_t* Ps = (LAS bf16_t*)(lds + 94208);
    LAS float* Hs = (LAS float*)lds;
    LAS float* sm = (LAS float*)(lds + 103424);
    LAS float* g_s = sm, *Mt = sm + 64, *wint = sm + 128, *eneg = sm + 192, *qn = sm + 256, *rden = sm + 320, *nvec = sm + 384;
    const float* ifp = (const float*)(ws + WS_IFP);
    const bf16_t* QK = (const bf16_t*)(ws + WS_QK); const bf16_t* VV = (const bf16_t*)(ws + WS_VV);
    const int tid = W.tid, lane = W.lane, wid = W.wave, r32 = lane & 31, hi = lane >> 5;
    int kq = 0; int u = unit_of(W, 0); if (u < 0) return;
    u32x4 qa[3], qb[3], qc[5]; float pli = 0.f, pf = 0.f, pn = 0.f, pc0 = 0.f, pbl = 0.f, pml = 0.f;
    u32x4 Cr[5]; float n_reg = 0.f, m_cur = 0.f;
#define P3_LOAD(uu) do { const int bh_ = (uu) >> 6, c_ = (uu) & 63, b_ = bh_ >> 2, h_ = bh_ & 3, row0_ = b_ * SEQ + c_ * 64; \
        const char* CS_ = (const char*)P.out + (size_t)(uu) * (192 * 96 * 2); \
        _Pragma("unroll") for (int i = 0; i < 3; ++i) { const int id = tid + 512 * i; \
            { const int which = id / 768, i2 = id % 768, row = i2 / 12, cc = i2 % 12; qa[i] = *(const u32x4*)((const char*)QK + (unsigned)((((bh_ * SEQ) + c_ * 64 + row) * 192 + which * 96 + cc * 8) * 2)); } \
            { const int cc = id >> 6, row = id & 63; qb[i] = *(const u32x4*)((const char*)VV + (unsigned)((((bh_ * SEQ) + c_ * 64 + row) * 192 + cc * 8) * 2)); } } \
        _Pragma("unroll") for (int i = 0; i < 5; ++i) { const int id = tid + 512 * i; if (id < 2304) qc[i] = *(const u32x4*)(CS_ + (unsigned)(id * 16)); } \
        pbl = ((const float*)(ws + WS_BL))[uu]; pml = ((const float*)(ws + WS_MLOC))[uu]; \
        if (wid == 0) { pc0 = ((const float*)(ws + WS_C0))[bh_]; pli = *(const float*)((const char*)ifp + (unsigned)(((row0_ + lane) * 8 + h_) * 4)); pf = *(const float*)((const char*)ifp + (unsigned)(((row0_ + lane) * 8 + 4 + h_) * 4)); } \
        if (tid < 96) pn = *(const float*)((const char*)(ws + WS_DN) + (unsigned)(((uu) * 96 + tid) * 4)); } while (0)
    P3_LOAD(u);
    for (;;) {
        const int bh = u >> 6, c = u & 63, b = bh >> 2, h = bh & 3, row0 = b * SEQ + c * 64;
        const int un = unit_of(W, kq + 1);
        const float c0cur = pc0;
        int tid_l = W.tid; asm volatile("" : "+v"(tid_l));
        const int tid = tid_l, lane = tid & 63, r32 = lane & 31, hi = lane >> 5;
        if ((kq & 7) == 0) {
            const int run = u >> 3; const char* RSb = (const char*)(ws + WS_RS) + (size_t)run * (192 * 96 * 2);
#pragma unroll
            for (int i = 0; i < 5; ++i) { const int id = tid + 512 * i; if (id < 2304) Cr[i] = *(const u32x4*)(RSb + (unsigned)(id * 16)); }
            if (tid < 96) n_reg = ((const float*)(ws + WS_RN))[run * 96 + tid];
            m_cur = ((const float*)(ws + WS_RBL))[512 + run];
        }
        if (wid == 0) {
            const float bcs = scan_add(logsigmoid_f(pf), lane);
            const float g = pli - bcs;
            const float pmx = scan_max(g, lane);
            const float M = fmaxf(m_cur, pmx);
            g_s[lane] = g; Mt[lane] = M; wint[lane] = __expf(m_cur - M); eneg[lane] = __expf(-bcs - M);
        }
#pragma unroll
        for (int i = 0; i < 3; ++i) { const int id = tid + 512 * i;
            { const int which = id / 768, i2 = id % 768, row = i2 / 12, cc = i2 % 12; *(LAS u32x4*)((which ? Ks : Qs) + row * P104 + cc * 8) = qa[i]; }
            { const int cc = id >> 6, row = id & 63;
              const unsigned short e[8] = {(unsigned short)(qb[i].x & 0xffff), (unsigned short)(qb[i].x >> 16), (unsigned short)(qb[i].y & 0xffff), (unsigned short)(qb[i].y >> 16), (unsigned short)(qb[i].z & 0xffff), (unsigned short)(qb[i].z >> 16), (unsigned short)(qb[i].w & 0xffff), (unsigned short)(qb[i].w >> 16)};
#pragma unroll
              for (int j = 0; j < 8; ++j) vT[(cc * 8 + j) * P72 + row] = e[j]; } }
        {
            const float mn = fmaxf(pbl + m_cur, pml), a_ = __expf(pbl + m_cur - mn), w_ = __expf(pml - mn);
#pragma unroll
            for (int i = 0; i < 5; ++i) { const int id = tid + 512 * i; if (id < 2304) { const int dv = id / 12, cc = id % 12;
                const u32x4 cq = Cr[i], d = qc[i];
                *(LAS u32x4*)(CT + dv * P104 + cc * 8) = cq;
                u32x4 o;
                o.x = cvt_pk_bf16(a_ * bflo(cq.x) + w_ * bflo(d.x), a_ * bfhi(cq.x) + w_ * bfhi(d.x)); o.y = cvt_pk_bf16(a_ * bflo(cq.y) + w_ * bflo(d.y), a_ * bfhi(cq.y) + w_ * bfhi(d.y));
                o.z = cvt_pk_bf16(a_ * bflo(cq.z) + w_ * bflo(d.z), a_ * bfhi(cq.z) + w_ * bfhi(d.z)); o.w = cvt_pk_bf16(a_ * bflo(cq.w) + w_ * bflo(d.w), a_ * bfhi(cq.w) + w_ * bfhi(d.w));
                Cr[i] = o; } }
            if (tid < 96) { nvec[tid] = n_reg; n_reg = a_ * n_reg + w_ * pn; }
            m_cur = mn;
        }
        __syncthreads();
        if (un >= 0) P3_LOAD(un);
        __builtin_amdgcn_sched_barrier(0);
        if (wid < 4) {
            const int mt = wid >> 1, nt = wid & 1;
            f32x16 acc = f32x16{};
            acc = tile32<6>(Qs + mt * 32 * P104, P104, Ks + nt * 32 * P104, P104, r32, hi, acc);
#ifndef NO_FIRST_TOKEN
            if (c == 0 && wid == 0 && lane == 0) acc[0] = c0cur;
#endif
            const int s = nt * 32 + r32; const float gs = g_s[s];
#pragma unroll
            for (int r = 0; r < 16; ++r) { const int t = mt * 32 + crow(r, hi);
                const float w = (s <= t) ? __expf(gs - Mt[t]) : 0.f;
                Ps[t * P72 + s] = f2bf(acc[r] * w); }
        } else {
            const int t = (tid - 256) >> 2, sub = tid & 3; float a = 0.f;
#pragma unroll
            for (int j = 0; j < 3; ++j) { const int cc = sub + 4 * j; const u32x4 q = *(const LAS u32x4*)(Qs + t * P104 + cc * 8); const LAS float* nv = nvec + cc * 8;
                a += (bflo(q.x) * nv[0] + bfhi(q.x) * nv[1]) + (bflo(q.y) * nv[2] + bfhi(q.y) * nv[3]) + (bflo(q.z) * nv[4] + bfhi(q.z) * nv[5]) + (bflo(q.w) * nv[6] + bfhi(q.w) * nv[7]); }
            a += __shfl_xor(a, 1); a += __shfl_xor(a, 2);
            if (sub == 0) qn[t] = a;
        }
        __syncthreads();
        { const int t = tid >> 3, sub = tid & 7;
          float rs = sum8(*(const LAS u32x4*)(Ps + t * P72 + sub * 8));
          rs += __shfl_xor(rs, 1); rs += __shfl_xor(rs, 2); rs += __shfl_xor(rs, 4);
          if (sub == 0) { float den = wint[t] * qn[t] + rs; den = fmaxf(fabsf(den), eneg[t]); rden[t] = __builtin_amdgcn_rcpf(den); } }
        const int te = tid >> 3, sube = tid & 7;
        const bf16_t* G2 = (const bf16_t*)(ws + WS_G) + (size_t)(row0 + te) * G2W; const bf16_t* UC = (const bf16_t*)(ws + WS_UC) + (size_t)(row0 + te) * 768;
        u32x4 eop[3], egq[3], euq[3];
#pragma unroll
        for (int j = 0; j < 3; ++j) { const int col = h * 192 + (sube + 8 * j) * 8; eop[j] = *(const u32x4*)(G2 + G2_O + col); egq[j] = *(const u32x4*)(G2 + G2_GATE + col); euq[j] = *(const u32x4*)(UC + col); }
        f32x16 accA = f32x16{}, accB = f32x16{};
        {
            const int tt = (wid < 4) ? (8 + wid) : (wid - 4), mt = tt / 6, nt = tt % 6;
            accA = tile32<6>(Qs + mt * 32 * P104, P104, CT + nt * 32 * P104, P104, r32, hi, accA);
#pragma unroll
            for (int r = 0; r < 16; ++r) accA[r] *= wint[mt * 32 + crow(r, hi)];
            accA = tile32<4>(Ps + mt * 32 * P72, P72, vT + nt * 32 * P72, P72, r32, hi, accA);
        }
        if (wid >= 4) {
            const int tt = wid, mt = tt / 6, nt = tt % 6;
            accB = tile32<6>(Qs + mt * 32 * P104, P104, CT + nt * 32 * P104, P104, r32, hi, accB);
#pragma unroll
            for (int r = 0; r < 16; ++r) accB[r] *= wint[mt * 32 + crow(r, hi)];
            accB = tile32<4>(Ps + mt * 32 * P72, P72, vT + nt * 32 * P72, P72, r32, hi, accB);
        }
        __syncthreads();
        {
            const int tt = (wid < 4) ? (8 + wid) : (wid - 4), mt = tt / 6, nt = tt % 6;
#pragma unroll
            for (int r = 0; r < 16; ++r) { const int t = mt * 32 + crow(r, hi); Hs[t * 196 + nt * 32 + r32] = accA[r] * rden[t]; }
        }
        if (wid >= 4) {
            const int tt = wid, mt = tt / 6, nt = tt % 6;
#pragma unroll
            for (int r = 0; r < 16; ++r) { const int t = mt * 32 + crow(r, hi); Hs[t * 196 + nt * 32 + r32] = accB[r] * rden[t]; }
        }
        __syncthreads();
        __builtin_amdgcn_sched_barrier(0);
        {
            float hv[3][8]; float ss = 0.f;
#pragma unroll
            for (int j = 0; j < 3; ++j) { const int col = (sube + 8 * j) * 8;
                const f32x4 a = *(const LAS f32x4*)(Hs + te * 196 + col), bq = *(const LAS f32x4*)(Hs + te * 196 + col + 4);
                hv[j][0] = a.x; hv[j][1] = a.y; hv[j][2] = a.z; hv[j][3] = a.w; hv[j][4] = bq.x; hv[j][5] = bq.y; hv[j][6] = bq.z; hv[j][7] = bq.w;
#pragma unroll
                for (int e = 0; e < 8; ++e) ss += hv[j][e] * hv[j][e]; }
            ss += __shfl_xor(ss, 1); ss += __shfl_xor(ss, 2); ss += __shfl_xor(ss, 4);
            const float rstd = rsqrtf(ss * (1.f / 192.f) + EPS);
            bf16_t* Y = (bf16_t*)(ws + WS_Y2) + (size_t)(row0 + te) * DM;
#pragma unroll
            for (int j = 0; j < 3; ++j) { const int col = h * 192 + (sube + 8 * j) * 8;
                const u32x4 op = eop[j], gq = egq[j], uq = euq[j];
                const float ov[8] = {bflo(op.x), bfhi(op.x), bflo(op.y), bfhi(op.y), bflo(op.z), bfhi(op.z), bflo(op.w), bfhi(op.w)};
                const float gv[8] = {bflo(gq.x), bfhi(gq.x), bflo(gq.y), bfhi(gq.y), bflo(gq.z), bfhi(gq.z), bflo(gq.w), bfhi(gq.w)};
                const float uv[8] = {bflo(uq.x), bfhi(uq.x), bflo(uq.y), bfhi(uq.y), bflo(uq.z), bfhi(uq.z), bflo(uq.w), bfhi(uq.w)};
                float o[8];
#pragma unroll
                for (int e = 0; e < 8; ++e) { const float hn = hv[j][e] * rstd * P.b_head_g[col + e]; const float mix = sigmoid_f(ov[e]) * hn + P.b_skip[col + e] * uv[e]; o[e] = mix * silu_f(gv[e]); }
                u32x4 w; w.x = cvt_pk_bf16(o[0], o[1]); w.y = cvt_pk_bf16(o[2], o[3]); w.z = cvt_pk_bf16(o[4], o[5]); w.w = cvt_pk_bf16(o[6], o[7]);
                *(u32x4*)(Y + col) = w; }
        }
        __syncthreads();
        if (un < 0) break;
        u = un; ++kq;
    }
#undef P3_LOAD
}
}
typedef GAS unsigned gu32;
#define XB_TMO      128
#define XB_XCNT(j)  (256  + 64 * (j))
#define XB_XSUB(j)  (1280 + 64 * (j))
#define XB_XGEN(j)  (2304 + 64 * (j))
#define XB_TOP      3328
#define XB_TOPGEN   3392
#define XCD_BAR_WORDS 3456
#define XB_SPIN_CAP (1u << 18)
__device__ __forceinline__ unsigned xb_ld(unsigned* p)              { return __hip_atomic_load(p, __ATOMIC_RELAXED, __HIP_MEMORY_SCOPE_AGENT); }
__device__ __forceinline__ unsigned xb_add(unsigned* p, unsigned v) { return __hip_atomic_fetch_add(p, v, __ATOMIC_RELAXED, __HIP_MEMORY_SCOPE_AGENT); }
__device__ __forceinline__ unsigned xb_xcc_id() { return (unsigned)__builtin_amdgcn_s_getreg((3 << 11) | 20) & 0xFu; }
#define XB_SPIN(cond, bar) do { unsigned _sp = 0; while (cond) { __builtin_amdgcn_s_sleep(1); \
    if ((++_sp & 255u) == 0u) { if (xb_ld(&(bar)[XB_TMO])) break; if (_sp > XB_SPIN_CAP) { atomicAdd(&(bar)[XB_TMO], 1u); break; } } } } while (0)
struct XcdBarrier { unsigned* bar; unsigned x; volatile LAS unsigned* st; };
__device__ __forceinline__ XcdBarrier xcd_barrier_post(unsigned* bar, volatile LAS unsigned* st) {
    XcdBarrier b; b.bar = bar; b.x = xb_xcc_id(); b.st = st;
    if (threadIdx.x == 0) (void)xb_add(&bar[XB_XCNT(b.x)], 1u);
    return b;
}
__device__ __forceinline__ void xcd_barrier_complete(unsigned* bar, unsigned x, unsigned& nloc, unsigned& nx) {
    const unsigned G = gridDim.x * gridDim.y * gridDim.z;
    unsigned sum, cnt, mine, sp = 0u;
    for (;;) {
        sum = 0u; cnt = 0u; mine = 0u;
#pragma unroll
        for (unsigned j = 0; j < 16; ++j) { const unsigned c = xb_ld(&bar[XB_XCNT(j)]); sum += c; cnt += (c > 0u) ? 1u : 0u; mine = (j == x) ? c : mine; }
        if (sum == G) break;
        __builtin_amdgcn_s_sleep(1);
        if ((++sp & 255u) == 0u) { if (xb_ld(&bar[XB_TMO])) break; if (sp > XB_SPIN_CAP) { atomicAdd(&bar[XB_TMO], 1u); break; } }
    }
    nloc = mine > 0u ? mine : 1u; nx = cnt > 0u ? cnt : 1u;
}
__device__ __forceinline__ void xcd_barrier(const XcdBarrier& b) {
    asm volatile("s_waitcnt vmcnt(0)" ::: "memory");
    __syncthreads();
    if (threadIdx.x == 0) {
        unsigned* bar = b.bar;
        __builtin_amdgcn_s_waitcnt(0);
        unsigned nloc = b.st[0], nx = b.st[1];
        if (nloc == 0u) { xcd_barrier_complete(bar, b.x, nloc, nx); b.st[0] = nloc; b.st[1] = nx; }
        const unsigned old = xb_add(&bar[XB_XSUB(b.x)], 1u);
        const unsigned gen = old / nloc;
        if (old + 1u == (gen + 1u) * nloc) {
            __builtin_amdgcn_fence(__ATOMIC_RELEASE, "agent");
            asm volatile("s_waitcnt vmcnt(0)" ::: "memory");
            const unsigned og = xb_add(&bar[XB_TOP], 1u);
            const unsigned tg = og / nx;
            if (og + 1u == (tg + 1u) * nx) xb_add(&bar[XB_TOPGEN], 1u);
            else XB_SPIN(xb_ld(&bar[XB_TOPGEN]) == tg, bar);
            __builtin_amdgcn_fence(__ATOMIC_ACQUIRE, "agent");
            xb_add(&bar[XB_XGEN(b.x)], 1u);
            asm volatile("s_waitcnt vmcnt(0)" ::: "memory");
        } else {
            XB_SPIN(xb_ld(&bar[XB_XGEN(b.x)]) == gen, bar);
            __builtin_amdgcn_fence(__ATOMIC_ACQUIRE, "agent");
            asm volatile("s_waitcnt vmcnt(0)" ::: "memory");
        }
    }
    __syncthreads();
}

constexpr int RING_BYTES = 131072, LDSCTL_OFF = RING_BYTES, LDS_BYTES = 147456;
constexpr int CW_BAR = 4096;
constexpr int CW_XCNT = 16384;
constexpr int CW_XTMO = 8192;
#ifdef FUSED_FINAL
constexpr int N_PHASES = 13;
#else
constexpr int N_PHASES = 14;
#endif

__device__ __forceinline__ void setup_job(const Params& P, int j, pg8::Gemm& g, pg8::Epi& E) {
    unsigned char* ws = P.ws;
    E.out = nullptr; E.ldc = 0; E.ncols = 1 << 30; E.out2 = nullptr; E.ldc2 = 0; E.split = 1 << 30; E.rs = nullptr; E.rs_mode = 0; E.rs_invdim = 0.f;
    E.ssqA = nullptr; E.ssqB = nullptr; E.ssq_mode = 0; E.rope = (const float2*)(ws + WS_ROPE); E.rope_mode = 0; E.hm_mode = 0;
    E.after = 0; E.fbase = nullptr; E.fout = nullptr; E.fgain = nullptr; E.xslots = (unsigned*)(ws + WS_XSL); E.xcnt = (unsigned*)(ws + WS_CTL) + CW_XCNT; E.xtmo = (unsigned*)(ws + WS_CTL) + CW_XTMO;
    g.M = T; g.lda = 1024; g.apn = 0;
    switch (j) {
    case 0: g.A = (const bf16_t*)(ws + WS_XB); g.Bt = (const bf16_t*)(ws + WS_WINA); g.N = 2048; g.K = 1024;
        E.out = (bf16_t*)(ws + WS_G); E.ldc = G1W; E.rs = (const float*)(ws + WS_RSTD); E.rs_mode = 1; E.ssqA = (float*)(ws + WS_SSQA); E.ssqB = (float*)(ws + WS_SSQB); E.ssq_mode = 1; E.rope_mode = 1; break;
    case 1: g.A = (const bf16_t*)(ws + WS_MEMN); g.Bt = (const bf16_t*)(ws + WS_WMKV); g.M = NB * NMEM; g.N = 1024; g.K = 1024;
        E.out = (bf16_t*)(ws + WS_KVM); E.ldc = 1024; break;
    case 2: g.A = (const bf16_t*)(ws + WS_G) + G1_CQ; g.lda = G1W; g.Bt = (const bf16_t*)(ws + WS_WUQ); g.N = 1280; g.K = 384;
        E.out = (bf16_t*)(ws + WS_Q); E.ldc = QW; E.ncols = QW; E.rs = (const float*)(ws + WS_SSQA); E.rs_mode = 2; E.rs_invdim = 1.f / 384.f; E.rope_mode = 2; break;
    case 3: g.A = (const bf16_t*)(ws + WS_G) + G1_CKV; g.lda = G1W; g.Bt = (const bf16_t*)(ws + WS_WUKV); g.N = 1536; g.K = 256;
        E.out = (bf16_t*)(ws + WS_KN); E.ldc = 768; E.out2 = (bf16_t*)(ws + WS_V); E.ldc2 = 768; E.split = 768; E.rs = (const float*)(ws + WS_SSQB); E.rs_mode = 2; E.rs_invdim = 1.f / 256.f; break;
    case 4: g.A = (const bf16_t*)(ws + WS_Y); g.Bt = (const bf16_t*)(ws + WS_WOA); g.N = 1024; g.K = 1024; E.out = (bf16_t*)(ws + WS_Z); E.ldc = 1024; break;
    case 5: g.A = (const bf16_t*)(ws + WS_XB); g.Bt = (const bf16_t*)(ws + WS_WINB); g.N = G2W; g.K = 1024;
        E.out = (bf16_t*)(ws + WS_G); E.ldc = G2W; E.rs = (const float*)(ws + WS_RSTD); E.rs_mode = 1; break;
    case 6: g.A = (const bf16_t*)(ws + WS_UC); g.lda = 768; g.apn = 192; g.Bt = (const bf16_t*)(ws + WS_WQK); g.N = 768; g.K = 384; E.out = (bf16_t*)(ws + WS_QK); E.ldc = 768; E.hm_mode = 1; break;
    case 7: g.A = (const bf16_t*)(ws + WS_G) + G2_U; g.lda = G2W; g.apn = 192; g.Bt = (const bf16_t*)(ws + WS_WV); g.N = 768; g.K = 384; E.out = (bf16_t*)(ws + WS_VV); E.ldc = 768; E.hm_mode = 1; break;
    default: g.A = (const bf16_t*)(ws + WS_Y2); g.Bt = (const bf16_t*)(ws + WS_WOB); g.N = 1024; g.K = 1024;
#ifdef FUSED_FINAL
        E.after = 1; E.fbase = P.out; E.fout = P.out; E.fgain = P.b_post_g; E.xcnt = (unsigned*)(ws + WS_CTL) + CW_XCNT + (j - 8) * 128 * 64;
#else
        E.out = (bf16_t*)(ws + WS_Z); E.ldc = 1024;
#endif
        break;
    }
}

__device__ __forceinline__ void phase_memattn(const Params& P, const Wk& W, LAS unsigned char* lds, int L) {
    unsigned char* ws = P.ws;
    const bf16_t* G = (const bf16_t*)(ws + WS_G); const bf16_t* KVM = (const bf16_t*)(ws + WS_KVM);
    const int gpitch = L ? G2W : G1W, qm_off = L ? G2_QM : G1_QM, gate_off = L ? G2_GATE : G1_GATE;
    bf16_t* Yb = (bf16_t*)(ws + (L ? WS_Y2 : WS_Y));
    for (int u = W.vcu; u < 512; u += W.G) {
        const int rb = u >> 2, hm = u & 3, row0 = rb * 256, b = row0 / SEQ;
        const bf16_t* Km = KVM + (size_t)(b * NMEM) * 1024 + L * 512 + hm * 64;
        att::attn_unit<64, 64, false>(G + (size_t)row0 * gpitch + qm_off + hm * 64, gpitch, Km, 1024, 8, Km, 1024, Km + 256, 1024, 4, 0,
                                      G + (size_t)row0 * gpitch + gate_off + 768 + hm * 64, gpitch, Yb + (size_t)row0 * DM + 768 + hm * 64, DM, lds, W.tid);
    }
}
template <int ABL>
__device__ __forceinline__ void phase_attn(const Params& P, const Wk& W, LAS unsigned char* lds) {
    unsigned char* ws = P.ws;
    const bf16_t* G = (const bf16_t*)(ws + WS_G); const bf16_t* Qp = (const bf16_t*)(ws + WS_Q); const bf16_t* KN = (const bf16_t*)(ws + WS_KN); const bf16_t* Vp = (const bf16_t*)(ws + WS_V);
    bf16_t* Yb = (bf16_t*)(ws + (ABL ? WS_Z : WS_Y));
    for (int u = W.vcu; u < 768; u += W.G) {
        const int k = u >> 8, cu = u & 255, grp = cu >> 4, i = cu & 15, bh = grp * 3 + k;
        const int qb = (k == 0) ? i : (k == 1) ? ((i + 8) & 15) : (i < 8 ? 15 - 2 * i : 30 - 2 * i);
        const int b = bh / 6, h = bh % 6; const size_t rowb = (size_t)b * SEQ, row0 = rowb + (size_t)qb * 256;
        int tid_u = W.tid; asm volatile("" : "+v"(tid_u));
        att::attn_unit<192, 128, true, ABL>(Qp + row0 * QW + h * 192, QW, KN + rowb * 768 + h * 128, 768, 16, G + rowb * G1W + G1_KR, G1W, Vp + rowb * 768 + h * 128, 768,
                                       4 * (qb + 1), qb * 256, G + row0 * G1W + G1_GATE + h * 128, G1W, Yb + row0 * DM + h * 128, DM, lds, tid_u);
    }
}

__global__ void __launch_bounds__(512, 2) mega_fwd(Params P) {
    extern __shared__ __attribute__((aligned(16))) unsigned char lds_raw[];
    LAS unsigned char* lds = (LAS unsigned char*)lds_raw;
    Wk W; W.tid = threadIdx.x; W.lane = W.tid & 63; W.wave = __builtin_amdgcn_readfirstlane(W.tid >> 6);
    W.G = gridDim.x; { const int bx = blockIdx.x; W.vcu = (W.G % 8 == 0) ? (bx % 8) * (W.G / 8) + bx / 8 : bx; }
    volatile LAS unsigned* MISC = (volatile LAS unsigned*)(lds + LDSCTL_OFF);
    if (W.tid < 64) MISC[W.tid] = 0u;
    __syncthreads();
    const int lo = P.ph_lo, hi = P.ph_hi;
    const int vcu_s = W.vcu;
    const int wave_s = __builtin_amdgcn_readfirstlane(threadIdx.x >> 6);
    XcdBarrier bar; bar.bar = (unsigned*)(P.ws + WS_CTL) + CW_BAR; bar.x = 0; bar.st = nullptr;
    if (hi - lo > 1) bar = xcd_barrier_post((unsigned*)(P.ws + WS_CTL) + CW_BAR, MISC + 8);
#ifndef PROBE_REP
#define PROBE_REP 0
#endif
#ifdef PROBE_PAIR
    bool pair_done = false;
#endif
    for (int ph2 = 2 * lo; ph2 < 2 * hi; ++ph2) {
        const int ph = ph2 >> 1;
        if ((ph2 & 1) && !((PROBE_REP >> ph) & 1)) continue;
        const bool more_ = (ph + 1 < hi) || (!(ph2 & 1) && ((PROBE_REP >> ph) & 1));
        { int t_; asm volatile("v_mbcnt_lo_u32_b32 %0, -1, 0\n\tv_mbcnt_hi_u32_b32 %0, -1, %0" : "=v"(t_)); t_ += wave_s * 64; { int g_ = gridDim.x, v_ = vcu_s; asm volatile("" : "+s"(g_), "+s"(v_)); W.G = g_; W.vcu = v_; } W.tid = t_; W.lane = t_ & 63; W.wave = __builtin_amdgcn_readfirstlane(t_ >> 6); }
        int j0 = 0, j1 = 0;
#ifdef DBG_CUT
        if (ph == 100) { const bf16_t* src = (const bf16_t*)(P.ws + (size_t)DBG_OFF); const int gt_ = W.vcu * 512 + W.tid, NGT_ = W.G * 512; for (int i = gt_; i < T * DM; i += NGT_) {
#ifdef DBG_F32N
            P.out[i] = (i < DBG_F32N) ? ((const float*)src)[i] : 0.f;
#else
            P.out[i] = bf2f(src[i]);
#endif
            } continue; }
#endif
#ifndef PHM
#define PHM 0xffff
#endif
#define PHON(k) ((PHM >> (k)) & 1)
        switch (ph) {
        case 0: if (PHON(0)) phase_prologue(P, W, lds); break;
        case 1: j0 = 0; j1 = 1; break;
        case 2: j0 = 1; j1 = 4; break;
        case 3: if (PHON(3)) {
#ifdef PROBE_ABL
            if (ph2 & 1) phase_attn<PROBE_ABL>(P, W, lds); else
#endif
            phase_attn<0>(P, W, lds); } break;
        case 4: j0 = 4; j1 = 5; break;
        case 5: if (PHON(5)) phase_rowmid(P, W, lds); break;
        case 6: j0 = 5; j1 = 6; break;
        case 7: if (PHON(7)) phase_conv(P, W); break;
        case 8: j0 = 6; j1 = 8; break;
        case 9: if (PHON(9)) ml::pass1_phase(P, W, lds); break;
        case 10: if (PHON(10)) { ml::pass2(P, W);
#ifndef NO_FIRST_TOKEN
            first_token_qk(P, W, lds);
#endif
            } break;
        case 11: if (PHON(11)) ml::pass3_phase(P, W, lds); break;
#ifdef FUSED_FINAL
        case 12: j0 = 8; j1 = 10; break;
        default: break;
#else
        case 12: j0 = 8; j1 = 9; break;
        default: if (PHON(13)) phase_rowfinal(P, W); break;
#endif
        }
        if (PHON(14) && (ph == 3 || ph == 9) && !(ph2 & 1)) phase_memattn(P, W, lds, ph == 9 ? 1 : 0);
        if (PHON(1)) for (int j = j0; j < j1; ++j) {
            pg8::Gemm g; pg8::Epi E; setup_job(P, j, g, E);
            const int shift = (j == 1) ? 128 : (j == 7) ? 128 : 0;
            pg8::StaticOrder S; S.init(g.M, g.N, W.G, (int)((blockIdx.x + shift) % W.G));
#ifdef FUSED_FINAL
            if (j >= 8) { S.i0 = j - 8; S.nmax = 1; }
#endif
            if (j == 2 && W.G == 256) S.give_lo = 128;
            pg8::gemm_phase<true>(lds, g, S, E, W.tid);
        }
#ifndef NO_FIRST_TOKEN
        if (ph == 6) { const int half = W.G / 2, nwk = W.G - half;
            if ((int)blockIdx.x >= half) for (int widx = (int)blockIdx.x - half; widx < 128; widx += nwk) first_token_u0(P, W, lds, widx); }
#endif
        if (more_) xcd_barrier(bar);
#ifdef PROBE_PAIR
        if (ph == PROBE_PAIR + 1 && !pair_done) { pair_done = true; ph2 = 2 * PROBE_PAIR - 1; }
#endif
    }
}

extern "C" void kernel_launch(void* const* d_in, const int* in_sizes, int n_in, void* d_out, int out_size, void* d_ws, size_t ws_size, hipStream_t stream) {
    static int grid = 0;
    if (grid == 0) {
        if (n_in != 27 || in_sizes[0] != T * DM || out_size != T * DM || ws_size < WS_END) {
            fprintf(stderr, "kernel_launch: unexpected shapes (n_in %d in0 %d out %d ws %zu)\n", n_in, n_in > 0 ? in_sizes[0] : -1, out_size, ws_size); grid = -1; return; }
        int dev = 0, cus = 0, per_cu = 0;
        if (hipGetDevice(&dev) != hipSuccess || hipDeviceGetAttribute(&cus, hipDeviceAttributeMultiprocessorCount, dev) != hipSuccess) { grid = -1; return; }
        if (hipFuncSetAttribute((const void*)mega_fwd, hipFuncAttributeMaxDynamicSharedMemorySize, LDS_BYTES) != hipSuccess) { fprintf(stderr, "kernel_launch: hipFuncSetAttribute failed\n"); grid = -1; return; }
        if (hipOccupancyMaxActiveBlocksPerMultiprocessor(&per_cu, (const void*)mega_fwd, 512, LDS_BYTES) != hipSuccess || per_cu < 1) { fprintf(stderr, "kernel_launch: occupancy query says %d\n", per_cu); }
        (void)hipGetLastError();
        grid = cus;
    }
    if (grid < 0) return;
    (void)hipMemsetAsync((char*)d_ws + WS_CTL, 0, CTL_ZERO_BYTES, stream);
    Params p{};
    const float** fp = (const float**)&p.a_pre_g;
    p.x = (const float*)d_in[0]; p.mem = (const float*)d_in[1]; p.pos = (const int*)d_in[2];
    for (int i = 0; i < 24; ++i) fp[i] = (const float*)d_in[3 + i];
    p.out = (float*)d_out; p.ws = (unsigned char*)d_ws;
#ifndef N_LAUNCH_SPLIT
#define N_LAUNCH_SPLIT 0
#endif
#ifdef DBG_CUT
    for (int ph = 0; ph < DBG_CUT; ++ph) { p.ph_lo = ph; p.ph_hi = ph + 1; hipLaunchKernelGGL(mega_fwd, dim3(grid), dim3(512), LDS_BYTES, stream, p); }
    p.ph_lo = 100; p.ph_hi = 101; hipLaunchKernelGGL(mega_fwd, dim3(grid), dim3(512), LDS_BYTES, stream, p);
#elif N_LAUNCH_SPLIT
    for (int ph = 0; ph < N_PHASES; ++ph) { p.ph_lo = ph; p.ph_hi = ph + 1; hipLaunchKernelGGL(mega_fwd, dim3(grid), dim3(512), LDS_BYTES, stream, p); }
#else
    p.ph_lo = 0; p.ph_hi = N_PHASES; hipLaunchKernelGGL(mega_fwd, dim3(grid), dim3(512), LDS_BYTES, stream, p);
#endif
}
```
